# Optimizing an MI355X kernel written in HIP

```python
import math
import jax, jax.numpy as jnp
from jax import lax
import numpy as np

D_MODEL = 1024
BATCH = 32
SEQ = 2048
DEPTH = 4

GRID_W = 64
ROPE_THETA = 500000.0
Q_BLOCK = 128

A_HEADS = 4
A_HEAD_DIM = 64
A_ROT = A_HEAD_DIM // 4
A_Q = A_HEADS * 2 * A_HEAD_DIM
A_K = A_HEADS * 2 * A_HEAD_DIM
A_V = A_HEADS * 2 * A_HEAD_DIM

B_HEADS = 8
B_NOPE = 64
B_ROPE = 32
B_V = 64
B_Q_RANK = 256
B_KV_RANK = 128

C_HEADS = 16
C_HEAD_DIM = 64
C_WIDTH = C_HEADS * C_HEAD_DIM
NA_ROWS = 8
NA_COLS = 16

N_GROUPS = 4
EXPERTS_PER_GROUP = 8
N_EXPERTS = N_GROUPS * EXPERTS_PER_GROUP
TOP_K = 2
D_EXPERT = 512
MOE_BLOCK = 128

DN_ALPHA = (2 * DEPTH) ** 0.25
DN_BETA = (8 * DEPTH) ** -0.25
LN_EPS = 1e-5
RMS_EPS = 1e-6

EVEN_IN = A_Q + A_K + A_V + B_Q_RANK + B_KV_RANK + B_ROPE
EVEN_SPLITS = (A_Q, A_Q + A_K, A_Q + A_K + A_V, A_Q + A_K + A_V + B_Q_RANK,
               A_Q + A_K + A_V + B_Q_RANK + B_KV_RANK)
EVEN_OUT = A_HEADS * 2 * A_HEAD_DIM + B_HEADS * B_V
N_EVEN = (DEPTH + 1) // 2
N_ODD = DEPTH // 2

kernel_name = "hybrid_diffattn_mla_natten_hmoe_encoder"


def layer_norm(x, g, b):
    xf = x.astype(jnp.float32)
    mu = jnp.mean(xf, axis=-1, keepdims=True)
    var = jnp.mean(jnp.square(xf - mu), axis=-1, keepdims=True)
    y = (xf - mu) * lax.rsqrt(var + LN_EPS) * g.astype(jnp.float32) + b.astype(jnp.float32)
    return y.astype(x.dtype)


def rms_norm(x, g):
    xf = x.astype(jnp.float32)
    y = xf * lax.rsqrt(jnp.mean(xf * xf, axis=-1, keepdims=True) + RMS_EPS) * g.astype(jnp.float32)
    return y.astype(x.dtype)


def rope_tables(seq, rot_dim):
    inv_freq = ROPE_THETA ** (-jnp.arange(0, rot_dim, 2, dtype=jnp.float32) / rot_dim)
    ang = jnp.arange(seq, dtype=jnp.float32)[:, None] * inv_freq[None, :]
    return jnp.cos(ang), jnp.sin(ang)


def apply_rope(x, cos, sin):
    half = cos.shape[-1]
    r = 2 * half
    cos = cos.astype(x.dtype)
    sin = sin.astype(x.dtype)
    x1 = x[..., :half]
    x2 = x[..., half:r]
    return jnp.concatenate([x1 * cos - x2 * sin, x2 * cos + x1 * sin, x[..., r:]], axis=-1)


def diff_attention(q, k, v, lam, subln_g, lambda_init, cos, sin):
    B, S, H, _, d = q.shape
    nb = S // Q_BLOCK
    q = apply_rope(q.transpose(0, 2, 3, 1, 4), cos, sin)
    k = apply_rope(k.transpose(0, 2, 3, 1, 4), cos, sin)
    v = v.transpose(0, 2, 1, 3)
    q_blocks = q.reshape(B, H, 2, nb, Q_BLOCK, d).transpose(3, 0, 1, 2, 4, 5)
    scale = d ** -0.5

    def block(qb):
        s = jnp.einsum('bhmqd,bhmkd->bhmqk', qb, k).astype(jnp.float32) * scale
        p = jax.nn.softmax(s, axis=-1)
        w = p[:, :, 0] - lam * p[:, :, 1]
        return jnp.einsum('bhqk,bhke->bhqe', w.astype(v.dtype), v)

    o = lax.map(block, q_blocks)
    o = rms_norm(o, subln_g) * (1.0 - lambda_init)
    return o.transpose(1, 0, 3, 2, 4).reshape(B, S, H * 2 * d)


def latent_attention(c_q, c_kv, k_r, q_norm_g, w_uq, kv_norm_g, w_ukv, cos, sin):
    B, S, _ = c_q.shape
    H = B_HEADS
    nb = S // Q_BLOCK
    q = (rms_norm(c_q, q_norm_g) @ w_uq).reshape(B, S, H, B_NOPE + B_ROPE).transpose(0, 2, 1, 3)
    q_nope = q[..., :B_NOPE]
    q_rope = apply_rope(q[..., B_NOPE:], cos, sin)
    kv = (rms_norm(c_kv, kv_norm_g) @ w_ukv).reshape(B, S, H, B_NOPE + B_V).transpose(0, 2, 1, 3)
    k_nope = kv[..., :B_NOPE]
    v = kv[..., B_NOPE:]
    k_rope = apply_rope(k_r, cos, sin)
    qn_blocks = q_nope.reshape(B, H, nb, Q_BLOCK, B_NOPE).transpose(2, 0, 1, 3, 4)
    qr_blocks = q_rope.reshape(B, H, nb, Q_BLOCK, B_ROPE).transpose(2, 0, 1, 3, 4)
    scale = (B_NOPE + B_ROPE) ** -0.5

    def block(args):
        qn, qr = args
        s = (jnp.einsum('bhqd,bhkd->bhqk', qn, k_nope)
             + jnp.einsum('bhqr,bkr->bhqk', qr, k_rope)).astype(jnp.float32) * scale
        p = jax.nn.softmax(s, axis=-1)
        return jnp.einsum('bhqk,bhke->bhqe', p.astype(v.dtype), v)

    o = lax.map(block, (qn_blocks, qr_blocks))
    return o.transpose(1, 0, 3, 2, 4).reshape(B, S, H * B_V)


def neighbourhood_attention(q, k, v, rel_bias):
    B, S, H, d = q.shape
    rows = S // GRID_W
    kh = min(NA_ROWS, rows)
    kw = NA_COLS
    to_grid = lambda t: t.reshape(B, rows, GRID_W, H, d).transpose(0, 3, 1, 2, 4)
    qg, kg, vg = to_grid(q), to_grid(k), to_grid(v)
    cols = jnp.arange(GRID_W)
    col_start = jnp.clip(cols - kw // 2, 0, GRID_W - kw)
    col_idx = col_start[:, None] + jnp.arange(kw)[None, :]
    col_off = col_idx - cols[:, None] + (NA_COLS - 1)
    scale = d ** -0.5

    def row(args):
        r, q_row = args
        r0 = jnp.clip(r - kh // 2, 0, rows - kh)
        k_band = lax.dynamic_slice_in_dim(kg, r0, kh, axis=2)
        v_band = lax.dynamic_slice_in_dim(vg, r0, kh, axis=2)
        k_win = k_band[:, :, :, col_idx]
        v_win = v_band[:, :, :, col_idx]
        row_off = r0 + jnp.arange(kh) - r + (NA_ROWS - 1)
        bias = rel_bias[:, row_off[:, None, None], col_off[None]]
        bias = bias.transpose(0, 2, 1, 3).astype(jnp.float32)
        s = jnp.einsum('bhcd,bhicjd->bhcij', q_row, k_win).astype(jnp.float32) * scale + bias[None]
        p = jax.nn.softmax(s.reshape(B, H, GRID_W, kh * kw), axis=-1).reshape(B, H, GRID_W, kh, kw)
        return jnp.einsum('bhcij,bhicje->bhce', p.astype(v_win.dtype), v_win)

    o = lax.map(row, (jnp.arange(rows), qg.transpose(2, 0, 1, 3, 4)))
    return o.transpose(1, 0, 3, 2, 4).reshape(B, S, H * d)


def even_mixer(x, w_in, lam_q1, lam_k1, lam_q2, lam_k2, subln_g, q_norm_g, w_uq,
               kv_norm_g, w_ukv, w_o, lambda_init, rope_a, rope_b):
    B, S, _ = x.shape
    h = x @ w_in
    qa, ka, va, cq, ckv, kr = jnp.split(h, EVEN_SPLITS, axis=-1)
    f32 = jnp.float32
    lam = (jnp.exp(jnp.sum(lam_q1.astype(f32) * lam_k1.astype(f32)))
           - jnp.exp(jnp.sum(lam_q2.astype(f32) * lam_k2.astype(f32))) + lambda_init)
    a_out = diff_attention(qa.reshape(B, S, A_HEADS, 2, A_HEAD_DIM),
                           ka.reshape(B, S, A_HEADS, 2, A_HEAD_DIM),
                           va.reshape(B, S, A_HEADS, 2 * A_HEAD_DIM),
                           lam, subln_g, lambda_init, rope_a[0], rope_a[1])
    b_out = latent_attention(cq, ckv, kr, q_norm_g, w_uq, kv_norm_g, w_ukv, rope_b[0], rope_b[1])
    return jnp.concatenate([a_out, b_out], axis=-1) @ w_o


def odd_mixer(x, w_qkv, rel_bias, w_o):
    B, S, _ = x.shape
    q, k, v = jnp.split(x @ w_qkv, 3, axis=-1)
    shp = (B, S, C_HEADS, C_HEAD_DIM)
    o = neighbourhood_attention(q.reshape(shp), k.reshape(shp), v.reshape(shp), rel_bias)
    return o @ w_o


def hier_moe(x, w_rg, b_rg, w_re, b_re, w1, w3, w2):
    B, S, D = x.shape
    N = B * S
    xt = x.reshape(N, D)
    g_prob = jax.nn.softmax((xt @ w_rg).astype(jnp.float32) + b_rg.astype(jnp.float32), axis=-1)
    grp = jnp.argmax(g_prob, axis=-1).astype(jnp.int32)
    g_w = jnp.take_along_axis(g_prob, grp[:, None], axis=-1)
    e_logits = ((xt @ w_re).astype(jnp.float32) + b_re.astype(jnp.float32)).reshape(N, N_GROUPS, EXPERTS_PER_GROUP)
    idx = jnp.broadcast_to(grp[:, None, None], (N, 1, EXPERTS_PER_GROUP))
    e_logits = jnp.take_along_axis(e_logits, idx, axis=1)[:, 0]
    top_v, top_i = lax.top_k(e_logits, TOP_K)
    gate = jax.nn.softmax(top_v, axis=-1) * g_w
    expert = grp[:, None] * EXPERTS_PER_GROUP + top_i.astype(jnp.int32)
    A = N * TOP_K
    e_flat = expert.reshape(A)
    w_flat = gate.reshape(A)
    tok = jnp.repeat(jnp.arange(N, dtype=jnp.int32), TOP_K)
    order = jnp.argsort(e_flat)
    e_s, tok_s, w_s = e_flat[order], tok[order], w_flat[order]
    counts = jnp.bincount(e_flat, length=N_EXPERTS)
    start = jnp.cumsum(counts) - counts
    padded = (counts + MOE_BLOCK - 1) // MOE_BLOCK * MOE_BLOCK
    pad_end = jnp.cumsum(padded)
    pad_start = pad_end - padded
    dest = pad_start[e_s] + jnp.arange(A) - start[e_s]
    n_blocks = -(-A // MOE_BLOCK) + N_EXPERTS
    P = n_blocks * MOE_BLOCK
    slot_tok = jnp.full((P,), N, jnp.int32).at[dest].set(tok_s)
    slot_w = jnp.zeros((P,), jnp.float32).at[dest].set(w_s)
    block_exp = jnp.minimum(jnp.searchsorted(pad_end, jnp.arange(n_blocks) * MOE_BLOCK, side='right'),
                            N_EXPERTS - 1).astype(jnp.int32)
    x_pad = jnp.concatenate([xt, jnp.zeros((1, D), xt.dtype)], axis=0)

    def block(args):
        tids, e, w = args
        xb = x_pad[tids]
        hdn = jax.nn.silu(xb @ w1[e]) * (xb @ w3[e])
        return (hdn @ w2[e]) * w[:, None].astype(xb.dtype)

    y = lax.map(block, (slot_tok.reshape(n_blocks, MOE_BLOCK), block_exp,
                        slot_w.reshape(n_blocks, MOE_BLOCK)))
    out = jax.ops.segment_sum(y.reshape(P, D), slot_tok, num_segments=N + 1)[:N]
    return out.reshape(B, S, D)


def setup_inputs(seed: int = 0) -> dict:
    key = jax.random.key(seed)
    ks = iter(jax.random.split(key, 32))
    nrm = lambda shape, scale: jax.random.normal(next(ks), shape, jnp.float32) * scale
    gain = lambda shape: 1.0 + nrm(shape, 0.02)
    D = D_MODEL
    return {
        "x": nrm((BATCH, SEQ, D), 1.0),
        "even_w_in": nrm((N_EVEN, D, EVEN_IN), D ** -0.5),
        "even_lam_q1": nrm((N_EVEN, A_HEAD_DIM), 0.1),
        "even_lam_k1": nrm((N_EVEN, A_HEAD_DIM), 0.1),
        "even_lam_q2": nrm((N_EVEN, A_HEAD_DIM), 0.1),
        "even_lam_k2": nrm((N_EVEN, A_HEAD_DIM), 0.1),
        "even_subln_g": gain((N_EVEN, 2 * A_HEAD_DIM)),
        "even_q_norm_g": gain((N_EVEN, B_Q_RANK)),
        "even_w_uq": nrm((N_EVEN, B_Q_RANK, B_HEADS * (B_NOPE + B_ROPE)), B_Q_RANK ** -0.5),
        "even_kv_norm_g": gain((N_EVEN, B_KV_RANK)),
        "even_w_ukv": nrm((N_EVEN, B_KV_RANK, B_HEADS * (B_NOPE + B_V)), B_KV_RANK ** -0.5),
        "even_w_o": nrm((N_EVEN, EVEN_OUT, D), EVEN_OUT ** -0.5 * DN_BETA),
        "odd_w_qkv": nrm((N_ODD, D, 3 * C_WIDTH), D ** -0.5),
        "odd_rel_bias": nrm((N_ODD, C_HEADS, 2 * NA_ROWS - 1, 2 * NA_COLS - 1), 0.02),
        "odd_w_o": nrm((N_ODD, C_WIDTH, D), C_WIDTH ** -0.5 * DN_BETA),
        "ln1_g": gain((DEPTH, D)),
        "ln1_b": nrm((DEPTH, D), 0.02),
        "ln2_g": gain((DEPTH, D)),
        "ln2_b": nrm((DEPTH, D), 0.02),
        "w_router_group": nrm((DEPTH, D, N_GROUPS), D ** -0.5),
        "b_router_group": nrm((DEPTH, N_GROUPS), 0.01),
        "w_router_expert": nrm((DEPTH, D, N_EXPERTS), D ** -0.5),
        "b_router_expert": nrm((DEPTH, N_EXPERTS), 0.01),
        "w_gate": nrm((DEPTH, N_EXPERTS, D, D_EXPERT), D ** -0.5),
        "w_up": nrm((DEPTH, N_EXPERTS, D, D_EXPERT), D ** -0.5),
        "w_down": nrm((DEPTH, N_EXPERTS, D_EXPERT, D), D_EXPERT ** -0.5 * DN_BETA),
    }


def reference(x, even_w_in, even_lam_q1, even_lam_k1, even_lam_q2, even_lam_k2, even_subln_g,
              even_q_norm_g, even_w_uq, even_kv_norm_g, even_w_ukv, even_w_o,
              odd_w_qkv, odd_rel_bias, odd_w_o, ln1_g, ln1_b, ln2_g, ln2_b,
              w_router_group, b_router_group, w_router_expert, b_router_expert,
              w_gate, w_up, w_down):
    S = x.shape[1]
    rope_a = rope_tables(S, A_ROT)
    rope_b = rope_tables(S, B_ROPE)
    for i in range(DEPTH):
        j = i // 2
        if i % 2 == 0:
            lambda_init = 0.8 - 0.6 * math.exp(-0.3 * i)
            m = even_mixer(x, even_w_in[j], even_lam_q1[j], even_lam_k1[j], even_lam_q2[j],
                           even_lam_k2[j], even_subln_g[j], even_q_norm_g[j], even_w_uq[j],
                           even_kv_norm_g[j], even_w_ukv[j], even_w_o[j], lambda_init, rope_a, rope_b)
        else:
            m = odd_mixer(x, odd_w_qkv[j], odd_rel_bias[j], odd_w_o[j])
        x = layer_norm(DN_ALPHA * x + m, ln1_g[i], ln1_b[i])
        f = hier_moe(x, w_router_group[i], b_router_group[i], w_router_expert[i], b_router_expert[i],
                     w_gate[i], w_up[i], w_down[i])
        x = layer_norm(DN_ALPHA * x + f, ln2_g[i], ln2_b[i])
    return x
```

```cpp
#include <hip/hip_runtime.h>
#include <cstdio>
#include <cstdint>

#ifndef MK_ONE_LAUNCH
#define MK_ONE_LAUNCH 1
#endif

typedef unsigned short bf16_t;
typedef short bf16x8 __attribute__((ext_vector_type(8)));
typedef float f32x4 __attribute__((ext_vector_type(4)));
typedef float f32x2 __attribute__((ext_vector_type(2)));
typedef unsigned u32x4 __attribute__((ext_vector_type(4)));
typedef unsigned u32x2 __attribute__((ext_vector_type(2)));
#define LAS __attribute__((address_space(3)))

constexpr int NTOK = 65536, DM = 1024, SEQ = 2048, NBATCH = 32, DEPTH = 4;
constexpr int EVEN_IN = 1952, HLD = 2048;
constexpr int NEXP = 32, DEXP = 512;
constexpr int MAXTILES = NTOK * 2 / 256 + NEXP;
constexpr int MAXSLOTS = MAXTILES * 256;
constexpr float DN_ALPHA = 1.681792830507429f;
constexpr float LN_EPS = 1e-5f, RMS_EPS = 1e-6f;
constexpr int NTHREADS = 512;

constexpr size_t MiB = 1024ull * 1024ull;
constexpr size_t WS_CTL = 0;
constexpr size_t WS_ROPEA = 64 * 1024;
constexpr size_t WS_ROPEB = WS_ROPEA + 128 * 1024;
constexpr size_t WS_WR = WS_ROPEB + 256 * 1024;
constexpr size_t WS_ROUTE = WS_WR + 640 * 1024;
constexpr size_t WS_CNT = WS_ROUTE + 1 * MiB;
constexpr size_t WS_TILE = WS_CNT + 32 * 1024;
constexpr size_t WS_SLOT_TOK = WS_TILE + 4 * 1024;
constexpr size_t WS_SLOT_G = WS_SLOT_TOK + 576 * 1024;
constexpr size_t WS_SLOT_DST = WS_SLOT_G + 576 * 1024;
constexpr size_t WS_SSQ = WS_SLOT_DST + 576 * 1024;
constexpr size_t WS_WIN = 6 * MiB;
constexpr size_t WS_WUQ = WS_WIN + 8 * MiB;
constexpr size_t WS_WUKV = WS_WUQ + 1 * MiB;
constexpr size_t WS_WOE = WS_WUKV + 1 * MiB;
constexpr size_t WS_WQKV = WS_WOE + 4 * MiB;
constexpr size_t WS_WOO = WS_WQKV + 12 * MiB;
constexpr size_t WS_W13 = 36 * MiB;
constexpr size_t WS_W2 = WS_W13 + 64 * MiB;
constexpr size_t WS_X = WS_W2 + 32 * MiB;
constexpr size_t WS_R1 = WS_X + 128 * MiB;
constexpr size_t WS_R2 = WS_R1 + 384 * MiB;
constexpr size_t WS_R3 = WS_R2 + 228 * MiB;
constexpr size_t WS_END = WS_R3 + 128 * MiB;
static_assert(WS_SSQ + 2 * MiB <= WS_WIN, "misc region");
static_assert(WS_WOO + 4 * MiB <= WS_W13, "small weights region");

__device__ __forceinline__ unsigned cvt_pk_bf16(float lo, float hi) { unsigned r; asm volatile("v_cvt_pk_bf16_f32 %0, %1, %2" : "=v"(r) : "v"(lo), "v"(hi)); return r; }
__device__ __forceinline__ float bf_lo(unsigned w) { return __uint_as_float(w << 16); }
__device__ __forceinline__ float bf_hi(unsigned w) { return __uint_as_float(w & 0xffff0000u); }
__device__ __forceinline__ float bf2f(bf16_t b) { return __uint_as_float(((unsigned)b) << 16); }
__device__ __forceinline__ void unpack8(const u32x4 w, float (&f)[8]) {
    f[0] = bf_lo(w.x); f[1] = bf_hi(w.x); f[2] = bf_lo(w.y); f[3] = bf_hi(w.y); f[4] = bf_lo(w.z); f[5] = bf_hi(w.z); f[6] = bf_lo(w.w); f[7] = bf_hi(w.w); }
__device__ __forceinline__ u32x4 pack8(const float (&f)[8]) { u32x4 w; w.x = cvt_pk_bf16(f[0], f[1]); w.y = cvt_pk_bf16(f[2], f[3]); w.z = cvt_pk_bf16(f[4], f[5]); w.w = cvt_pk_bf16(f[6], f[7]); return w; }
__device__ __forceinline__ float wave_sum(float v) {
#pragma unroll
    for (int o = 32; o >= 1; o >>= 1) v += __shfl_xor(v, o);
    return v; }

struct Frame { LAS unsigned char* lds; int tid, lane, wave, G, bid; };
#define XB_TMO      128
#define XB_XCNT(j)  (256  + 64 * (j))
#define XB_XSUB(j)  (1280 + 64 * (j))
#define XB_XGEN(j)  (2304 + 64 * (j))
#define XB_TOP      3328
#define XB_TOPGEN   3392
#define XCD_BAR_WORDS 3456
#define XB_SPIN_CAP (1u << 21)
__device__ __forceinline__ unsigned xb_ld(unsigned* p)              { return __hip_atomic_load(p, __ATOMIC_RELAXED, __HIP_MEMORY_SCOPE_AGENT); }
__device__ __forceinline__ unsigned xb_add(unsigned* p, unsigned v) { return __hip_atomic_fetch_add(p, v, __ATOMIC_RELAXED, __HIP_MEMORY_SCOPE_AGENT); }
__device__ __forceinline__ unsigned xb_xcc_id() { return (unsigned)__builtin_amdgcn_s_getreg((3 << 11) | 20) & 0xFu; }
#define XB_SPIN(cond, bar) do { unsigned _sp = 0; while (cond) { __builtin_amdgcn_s_sleep(1); \
    if ((++_sp & 255u) == 0u) { if (xb_ld(&(bar)[XB_TMO])) break; if (_sp > XB_SPIN_CAP) { atomicAdd(&(bar)[XB_TMO], 1u); break; } } } } while (0)
struct XcdBarrier { unsigned* bar; unsigned x; volatile LAS unsigned* st; };
__device__ __forceinline__ XcdBarrier xcd_barrier_post(unsigned* bar, volatile LAS unsigned* st, int tid) {
    XcdBarrier b; b.bar = bar; b.x = xb_xcc_id(); b.st = st;
    if (tid == 0) (void)xb_add(&bar[XB_XCNT(b.x)], 1u);
    return b;
}
__device__ __forceinline__ void xcd_barrier_complete(unsigned* bar, unsigned x, unsigned& nloc, unsigned& nx) {
    const unsigned G = gridDim.x * gridDim.y * gridDim.z;
    unsigned sum, cnt, mine, sp = 0u;
    for (;;) {
        sum = 0u; cnt = 0u; mine = 0u;
#pragma unroll
        for (unsigned j = 0; j < 16; ++j) { const unsigned c = xb_ld(&bar[XB_XCNT(j)]); sum += c; cnt += (c > 0u) ? 1u : 0u; mine = (j == x) ? c : mine; }
        if (sum == G) break;
        __builtin_amdgcn_s_sleep(1);
        if ((++sp & 255u) == 0u) { if (xb_ld(&bar[XB_TMO])) break; if (sp > XB_SPIN_CAP) { atomicAdd(&bar[XB_TMO], 1u); break; } }
    }
    nloc = mine > 0u ? mine : 1u; nx = cnt > 0u ? cnt : 1u;
}
__device__ __forceinline__ void xcd_barrier(const XcdBarrier& b, int tid) {
    asm volatile("s_waitcnt vmcnt(0)" ::: "memory");
    __syncthreads();
    if (tid == 0) {
        unsigned* bar = b.bar; unsigned bx = b.x; asm volatile("" : "+s"(bx));
        __builtin_amdgcn_s_waitcnt(0);
        unsigned nloc = b.st[0], nx = b.st[1];
        if (nloc == 0u) { xcd_barrier_complete(bar, bx, nloc, nx); b.st[0] = nloc; b.st[1] = nx; }
        const unsigned old = xb_add(&bar[XB_XSUB(bx)], 1u);
        const unsigned gen = old / nloc;
        if (old + 1u == (gen + 1u) * nloc) {
            __builtin_amdgcn_fence(__ATOMIC_RELEASE, "agent");
            asm volatile("s_waitcnt vmcnt(0)" ::: "memory");
            const unsigned og = xb_add(&bar[XB_TOP], 1u);
            const unsigned tg = og / nx;
            if (og + 1u == (tg + 1u) * nx) xb_add(&bar[XB_TOPGEN], 1u);
            else XB_SPIN(xb_ld(&bar[XB_TOPGEN]) == tg, bar);
            __builtin_amdgcn_fence(__ATOMIC_ACQUIRE, "agent");
            xb_add(&bar[XB_XGEN(bx)], 1u);
            asm volatile("s_waitcnt vmcnt(0)" ::: "memory");
        } else {
            XB_SPIN(xb_ld(&bar[XB_XGEN(bx)]) == gen, bar);
            __builtin_amdgcn_fence(__ATOMIC_ACQUIRE, "agent");
            asm volatile("s_waitcnt vmcnt(0)" ::: "memory");
        }
    }
    __syncthreads();
}

namespace g8 {
constexpr int BM = 256, BK = 64, HALF = 128, HTB = HALF * BK * 2, STAGE_BYTES = 8 * HTB, NXCD = 8, WGM = 8;
__device__ __forceinline__ int lds_byte(int r, int c) { const int st = (r >> 4) * 2 + (c >> 5), rr = r & 15, cc = c & 31, ob = rr * 64 + cc * 2; return st * 1024 + (ob ^ (((ob >> 9) & 1) << 5)); }
__device__ __forceinline__ void stage_rc(int b, int& R, int& C) { const int st = b / 1024, sb = b % 1024, swz = sb ^ (((sb >> 9) & 1) << 5); R = (st >> 1) * 16 + swz / 64; C = (st & 1) * 32 + (swz % 64) / 2; }
__device__ __forceinline__ int perm32(int rho) { const int n = rho >> 4, i = rho & 15; return 8 * (i >> 2) + 4 * n + (i & 3); }

struct Unit { const char* A; const char* B; int row0, pm, pn, e; };
typedef f32x4 Acc[2][2][4][2];

struct DenseSched {
    const char* A; const char* Bt; unsigned lda2; int K2; int nM, nN, nwg, G, c;
    __device__ __forceinline__ void init(const void* A_, int lda, const void* Bt_, int K, int M, int N, int G_, int c_) { A = (const char*)A_; Bt = (const char*)Bt_; lda2 = (unsigned)lda * 2u; K2 = K * 2; nM = M / BM; nN = N / BM; nwg = nM * nN; G = G_; c = c_; }
    __device__ __forceinline__ bool next(int i, Unit& u) const {
        const long L = (long)i * G + c; if (L >= nwg) return false;
        int wgid = (int)L; { const int q = nwg / NXCD, r = nwg % NXCD, xcd = wgid % NXCD, off = wgid / NXCD; wgid = (xcd < r ? xcd * (q + 1) : r * (q + 1) + (xcd - r) * q) + off; }
        const int nig = WGM * nN, gid = wgid / nig, fm = gid * WGM, gsz = (nM - fm) < WGM ? (nM - fm) : WGM;
        u.pm = fm + ((wgid % nig) % gsz); u.pn = (wgid % nig) / gsz; u.row0 = u.pm * BM; u.e = 0;
        u.A = A + (size_t)u.row0 * lda2; u.B = Bt + (size_t)u.pn * BM * K2; return true;
    }
    static constexpr bool GATHER = false;
    __device__ __forceinline__ unsigned rowoff(const Unit&, int r) const { return (unsigned)r * lda2; }
};
template <bool GATHER_> struct MoeSched {
    const char* A; const char* Wt; const int* tile; const int* slot_tok; unsigned lda2; int K2; size_t wstride; int T, G, c;
    __device__ __forceinline__ bool next(int i, Unit& u) const {
        const int L = i * G + c; if (L >= T * 4) return false;
        const int t = L >> 2; u.pn = L & 3; u.pm = t; u.row0 = t * BM; u.e = tile[1 + t];
        u.A = GATHER_ ? A : A + (size_t)u.row0 * lda2; u.B = Wt + (size_t)u.e * wstride + (size_t)u.pn * BM * K2; return true;
    }
    static constexpr bool GATHER = GATHER_;
    __device__ __forceinline__ unsigned rowoff(const Unit& u, int r) const { return GATHER_ ? (unsigned)slot_tok[u.row0 + r] * lda2 : (unsigned)r * lda2; }
};

template <class Epi, class Sched>
__device__ __forceinline__ void gemm_phase(const Frame& F, const int K_, const Sched& S, const Epi& E) {
    LAS unsigned char* lds = F.lds;
    int K = K_; asm volatile("" : "+s"(K));
    const int tid = F.tid, wid = __builtin_amdgcn_readfirstlane(tid >> 6), lane = tid & 63, wr = wid >> 2, wc = wid & 3, fr = lane & 15, fq = lane >> 4;
    const int nt = K / BK;
    int RA[2]; unsigned CA[2], voffB[2];
#pragma unroll
    for (int i = 0; i < 2; ++i) { int R, C; stage_rc(tid * 16 + i * 8192, R, C); const int Rb = (R & ~31) + perm32(R & 31);
        RA[i] = R; CA[i] = (unsigned)C * 2u; voffB[i] = (unsigned)(Rb * K + C) * 2u; }
    const size_t kstep = (size_t)(BK * 2);
    const size_t hstepB = (size_t)HALF * K * 2;
    size_t hstepA = 0; if constexpr (!Sched::GATHER) hstepA = (size_t)S.rowoff(Unit{}, HALF);
    const unsigned ldsw = (unsigned)wid * 1024u;
    const int aoff = lds_byte(wr * 64 + fr, fq * 8), boff = lds_byte(wc * 32 + fr, fq * 8);
#define G8_SA(b, h) (((b) * 2 + (h)) * HTB)
#define G8_SB(b, h) ((4 + (b) * 2 + (h)) * HTB)
#define G8_STAGE(bufoff, gbase, voff) do { _Pragma("unroll") for (int _i = 0; _i < 2; ++_i) \
        __builtin_amdgcn_global_load_lds((const unsigned*)((const char*)(gbase) + (voff)[_i]), (LAS unsigned*)(lds + (bufoff) + ldsw + _i * 8192), 16, 0, 0); } while (0)
#define G8_STA(bufoff, gbase, h, V0, V1) do { if constexpr (Sched::GATHER) { if (h) G8_STAGE(bufoff, gbase, V1); else G8_STAGE(bufoff, gbase, V0); } else { G8_STAGE(bufoff, (gbase) + (h) * hstepA, vA0); } } while (0)
#define G8_LDA(dst, b, h) do { _Pragma("unroll") for (int m = 0; m < 4; ++m) _Pragma("unroll") for (int k = 0; k < 2; ++k) dst[m][k] = *(const LAS bf16x8*)(lds + G8_SA(b, h) + aoff + m * 2048 + k * 1024); } while (0)
#define G8_LDB(dst, b, h) do { _Pragma("unroll") for (int n = 0; n < 2; ++n) _Pragma("unroll") for (int k = 0; k < 2; ++k) dst[n][k] = *(const LAS bf16x8*)(lds + G8_SB(b, h) + boff + n * 2048 + k * 1024); } while (0)
#define G8_MMA(ai, bj, At, Bt) do { __builtin_amdgcn_s_setprio(1); _Pragma("unroll") for (int m = 0; m < 4; ++m) _Pragma("unroll") for (int n = 0; n < 2; ++n) _Pragma("unroll") for (int k = 0; k < 2; ++k) \
        acc[ai][bj][m][n] = __builtin_amdgcn_mfma_f32_16x16x32_bf16(Bt[n][k], At[m][k], acc[ai][bj][m][n], 0, 0, 0); __builtin_amdgcn_s_setprio(0); } while (0)
#define G8_WAIT_V(n) asm volatile("s_waitcnt vmcnt(" #n ")" ::: "memory")
#define G8_WAIT_L(n) asm volatile("s_waitcnt lgkmcnt(" #n ")" ::: "memory")
#define G8_BAR __builtin_amdgcn_s_barrier()
#define G8_SCHED __builtin_amdgcn_sched_barrier(0)
    Unit cur, nxt; int ui = 0;
    if (!S.next(0, cur)) return;
    Acc acc;
#pragma unroll
    for (int a = 0; a < 2; ++a)
#pragma unroll
        for (int b = 0; b < 2; ++b)
#pragma unroll
            for (int m = 0; m < 4; ++m)
#pragma unroll
                for (int n = 0; n < 2; ++n) acc[a][b][m][n] = (f32x4){0.f, 0.f, 0.f, 0.f};
    bf16x8 At[4][2], B0[2][2], B1[2][2];
    unsigned vA0[2], vA1[2], nA0[2], nA1[2];
#pragma unroll
    for (int i = 0; i < 2; ++i) { vA0[i] = S.rowoff(cur, RA[i]) + CA[i]; vA1[i] = S.rowoff(cur, HALF + RA[i]) + CA[i]; }
    const char* cA = cur.A; const char* cB = cur.B;
    G8_STAGE(G8_SB(0, 0), cB, voffB); G8_STA(G8_SA(0, 0), cA, 0, vA0, vA1); G8_STAGE(G8_SB(0, 1), cB + hstepB, voffB); G8_STA(G8_SA(0, 1), cA, 1, vA0, vA1);
    if (wr == 1) G8_BAR;
    G8_WAIT_V(4); G8_BAR;
    G8_STAGE(G8_SB(1, 0), cB + kstep, voffB); G8_STA(G8_SA(1, 0), cA + kstep, 0, vA0, vA1); G8_STAGE(G8_SB(1, 1), cB + hstepB + kstep, voffB);
    G8_WAIT_V(6); G8_BAR;
    for (;;) {
        const bool has_next = S.next(ui + 1, nxt);
        const char* nAp = has_next ? nxt.A : cA; const char* nBp = has_next ? nxt.B : cB;
#pragma unroll
        for (int i = 0; i < 2; ++i) { nA0[i] = has_next ? S.rowoff(nxt, RA[i]) + CA[i] : vA0[i]; nA1[i] = has_next ? S.rowoff(nxt, HALF + RA[i]) + CA[i] : vA1[i]; }
        for (int t = 0; t < nt; t += 2) {
            const bool last = (t == nt - 2);
            const char* a1 = cA + (size_t)(t + 1) * kstep;
            const char* a2 = last ? nAp : cA + (size_t)(t + 2) * kstep; const char* b2 = last ? nBp : cB + (size_t)(t + 2) * kstep;
            const char* a3 = a2 + kstep; const char* b3 = b2 + kstep;
            unsigned w0[2], w1[2];
#pragma unroll
            for (int i = 0; i < 2; ++i) { w0[i] = last ? nA0[i] : vA0[i]; w1[i] = last ? nA1[i] : vA1[i]; }
            G8_LDB(B0, 0, 0); G8_SCHED; G8_LDA(At, 0, 0); G8_STA(G8_SA(1, 1), a1, 1, vA0, vA1);
            G8_WAIT_L(8); G8_BAR; G8_WAIT_L(0); G8_MMA(0, 0, At, B0); G8_BAR; G8_SCHED;
            G8_LDB(B1, 0, 1); G8_STAGE(G8_SB(0, 0), b2, voffB);
            G8_BAR; G8_WAIT_L(0); G8_MMA(0, 1, At, B1); G8_BAR;
            G8_LDA(At, 0, 1); G8_STA(G8_SA(0, 0), a2, 0, w0, w1);
            G8_BAR; G8_WAIT_L(0); G8_MMA(1, 0, At, B0); G8_BAR; G8_SCHED;
            G8_STAGE(G8_SB(0, 1), b2 + hstepB, voffB);
            G8_WAIT_V(6); G8_BAR; G8_MMA(1, 1, At, B1); G8_BAR;
            G8_LDB(B0, 1, 0); G8_SCHED; G8_LDA(At, 1, 0); G8_STA(G8_SA(0, 1), a2, 1, w0, w1);
            G8_WAIT_L(8); G8_BAR; G8_WAIT_L(0); G8_MMA(0, 0, At, B0); G8_BAR; G8_SCHED;
            G8_LDB(B1, 1, 1); G8_STAGE(G8_SB(1, 0), b3, voffB);
            G8_BAR; G8_WAIT_L(0); G8_MMA(0, 1, At, B1); G8_BAR;
            G8_LDA(At, 1, 1); G8_STA(G8_SA(1, 0), a3, 0, w0, w1);
            G8_BAR; G8_WAIT_L(0); G8_MMA(1, 0, At, B0); G8_BAR; G8_SCHED;
            G8_STAGE(G8_SB(1, 1), b3 + hstepB, voffB);
            G8_WAIT_V(6); G8_BAR; G8_MMA(1, 1, At, B1); G8_BAR;
        }
        E(acc, cur, wr, wc, fr, fq);
        if (!has_next) break;
#pragma unroll
        for (int a = 0; a < 2; ++a)
#pragma unroll
            for (int b = 0; b < 2; ++b)
#pragma unroll
                for (int m = 0; m < 4; ++m)
#pragma unroll
                    for (int n = 0; n < 2; ++n) acc[a][b][m][n] = (f32x4){0.f, 0.f, 0.f, 0.f};
        cur = nxt; cA = nAp; cB = nBp; ++ui;
#pragma unroll
        for (int i = 0; i < 2; ++i) { vA0[i] = nA0[i]; vA1[i] = nA1[i]; }
    }
    G8_WAIT_V(0);
    if (wr == 0) G8_BAR;
    G8_BAR;
#undef G8_SA
#undef G8_SB
#undef G8_STAGE
#undef G8_STA
#undef G8_LDA
#undef G8_LDB
#undef G8_MMA
#undef G8_WAIT_V
#undef G8_WAIT_L
#undef G8_BAR
#undef G8_SCHED
}

__device__ __forceinline__ u32x4 pack_acc8(const f32x4 v0, const f32x4 v1) { u32x4 w; w.x = cvt_pk_bf16(v0[0], v0[1]); w.y = cvt_pk_bf16(v0[2], v0[3]); w.z = cvt_pk_bf16(v1[0], v1[1]); w.w = cvt_pk_bf16(v1[2], v1[3]); return w; }

struct EpiPlain {
    bf16_t* O; int ldc;
    __device__ __forceinline__ void operator()(Acc& acc, const Unit& u, int wr, int wc, int fr, int fq) const {
        const int row0 = u.pm * BM + wr * 64 + fr, col0 = u.pn * BM + wc * 32 + 8 * fq;
#pragma unroll
        for (int ai = 0; ai < 2; ++ai)
#pragma unroll
            for (int m = 0; m < 4; ++m) { bf16_t* rowp = O + (size_t)(row0 + ai * HALF + m * 16) * ldc + col0;
#pragma unroll
                for (int bj = 0; bj < 2; ++bj) *(u32x4*)(rowp + bj * HALF) = pack_acc8(acc[ai][bj][m][0], acc[ai][bj][m][1]); }
    }
};

struct EpiEvenIn {
    bf16_t* H; bf16_t* KR; float* ssq; const float* ropeA; const float* ropeB;
    __device__ __forceinline__ void operator()(Acc& acc, const Unit& u, int wr, int wc, int fr, int fq) const {
        const int row0 = u.pm * BM + wr * 64 + fr, col0 = u.pn * BM + wc * 32 + 8 * fq;
        if (u.pn < 4 && (wc & 1) == 0) {
#pragma unroll
            for (int ai = 0; ai < 2; ++ai)
#pragma unroll
                for (int m = 0; m < 4; ++m) { const int pos = (row0 + ai * HALF + m * 16) & (SEQ - 1);
                    const f32x4 c0 = *(const f32x4*)(ropeA + pos * 8), c1 = *(const f32x4*)(ropeA + pos * 8 + 4);
                    const f32x4 s0 = *(const f32x4*)(ropeA + SEQ * 8 + pos * 8), s1 = *(const f32x4*)(ropeA + SEQ * 8 + pos * 8 + 4);
#pragma unroll
                    for (int bj = 0; bj < 2; ++bj)
#pragma unroll
                        for (int n = 0; n < 2; ++n) { const f32x4 own = acc[ai][bj][m][n]; f32x4 oth;
#pragma unroll
                            for (int j = 0; j < 4; ++j) oth[j] = __shfl_xor(own[j], 16);
                            const f32x4 cs = n ? c1 : c0, sn = n ? s1 : s0;
                            if (fq == 0) acc[ai][bj][m][n] = own * cs - oth * sn;
                            else if (fq == 1) acc[ai][bj][m][n] = own * cs + oth * sn; } }
        }
        if (u.pn >= 6) {
#pragma unroll
            for (int ai = 0; ai < 2; ++ai)
#pragma unroll
                for (int m = 0; m < 4; ++m) { float s = 0.f;
#pragma unroll
                    for (int bj = 0; bj < 2; ++bj) if (u.pn == 6 || bj == 0)
#pragma unroll
                        for (int n = 0; n < 2; ++n) { const f32x4 x = acc[ai][bj][m][n]; s += (x[0] * x[0] + x[1] * x[1]) + (x[2] * x[2] + x[3] * x[3]); }
                    s += __shfl_xor(s, 16); s += __shfl_xor(s, 32);
                    if (fq == 0) ssq[(size_t)(row0 + ai * HALF + m * 16) * 8 + (u.pn == 6 ? 0 : 4) + wc] = s; }
        }
        if (u.pn == 7 && wc == 0) {
#pragma unroll
            for (int ai = 0; ai < 2; ++ai)
#pragma unroll
                for (int m = 0; m < 4; ++m) { const int row = row0 + ai * HALF + m * 16, pos = row & (SEQ - 1); f32x4 o[2];
#pragma unroll
                    for (int n = 0; n < 2; ++n) { const f32x4 own = acc[ai][1][m][n]; f32x4 oth;
#pragma unroll
                        for (int j = 0; j < 4; ++j) oth[j] = __shfl_xor(own[j], 32);
                        const int i0 = 8 * (fq & 1) + 4 * n;
                        const f32x4 cs = *(const f32x4*)(ropeB + pos * 16 + i0), sn = *(const f32x4*)(ropeB + SEQ * 16 + pos * 16 + i0);
                        o[n] = (fq < 2) ? own * cs - oth * sn : own * cs + oth * sn; }
                    *(u32x4*)(KR + (size_t)row * 32 + 8 * fq) = pack_acc8(o[0], o[1]); }
        }
#pragma unroll
        for (int ai = 0; ai < 2; ++ai)
#pragma unroll
            for (int m = 0; m < 4; ++m) { bf16_t* rowp = H + (size_t)(row0 + ai * HALF + m * 16) * HLD + col0;
#pragma unroll
                for (int bj = 0; bj < 2; ++bj) *(u32x4*)(rowp + bj * HALF) = pack_acc8(acc[ai][bj][m][0], acc[ai][bj][m][1]); }
    }
};

template <int MODE> struct EpiMla {
    bf16_t* O; const float* ssq;
    __device__ __forceinline__ void operator()(Acc& acc, const Unit& u, int wr, int wc, int fr, int fq) const {
        const int row0 = u.pm * BM + wr * 64 + fr, col0 = u.pn * BM + wc * 32 + 8 * fq;
        constexpr int ldc = MODE == 0 ? 768 : 1024;
#pragma unroll
        for (int ai = 0; ai < 2; ++ai)
#pragma unroll
            for (int m = 0; m < 4; ++m) { const int row = row0 + ai * HALF + m * 16;
                const f32x4 p = *(const f32x4*)(ssq + (size_t)row * 8 + (MODE == 0 ? 0 : 4));
                const float rstd = 1.0f / sqrtf(((p[0] + p[1]) + (p[2] + p[3])) * (MODE == 0 ? 1.0f / 256.0f : 1.0f / 128.0f) + RMS_EPS);
                bf16_t* rowp = O + (size_t)row * ldc + col0;
#pragma unroll
                for (int bj = 0; bj < 2; ++bj) *(u32x4*)(rowp + bj * HALF) = pack_acc8(acc[ai][bj][m][0] * rstd, acc[ai][bj][m][1] * rstd);
                asm volatile("" ::: "memory"); }
    }
};

struct EpiMoe1 {
    bf16_t* Hdn;
    __device__ __forceinline__ void operator()(Acc& acc, const Unit& u, int wr, int wc, int fr, int fq) const {
        const int row0 = u.row0 + wr * 64 + fr, col0 = u.pn * 128 + wc * 32 + 8 * fq;
#pragma unroll
        for (int ai = 0; ai < 2; ++ai)
#pragma unroll
            for (int m = 0; m < 4; ++m) { f32x4 h[2];
#pragma unroll
                for (int n = 0; n < 2; ++n)
#pragma unroll
                    for (int j = 0; j < 4; ++j) { const float g = acc[ai][0][m][n][j], up = acc[ai][1][m][n][j]; h[n][j] = g / (1.0f + __expf(-g)) * up; }
                *(u32x4*)(Hdn + (size_t)(row0 + ai * HALF + m * 16) * DEXP + col0) = pack_acc8(h[0], h[1]); }
    }
};
struct EpiMoe2 {
    bf16_t* Y; const float* slot_g; const int* slot_dst;
    __device__ __forceinline__ void operator()(Acc& acc, const Unit& u, int wr, int wc, int fr, int fq) const {
        const int row0 = u.row0 + wr * 64 + fr, col0 = u.pn * BM + wc * 32 + 8 * fq;
#pragma unroll
        for (int ai = 0; ai < 2; ++ai)
#pragma unroll
            for (int m = 0; m < 4; ++m) { const int slot = row0 + ai * HALF + m * 16; const int dst = slot_dst[slot]; const float g = slot_g[slot];
                if (dst >= 0) { bf16_t* rowp = Y + (size_t)dst * DM + col0;
#pragma unroll
                    for (int bj = 0; bj < 2; ++bj) *(u32x4*)(rowp + bj * HALF) = pack_acc8(acc[ai][bj][m][0] * g, acc[ai][bj][m][1] * g); } }
    }
};
}

struct Args { const float* in[26]; float* out; unsigned char* ws; int lo, hi; };
enum { IN_X = 0, IN_EWIN, IN_LQ1, IN_LK1, IN_LQ2, IN_LK2, IN_SUBLN, IN_QNG, IN_WUQ, IN_KVNG, IN_WUKV, IN_EWO, IN_OWQKV, IN_RELB, IN_OWO,
       IN_LN1G, IN_LN1B, IN_LN2G, IN_LN2B, IN_WRG, IN_BRG, IN_WRE, IN_BRE, IN_WG, IN_WU, IN_WD };

__device__ __forceinline__ Frame fresh(const Frame& F) { Frame R = F; int wv = F.wave, g = F.G, b = F.bid; asm volatile("" : "+s"(wv), "+s"(g), "+s"(b));
    int ln = (int)__builtin_amdgcn_mbcnt_hi(~0u, __builtin_amdgcn_mbcnt_lo(~0u, 0u)); asm volatile("" : "+v"(ln));
    __builtin_assume(ln >= 0 && ln < 64); __builtin_assume(wv >= 0 && wv < NTHREADS / 64); __builtin_assume(g > 0 && g <= 1024); __builtin_assume(b >= 0 && b < g);
    R.tid = wv * 64 + ln; R.lane = ln; R.wave = wv; R.G = g; R.bid = b; return R; }
__device__ __forceinline__ Args fresh(const Args& a) { Args r = a; unsigned char* w = a.ws; asm volatile("" : "+s"(w)); r.ws = w; return r; }

__device__ __forceinline__ void tr_tile(const Frame& F, const float* src, int ldsrc, int Kv, int Nv, int k0, int n0, bf16_t* dst, int lddst, int rowmap, const float* scale) {
    LAS float* T = (LAS float*)F.lds;
    __syncthreads();
#pragma unroll
    for (int it = 0; it < 8; ++it) { const int e = it * NTHREADS + F.tid, i = e >> 6, j = e & 63; const int k = k0 + i, n = n0 + j;
        float v = 0.f; if (k < Kv && n < Nv) { v = src[(size_t)k * ldsrc + n]; if (scale) v *= scale[k]; }
        T[i * 65 + j] = v; }
    __syncthreads();
    {
        const int j = F.tid >> 3, i0 = (F.tid & 7) * 8; float f[8];
#pragma unroll
        for (int q = 0; q < 8; ++q) f[q] = T[(i0 + q) * 65 + j];
        int n = n0 + j; if (rowmap) n = (n >> 7) * 256 + (n & 127) + (rowmap == 2 ? 128 : 0);
        *(u32x4*)(dst + (size_t)n * lddst + k0 + i0) = pack8(f); }
}
__device__ __forceinline__ void tr_matrix(const Frame& F, int& cursor, const float* src, int ldsrc, int Kv, int Nv, int Kp, int Np, bf16_t* dst, int lddst, int rowmap, const float* scale) {
    const int tk = Kp / 64, tn = Np / 64, ntile = tk * tn;
    int first = (F.bid - cursor % F.G + F.G) % F.G;
    for (int t = first; t < ntile; t += F.G) tr_tile(F, src, ldsrc, Kv, Nv, (t / tn) * 64, (t % tn) * 64, dst, lddst, rowmap, scale);
    cursor += ntile;
}

__device__ __forceinline__ void phase_prologue(const Frame& F, const Args& a) {
    unsigned char* ws = a.ws;
    { const float* x = a.in[IN_X]; bf16_t* X = (bf16_t*)(ws + WS_X); const size_t n8 = (size_t)NTOK * DM / 8;
      for (size_t i = (size_t)F.bid * NTHREADS + F.tid; i < n8; i += (size_t)F.G * NTHREADS) { const f32x4 v0 = *(const f32x4*)(x + i * 8), v1 = *(const f32x4*)(x + i * 8 + 4); *(u32x4*)(X + i * 8) = g8::pack_acc8(v0, v1); } }
    { float* ra = (float*)(ws + WS_ROPEA); float* rb = (float*)(ws + WS_ROPEB);
      for (int i = F.bid * NTHREADS + F.tid; i < SEQ * 8; i += F.G * NTHREADS) { const int pos = i >> 3, f = i & 7; const float inv = powf(500000.0f, -(float)(2 * f) / 16.0f); const float ang = (float)pos * inv; ra[i] = cosf(ang); ra[SEQ * 8 + i] = sinf(ang); }
      for (int i = F.bid * NTHREADS + F.tid; i < SEQ * 16; i += F.G * NTHREADS) { const int pos = i >> 4, f = i & 15; const float inv = powf(500000.0f, -(float)(2 * f) / 32.0f); const float ang = (float)pos * inv; rb[i] = cosf(ang); rb[SEQ * 16 + i] = sinf(ang); } }
    { float* wr = (float*)(ws + WS_WR); const float* wrg = a.in[IN_WRG]; const float* wre = a.in[IN_WRE];
      for (int i = F.bid * NTHREADS + F.tid; i < DEPTH * 36 * DM; i += F.G * NTHREADS) { const int l = i / (36 * DM), r = i % (36 * DM), j = r / DM, k = r % DM;
          wr[i] = j < 4 ? wrg[((size_t)l * DM + k) * 4 + j] : wre[((size_t)l * DM + k) * 32 + (j - 4)]; } }
    int cur = 0;
    for (int l = 0; l < 2; ++l) {
        tr_matrix(F, cur, a.in[IN_EWIN] + (size_t)l * DM * EVEN_IN, EVEN_IN, DM, EVEN_IN, DM, HLD, (bf16_t*)(ws + WS_WIN) + (size_t)l * HLD * DM, DM, 0, nullptr);
        tr_matrix(F, cur, a.in[IN_WUQ] + (size_t)l * 256 * 768, 768, 256, 768, 256, 768, (bf16_t*)(ws + WS_WUQ) + (size_t)l * 768 * 256, 256, 0, a.in[IN_QNG] + l * 256);
        tr_matrix(F, cur, a.in[IN_WUKV] + (size_t)l * 128 * 1024, 1024, 128, 1024, 256, 1024, (bf16_t*)(ws + WS_WUKV) + (size_t)l * 1024 * 256, 256, 0, a.in[IN_KVNG] + l * 128);
        tr_matrix(F, cur, a.in[IN_EWO] + (size_t)l * DM * DM, DM, DM, DM, DM, DM, (bf16_t*)(ws + WS_WOE) + (size_t)l * DM * DM, DM, 0, nullptr);
        tr_matrix(F, cur, a.in[IN_OWQKV] + (size_t)l * DM * 3072, 3072, DM, 3072, DM, 3072, (bf16_t*)(ws + WS_WQKV) + (size_t)l * 3072 * DM, DM, 0, nullptr);
        tr_matrix(F, cur, a.in[IN_OWO] + (size_t)l * DM * DM, DM, DM, DM, DM, DM, (bf16_t*)(ws + WS_WOO) + (size_t)l * DM * DM, DM, 0, nullptr);
    }
    __syncthreads();
}
__device__ __forceinline__ void phase_moe_weights(const Frame& F, const Args& a, int layer) {
    unsigned char* ws = a.ws; int cur = 0;
    for (int e = 0; e < NEXP; ++e) {
        const size_t so = ((size_t)layer * NEXP + e) * DM * DEXP;
        tr_matrix(F, cur, a.in[IN_WG] + so, DEXP, DM, DEXP, DM, DEXP, (bf16_t*)(ws + WS_W13) + (size_t)e * 1024 * 1024, DM, 1, nullptr);
        tr_matrix(F, cur, a.in[IN_WU] + so, DEXP, DM, DEXP, DM, DEXP, (bf16_t*)(ws + WS_W13) + (size_t)e * 1024 * 1024, DM, 2, nullptr);
        tr_matrix(F, cur, a.in[IN_WD] + so, DM, DEXP, DM, DEXP, DM, (bf16_t*)(ws + WS_W2) + (size_t)e * 1024 * 512, DEXP, 0, nullptr);
    }
    __syncthreads();
}

template <int MODE>
__device__ __forceinline__ void phase_ln(const Frame& F, const Args& a, int layer, bool last_layer) {
    unsigned char* ws = a.ws;
    bf16_t* X = (bf16_t*)(ws + WS_X);
    const bf16_t* Ra = MODE == 0 ? (const bf16_t*)(ws + WS_R1) : (const bf16_t*)(ws + WS_R2);
    const float* gam = a.in[MODE == 0 ? IN_LN1G : IN_LN2G] + layer * DM; const float* bet = a.in[MODE == 0 ? IN_LN1B : IN_LN2B] + layer * DM;
    const float* WR = (const float*)(ws + WS_WR) + (size_t)layer * 36 * DM;
    LAS int* hist = (LAS int*)F.lds;
    for (int chunk = F.bid; chunk < NTOK / 256; chunk += F.G) {
        if (MODE == 0) { __syncthreads(); if (F.tid < NEXP) hist[F.tid] = 0; __syncthreads(); }
        for (int rr = F.wave; rr < 256; rr += NTHREADS / 64) {
            const int row = chunk * 256 + rr; float y[16];
#pragma unroll
            for (int hh = 0; hh < 2; ++hh) { const int c = hh * 512 + F.lane * 8; float xv[8], rv[8];
                unpack8(*(const u32x4*)(X + (size_t)row * DM + c), xv);
                if (MODE == 0) unpack8(*(const u32x4*)(Ra + (size_t)row * DM + c), rv);
                else { float r0[8], r1[8]; unpack8(*(const u32x4*)(Ra + (size_t)row * 2 * DM + c), r0); unpack8(*(const u32x4*)(Ra + (size_t)row * 2 * DM + DM + c), r1);
#pragma unroll
                    for (int q = 0; q < 8; ++q) rv[q] = r0[q] + r1[q]; }
#pragma unroll
                for (int q = 0; q < 8; ++q) y[hh * 8 + q] = DN_ALPHA * xv[q] + rv[q]; }
            float s = 0.f;
#pragma unroll
            for (int q = 0; q < 16; ++q) s += y[q];
            const float mean = wave_sum(s) * (1.0f / DM);
            float v = 0.f;
#pragma unroll
            for (int q = 0; q < 16; ++q) { const float d = y[q] - mean; v += d * d; }
            const float rstd = 1.0f / sqrtf(wave_sum(v) * (1.0f / DM) + LN_EPS);
#pragma unroll
            for (int hh = 0; hh < 2; ++hh) { const int c = hh * 512 + F.lane * 8;
                const f32x4 g0 = *(const f32x4*)(gam + c), g1 = *(const f32x4*)(gam + c + 4), b0 = *(const f32x4*)(bet + c), b1 = *(const f32x4*)(bet + c + 4);
#pragma unroll
                for (int q = 0; q < 4; ++q) { y[hh * 8 + q] = (y[hh * 8 + q] - mean) * rstd * g0[q] + b0[q]; y[hh * 8 + 4 + q] = (y[hh * 8 + 4 + q] - mean) * rstd * g1[q] + b1[q]; } }
            if (MODE == 1 && last_layer) {
#pragma unroll
                for (int hh = 0; hh < 2; ++hh) { float* o = a.out + (size_t)row * DM + hh * 512 + F.lane * 8;
                    *(f32x4*)o = (f32x4){y[hh * 8], y[hh * 8 + 1], y[hh * 8 + 2], y[hh * 8 + 3]}; *(f32x4*)(o + 4) = (f32x4){y[hh * 8 + 4], y[hh * 8 + 5], y[hh * 8 + 6], y[hh * 8 + 7]}; }
            } else {
#pragma unroll
                for (int hh = 0; hh < 2; ++hh) { float t8[8];
#pragma unroll
                    for (int q = 0; q < 8; ++q) t8[q] = y[hh * 8 + q];
                    *(u32x4*)(X + (size_t)row * DM + hh * 512 + F.lane * 8) = pack8(t8); }
            }
            if (MODE == 0) {
                float mine = 0.f;
#pragma unroll 2
                for (int j = 0; j < 36; ++j) { float p = 0.f;
#pragma unroll
                    for (int hh = 0; hh < 2; ++hh) { const float* w = WR + (size_t)j * DM + hh * 512 + F.lane * 8; const f32x4 w0 = *(const f32x4*)w, w1 = *(const f32x4*)(w + 4);
#pragma unroll
                        for (int q = 0; q < 4; ++q) { p += y[hh * 8 + q] * w0[q]; p += y[hh * 8 + 4 + q] * w1[q]; } }
                    p = wave_sum(p); mine = (F.lane == j) ? p : mine; }
                { const float* brg = a.in[IN_BRG] + layer * 4; const float* bre = a.in[IN_BRE] + layer * 32;
                  mine += (F.lane < 4) ? brg[F.lane] : (F.lane < 36 ? bre[F.lane - 4] : 0.f); }
                float lg[4];
#pragma unroll
                for (int j = 0; j < 4; ++j) lg[j] = __shfl(mine, j);
                int grp = 0; float gm = lg[0];
#pragma unroll
                for (int j = 1; j < 4; ++j) if (lg[j] > gm) { gm = lg[j]; grp = j; }
                float gs = 0.f;
#pragma unroll
                for (int j = 0; j < 4; ++j) gs += __expf(lg[j] - gm);
                const float gw = 1.0f / gs;
                float le[8];
#pragma unroll
                for (int i = 0; i < 8; ++i) le[i] = __shfl(mine, 4 + grp * 8 + i);
                int i1 = 0; float m1 = le[0];
#pragma unroll
                for (int i = 1; i < 8; ++i) if (le[i] > m1) { m1 = le[i]; i1 = i; }
                int i2 = -1; float m2 = -3.0e38f;
#pragma unroll
                for (int i = 0; i < 8; ++i) if (i != i1 && le[i] > m2) { m2 = le[i]; i2 = i; }
                const float e2 = __expf(m2 - m1), den = 1.0f / (1.0f + e2);
                if (F.lane == 0) {
                    const int e0 = grp * 8 + i1, e1 = grp * 8 + i2;
                    int* ri = (int*)(ws + WS_ROUTE) + (size_t)row * 4; ri[0] = e0; ri[1] = e1; ((float*)ri)[2] = den * gw; ((float*)ri)[3] = e2 * den * gw;
                    atomicAdd((int*)&hist[e0], 1); atomicAdd((int*)&hist[e1], 1);
                }
            }
        }
        if (MODE == 0) { __syncthreads(); if (F.tid < NEXP) ((int*)(ws + WS_CNT))[chunk * NEXP + F.tid] = hist[F.tid]; }
    }
    __syncthreads();
}

__device__ __forceinline__ void phase_scatter(const Frame& F, const Args& a) {
    unsigned char* ws = a.ws;
    const int* cnt = (const int*)(ws + WS_CNT); int* tile = (int*)(ws + WS_TILE);
    int* slot_tok = (int*)(ws + WS_SLOT_TOK); float* slot_g = (float*)(ws + WS_SLOT_G); int* slot_dst = (int*)(ws + WS_SLOT_DST);
    LAS int* C = (LAS int*)F.lds;
    LAS int* total = C + 256 * NEXP;
    LAS int* tstart = total + NEXP;
    LAS int* base = tstart + NEXP + 1;
    LAS int* el = base + NEXP;
    __syncthreads();
    for (int i = F.tid; i < 256 * NEXP; i += NTHREADS) C[i] = cnt[i];
    __syncthreads();
    if (F.tid < NEXP) { int s = 0; for (int c = 0; c < 256; ++c) s += C[c * NEXP + F.tid]; total[F.tid] = s; }
    __syncthreads();
    if (F.tid == 0) { int t = 0; for (int e = 0; e < NEXP; ++e) { tstart[e] = t; t += (total[e] + 255) >> 8; } tstart[NEXP] = t; }
    __syncthreads();
    const int T = tstart[NEXP];
    if (F.bid == 0) { if (F.tid == 0) tile[0] = T; for (int e = 0; e < NEXP; ++e) for (int t = tstart[e] + F.tid; t < tstart[e + 1]; t += NTHREADS) tile[1 + t] = e; }
    for (int e = F.bid; e < NEXP; e += F.G) { const int s0 = tstart[e] * 256 + total[e], s1 = tstart[e + 1] * 256;
        for (int s = s0 + F.tid; s < s1; s += NTHREADS) { slot_tok[s] = 0; slot_g[s] = 0.f; slot_dst[s] = -1; } }
    for (int chunk = F.bid; chunk < NTOK / 256; chunk += F.G) {
        __syncthreads();
        if (F.tid < NEXP) { int s = 0; for (int c = 0; c < chunk; ++c) s += C[c * NEXP + F.tid]; base[F.tid] = tstart[F.tid] * 256 + s; }
        const int tok = chunk * 256 + (F.tid >> 1), k = F.tid & 1;
        const int* ri = (const int*)(ws + WS_ROUTE) + (size_t)tok * 4;
        const int e = ri[k]; const float g = ((const float*)ri)[2 + k];
        el[F.tid] = e;
        __syncthreads();
        int rank = 0;
        for (int q = 0; q < F.tid; ++q) rank += (el[q] == e) ? 1 : 0;
        const int slot = base[e] + rank;
        slot_tok[slot] = tok; slot_g[slot] = g; slot_dst[slot] = tok * 2 + k;
    }
    __syncthreads();
}

template <int DQK, int VP>
__device__ __forceinline__ void attn_keys64(const LAS float* Ks, const LAS float* Vs, const float (&q)[DQK], float (&o)[64], float& m, float& l, const float sc) {
#pragma unroll 1
    for (int jj = 0; jj < 64; ++jj) {
        float acc = 0.f; const LAS float* kr = Ks + jj * DQK;
#pragma unroll
        for (int d = 0; d < DQK; d += 4) { const f32x4 kv = *(const LAS f32x4*)(kr + d); acc += q[d] * kv[0] + q[d + 1] * kv[1] + q[d + 2] * kv[2] + q[d + 3] * kv[3]; }
        const float s = acc * sc, mx = fmaxf(m, s), corr = __builtin_amdgcn_exp2f(m - mx), p = __builtin_amdgcn_exp2f(s - mx);
        m = mx; l = l * corr + p; const LAS float* vr = Vs + jj * VP;
#pragma unroll
        for (int e = 0; e < 64; e += 4) { const f32x4 vv = *(const LAS f32x4*)(vr + e); o[e] = o[e] * corr + p * vv[0]; o[e + 1] = o[e + 1] * corr + p * vv[1]; o[e + 2] = o[e + 2] * corr + p * vv[2]; o[e + 3] = o[e + 3] * corr + p * vv[3]; }
    }
}
__device__ __forceinline__ void stage8(LAS float* dst, const bf16_t* src) { float f[8]; unpack8(*(const u32x4*)src, f); *(LAS f32x4*)dst = (f32x4){f[0], f[1], f[2], f[3]}; *(LAS f32x4*)(dst + 4) = (f32x4){f[4], f[5], f[6], f[7]}; }

__device__ __forceinline__ void attn_diff_naive(const Frame& F, const Args& a, int layer, int unit) {
    unsigned char* ws = a.ws; const bf16_t* H = (const bf16_t*)(ws + WS_R1); bf16_t* O = (bf16_t*)(ws + WS_R3); float* TS = (float*)(ws + WS_R1 + 256 * MiB);
    const int j = layer >> 1; const float lambda_init = 0.8f - 0.6f * expf(-0.3f * (float)layer);
    float d1 = 0.f, d2 = 0.f;
    for (int i = 0; i < 64; ++i) { d1 += a.in[IN_LQ1][j * 64 + i] * a.in[IN_LK1][j * 64 + i]; d2 += a.in[IN_LQ2][j * 64 + i] * a.in[IN_LK2][j * 64 + i]; }
    const float lam = expf(d1) - expf(d2) + lambda_init;
    const int qb = unit & 7, h = (unit >> 3) & 3, b = unit >> 5;
    const int ql = (F.tid & 31) + 32 * (F.tid >> 6), half = (F.tid >> 5) & 1;
    const size_t row = (size_t)b * SEQ + qb * 256 + ql;
    LAS float* Ks = (LAS float*)F.lds; LAS float* Vs = Ks + 64 * 64;
    const float sc = 0.125f * 1.4426950408889634f;
    float* stash = TS + row * 512 + h * 128 + half * 64;
#pragma unroll 1
    for (int st = 0; st < 2; ++st) {
        float o[64], q[64];
#pragma unroll
        for (int d = 0; d < 64; d += 8) { float f[8]; unpack8(*(const u32x4*)(H + row * HLD + h * 128 + st * 64 + d), f);
#pragma unroll
            for (int t = 0; t < 8; ++t) q[d + t] = f[t]; }
        float m = -INFINITY, l = 0.f;
#pragma unroll
        for (int e = 0; e < 64; ++e) o[e] = 0.f;
#pragma unroll 1
        for (int kt = 0; kt < SEQ / 64; ++kt) {
            __syncthreads();
            { const int key = F.tid >> 3, d8 = (F.tid & 7) * 8; const size_t krow = (size_t)b * SEQ + kt * 64 + key;
              stage8(Ks + key * 64 + d8, H + krow * HLD + 512 + h * 128 + st * 64 + d8);
              stage8(Vs + key * 128 + d8, H + krow * HLD + 1024 + h * 128 + d8); stage8(Vs + key * 128 + 64 + d8, H + krow * HLD + 1024 + h * 128 + 64 + d8); }
            __syncthreads();
            attn_keys64<64, 128>(Ks, Vs + half * 64, q, o, m, l, sc);
        }
        const float inv = 1.0f / l;
        if (st == 0) {
#pragma unroll
            for (int e = 0; e < 64; e += 4) *(f32x4*)(stash + e) = (f32x4){o[e] * inv, o[e + 1] * inv, o[e + 2] * inv, o[e + 3] * inv};
        } else {
            float ss = 0.f;
#pragma unroll
            for (int e = 0; e < 64; e += 4) { const f32x4 p0 = *(const f32x4*)(stash + e);
#pragma unroll
                for (int t = 0; t < 4; ++t) { o[e + t] = p0[t] - lam * (o[e + t] * inv); ss += o[e + t] * o[e + t]; } }
            ss += __shfl_xor(ss, 32);
            const float rs = 1.0f / sqrtf(ss * (1.0f / 128.0f) + RMS_EPS) * (1.0f - lambda_init);
            const float* g = a.in[IN_SUBLN] + j * 128 + half * 64;
#pragma unroll
            for (int e = 0; e < 64; e += 8) { float t8[8];
#pragma unroll
                for (int t = 0; t < 8; ++t) t8[t] = o[e + t] * rs * g[e + t];
                *(u32x4*)(O + row * DM + h * 128 + half * 64 + e) = pack8(t8); }
        }
    }
}
__device__ __forceinline__ void attn_mla_naive(const Frame& F, const Args& a, int unit) {
    unsigned char* ws = a.ws; const bf16_t* QB = (const bf16_t*)(ws + WS_R2); const bf16_t* KVB = QB + (size_t)NTOK * 768; const bf16_t* KR = KVB + (size_t)NTOK * 1024; bf16_t* O = (bf16_t*)(ws + WS_R3);
    const int qb = unit & 3, h = (unit >> 2) & 7, b = unit >> 5;
    const size_t row = (size_t)b * SEQ + qb * 512 + F.tid;
    LAS float* Ks = (LAS float*)F.lds; LAS float* Vs = Ks + 64 * 96;
    const float sc = 0.10206207261596575f * 1.4426950408889634f;
    float q[96], o[64];
#pragma unroll
    for (int d = 0; d < 96; d += 8) { float f[8]; unpack8(*(const u32x4*)(QB + row * 768 + h * 96 + d), f);
#pragma unroll
        for (int t = 0; t < 8; ++t) q[d + t] = f[t]; }
    { const float* rb = (const float*)(ws + WS_ROPEB); const int pos = (int)(row & (SEQ - 1));
#pragma unroll
      for (int i = 0; i < 16; i += 4) { const f32x4 cs = *(const f32x4*)(rb + pos * 16 + i), sn = *(const f32x4*)(rb + SEQ * 16 + pos * 16 + i);
#pragma unroll
          for (int t = 0; t < 4; ++t) { const float x1 = q[64 + i + t], x2 = q[80 + i + t]; q[64 + i + t] = x1 * cs[t] - x2 * sn[t]; q[80 + i + t] = x2 * cs[t] + x1 * sn[t]; } } }
    float m = -INFINITY, l = 0.f;
#pragma unroll
    for (int e = 0; e < 64; ++e) o[e] = 0.f;
#pragma unroll 1
    for (int kt = 0; kt < SEQ / 64; ++kt) {
        __syncthreads();
        { const int key = F.tid >> 3, d8 = (F.tid & 7) * 8; const size_t krow = (size_t)b * SEQ + kt * 64 + key;
          stage8(Ks + key * 96 + d8, KVB + krow * 1024 + h * 128 + d8);
          stage8(Vs + key * 64 + d8, KVB + krow * 1024 + h * 128 + 64 + d8);
          if (F.tid < 256) { const int key2 = F.tid >> 2, r8 = (F.tid & 3) * 8; stage8(Ks + key2 * 96 + 64 + r8, KR + ((size_t)b * SEQ + kt * 64 + key2) * 32 + r8); } }
        __syncthreads();
        attn_keys64<96, 64>(Ks, Vs, q, o, m, l, sc);
    }
    const float inv = 1.0f / l;
#pragma unroll
    for (int e = 0; e < 64; e += 8) { float t8[8];
#pragma unroll
        for (int t = 0; t < 8; ++t) t8[t] = o[e + t] * inv;
        *(u32x4*)(O + row * DM + 512 + h * 64 + e) = pack8(t8); }
}
__device__ __forceinline__ void attn_na_naive(const Frame& F, const Args& a, int layer, int unit) {
    unsigned char* ws = a.ws; const bf16_t* QKV = (const bf16_t*)(ws + WS_R1); bf16_t* O = (bf16_t*)(ws + WS_R3);
    const float* relb = a.in[IN_RELB] + (size_t)(layer >> 1) * 16 * 15 * 31;
    const int hh = unit & 1, r = (unit >> 1) & 31, b = unit >> 6;
    const int c = F.tid & 63, h = hh * 8 + (F.tid >> 6);
    const int r0 = min(max(r - 4, 0), 24), c0 = min(max(c - 8, 0), 48);
    const size_t row = (size_t)b * SEQ + r * 64 + c;
    const float LOG2E = 1.4426950408889634f;
    float q[64], o[64];
#pragma unroll
    for (int d = 0; d < 64; d += 8) { float f[8]; unpack8(*(const u32x4*)(QKV + row * 3072 + h * 64 + d), f);
#pragma unroll
        for (int t = 0; t < 8; ++t) q[d + t] = f[t]; }
    float m = -INFINITY, l = 0.f;
#pragma unroll
    for (int e = 0; e < 64; ++e) o[e] = 0.f;
#pragma unroll 1
    for (int ij = 0; ij < 128; ++ij) {
        const int i = ij >> 4, jj = ij & 15;
        const size_t krow = (size_t)b * SEQ + (r0 + i) * 64 + c0 + jj;
        const float bias = relb[((size_t)h * 15 + (r0 + i - r + 7)) * 31 + (c0 + jj - c + 15)];
        float acc = 0.f; const bf16_t* kp = QKV + krow * 3072 + 1024 + h * 64;
#pragma unroll
        for (int d = 0; d < 64; d += 8) { float f[8]; unpack8(*(const u32x4*)(kp + d), f);
#pragma unroll
            for (int t = 0; t < 8; ++t) acc += q[d + t] * f[t]; }
        const float s = (acc * 0.125f + bias) * LOG2E, mx = fmaxf(m, s), corr = __builtin_amdgcn_exp2f(m - mx), p = __builtin_amdgcn_exp2f(s - mx);
        m = mx; l = l * corr + p; const bf16_t* vp = kp + 1024;
#pragma unroll
        for (int e = 0; e < 64; e += 8) { float f[8]; unpack8(*(const u32x4*)(vp + e), f);
#pragma unroll
            for (int t = 0; t < 8; ++t) o[e + t] = o[e + t] * corr + p * f[t]; }
    }
    const float inv = 1.0f / l;
#pragma unroll
    for (int e = 0; e < 64; e += 8) { float t8[8];
#pragma unroll
        for (int t = 0; t < 8; ++t) t8[t] = o[e + t] * inv;
        *(u32x4*)(O + row * DM + h * 64 + e) = pack8(t8); }
}

constexpr int LDS_BYTES = 144 * 1024;
constexpr int MISC_OFF = g8::STAGE_BYTES;
constexpr int NPH_LAYER = 9, NPHASES = 1 + DEPTH * NPH_LAYER;

__global__ void __launch_bounds__(NTHREADS, 2) fwd_kernel(Args a) {
    extern __shared__ __attribute__((aligned(16))) unsigned char lds_raw[];
    Frame F; F.lds = (LAS unsigned char*)lds_raw; F.wave = __builtin_amdgcn_readfirstlane((int)threadIdx.x >> 6); F.tid = 0; F.lane = 0; F.G = gridDim.x; F.bid = blockIdx.x;
    unsigned char* ws = a.ws;
    volatile LAS unsigned* MISC = (volatile LAS unsigned*)(F.lds + MISC_OFF);
    { const Frame Fp = fresh(F); if (Fp.tid < 4) MISC[Fp.tid] = 0u; }
    __syncthreads();
    const bool one = (a.hi - a.lo) > 1;
    XcdBarrier bar; bar.bar = (unsigned*)(ws + WS_CTL); bar.x = 0; bar.st = MISC;
    if (one) { const Frame Fp = fresh(F); bar = xcd_barrier_post((unsigned*)(ws + WS_CTL), MISC, Fp.tid); }
#define IN(k) (a.lo <= (k) && (k) < a.hi)
#define SEAM(k) do { if (IN(k) && IN((k) + 1)) { const Frame Fb = fresh(F); xcd_barrier(bar, Fb.tid); } } while (0)

    if (IN(0)) { const Frame Fp = fresh(F); const Args ap = fresh(a); phase_prologue(Fp, ap); }
    SEAM(0);
#pragma unroll 1
    for (int layer = 0; layer < DEPTH; ++layer) {
        const int p0 = 1 + layer * NPH_LAYER, j = layer >> 1; const bool even = (layer & 1) == 0;
        if (IN(p0)) {
            const Frame Fp = fresh(F); const Args ap = fresh(a); unsigned char* w = ap.ws;
            phase_moe_weights(Fp, ap, layer);
            if (even) { g8::DenseSched S; S.init(w + WS_X, DM, (const bf16_t*)(w + WS_WIN) + (size_t)j * HLD * DM, DM, NTOK, HLD, Fp.G, Fp.bid);
                g8::EpiEvenIn E{(bf16_t*)(w + WS_R1), (bf16_t*)(w + WS_R2) + (size_t)NTOK * 1792, (float*)(w + WS_SSQ), (const float*)(w + WS_ROPEA), (const float*)(w + WS_ROPEB)}; g8::gemm_phase(Fp, DM, S, E); }
            else { g8::DenseSched S; S.init(w + WS_X, DM, (const bf16_t*)(w + WS_WQKV) + (size_t)j * 3072 * DM, DM, NTOK, 3072, Fp.G, Fp.bid);
                g8::EpiPlain E{(bf16_t*)(w + WS_R1), 3072}; g8::gemm_phase(Fp, DM, S, E); }
        }
        SEAM(p0);
        if (IN(p0 + 1) && even) {
            const Frame Fp = fresh(F); const Args ap = fresh(a); unsigned char* w = ap.ws;
            { g8::DenseSched S; S.init((bf16_t*)(w + WS_R1) + 1536, HLD, (const bf16_t*)(w + WS_WUQ) + (size_t)j * 768 * 256, 256, NTOK, 768, Fp.G, Fp.bid);
              g8::EpiMla<0> E{(bf16_t*)(w + WS_R2), (const float*)(w + WS_SSQ)}; g8::gemm_phase(Fp, 256, S, E); }
            const Frame Fq = fresh(F);
            { g8::DenseSched S; S.init((bf16_t*)(w + WS_R1) + 1792, HLD, (const bf16_t*)(w + WS_WUKV) + (size_t)j * 1024 * 256, 256, NTOK, 1024, Fq.G, Fq.bid);
              g8::EpiMla<1> E{(bf16_t*)(w + WS_R2) + (size_t)NTOK * 768, (const float*)(w + WS_SSQ)}; g8::gemm_phase(Fq, 256, S, E); }
        }
        SEAM(p0 + 1);
        if (IN(p0 + 2)) {
            const Frame Fp = fresh(F); const Args ap = fresh(a);
            if (even) { for (int u = Fp.bid; u < NBATCH * 4 * 8; u += Fp.G) attn_diff_naive(Fp, ap, layer, u);
                        for (int u = Fp.bid; u < NBATCH * 8 * 4; u += Fp.G) attn_mla_naive(Fp, ap, u); }
            else { for (int u = Fp.bid; u < NBATCH * 32 * 2; u += Fp.G) attn_na_naive(Fp, ap, layer, u); }
            __syncthreads();
        }
        SEAM(p0 + 2);
        if (IN(p0 + 3)) {
            const Frame Fp = fresh(F); const Args ap = fresh(a); unsigned char* w = ap.ws;
            g8::DenseSched S; S.init(w + WS_R3, DM, (const bf16_t*)(w + (even ? WS_WOE : WS_WOO)) + (size_t)j * DM * DM, DM, NTOK, DM, Fp.G, Fp.bid);
            g8::EpiPlain E{(bf16_t*)(w + WS_R1), DM}; g8::gemm_phase(Fp, DM, S, E);
        }
        SEAM(p0 + 3);
        if (IN(p0 + 4)) { const Frame Fp = fresh(F); const Args ap = fresh(a); phase_ln<0>(Fp, ap, layer, false); }
        SEAM(p0 + 4);
        if (IN(p0 + 5)) { const Frame Fp = fresh(F); const Args ap = fresh(a); phase_scatter(Fp, ap); }
        SEAM(p0 + 5);
        if (IN(p0 + 6)) {
            const Frame Fp = fresh(F); const Args ap = fresh(a); unsigned char* w = ap.ws;
            g8::MoeSched<true> S; S.A = (const char*)(w + WS_X); S.Wt = (const char*)(w + WS_W13); S.tile = (const int*)(w + WS_TILE); S.slot_tok = (const int*)(w + WS_SLOT_TOK);
            S.lda2 = DM * 2; S.K2 = DM * 2; S.wstride = (size_t)1024 * 1024 * 2; S.T = S.tile[0]; S.G = Fp.G; S.c = Fp.bid;
            g8::EpiMoe1 E{(bf16_t*)(w + WS_R1)}; g8::gemm_phase(Fp, DM, S, E);
        }
        SEAM(p0 + 6);
        if (IN(p0 + 7)) {
            const Frame Fp = fresh(F); const Args ap = fresh(a); unsigned char* w = ap.ws;
            g8::MoeSched<false> S; S.A = (const char*)(w + WS_R1); S.Wt = (const char*)(w + WS_W2); S.tile = (const int*)(w + WS_TILE); S.slot_tok = (const int*)(w + WS_SLOT_TOK);
            S.lda2 = DEXP * 2; S.K2 = DEXP * 2; S.wstride = (size_t)1024 * 512 * 2; S.T = S.tile[0]; S.G = Fp.G; S.c = Fp.bid;
            g8::EpiMoe2 E{(bf16_t*)(w + WS_R2), (const float*)(w + WS_SLOT_G), (const int*)(w + WS_SLOT_DST)}; g8::gemm_phase(Fp, DEXP, S, E);
        }
        SEAM(p0 + 7);
        if (IN(p0 + 8)) { const Frame Fp = fresh(F); const Args ap = fresh(a); phase_ln<1>(Fp, ap, layer, layer == DEPTH - 1); }
        SEAM(p0 + 8);
    }
#undef IN
#undef SEAM
}

extern "C" void kernel_launch(void* const* d_in, const int* in_sizes, int n_in, void* d_out, int out_size, void* d_ws, size_t ws_size, hipStream_t stream) {
    static int grid = 0;
    if (grid == 0) {
        if (n_in != 26 || in_sizes[0] != NTOK * DM || out_size != NTOK * DM || ws_size < WS_END) {
            fprintf(stderr, "kernel_launch: unexpected shapes / workspace (n_in %d, in0 %d, out %d, ws %zu, need %zu)\n", n_in, n_in > 0 ? in_sizes[0] : -1, out_size, ws_size, (size_t)WS_END); grid = -1; return; }
        int dev = 0, cus = 0, per_cu = 0;
        if (hipGetDevice(&dev) != hipSuccess || hipDeviceGetAttribute(&cus, hipDeviceAttributeMultiprocessorCount, dev) != hipSuccess) { grid = -1; return; }
        if (hipFuncSetAttribute((const void*)fwd_kernel, hipFuncAttributeMaxDynamicSharedMemorySize, LDS_BYTES) != hipSuccess) { fprintf(stderr, "kernel_launch: hipFuncSetAttribute failed\n"); grid = -1; return; }
        if (hipOccupancyMaxActiveBlocksPerMultiprocessor(&per_cu, (const void*)fwd_kernel, NTHREADS, LDS_BYTES) != hipSuccess || per_cu < 1) fprintf(stderr, "kernel_launch: occupancy query reports %d\n", per_cu);
        (void)hipGetLastError();
        grid = cus;
    }
    if (grid < 0) return;
    (void)hipMemsetAsync((char*)d_ws + WS_CTL, 0, 64 * 1024, stream);
    Args a{};
    for (int i = 0; i < 26; ++i) a.in[i] = (const float*)d_in[i];
    a.out = (float*)d_out; a.ws = (unsigned char*)d_ws;
#if MK_ONE_LAUNCH
    a.lo = 0; a.hi = NPHASES;
    hipLaunchKernelGGL(fwd_kernel, dim3(grid), dim3(NTHREADS), LDS_BYTES, stream, a);
#else
    for (int p = 0; p < NPHASES; ++p) {
        if (p >= 1 && ((p - 1) % NPH_LAYER) == 1 && (((p - 1) / NPH_LAYER) & 1)) continue;
        a.lo = p; a.hi = p + 1;
        hipLaunchKernelGGL(fwd_kernel, dim3(grid), dim3(NTHREADS), LDS_BYTES, stream, a);
    }
#endif
}
```

```cpp
#include <hip/hip_runtime.h>
#include <cstdio>
#include <cstdint>

#ifndef NAIVE_ATTN
#define NAIVE_ATTN 0
#endif
#ifndef NAIVE_NA
#define NAIVE_NA 0
#endif
#ifndef MK_ONE_LAUNCH
#define MK_ONE_LAUNCH 1
#endif

typedef unsigned short bf16_t;
typedef short bf16x8 __attribute__((ext_vector_type(8)));
typedef float f32x4 __attribute__((ext_vector_type(4)));
typedef float f32x2 __attribute__((ext_vector_type(2)));
typedef unsigned u32x4 __attribute__((ext_vector_type(4)));
typedef unsigned u32x2 __attribute__((ext_vector_type(2)));
#define LAS __attribute__((address_space(3)))

constexpr int NTOK = 65536, DM = 1024, SEQ = 2048, NBATCH = 32, DEPTH = 4;
constexpr int EVEN_IN = 1952, HLD = 2048;
constexpr int NEXP = 32, DEXP = 512;
constexpr int MAXTILES = NTOK * 2 / 256 + NEXP;
constexpr int MAXSLOTS = MAXTILES * 256;
constexpr float DN_ALPHA = 1.681792830507429f;
constexpr float LN_EPS = 1e-5f, RMS_EPS = 1e-6f;
constexpr int NTHREADS = 512;

constexpr size_t MiB = 1024ull * 1024ull;
constexpr size_t WS_CTL = 0;
constexpr size_t WS_LAM = 48 * 1024;
constexpr size_t WS_ROPEA = 64 * 1024;
constexpr size_t WS_ROPEB = WS_ROPEA + 128 * 1024;
constexpr size_t WS_WR = WS_ROPEB + 256 * 1024;
constexpr size_t WS_ROUTE = WS_WR + 640 * 1024;
constexpr size_t WS_CNT = WS_ROUTE + 1 * MiB;
constexpr size_t WS_TILE = WS_CNT + 32 * 1024;
constexpr size_t WS_SLOT_TOK = WS_TILE + 4 * 1024;
constexpr size_t WS_SLOT_G = WS_SLOT_TOK + 576 * 1024;
constexpr size_t WS_SLOT_DST = WS_SLOT_G + 576 * 1024;
constexpr size_t WS_SSQ = WS_SLOT_DST + 576 * 1024;
constexpr size_t WS_WIN = 6 * MiB;
constexpr size_t WS_WUQ = WS_WIN + 8 * MiB;
constexpr size_t WS_WUKV = WS_WUQ + 1 * MiB;
constexpr size_t WS_WOE = WS_WUKV + 1 * MiB;
constexpr size_t WS_WQKV = WS_WOE + 4 * MiB;
constexpr size_t WS_WOO = WS_WQKV + 12 * MiB;
constexpr size_t WS_W13 = 36 * MiB;
constexpr size_t WS_W2 = WS_W13 + 64 * MiB;
constexpr size_t WS_X = WS_W2 + 32 * MiB;
constexpr size_t WS_R1 = WS_X + 128 * MiB;
constexpr size_t WS_R2 = WS_R1 + 384 * MiB;
constexpr size_t WS_R3 = WS_R2 + 228 * MiB;
constexpr size_t WS_END = WS_R3 + 128 * MiB;
static_assert(WS_SSQ + 2 * MiB <= WS_WIN, "misc region");
static_assert(WS_WOO + 4 * MiB <= WS_W13, "small weights region");

__device__ __forceinline__ unsigned cvt_pk_bf16(float lo, float hi) { unsigned r; asm volatile("v_cvt_pk_bf16_f32 %0, %1, %2" : "=v"(r) : "v"(lo), "v"(hi)); return r; }
__device__ __forceinline__ float bf_lo(unsigned w) { return __uint_as_float(w << 16); }
__device__ __forceinline__ float bf_hi(unsigned w) { return __uint_as_float(w & 0xffff0000u); }
__device__ __forceinline__ float bf2f(bf16_t b) { return __uint_as_float(((unsigned)b) << 16); }
__device__ __forceinline__ void unpack8(const u32x4 w, float (&f)[8]) {
    f[0] = bf_lo(w.x); f[1] = bf_hi(w.x); f[2] = bf_lo(w.y); f[3] = bf_hi(w.y); f[4] = bf_lo(w.z); f[5] = bf_hi(w.z); f[6] = bf_lo(w.w); f[7] = bf_hi(w.w); }
__device__ __forceinline__ u32x4 pack8(const float (&f)[8]) { u32x4 w; w.x = cvt_pk_bf16(f[0], f[1]); w.y = cvt_pk_bf16(f[2], f[3]); w.z = cvt_pk_bf16(f[4], f[5]); w.w = cvt_pk_bf16(f[6], f[7]); return w; }
__device__ __forceinline__ float wave_sum(float v) {
#pragma unroll
    for (int o = 32; o >= 1; o >>= 1) v += __shfl_xor(v, o);
    return v; }

struct Frame { LAS unsigned char* lds; int tid, lane, wave, G, bid; };
#define XB_TMO      128
#define XB_XCNT(j)  (256  + 64 * (j))
#define XB_XSUB(j)  (1280 + 64 * (j))
#define XB_XGEN(j)  (2304 + 64 * (j))
#define XB_TOP      3328
#define XB_TOPGEN   3392
#define XCD_BAR_WORDS 3456
#define XB_SPIN_CAP (1u << 21)
__device__ __forceinline__ unsigned xb_ld(unsigned* p)              { return __hip_atomic_load(p, __ATOMIC_RELAXED, __HIP_MEMORY_SCOPE_AGENT); }
__device__ __forceinline__ unsigned xb_add(unsigned* p, unsigned v) { return __hip_atomic_fetch_add(p, v, __ATOMIC_RELAXED, __HIP_MEMORY_SCOPE_AGENT); }
__device__ __forceinline__ unsigned xb_xcc_id() { return (unsigned)__builtin_amdgcn_s_getreg((3 << 11) | 20) & 0xFu; }
#define XB_SPIN(cond, bar) do { unsigned _sp = 0; while (cond) { __builtin_amdgcn_s_sleep(1); \
    if ((++_sp & 255u) == 0u) { if (xb_ld(&(bar)[XB_TMO])) break; if (_sp > XB_SPIN_CAP) { atomicAdd(&(bar)[XB_TMO], 1u); break; } } } } while (0)
struct XcdBarrier { unsigned* bar; unsigned x; volatile LAS unsigned* st; };
__device__ __forceinline__ XcdBarrier xcd_barrier_post(unsigned* bar, volatile LAS unsigned* st, int tid) {
    XcdBarrier b; b.bar = bar; b.x = xb_xcc_id(); b.st = st;
    if (tid == 0) (void)xb_add(&bar[XB_XCNT(b.x)], 1u);
    return b;
}
__device__ __forceinline__ void xcd_barrier_complete(unsigned* bar, unsigned x, unsigned& nloc, unsigned& nx) {
    const unsigned G = gridDim.x * gridDim.y * gridDim.z;
    unsigned sum, cnt, mine, sp = 0u;
    for (;;) {
        sum = 0u; cnt = 0u; mine = 0u;
#pragma unroll
        for (unsigned j = 0; j < 16; ++j) { const unsigned c = xb_ld(&bar[XB_XCNT(j)]); sum += c; cnt += (c > 0u) ? 1u : 0u; mine = (j == x) ? c : mine; }
        if (sum == G) break;
        __builtin_amdgcn_s_sleep(1);
        if ((++sp & 255u) == 0u) { if (xb_ld(&bar[XB_TMO])) break; if (sp > XB_SPIN_CAP) { atomicAdd(&bar[XB_TMO], 1u); break; } }
    }
    nloc = mine > 0u ? mine : 1u; nx = cnt > 0u ? cnt : 1u;
}
__device__ __forceinline__ void xcd_barrier(const XcdBarrier& b, int tid) {
    asm volatile("s_waitcnt vmcnt(0)" ::: "memory");
    __syncthreads();
    if (tid == 0) {
        unsigned* bar = b.bar; unsigned bx = b.x; asm volatile("" : "+s"(bx));
        __builtin_amdgcn_s_waitcnt(0);
        unsigned nloc = b.st[0], nx = b.st[1];
        if (nloc == 0u) { xcd_barrier_complete(bar, bx, nloc, nx); b.st[0] = nloc; b.st[1] = nx; }
        const unsigned old = xb_add(&bar[XB_XSUB(bx)], 1u);
        const unsigned gen = old / nloc;
        if (old + 1u == (gen + 1u) * nloc) {
            __builtin_amdgcn_fence(__ATOMIC_RELEASE, "agent");
            asm volatile("s_waitcnt vmcnt(0)" ::: "memory");
            const unsigned og = xb_add(&bar[XB_TOP], 1u);
            const unsigned tg = og / nx;
            if (og + 1u == (tg + 1u) * nx) xb_add(&bar[XB_TOPGEN], 1u);
            else XB_SPIN(xb_ld(&bar[XB_TOPGEN]) == tg, bar);
            __builtin_amdgcn_fence(__ATOMIC_ACQUIRE, "agent");
            xb_add(&bar[XB_XGEN(bx)], 1u);
            asm volatile("s_waitcnt vmcnt(0)" ::: "memory");
        } else {
            XB_SPIN(xb_ld(&bar[XB_XGEN(bx)]) == gen, bar);
            __builtin_amdgcn_fence(__ATOMIC_ACQUIRE, "agent");
            asm volatile("s_waitcnt vmcnt(0)" ::: "memory");
        }
    }
    __syncthreads();
}

namespace g8 {
constexpr int BM = 256, BK = 64, HALF = 128, HTB = HALF * BK * 2, STAGE_BYTES = 8 * HTB, NXCD = 8, WGM = 8;
__device__ __forceinline__ int lds_byte(int r, int c) { const int st = (r >> 4) * 2 + (c >> 5), rr = r & 15, cc = c & 31, ob = rr * 64 + cc * 2; return st * 1024 + (ob ^ (((ob >> 9) & 1) << 5)); }
__device__ __forceinline__ void stage_rc(int b, int& R, int& C) { const int st = b / 1024, sb = b % 1024, swz = sb ^ (((sb >> 9) & 1) << 5); R = (st >> 1) * 16 + swz / 64; C = (st & 1) * 32 + (swz % 64) / 2; }
__device__ __forceinline__ int perm32(int rho) { const int n = rho >> 4, i = rho & 15; return 8 * (i >> 2) + 4 * n + (i & 3); }

struct Unit { const char* A; const char* B; int row0, pm, pn, e; };
typedef f32x4 Acc[2][2][4][2];

struct DenseSched {
    const char* A; const char* Bt; unsigned lda2; int K2; int nM, nN, nwg, G, c;
    __device__ __forceinline__ void init(const void* A_, int lda, const void* Bt_, int K, int M, int N, int G_, int c_) { A = (const char*)A_; Bt = (const char*)Bt_; lda2 = (unsigned)lda * 2u; K2 = K * 2; nM = M / BM; nN = N / BM; nwg = nM * nN; G = G_; c = c_; }
    __device__ __forceinline__ bool next(int i, Unit& u) const {
        const long L = (long)i * G + c; if (L >= nwg) return false;
        int wgid = (int)L; { const int q = nwg / NXCD, r = nwg % NXCD, xcd = wgid % NXCD, off = wgid / NXCD; wgid = (xcd < r ? xcd * (q + 1) : r * (q + 1) + (xcd - r) * q) + off; }
        const int nig = WGM * nN, gid = wgid / nig, fm = gid * WGM, gsz = (nM - fm) < WGM ? (nM - fm) : WGM;
        u.pm = fm + ((wgid % nig) % gsz); u.pn = (wgid % nig) / gsz; u.row0 = u.pm * BM; u.e = 0;
        u.A = A + (size_t)u.row0 * lda2; u.B = Bt + (size_t)u.pn * BM * K2; return true;
    }
    static constexpr bool GATHER = false;
    __device__ __forceinline__ unsigned rowoff(const Unit&, int r) const { return (unsigned)r * lda2; }
};
template <bool GATHER_> struct MoeSched {
    const char* A; const char* Wt; const int* tile; const int* slot_tok; unsigned lda2; int K2; size_t wstride; int T, G, c;
    __device__ __forceinline__ bool next(int i, Unit& u) const {
        const int L = i * G + c; if (L >= T * 4) return false;
        const int t = L >> 2; u.pn = L & 3; u.pm = t; u.row0 = t * BM; u.e = tile[1 + t];
        u.A = GATHER_ ? A : A + (size_t)u.row0 * lda2; u.B = Wt + (size_t)u.e * wstride + (size_t)u.pn * BM * K2; return true;
    }
    static constexpr bool GATHER = GATHER_;
    __device__ __forceinline__ unsigned rowoff(const Unit& u, int r) const { return GATHER_ ? (unsigned)slot_tok[u.row0 + r] * lda2 : (unsigned)r * lda2; }
};

template <class Epi, class Sched>
__device__ __forceinline__ void gemm_phase(const Frame& F, const int K_, const Sched& S, const Epi& E) {
    LAS unsigned char* lds = F.lds;
    int K = K_; asm volatile("" : "+s"(K));
    const int tid = F.tid, wid = __builtin_amdgcn_readfirstlane(tid >> 6), lane = tid & 63, wr = wid >> 2, wc = wid & 3, fr = lane & 15, fq = lane >> 4;
    const int nt = K / BK;
    int RA[2]; unsigned CA[2], voffB[2];
#pragma unroll
    for (int i = 0; i < 2; ++i) { int R, C; stage_rc(tid * 16 + i * 8192, R, C); const int Rb = (R & ~31) + perm32(R & 31);
        RA[i] = R; CA[i] = (unsigned)C * 2u; voffB[i] = (unsigned)(Rb * K + C) * 2u; }
    const size_t kstep = (size_t)(BK * 2);
    const size_t hstepB = (size_t)HALF * K * 2;
    size_t hstepA = 0; if constexpr (!Sched::GATHER) hstepA = (size_t)S.rowoff(Unit{}, HALF);
    const unsigned ldsw = (unsigned)wid * 1024u;
    const int aoff = lds_byte(wr * 64 + fr, fq * 8), boff = lds_byte(wc * 32 + fr, fq * 8);
#define G8_SA(b, h) (((b) * 2 + (h)) * HTB)
#define G8_SB(b, h) ((4 + (b) * 2 + (h)) * HTB)
#define G8_STAGE(bufoff, gbase, voff) do { _Pragma("unroll") for (int _i = 0; _i < 2; ++_i) \
        __builtin_amdgcn_global_load_lds((const unsigned*)((const char*)(gbase) + (voff)[_i]), (LAS unsigned*)(lds + (bufoff) + ldsw + _i * 8192), 16, 0, 0); } while (0)
#define G8_STA(bufoff, gbase, h, V0, V1) do { if constexpr (Sched::GATHER) { if (h) G8_STAGE(bufoff, gbase, V1); else G8_STAGE(bufoff, gbase, V0); } else { G8_STAGE(bufoff, (gbase) + (h) * hstepA, vA0); } } while (0)
#define G8_LDA(dst, b, h) do { _Pragma("unroll") for (int m = 0; m < 4; ++m) _Pragma("unroll") for (int k = 0; k < 2; ++k) dst[m][k] = *(const LAS bf16x8*)(lds + G8_SA(b, h) + aoff + m * 2048 + k * 1024); } while (0)
#define G8_LDB(dst, b, h) do { _Pragma("unroll") for (int n = 0; n < 2; ++n) _Pragma("unroll") for (int k = 0; k < 2; ++k) dst[n][k] = *(const LAS bf16x8*)(lds + G8_SB(b, h) + boff + n * 2048 + k * 1024); } while (0)
#define G8_MMA(ai, bj, At, Bt) do { __builtin_amdgcn_s_setprio(1); _Pragma("unroll") for (int m = 0; m < 4; ++m) _Pragma("unroll") for (int n = 0; n < 2; ++n) _Pragma("unroll") for (int k = 0; k < 2; ++k) \
        acc[ai][bj][m][n] = __builtin_amdgcn_mfma_f32_16x16x32_bf16(Bt[n][k], At[m][k], acc[ai][bj][m][n], 0, 0, 0); __builtin_amdgcn_s_setprio(0); } while (0)
#define G8_WAIT_V(n) asm volatile("s_waitcnt vmcnt(" #n ")" ::: "memory")
#define G8_WAIT_L(n) asm volatile("s_waitcnt lgkmcnt(" #n ")" ::: "memory")
#define G8_BAR __builtin_amdgcn_s_barrier()
#define G8_SCHED __builtin_amdgcn_sched_barrier(0)
    Unit cur, nxt; int ui = 0;
    if (!S.next(0, cur)) return;
    Acc acc;
#pragma unroll
    for (int a = 0; a < 2; ++a)
#pragma unroll
        for (int b = 0; b < 2; ++b)
#pragma unroll
            for (int m = 0; m < 4; ++m)
#pragma unroll
                for (int n = 0; n < 2; ++n) acc[a][b][m][n] = (f32x4){0.f, 0.f, 0.f, 0.f};
    bf16x8 At[4][2], B0[2][2], B1[2][2];
    unsigned vA0[2], vA1[2], nA0[2], nA1[2];
#pragma unroll
    for (int i = 0; i < 2; ++i) { vA0[i] = S.rowoff(cur, RA[i]) + CA[i]; vA1[i] = S.rowoff(cur, HALF + RA[i]) + CA[i]; }
    const char* cA = cur.A; const char* cB = cur.B;
    G8_STAGE(G8_SB(0, 0), cB, voffB); G8_STA(G8_SA(0, 0), cA, 0, vA0, vA1); G8_STAGE(G8_SB(0, 1), cB + hstepB, voffB); G8_STA(G8_SA(0, 1), cA, 1, vA0, vA1);
    if (wr == 1) G8_BAR;
    G8_WAIT_V(4); G8_BAR;
    G8_STAGE(G8_SB(1, 0), cB + kstep, voffB); G8_STA(G8_SA(1, 0), cA + kstep, 0, vA0, vA1); G8_STAGE(G8_SB(1, 1), cB + hstepB + kstep, voffB);
    G8_WAIT_V(6); G8_BAR;
    for (;;) {
        const bool has_next = S.next(ui + 1, nxt);
        const char* nAp = has_next ? nxt.A : cA; const char* nBp = has_next ? nxt.B : cB;
#pragma unroll
        for (int i = 0; i < 2; ++i) { nA0[i] = has_next ? S.rowoff(nxt, RA[i]) + CA[i] : vA0[i]; nA1[i] = has_next ? S.rowoff(nxt, HALF + RA[i]) + CA[i] : vA1[i]; }
        for (int t = 0; t < nt; t += 2) {
            const bool last = (t == nt - 2);
            const char* a1 = cA + (size_t)(t + 1) * kstep;
            const char* a2 = last ? nAp : cA + (size_t)(t + 2) * kstep; const char* b2 = last ? nBp : cB + (size_t)(t + 2) * kstep;
            const char* a3 = a2 + kstep; const char* b3 = b2 + kstep;
            unsigned w0[2], w1[2];
#pragma unroll
            for (int i = 0; i < 2; ++i) { w0[i] = last ? nA0[i] : vA0[i]; w1[i] = last ? nA1[i] : vA1[i]; }
            G8_LDB(B0, 0, 0); G8_SCHED; G8_LDA(At, 0, 0); G8_STA(G8_SA(1, 1), a1, 1, vA0, vA1);
            G8_WAIT_L(8); G8_BAR; G8_WAIT_L(0); G8_MMA(0, 0, At, B0); G8_BAR; G8_SCHED;
            G8_LDB(B1, 0, 1); G8_STAGE(G8_SB(0, 0), b2, voffB);
            G8_BAR; G8_WAIT_L(0); G8_MMA(0, 1, At, B1); G8_BAR;
            G8_LDA(At, 0, 1); G8_STA(G8_SA(0, 0), a2, 0, w0, w1);
            G8_BAR; G8_WAIT_L(0); G8_MMA(1, 0, At, B0); G8_BAR; G8_SCHED;
            G8_STAGE(G8_SB(0, 1), b2 + hstepB, voffB);
            G8_WAIT_V(6); G8_BAR; G8_MMA(1, 1, At, B1); G8_BAR;
            G8_LDB(B0, 1, 0); G8_SCHED; G8_LDA(At, 1, 0); G8_STA(G8_SA(0, 1), a2, 1, w0, w1);
            G8_WAIT_L(8); G8_BAR; G8_WAIT_L(0); G8_MMA(0, 0, At, B0); G8_BAR; G8_SCHED;
            G8_LDB(B1, 1, 1); G8_STAGE(G8_SB(1, 0), b3, voffB);
            G8_BAR; G8_WAIT_L(0); G8_MMA(0, 1, At, B1); G8_BAR;
            G8_LDA(At, 1, 1); G8_STA(G8_SA(1, 0), a3, 0, w0, w1);
            G8_BAR; G8_WAIT_L(0); G8_MMA(1, 0, At, B0); G8_BAR; G8_SCHED;
            G8_STAGE(G8_SB(1, 1), b3 + hstepB, voffB);
            G8_WAIT_V(6); G8_BAR; G8_MMA(1, 1, At, B1); G8_BAR;
        }
        E(acc, cur, wr, wc, fr, fq);
        if (!has_next) break;
#pragma unroll
        for (int a = 0; a < 2; ++a)
#pragma unroll
            for (int b = 0; b < 2; ++b)
#pragma unroll
                for (int m = 0; m < 4; ++m)
#pragma unroll
                    for (int n = 0; n < 2; ++n) acc[a][b][m][n] = (f32x4){0.f, 0.f, 0.f, 0.f};
        cur = nxt; cA = nAp; cB = nBp; ++ui;
#pragma unroll
        for (int i = 0; i < 2; ++i) { vA0[i] = nA0[i]; vA1[i] = nA1[i]; }
    }
    G8_WAIT_V(0);
    if (wr == 0) G8_BAR;
    G8_BAR;
#undef G8_SA
#undef G8_SB
#undef G8_STAGE
#undef G8_STA
#undef G8_LDA
#undef G8_LDB
#undef G8_MMA
#undef G8_WAIT_V
#undef G8_WAIT_L
#undef G8_BAR
#undef G8_SCHED
}

__device__ __forceinline__ u32x4 pack_acc8(const f32x4 v0, const f32x4 v1) { u32x4 w; w.x = cvt_pk_bf16(v0[0], v0[1]); w.y = cvt_pk_bf16(v0[2], v0[3]); w.z = cvt_pk_bf16(v1[0], v1[1]); w.w = cvt_pk_bf16(v1[2], v1[3]); return w; }

struct EpiPlain {
    bf16_t* O; int ldc;
    __device__ __forceinline__ void operator()(Acc& acc, const Unit& u, int wr, int wc, int fr, int fq) const {
        const int row0 = u.pm * BM + wr * 64 + fr, col0 = u.pn * BM + wc * 32 + 8 * fq;
#pragma unroll
        for (int ai = 0; ai < 2; ++ai)
#pragma unroll
            for (int m = 0; m < 4; ++m) { bf16_t* rowp = O + (size_t)(row0 + ai * HALF + m * 16) * ldc + col0;
#pragma unroll
                for (int bj = 0; bj < 2; ++bj) *(u32x4*)(rowp + bj * HALF) = pack_acc8(acc[ai][bj][m][0], acc[ai][bj][m][1]); }
    }
};

struct EpiQKV {
    bf16_t* Qc; bf16_t* Kc; bf16_t* Vt;
    __device__ __forceinline__ void operator()(Acc& acc, const Unit& u, int wr, int wc, int fr, int fq) const {
        const int which = u.pn >> 2, tok0 = u.pm * BM + wr * 64 + fr;
        const int b = tok0 >> 11;
#pragma unroll
        for (int ai = 0; ai < 2; ++ai)
#pragma unroll
            for (int m = 0; m < 4; ++m) { const int s = (tok0 + ai * HALF + m * 16) & (SEQ - 1);
#pragma unroll
                for (int bj = 0; bj < 2; ++bj) { const int h = (u.pn & 3) * 4 + 2 * bj + (wc >> 1), d0 = (wc & 1) * 32 + 8 * fq;
                    if (which < 2) { bf16_t* dst = (which == 0 ? Qc : Kc) + ((size_t)(b * 16 + h) * SEQ + s) * 64 + d0;
                        *(u32x4*)dst = pack_acc8(acc[ai][bj][m][0], acc[ai][bj][m][1]); }
                    else { bf16_t* dst = Vt + ((size_t)(b * 16 + h) * 64 + d0) * SEQ + s;
#pragma unroll
                        for (int n = 0; n < 2; ++n)
#pragma unroll
                            for (int jj = 0; jj < 4; ++jj) dst[(size_t)(4 * n + jj) * SEQ] = (bf16_t)(cvt_pk_bf16(acc[ai][bj][m][n][jj], 0.f) & 0xffffu); } } }
    }
};

struct EpiEvenIn {
    bf16_t* H; bf16_t* KR; float* ssq; const float* ropeA; const float* ropeB;
    __device__ __forceinline__ void operator()(Acc& acc, const Unit& u, int wr, int wc, int fr, int fq) const {
        const int row0 = u.pm * BM + wr * 64 + fr, col0 = u.pn * BM + wc * 32 + 8 * fq;
        if (u.pn < 4 && (wc & 1) == 0) {
#pragma unroll
            for (int ai = 0; ai < 2; ++ai)
#pragma unroll
                for (int m = 0; m < 4; ++m) { const int pos = (row0 + ai * HALF + m * 16) & (SEQ - 1);
                    const f32x4 c0 = *(const f32x4*)(ropeA + pos * 8), c1 = *(const f32x4*)(ropeA + pos * 8 + 4);
                    const f32x4 s0 = *(const f32x4*)(ropeA + SEQ * 8 + pos * 8), s1 = *(const f32x4*)(ropeA + SEQ * 8 + pos * 8 + 4);
#pragma unroll
                    for (int bj = 0; bj < 2; ++bj)
#pragma unroll
                        for (int n = 0; n < 2; ++n) { const f32x4 own = acc[ai][bj][m][n]; f32x4 oth;
#pragma unroll
                            for (int j = 0; j < 4; ++j) oth[j] = __shfl_xor(own[j], 16);
                            const f32x4 cs = n ? c1 : c0, sn = n ? s1 : s0;
                            if (fq == 0) acc[ai][bj][m][n] = own * cs - oth * sn;
                            else if (fq == 1) acc[ai][bj][m][n] = own * cs + oth * sn; } }
        }
        if (u.pn >= 6) {
#pragma unroll
            for (int ai = 0; ai < 2; ++ai)
#pragma unroll
                for (int m = 0; m < 4; ++m) { float s = 0.f;
#pragma unroll
                    for (int bj = 0; bj < 2; ++bj) if (u.pn == 6 || bj == 0)
#pragma unroll
                        for (int n = 0; n < 2; ++n) { const f32x4 x = acc[ai][bj][m][n]; s += (x[0] * x[0] + x[1] * x[1]) + (x[2] * x[2] + x[3] * x[3]); }
                    s += __shfl_xor(s, 16); s += __shfl_xor(s, 32);
                    if (fq == 0) ssq[(size_t)(row0 + ai * HALF + m * 16) * 8 + (u.pn == 6 ? 0 : 4) + wc] = s; }
        }
        if (u.pn == 7 && wc == 0) {
#pragma unroll
            for (int ai = 0; ai < 2; ++ai)
#pragma unroll
                for (int m = 0; m < 4; ++m) { const int row = row0 + ai * HALF + m * 16, pos = row & (SEQ - 1); f32x4 o[2];
#pragma unroll
                    for (int n = 0; n < 2; ++n) { const f32x4 own = acc[ai][1][m][n]; f32x4 oth;
#pragma unroll
                        for (int j = 0; j < 4; ++j) oth[j] = __shfl_xor(own[j], 32);
                        const int i0 = 8 * (fq & 1) + 4 * n;
                        const f32x4 cs = *(const f32x4*)(ropeB + pos * 16 + i0), sn = *(const f32x4*)(ropeB + SEQ * 16 + pos * 16 + i0);
                        o[n] = (fq < 2) ? own * cs - oth * sn : own * cs + oth * sn; }
                    *(u32x4*)(KR + (size_t)row * 32 + 8 * fq) = pack_acc8(o[0], o[1]); }
        }
#pragma unroll
        for (int ai = 0; ai < 2; ++ai)
#pragma unroll
            for (int m = 0; m < 4; ++m) { bf16_t* rowp = H + (size_t)(row0 + ai * HALF + m * 16) * HLD + col0;
#pragma unroll
                for (int bj = 0; bj < 2; ++bj) *(u32x4*)(rowp + bj * HALF) = pack_acc8(acc[ai][bj][m][0], acc[ai][bj][m][1]); }
    }
};

template <int MODE> struct EpiMla {
    bf16_t* O; const float* ssq;
    __device__ __forceinline__ void operator()(Acc& acc, const Unit& u, int wr, int wc, int fr, int fq) const {
        const int row0 = u.pm * BM + wr * 64 + fr, col0 = u.pn * BM + wc * 32 + 8 * fq;
        constexpr int ldc = MODE == 0 ? 768 : 1024;
#pragma unroll
        for (int ai = 0; ai < 2; ++ai)
#pragma unroll
            for (int m = 0; m < 4; ++m) { const int row = row0 + ai * HALF + m * 16;
                const f32x4 p = *(const f32x4*)(ssq + (size_t)row * 8 + (MODE == 0 ? 0 : 4));
                const float rstd = 1.0f / sqrtf(((p[0] + p[1]) + (p[2] + p[3])) * (MODE == 0 ? 1.0f / 256.0f : 1.0f / 128.0f) + RMS_EPS);
                bf16_t* rowp = O + (size_t)row * ldc + col0;
#pragma unroll
                for (int bj = 0; bj < 2; ++bj) *(u32x4*)(rowp + bj * HALF) = pack_acc8(acc[ai][bj][m][0] * rstd, acc[ai][bj][m][1] * rstd);
                asm volatile("" ::: "memory"); }
    }
};

struct EpiMoe1 {
    bf16_t* Hdn;
    __device__ __forceinline__ void operator()(Acc& acc, const Unit& u, int wr, int wc, int fr, int fq) const {
        const int row0 = u.row0 + wr * 64 + fr, col0 = u.pn * 128 + wc * 32 + 8 * fq;
#pragma unroll
        for (int ai = 0; ai < 2; ++ai)
#pragma unroll
            for (int m = 0; m < 4; ++m) { f32x4 h[2];
#pragma unroll
                for (int n = 0; n < 2; ++n)
#pragma unroll
                    for (int j = 0; j < 4; ++j) { const float g = acc[ai][0][m][n][j], up = acc[ai][1][m][n][j]; h[n][j] = g / (1.0f + __expf(-g)) * up; }
                *(u32x4*)(Hdn + (size_t)(row0 + ai * HALF + m * 16) * DEXP + col0) = pack_acc8(h[0], h[1]); }
    }
};
struct EpiMoe2 {
    bf16_t* Y; const float* slot_g; const int* slot_dst;
    __device__ __forceinline__ void operator()(Acc& acc, const Unit& u, int wr, int wc, int fr, int fq) const {
        const int row0 = u.row0 + wr * 64 + fr, col0 = u.pn * BM + wc * 32 + 8 * fq;
#pragma unroll
        for (int ai = 0; ai < 2; ++ai)
#pragma unroll
            for (int m = 0; m < 4; ++m) { const int slot = row0 + ai * HALF + m * 16; const int dst = slot_dst[slot]; const float g = slot_g[slot];
                if (dst >= 0) { bf16_t* rowp = Y + (size_t)dst * DM + col0;
#pragma unroll
                    for (int bj = 0; bj < 2; ++bj) *(u32x4*)(rowp + bj * HALF) = pack_acc8(acc[ai][bj][m][0] * g, acc[ai][bj][m][1] * g); } }
    }
};
}

struct Args { const float* in[26]; float* out; unsigned char* ws; int lo, hi; };
enum { IN_X = 0, IN_EWIN, IN_LQ1, IN_LK1, IN_LQ2, IN_LK2, IN_SUBLN, IN_QNG, IN_WUQ, IN_KVNG, IN_WUKV, IN_EWO, IN_OWQKV, IN_RELB, IN_OWO,
       IN_LN1G, IN_LN1B, IN_LN2G, IN_LN2B, IN_WRG, IN_BRG, IN_WRE, IN_BRE, IN_WG, IN_WU, IN_WD };

__device__ __forceinline__ Frame fresh(const Frame& F) { Frame R = F; int wv = F.wave, g = F.G, b = F.bid; asm volatile("" : "+s"(wv), "+s"(g), "+s"(b));
    int ln = (int)__builtin_amdgcn_mbcnt_hi(~0u, __builtin_amdgcn_mbcnt_lo(~0u, 0u)); asm volatile("" : "+v"(ln));
    __builtin_assume(ln >= 0 && ln < 64); __builtin_assume(wv >= 0 && wv < NTHREADS / 64); __builtin_assume(g > 0 && g <= 1024); __builtin_assume(b >= 0 && b < g);
    R.tid = wv * 64 + ln; R.lane = ln; R.wave = wv; R.G = g; R.bid = b; return R; }
__device__ __forceinline__ Args fresh(const Args& a) { Args r = a; unsigned char* w = a.ws; asm volatile("" : "+s"(w)); r.ws = w; return r; }

__device__ __forceinline__ void tr_tile(const Frame& F, const float* src, int ldsrc, int Kv, int Nv, int k0, int n0, bf16_t* dst, int lddst, int rowmap, const float* scale) {
    LAS float* T = (LAS float*)F.lds;
    __syncthreads();
#pragma unroll
    for (int it = 0; it < 8; ++it) { const int e = it * NTHREADS + F.tid, i = e >> 6, j = e & 63; const int k = k0 + i, n = n0 + j;
        float v = 0.f; if (k < Kv && n < Nv) { v = src[(size_t)k * ldsrc + n]; if (scale) v *= scale[k]; }
        T[i * 65 + j] = v; }
    __syncthreads();
    {
        const int j = F.tid >> 3, i0 = (F.tid & 7) * 8; float f[8];
#pragma unroll
        for (int q = 0; q < 8; ++q) f[q] = T[(i0 + q) * 65 + j];
        int n = n0 + j; if (rowmap) n = (n >> 7) * 256 + (n & 127) + (rowmap == 2 ? 128 : 0);
        *(u32x4*)(dst + (size_t)n * lddst + k0 + i0) = pack8(f); }
}
__device__ __forceinline__ void tr_matrix(const Frame& F, int& cursor, const float* src, int ldsrc, int Kv, int Nv, int Kp, int Np, bf16_t* dst, int lddst, int rowmap, const float* scale) {
    const int tk = Kp / 64, tn = Np / 64, ntile = tk * tn;
    int first = (F.bid - cursor % F.G + F.G) % F.G;
    for (int t = first; t < ntile; t += F.G) tr_tile(F, src, ldsrc, Kv, Nv, (t / tn) * 64, (t % tn) * 64, dst, lddst, rowmap, scale);
    cursor += ntile;
}

__device__ __forceinline__ void phase_prologue(const Frame& F, const Args& a) {
    unsigned char* ws = a.ws;
    { const float* x = a.in[IN_X]; bf16_t* X = (bf16_t*)(ws + WS_X); const size_t n8 = (size_t)NTOK * DM / 8;
      for (size_t i = (size_t)F.bid * NTHREADS + F.tid; i < n8; i += (size_t)F.G * NTHREADS) { const f32x4 v0 = *(const f32x4*)(x + i * 8), v1 = *(const f32x4*)(x + i * 8 + 4); *(u32x4*)(X + i * 8) = g8::pack_acc8(v0, v1); } }
    { float* ra = (float*)(ws + WS_ROPEA); float* rb = (float*)(ws + WS_ROPEB);
      for (int i = F.bid * NTHREADS + F.tid; i < SEQ * 8; i += F.G * NTHREADS) { const int pos = i >> 3, f = i & 7; const float inv = powf(500000.0f, -(float)(2 * f) / 16.0f); const float ang = (float)pos * inv; ra[i] = cosf(ang); ra[SEQ * 8 + i] = sinf(ang); }
      for (int i = F.bid * NTHREADS + F.tid; i < SEQ * 16; i += F.G * NTHREADS) { const int pos = i >> 4, f = i & 15; const float inv = powf(500000.0f, -(float)(2 * f) / 32.0f); const float ang = (float)pos * inv; rb[i] = cosf(ang); rb[SEQ * 16 + i] = sinf(ang); } }
    { float* wr = (float*)(ws + WS_WR); const float* wrg = a.in[IN_WRG]; const float* wre = a.in[IN_WRE];
      for (int i = F.bid * NTHREADS + F.tid; i < DEPTH * 36 * DM; i += F.G * NTHREADS) { const int l = i / (36 * DM), r = i % (36 * DM), j = r / DM, k = r % DM;
          wr[i] = j < 4 ? wrg[((size_t)l * DM + k) * 4 + j] : wre[((size_t)l * DM + k) * 32 + (j - 4)]; } }
    if (F.bid == 0 && F.tid < 2) { const int jl = F.tid; float d1 = 0.f, d2 = 0.f;
        for (int i = 0; i < 64; ++i) { d1 += a.in[IN_LQ1][jl * 64 + i] * a.in[IN_LK1][jl * 64 + i]; d2 += a.in[IN_LQ2][jl * 64 + i] * a.in[IN_LK2][jl * 64 + i]; }
        const float lambda_init = 0.8f - 0.6f * expf(-0.3f * (float)(2 * jl));
        ((float*)(ws + WS_LAM))[jl] = expf(d1) - expf(d2) + lambda_init; }
    int cur = 0;
    for (int l = 0; l < 2; ++l) {
        tr_matrix(F, cur, a.in[IN_EWIN] + (size_t)l * DM * EVEN_IN, EVEN_IN, DM, EVEN_IN, DM, HLD, (bf16_t*)(ws + WS_WIN) + (size_t)l * HLD * DM, DM, 0, nullptr);
        tr_matrix(F, cur, a.in[IN_WUQ] + (size_t)l * 256 * 768, 768, 256, 768, 256, 768, (bf16_t*)(ws + WS_WUQ) + (size_t)l * 768 * 256, 256, 0, a.in[IN_QNG] + l * 256);
        tr_matrix(F, cur, a.in[IN_WUKV] + (size_t)l * 128 * 1024, 1024, 128, 1024, 256, 1024, (bf16_t*)(ws + WS_WUKV) + (size_t)l * 1024 * 256, 256, 0, a.in[IN_KVNG] + l * 128);
        tr_matrix(F, cur, a.in[IN_EWO] + (size_t)l * DM * DM, DM, DM, DM, DM, DM, (bf16_t*)(ws + WS_WOE) + (size_t)l * DM * DM, DM, 0, nullptr);
        tr_matrix(F, cur, a.in[IN_OWQKV] + (size_t)l * DM * 3072, 3072, DM, 3072, DM, 3072, (bf16_t*)(ws + WS_WQKV) + (size_t)l * 3072 * DM, DM, 0, nullptr);
        tr_matrix(F, cur, a.in[IN_OWO] + (size_t)l * DM * DM, DM, DM, DM, DM, DM, (bf16_t*)(ws + WS_WOO) + (size_t)l * DM * DM, DM, 0, nullptr);
    }
    __syncthreads();
}
__device__ __forceinline__ void phase_moe_weights(const Frame& F, const Args& a, int layer) {
    unsigned char* ws = a.ws; int cur = 0;
    for (int e = 0; e < NEXP; ++e) {
        const size_t so = ((size_t)layer * NEXP + e) * DM * DEXP;
        tr_matrix(F, cur, a.in[IN_WG] + so, DEXP, DM, DEXP, DM, DEXP, (bf16_t*)(ws + WS_W13) + (size_t)e * 1024 * 1024, DM, 1, nullptr);
        tr_matrix(F, cur, a.in[IN_WU] + so, DEXP, DM, DEXP, DM, DEXP, (bf16_t*)(ws + WS_W13) + (size_t)e * 1024 * 1024, DM, 2, nullptr);
        tr_matrix(F, cur, a.in[IN_WD] + so, DM, DEXP, DM, DEXP, DM, (bf16_t*)(ws + WS_W2) + (size_t)e * 1024 * 512, DEXP, 0, nullptr);
    }
    __syncthreads();
}

template <int MODE>
__device__ __forceinline__ void phase_ln(const Frame& F, const Args& a, int layer, bool last_layer) {
    unsigned char* ws = a.ws;
    bf16_t* X = (bf16_t*)(ws + WS_X);
    const bf16_t* Ra = MODE == 0 ? (const bf16_t*)(ws + WS_R1) : (const bf16_t*)(ws + WS_R2);
    const float* gam = a.in[MODE == 0 ? IN_LN1G : IN_LN2G] + layer * DM; const float* bet = a.in[MODE == 0 ? IN_LN1B : IN_LN2B] + layer * DM;
    const float* WR = (const float*)(ws + WS_WR) + (size_t)layer * 36 * DM;
    LAS int* hist = (LAS int*)F.lds;
    for (int chunk = F.bid; chunk < NTOK / 256; chunk += F.G) {
        if (MODE == 0) { __syncthreads(); if (F.tid < NEXP) hist[F.tid] = 0; __syncthreads(); }
        for (int rr = F.wave; rr < 256; rr += NTHREADS / 64) {
            const int row = chunk * 256 + rr; float y[16];
#pragma unroll
            for (int hh = 0; hh < 2; ++hh) { const int c = hh * 512 + F.lane * 8; float xv[8], rv[8];
                unpack8(*(const u32x4*)(X + (size_t)row * DM + c), xv);
                if (MODE == 0) unpack8(*(const u32x4*)(Ra + (size_t)row * DM + c), rv);
                else { float r0[8], r1[8]; unpack8(*(const u32x4*)(Ra + (size_t)row * 2 * DM + c), r0); unpack8(*(const u32x4*)(Ra + (size_t)row * 2 * DM + DM + c), r1);
#pragma unroll
                    for (int q = 0; q < 8; ++q) rv[q] = r0[q] + r1[q]; }
#pragma unroll
                for (int q = 0; q < 8; ++q) y[hh * 8 + q] = DN_ALPHA * xv[q] + rv[q]; }
            float s = 0.f;
#pragma unroll
            for (int q = 0; q < 16; ++q) s += y[q];
            const float mean = wave_sum(s) * (1.0f / DM);
            float v = 0.f;
#pragma unroll
            for (int q = 0; q < 16; ++q) { const float d = y[q] - mean; v += d * d; }
            const float rstd = 1.0f / sqrtf(wave_sum(v) * (1.0f / DM) + LN_EPS);
#pragma unroll
            for (int hh = 0; hh < 2; ++hh) { const int c = hh * 512 + F.lane * 8;
                const f32x4 g0 = *(const f32x4*)(gam + c), g1 = *(const f32x4*)(gam + c + 4), b0 = *(const f32x4*)(bet + c), b1 = *(const f32x4*)(bet + c + 4);
#pragma unroll
                for (int q = 0; q < 4; ++q) { y[hh * 8 + q] = (y[hh * 8 + q] - mean) * rstd * g0[q] + b0[q]; y[hh * 8 + 4 + q] = (y[hh * 8 + 4 + q] - mean) * rstd * g1[q] + b1[q]; } }
            if (MODE == 1 && last_layer) {
#pragma unroll
                for (int hh = 0; hh < 2; ++hh) { float* o = a.out + (size_t)row * DM + hh * 512 + F.lane * 8;
                    *(f32x4*)o = (f32x4){y[hh * 8], y[hh * 8 + 1], y[hh * 8 + 2], y[hh * 8 + 3]}; *(f32x4*)(o + 4) = (f32x4){y[hh * 8 + 4], y[hh * 8 + 5], y[hh * 8 + 6], y[hh * 8 + 7]}; }
            } else {
#pragma unroll
                for (int hh = 0; hh < 2; ++hh) { float t8[8];
#pragma unroll
                    for (int q = 0; q < 8; ++q) t8[q] = y[hh * 8 + q];
                    *(u32x4*)(X + (size_t)row * DM + hh * 512 + F.lane * 8) = pack8(t8); }
            }
            if (MODE == 0) {
                float mine = 0.f;
#pragma unroll 2
                for (int j = 0; j < 36; ++j) { float p = 0.f;
#pragma unroll
                    for (int hh = 0; hh < 2; ++hh) { const float* w = WR + (size_t)j * DM + hh * 512 + F.lane * 8; const f32x4 w0 = *(const f32x4*)w, w1 = *(const f32x4*)(w + 4);
#pragma unroll
                        for (int q = 0; q < 4; ++q) { p += y[hh * 8 + q] * w0[q]; p += y[hh * 8 + 4 + q] * w1[q]; } }
                    p = wave_sum(p); mine = (F.lane == j) ? p : mine; }
                { const float* brg = a.in[IN_BRG] + layer * 4; const float* bre = a.in[IN_BRE] + layer * 32;
                  mine += (F.lane < 4) ? brg[F.lane] : (F.lane < 36 ? bre[F.lane - 4] : 0.f); }
                float lg[4];
#pragma unroll
                for (int j = 0; j < 4; ++j) lg[j] = __shfl(mine, j);
                int grp = 0; float gm = lg[0];
#pragma unroll
                for (int j = 1; j < 4; ++j) if (lg[j] > gm) { gm = lg[j]; grp = j; }
                float gs = 0.f;
#pragma unroll
                for (int j = 0; j < 4; ++j) gs += __expf(lg[j] - gm);
                const float gw = 1.0f / gs;
                float le[8];
#pragma unroll
                for (int i = 0; i < 8; ++i) le[i] = __shfl(mine, 4 + grp * 8 + i);
                int i1 = 0; float m1 = le[0];
#pragma unroll
                for (int i = 1; i < 8; ++i) if (le[i] > m1) { m1 = le[i]; i1 = i; }
                int i2 = -1; float m2 = -3.0e38f;
#pragma unroll
                for (int i = 0; i < 8; ++i) if (i != i1 && le[i] > m2) { m2 = le[i]; i2 = i; }
                const float e2 = __expf(m2 - m1), den = 1.0f / (1.0f + e2);
                if (F.lane == 0) {
                    const int e0 = grp * 8 + i1, e1 = grp * 8 + i2;
                    int* ri = (int*)(ws + WS_ROUTE) + (size_t)row * 4; ri[0] = e0; ri[1] = e1; ((float*)ri)[2] = den * gw; ((float*)ri)[3] = e2 * den * gw;
                    atomicAdd((int*)&hist[e0], 1); atomicAdd((int*)&hist[e1], 1);
                }
            }
        }
        if (MODE == 0) { __syncthreads(); if (F.tid < NEXP) ((int*)(ws + WS_CNT))[chunk * NEXP + F.tid] = hist[F.tid]; }
    }
    __syncthreads();
}

__device__ __forceinline__ void phase_scatter(const Frame& F, const Args& a) {
    unsigned char* ws = a.ws;
    const int* cnt = (const int*)(ws + WS_CNT); int* tile = (int*)(ws + WS_TILE);
    int* slot_tok = (int*)(ws + WS_SLOT_TOK); float* slot_g = (float*)(ws + WS_SLOT_G); int* slot_dst = (int*)(ws + WS_SLOT_DST);
    LAS int* C = (LAS int*)F.lds;
    LAS int* total = C + 256 * NEXP;
    LAS int* tstart = total + NEXP;
    LAS int* base = tstart + NEXP + 1;
    LAS int* el = base + NEXP;
    __syncthreads();
    for (int i = F.tid; i < 256 * NEXP; i += NTHREADS) C[i] = cnt[i];
    __syncthreads();
    if (F.tid < NEXP) { int s = 0; for (int c = 0; c < 256; ++c) s += C[c * NEXP + F.tid]; total[F.tid] = s; }
    __syncthreads();
    if (F.tid == 0) { int t = 0; for (int e = 0; e < NEXP; ++e) { tstart[e] = t; t += (total[e] + 255) >> 8; } tstart[NEXP] = t; }
    __syncthreads();
    const int T = tstart[NEXP];
    if (F.bid == 0) { if (F.tid == 0) tile[0] = T; for (int e = 0; e < NEXP; ++e) for (int t = tstart[e] + F.tid; t < tstart[e + 1]; t += NTHREADS) tile[1 + t] = e; }
    for (int e = F.bid; e < NEXP; e += F.G) { const int s0 = tstart[e] * 256 + total[e], s1 = tstart[e + 1] * 256;
        for (int s = s0 + F.tid; s < s1; s += NTHREADS) { slot_tok[s] = 0; slot_g[s] = 0.f; slot_dst[s] = -1; } }
    for (int chunk = F.bid; chunk < NTOK / 256; chunk += F.G) {
        __syncthreads();
        if (F.tid < NEXP) { int s = 0; for (int c = 0; c < chunk; ++c) s += C[c * NEXP + F.tid]; base[F.tid] = tstart[F.tid] * 256 + s; }
        const int tok = chunk * 256 + (F.tid >> 1), k = F.tid & 1;
        const int* ri = (const int*)(ws + WS_ROUTE) + (size_t)tok * 4;
        const int e = ri[k]; const float g = ((const float*)ri)[2 + k];
        el[F.tid] = e;
        __syncthreads();
        int rank = 0;
        for (int q = 0; q < F.tid; ++q) rank += (el[q] == e) ? 1 : 0;
        const int slot = base[e] + rank;
        slot_tok[slot] = tok; slot_g[slot] = g; slot_dst[slot] = tok * 2 + k;
    }
    __syncthreads();
}

template <int DQK, int VP>
__device__ __forceinline__ void attn_keys64(const LAS float* Ks, const LAS float* Vs, const float (&q)[DQK], float (&o)[64], float& m, float& l, const float sc) {
#pragma unroll 1
    for (int jj = 0; jj < 64; ++jj) {
        float acc = 0.f; const LAS float* kr = Ks + jj * DQK;
#pragma unroll
        for (int d = 0; d < DQK; d += 4) { const f32x4 kv = *(const LAS f32x4*)(kr + d); acc += q[d] * kv[0] + q[d + 1] * kv[1] + q[d + 2] * kv[2] + q[d + 3] * kv[3]; }
        const float s = acc * sc, mx = fmaxf(m, s), corr = __builtin_amdgcn_exp2f(m - mx), p = __builtin_amdgcn_exp2f(s - mx);
        m = mx; l = l * corr + p; const LAS float* vr = Vs + jj * VP;
#pragma unroll
        for (int e = 0; e < 64; e += 4) { const f32x4 vv = *(const LAS f32x4*)(vr + e); o[e] = o[e] * corr + p * vv[0]; o[e + 1] = o[e + 1] * corr + p * vv[1]; o[e + 2] = o[e + 2] * corr + p * vv[2]; o[e + 3] = o[e + 3] * corr + p * vv[3]; }
    }
}
__device__ __forceinline__ void stage8(LAS float* dst, const bf16_t* src) { float f[8]; unpack8(*(const u32x4*)src, f); *(LAS f32x4*)dst = (f32x4){f[0], f[1], f[2], f[3]}; *(LAS f32x4*)(dst + 4) = (f32x4){f[4], f[5], f[6], f[7]}; }

__device__ __forceinline__ void attn_diff_naive(const Frame& F, const Args& a, int layer, int unit) {
    unsigned char* ws = a.ws; const bf16_t* H = (const bf16_t*)(ws + WS_R1); bf16_t* O = (bf16_t*)(ws + WS_R3); float* TS = (float*)(ws + WS_R1 + 256 * MiB);
    const int j = layer >> 1; const float lambda_init = 0.8f - 0.6f * expf(-0.3f * (float)layer);
    float d1 = 0.f, d2 = 0.f;
    for (int i = 0; i < 64; ++i) { d1 += a.in[IN_LQ1][j * 64 + i] * a.in[IN_LK1][j * 64 + i]; d2 += a.in[IN_LQ2][j * 64 + i] * a.in[IN_LK2][j * 64 + i]; }
    const float lam = expf(d1) - expf(d2) + lambda_init;
    const int qb = unit & 7, h = (unit >> 3) & 3, b = unit >> 5;
    const int ql = (F.tid & 31) + 32 * (F.tid >> 6), half = (F.tid >> 5) & 1;
    const size_t row = (size_t)b * SEQ + qb * 256 + ql;
    LAS float* Ks = (LAS float*)F.lds; LAS float* Vs = Ks + 64 * 64;
    const float sc = 0.125f * 1.4426950408889634f;
    float* stash = TS + row * 512 + h * 128 + half * 64;
#pragma unroll 1
    for (int st = 0; st < 2; ++st) {
        float o[64], q[64];
#pragma unroll
        for (int d = 0; d < 64; d += 8) { float f[8]; unpack8(*(const u32x4*)(H + row * HLD + h * 128 + st * 64 + d), f);
#pragma unroll
            for (int t = 0; t < 8; ++t) q[d + t] = f[t]; }
        float m = -INFINITY, l = 0.f;
#pragma unroll
        for (int e = 0; e < 64; ++e) o[e] = 0.f;
#pragma unroll 1
        for (int kt = 0; kt < SEQ / 64; ++kt) {
            __syncthreads();
            { const int key = F.tid >> 3, d8 = (F.tid & 7) * 8; const size_t krow = (size_t)b * SEQ + kt * 64 + key;
              stage8(Ks + key * 64 + d8, H + krow * HLD + 512 + h * 128 + st * 64 + d8);
              stage8(Vs + key * 128 + d8, H + krow * HLD + 1024 + h * 128 + d8); stage8(Vs + key * 128 + 64 + d8, H + krow * HLD + 1024 + h * 128 + 64 + d8); }
            __syncthreads();
            attn_keys64<64, 128>(Ks, Vs + half * 64, q, o, m, l, sc);
        }
        const float inv = 1.0f / l;
        if (st == 0) {
#pragma unroll
            for (int e = 0; e < 64; e += 4) *(f32x4*)(stash + e) = (f32x4){o[e] * inv, o[e + 1] * inv, o[e + 2] * inv, o[e + 3] * inv};
        } else {
            float ss = 0.f;
#pragma unroll
            for (int e = 0; e < 64; e += 4) { const f32x4 p0 = *(const f32x4*)(stash + e);
#pragma unroll
                for (int t = 0; t < 4; ++t) { o[e + t] = p0[t] - lam * (o[e + t] * inv); ss += o[e + t] * o[e + t]; } }
            ss += __shfl_xor(ss, 32);
            const float rs = 1.0f / sqrtf(ss * (1.0f / 128.0f) + RMS_EPS) * (1.0f - lambda_init);
            const float* g = a.in[IN_SUBLN] + j * 128 + half * 64;
#pragma unroll
            for (int e = 0; e < 64; e += 8) { float t8[8];
#pragma unroll
                for (int t = 0; t < 8; ++t) t8[t] = o[e + t] * rs * g[e + t];
                *(u32x4*)(O + row * DM + h * 128 + half * 64 + e) = pack8(t8); }
        }
    }
}
__device__ __forceinline__ void attn_mla_naive(const Frame& F, const Args& a, int unit) {
    unsigned char* ws = a.ws; const bf16_t* QB = (const bf16_t*)(ws + WS_R2); const bf16_t* KVB = QB + (size_t)NTOK * 768; const bf16_t* KR = KVB + (size_t)NTOK * 1024; bf16_t* O = (bf16_t*)(ws + WS_R3);
    const int qb = unit & 3, h = (unit >> 2) & 7, b = unit >> 5;
    const size_t row = (size_t)b * SEQ + qb * 512 + F.tid;
    LAS float* Ks = (LAS float*)F.lds; LAS float* Vs = Ks + 64 * 96;
    const float sc = 0.10206207261596575f * 1.4426950408889634f;
    float q[96], o[64];
#pragma unroll
    for (int d = 0; d < 96; d += 8) { float f[8]; unpack8(*(const u32x4*)(QB + row * 768 + h * 96 + d), f);
#pragma unroll
        for (int t = 0; t < 8; ++t) q[d + t] = f[t]; }
    { const float* rb = (const float*)(ws + WS_ROPEB); const int pos = (int)(row & (SEQ - 1));
#pragma unroll
      for (int i = 0; i < 16; i += 4) { const f32x4 cs = *(const f32x4*)(rb + pos * 16 + i), sn = *(const f32x4*)(rb + SEQ * 16 + pos * 16 + i);
#pragma unroll
          for (int t = 0; t < 4; ++t) { const float x1 = q[64 + i + t], x2 = q[80 + i + t]; q[64 + i + t] = x1 * cs[t] - x2 * sn[t]; q[80 + i + t] = x2 * cs[t] + x1 * sn[t]; } } }
    float m = -INFINITY, l = 0.f;
#pragma unroll
    for (int e = 0; e < 64; ++e) o[e] = 0.f;
#pragma unroll 1
    for (int kt = 0; kt < SEQ / 64; ++kt) {
        __syncthreads();
        { const int key = F.tid >> 3, d8 = (F.tid & 7) * 8; const size_t krow = (size_t)b * SEQ + kt * 64 + key;
          stage8(Ks + key * 96 + d8, KVB + krow * 1024 + h * 128 + d8);
          stage8(Vs + key * 64 + d8, KVB + krow * 1024 + h * 128 + 64 + d8);
          if (F.tid < 256) { const int key2 = F.tid >> 2, r8 = (F.tid & 3) * 8; stage8(Ks + key2 * 96 + 64 + r8, KR + ((size_t)b * SEQ + kt * 64 + key2) * 32 + r8); } }
        __syncthreads();
        attn_keys64<96, 64>(Ks, Vs, q, o, m, l, sc);
    }
    const float inv = 1.0f / l;
#pragma unroll
    for (int e = 0; e < 64; e += 8) { float t8[8];
#pragma unroll
        for (int t = 0; t < 8; ++t) t8[t] = o[e + t] * inv;
        *(u32x4*)(O + row * DM + 512 + h * 64 + e) = pack8(t8); }
}
__device__ __forceinline__ void attn_na_naive(const Frame& F, const Args& a, int layer, int unit) {
    unsigned char* ws = a.ws; const bf16_t* QKV = (const bf16_t*)(ws + WS_R1); bf16_t* O = (bf16_t*)(ws + WS_R3);
    const float* relb = a.in[IN_RELB] + (size_t)(layer >> 1) * 16 * 15 * 31;
    const int hh = unit & 1, r = (unit >> 1) & 31, b = unit >> 6;
    const int c = F.tid & 63, h = hh * 8 + (F.tid >> 6);
    const int r0 = min(max(r - 4, 0), 24), c0 = min(max(c - 8, 0), 48);
    const size_t row = (size_t)b * SEQ + r * 64 + c;
    const float LOG2E = 1.4426950408889634f;
    float q[64], o[64];
#pragma unroll
    for (int d = 0; d < 64; d += 8) { float f[8]; unpack8(*(const u32x4*)(QKV + row * 3072 + h * 64 + d), f);
#pragma unroll
        for (int t = 0; t < 8; ++t) q[d + t] = f[t]; }
    float m = -INFINITY, l = 0.f;
#pragma unroll
    for (int e = 0; e < 64; ++e) o[e] = 0.f;
#pragma unroll 1
    for (int ij = 0; ij < 128; ++ij) {
        const int i = ij >> 4, jj = ij & 15;
        const size_t krow = (size_t)b * SEQ + (r0 + i) * 64 + c0 + jj;
        const float bias = relb[((size_t)h * 15 + (r0 + i - r + 7)) * 31 + (c0 + jj - c + 15)];
        float acc = 0.f; const bf16_t* kp = QKV + krow * 3072 + 1024 + h * 64;
#pragma unroll
        for (int d = 0; d < 64; d += 8) { float f[8]; unpack8(*(const u32x4*)(kp + d), f);
#pragma unroll
            for (int t = 0; t < 8; ++t) acc += q[d + t] * f[t]; }
        const float s = (acc * 0.125f + bias) * LOG2E, mx = fmaxf(m, s), corr = __builtin_amdgcn_exp2f(m - mx), p = __builtin_amdgcn_exp2f(s - mx);
        m = mx; l = l * corr + p; const bf16_t* vp = kp + 1024;
#pragma unroll
        for (int e = 0; e < 64; e += 8) { float f[8]; unpack8(*(const u32x4*)(vp + e), f);
#pragma unroll
            for (int t = 0; t < 8; ++t) o[e + t] = o[e + t] * corr + p * f[t]; }
    }
    const float inv = 1.0f / l;
#pragma unroll
    for (int e = 0; e < 64; e += 8) { float t8[8];
#pragma unroll
        for (int t = 0; t < 8; ++t) t8[t] = o[e + t] * inv;
        *(u32x4*)(O + row * DM + h * 64 + e) = pack8(t8); }
}

namespace fa {
typedef float f32x16 __attribute__((ext_vector_type(16)));
typedef short s16x4 __attribute__((ext_vector_type(4)));
#define FA_SBAR() __builtin_amdgcn_sched_barrier(0)
__device__ __forceinline__ int crow(int r, int hi) { return (r & 3) + 8 * (r >> 2) + 4 * hi; }
constexpr float THR = 8.f;
template <int SCALE_E6> __device__ __forceinline__ void partialSM(f32x16& p0, f32x16& p1, float& m_reg, float& mn, float& alpha) {
    constexpr float SCALE = SCALE_E6 * 1e-6f, C = SCALE * 1.4426950408889634f;
    float pmax = p0[0];
#pragma unroll
    for (int r = 1; r < 16; ++r) pmax = fmaxf(pmax, p0[r]);
#pragma unroll
    for (int r = 0; r < 16; ++r) pmax = fmaxf(pmax, p1[r]);
    { auto rr = __builtin_amdgcn_permlane32_swap(__float_as_uint(pmax), __float_as_uint(pmax), false, false); pmax = fmaxf(__uint_as_float(rr[0]), __uint_as_float(rr[1])); }
    if (__builtin_expect(__all(pmax - m_reg <= THR / SCALE), 1)) { mn = m_reg; alpha = 1.f; }
    else { mn = fmaxf(m_reg, pmax); alpha = __builtin_amdgcn_exp2f((m_reg - mn) * C); m_reg = mn; }
    const float mnC = -mn * C;
#pragma unroll
    for (int r = 0; r < 16; ++r) p0[r] = fmaf(p0[r], C, mnC);
#pragma unroll
    for (int r = 0; r < 16; ++r) p1[r] = fmaf(p1[r], C, mnC);
#pragma unroll
    for (int r = 0; r < 16; ++r) p0[r] = __builtin_amdgcn_exp2f(p0[r]);
}
__device__ __forceinline__ void finishSM(f32x16& p0, f32x16& p1, float alpha, float& l_reg, bf16x8& pa0, bf16x8& pa1, bf16x8& pa2, bf16x8& pa3) {
#pragma unroll
    for (int r = 0; r < 16; ++r) p1[r] = __builtin_amdgcn_exp2f(p1[r]);
    float ps = 0;
#pragma unroll
    for (int r = 0; r < 16; ++r) ps += p0[r];
#pragma unroll
    for (int r = 0; r < 16; ++r) ps += p1[r];
    { auto rr = __builtin_amdgcn_permlane32_swap(__float_as_uint(ps), __float_as_uint(ps), false, false); ps = __uint_as_float(rr[0]) + __uint_as_float(rr[1]); }
    l_reg = l_reg * alpha + ps;
#define FA_PK4(P, BASE, OUT) do { unsigned a0 = cvt_pk_bf16(P[BASE + 0], P[BASE + 1]), a1 = cvt_pk_bf16(P[BASE + 2], P[BASE + 3]);   \
    unsigned b0 = cvt_pk_bf16(P[BASE + 4], P[BASE + 5]), b1 = cvt_pk_bf16(P[BASE + 6], P[BASE + 7]);                              \
    auto r0 = __builtin_amdgcn_permlane32_swap(a0, b0, false, false); auto r1 = __builtin_amdgcn_permlane32_swap(a1, b1, false, false); \
    u32x4 w = {r0[0], r1[0], r0[1], r1[1]}; OUT = *reinterpret_cast<bf16x8*>(&w); } while (0)
    FA_PK4(p0, 0, pa0); FA_PK4(p0, 8, pa1); FA_PK4(p1, 0, pa2); FA_PK4(p1, 8, pa3);
#undef FA_PK4
}
template <int NKS> __device__ __forceinline__ void qkt(f32x16& p0, f32x16& p1, const LAS char* Ks, const bf16x8 (&qr)[NKS], int r32, int hi) {
    p0 = f32x16{}; p1 = f32x16{};
#pragma unroll
    for (int d0 = 0; d0 < NKS; ++d0) {
        const bf16x8 b0 = *(const LAS bf16x8*)(Ks + ((2 * d0 + hi) * 64 + r32) * 16);
        const bf16x8 b1 = *(const LAS bf16x8*)(Ks + ((2 * d0 + hi) * 64 + 32 + r32) * 16);
        p0 = __builtin_amdgcn_mfma_f32_32x32x16_bf16(b0, qr[d0], p0, 0, 0, 0);
        p1 = __builtin_amdgcn_mfma_f32_32x32x16_bf16(b1, qr[d0], p1, 0, 0, 0); }
}
template <int NCB> __device__ __forceinline__ int v_st(int k, int c) { const int kk = (k & ~0xC) | ((k & 4) << 1) | ((k & 8) >> 1); return ((kk >> 3) * NCB + (c >> 5)) * 512 + ((kk & 7) * 32 + (c & 31)) * 2; }
__device__ __forceinline__ int v_rd_base(int lane) { return ((lane & 3) << 3) | (((lane >> 2) & 3) << 6) | (((lane >> 4) & 1) << 5) | (((lane >> 5) & 1) << 8); }
template <int NCB> constexpr int v_rd_off(int d0, int ks, int half) { return d0 * 512 + ks * (NCB * 1024) + half * (NCB * 512); }
template <int OFF> __device__ __forceinline__ s16x4 tr_read(int vb) { s16x4 r; asm volatile("ds_read_b64_tr_b16 %0, %1 offset:%2" : "=&v"(r) : "v"(vb), "i"(OFF) : "memory"); return r; }
template <int D0, int NCB> __device__ __forceinline__ void pv_one(f32x16& od, int vb, bf16x8 pa0, bf16x8 pa1, bf16x8 pa2, bf16x8 pa3) {
    const s16x4 l0 = tr_read<v_rd_off<NCB>(D0, 0, 0)>(vb), h0 = tr_read<v_rd_off<NCB>(D0, 0, 1)>(vb), l1 = tr_read<v_rd_off<NCB>(D0, 1, 0)>(vb), h1 = tr_read<v_rd_off<NCB>(D0, 1, 1)>(vb);
    const s16x4 l2 = tr_read<v_rd_off<NCB>(D0, 2, 0)>(vb), h2 = tr_read<v_rd_off<NCB>(D0, 2, 1)>(vb), l3 = tr_read<v_rd_off<NCB>(D0, 3, 0)>(vb), h3 = tr_read<v_rd_off<NCB>(D0, 3, 1)>(vb);
    asm volatile("s_waitcnt lgkmcnt(0)" ::: "memory"); FA_SBAR();
#define FA_PK(L, H) (bf16x8){L[0], L[1], L[2], L[3], H[0], H[1], H[2], H[3]}
    od = __builtin_amdgcn_mfma_f32_32x32x16_bf16(pa0, FA_PK(l0, h0), od, 0, 0, 0);
    od = __builtin_amdgcn_mfma_f32_32x32x16_bf16(pa1, FA_PK(l1, h1), od, 0, 0, 0);
    od = __builtin_amdgcn_mfma_f32_32x32x16_bf16(pa2, FA_PK(l2, h2), od, 0, 0, 0);
    od = __builtin_amdgcn_mfma_f32_32x32x16_bf16(pa3, FA_PK(l3, h3), od, 0, 0, 0);
#undef FA_PK
}
template <int NCB> __device__ __forceinline__ void pv_all(f32x16 (&o)[NCB], int vb, bf16x8 pa0, bf16x8 pa1, bf16x8 pa2, bf16x8 pa3) {
    pv_one<0, NCB>(o[0], vb, pa0, pa1, pa2, pa3); pv_one<1, NCB>(o[1], vb, pa0, pa1, pa2, pa3);
    if constexpr (NCB == 4) { pv_one<2, NCB>(o[2], vb, pa0, pa1, pa2, pa3); pv_one<3, NCB>(o[3], vb, pa0, pa1, pa2, pa3); }
}

template <int DQK, int DV, int SCALE_E6, int SDEPTH>
__device__ __forceinline__ void attn_stream(const Frame& F, const bf16_t* __restrict__ Qb, int LDQ, const bf16_t* __restrict__ Kh, int LDK, const bf16_t* __restrict__ KRh, const bf16_t* __restrict__ Vh, int LDV,
                                            const float* ropeB, int qpos0, f32x16 (&o)[DV / 32], float (&rli)[16]) {
    constexpr int NKS = DQK / 16, NCB = DV / 32, SHM_K = 64 * DQK * 2, SHM_V = 64 * DV * 2;
    const int tid = F.tid, wid = F.wave, lane = F.lane, r32 = lane & 31, hi = lane >> 5;
    LAS char* V_lds = (LAS char*)F.lds; LAS char* K_lds = V_lds + 2 * SHM_V;
    LAS float* wsl = (LAS float*)(K_lds + 2 * SHM_K) + wid * 64; LAS float* li_l = wsl; LAS float* al_l = wsl + 32;
    float m_reg = -1e30f, l_reg = 0.f; bf16x8 qr[NKS];
#pragma unroll
    for (int d = 0; d < NCB; ++d) o[d] = f32x16{};
    const bf16_t* Qw = Qb + (size_t)(wid * 32 + r32) * LDQ + hi * 8;
#pragma unroll
    for (int d0 = 0; d0 < NKS; ++d0) qr[d0] = *(const bf16x8*)(Qw + d0 * 16);
    if constexpr (DQK == 96) {
        const int pos = qpos0 + wid * 32 + r32; float x1[8], x2[8];
        unpack8(*(const u32x4*)&qr[4], x1); unpack8(*(const u32x4*)&qr[5], x2);
        const float* cp = ropeB + pos * 16 + 8 * hi; const float* sp = ropeB + SEQ * 16 + pos * 16 + 8 * hi;
#pragma unroll
        for (int jj = 0; jj < 8; ++jj) { const float c = cp[jj], sn = sp[jj], a = x1[jj], b = x2[jj]; x1[jj] = a * c - b * sn; x2[jj] = b * c + a * sn; }
        u32x4 w1 = pack8(x1), w2 = pack8(x2); qr[4] = *(bf16x8*)&w1; qr[5] = *(bf16x8*)&w2;
    }
    const int krow = (tid & 7) + 8 * (tid >> 6), kcs = (tid >> 3) & 7;
    const int rrow = (tid & 7) + 8 * ((tid >> 5) & 7), rcs = (tid >> 3) & 3;
    const int vr0 = (DV == 128) ? (tid >> 4) : (tid >> 3), vc = (DV == 128) ? (tid & 15) * 8 : (tid & 7) * 8;
    const int vst0 = v_st<NCB>(vr0, vc), vst1 = v_st<NCB>(32 + vr0, vc);
    const int vb0 = (int)(uintptr_t)V_lds + v_rd_base(lane);
    struct Slot { bf16x8 k0, kr, v0, v1; } sl[SDEPTH];
    constexpr int SE = 0, SO = SDEPTH - 1;
#define FA_SLOAD(i, key0) do { sl[i].k0 = *(const bf16x8*)(Kh + (size_t)((key0) + krow) * LDK + kcs * 8); \
        if constexpr (DQK == 96) sl[i].kr = *(const bf16x8*)(KRh + (size_t)((key0) + rrow) * 32 + rcs * 8); \
        sl[i].v0 = *(const bf16x8*)(Vh + (size_t)((key0) + vr0) * LDV + vc); \
        if constexpr (DV == 128) sl[i].v1 = *(const bf16x8*)(Vh + (size_t)((key0) + 32 + vr0) * LDV + vc); } while (0)
#define FA_SWRITE(b, i) do { *(LAS bf16x8*)(K_lds + (b) * SHM_K + (kcs * 64 + krow) * 16) = sl[i].k0; \
        if constexpr (DQK == 96) { if (tid < 256) *(LAS bf16x8*)(K_lds + (b) * SHM_K + ((8 + rcs) * 64 + rrow) * 16) = sl[i].kr; } \
        *(LAS bf16x8*)(V_lds + (b) * SHM_V + vst0) = sl[i].v0; \
        if constexpr (DV == 128) *(LAS bf16x8*)(V_lds + (b) * SHM_V + vst1) = sl[i].v1; } while (0)
#define FA_SWAIT() do { if constexpr (SDEPTH == 2) asm volatile("s_waitcnt vmcnt(3)" ::: "memory"); else asm volatile("s_waitcnt vmcnt(0)" ::: "memory"); } while (0)
#define FA_RESC(a) do { if (__any((a) < 1.f)) { if (hi == 0) al_l[r32] = (a); asm volatile("s_waitcnt lgkmcnt(0)" ::: "memory"); \
        _Pragma("unroll") for (int d = 0; d < NCB; ++d) _Pragma("unroll") for (int r = 0; r < 16; ++r) o[d][r] *= al_l[crow(r, hi)]; } } while (0)
    f32x16 pA0, pA1, pB0, pB1; float mnA, mnB, alA, alB; bf16x8 pa0, pa1, pa2, pa3; constexpr int NT = SEQ / 64;
    FA_SLOAD(SE, 0); asm volatile("s_waitcnt vmcnt(0)" ::: "memory"); FA_SWRITE(0, SE); __syncthreads();
    qkt<NKS>(pA0, pA1, K_lds, qr, r32, hi); partialSM<SCALE_E6>(pA0, pA1, m_reg, mnA, alA);
    FA_SLOAD(SO, 64); if constexpr (SDEPTH == 2) FA_SLOAD(SE, 128);
    FA_SWAIT(); FA_SWRITE(1, SO); __syncthreads();
#pragma unroll 1
    for (int j = 1; j + 1 < NT; j += 2) {
        FA_SBAR(); qkt<NKS>(pB0, pB1, K_lds + SHM_K, qr, r32, hi);
        finishSM(pA0, pA1, alA, l_reg, pa0, pa1, pa2, pa3); FA_SBAR();
        FA_SLOAD(SO, (j + SDEPTH) * 64); FA_SBAR();
        pv_all<NCB>(o, vb0, pa0, pa1, pa2, pa3); partialSM<SCALE_E6>(pB0, pB1, m_reg, mnB, alB);
        __syncthreads(); FA_SWAIT(); FA_SWRITE(0, SE);
        FA_RESC(alB); __syncthreads();
        FA_SBAR(); qkt<NKS>(pA0, pA1, K_lds, qr, r32, hi);
        finishSM(pB0, pB1, alB, l_reg, pa0, pa1, pa2, pa3); FA_SBAR();
        if (SDEPTH == 1 || j + 3 < NT) FA_SLOAD(SE, (j + 1 + SDEPTH) * 64); FA_SBAR();
        pv_all<NCB>(o, vb0 + SHM_V, pa0, pa1, pa2, pa3); partialSM<SCALE_E6>(pA0, pA1, m_reg, mnA, alA);
        __syncthreads(); FA_SWAIT(); FA_SWRITE(1, SO);
        FA_RESC(alA); __syncthreads();
    }
    FA_SBAR(); qkt<NKS>(pB0, pB1, K_lds + SHM_K, qr, r32, hi);
    finishSM(pA0, pA1, alA, l_reg, pa0, pa1, pa2, pa3); FA_SBAR();
    pv_all<NCB>(o, vb0, pa0, pa1, pa2, pa3); partialSM<SCALE_E6>(pB0, pB1, m_reg, mnB, alB);
    __syncthreads(); FA_RESC(alB);
    finishSM(pB0, pB1, alB, l_reg, pa0, pa1, pa2, pa3); FA_SBAR();
    pv_all<NCB>(o, vb0 + SHM_V, pa0, pa1, pa2, pa3);
    if (hi == 0) li_l[r32] = l_reg;
    asm volatile("s_waitcnt lgkmcnt(0)" ::: "memory");
#pragma unroll
    for (int r = 0; r < 16; ++r) rli[r] = __builtin_amdgcn_rcpf(li_l[crow(r, hi)]);
#undef FA_SLOAD
#undef FA_SWRITE
#undef FA_SWAIT
#undef FA_RESC
}
}

__device__ __forceinline__ void attn_diff_mfma(const Frame& F, const Args& a, int layer, int unit) {
    unsigned char* ws = a.ws; const bf16_t* H = (const bf16_t*)(ws + WS_R1); bf16_t* O = (bf16_t*)(ws + WS_R3); float* TS = (float*)(ws + WS_R1 + 256 * MiB);
    const int jl = layer >> 1; const float lambda_init = 0.8f - 0.6f * expf(-0.3f * (float)layer);
    const float lam = ((const float*)(ws + WS_LAM))[jl];
    const int qb = unit & 7, h = (unit >> 3) & 3, b = unit >> 5;
    const size_t row0 = (size_t)b * SEQ + qb * 256, key0 = (size_t)b * SEQ;
    const int r32 = F.lane & 31, hi = F.lane >> 5;
#pragma unroll 1
    for (int st = 0; st < 2; ++st) {
        fa::f32x16 o[4]; float rli[16];
        __syncthreads();
        const Frame Fs = fresh(F);
        float* stash = TS + ((size_t)unit * NTHREADS + Fs.tid) * 64;
        fa::attn_stream<64, 128, 125000, 1>(Fs, H + row0 * HLD + h * 128 + st * 64, HLD, H + key0 * HLD + 512 + h * 128 + st * 64, HLD, nullptr, H + key0 * HLD + 1024 + h * 128, HLD, nullptr, 0, o, rli);
        if (st == 0) {
#pragma unroll
            for (int d = 0; d < 4; ++d)
#pragma unroll
                for (int r = 0; r < 16; r += 4) *(f32x4*)(stash + d * 16 + r) = (f32x4){o[d][r] * rli[r], o[d][r + 1] * rli[r + 1], o[d][r + 2] * rli[r + 2], o[d][r + 3] * rli[r + 3]};
        } else {
            float ss[16];
#pragma unroll
            for (int r = 0; r < 16; ++r) ss[r] = 0.f;
#pragma unroll
            for (int d = 0; d < 4; ++d)
#pragma unroll
                for (int r = 0; r < 16; r += 4) { const f32x4 p0 = *(const f32x4*)(stash + d * 16 + r);
#pragma unroll
                    for (int t = 0; t < 4; ++t) { const float v = p0[t] - lam * (o[d][r + t] * rli[r + t]); o[d][r + t] = v; ss[r + t] += v * v; } }
#pragma unroll
            for (int r = 0; r < 16; ++r) { float v = ss[r]; v += __shfl_xor(v, 1); v += __shfl_xor(v, 2); v += __shfl_xor(v, 4); v += __shfl_xor(v, 8); v += __shfl_xor(v, 16);
                ss[r] = 1.0f / sqrtf(v * (1.0f / 128.0f) + RMS_EPS) * (1.0f - lambda_init); }
            const float* g = a.in[IN_SUBLN] + jl * 128;
#pragma unroll
            for (int d = 0; d < 4; ++d) { const float gd = g[d * 32 + r32];
#pragma unroll
                for (int r = 0; r < 16; ++r) { const size_t row = row0 + F.wave * 32 + fa::crow(r, hi);
                    O[row * DM + h * 128 + d * 32 + r32] = (bf16_t)(cvt_pk_bf16(o[d][r] * ss[r] * gd, 0.f) & 0xffffu); } }
        }
    }
}
__device__ __forceinline__ void attn_mla_mfma(const Frame& F, const Args& a, int unit) {
    unsigned char* ws = a.ws; const bf16_t* QB = (const bf16_t*)(ws + WS_R2); const bf16_t* KVB = QB + (size_t)NTOK * 768; const bf16_t* KR = KVB + (size_t)NTOK * 1024; bf16_t* O = (bf16_t*)(ws + WS_R3);
    const int qb = unit & 7, h = (unit >> 3) & 7, b = unit >> 6;
    const size_t row0 = (size_t)b * SEQ + qb * 256, key0 = (size_t)b * SEQ;
    const int r32 = F.lane & 31, hi = F.lane >> 5;
    fa::f32x16 o[2]; float rli[16];
    __syncthreads();
    fa::attn_stream<96, 64, 102062, 1>(F, QB + row0 * 768 + h * 96, 768, KVB + key0 * 1024 + h * 128, 1024, KR + key0 * 32, KVB + key0 * 1024 + h * 128 + 64, 1024, (const float*)(ws + WS_ROPEB), qb * 256, o, rli);
#pragma unroll
    for (int d = 0; d < 2; ++d)
#pragma unroll
        for (int r = 0; r < 16; ++r) { const size_t row = row0 + F.wave * 32 + fa::crow(r, hi);
            O[row * DM + 512 + h * 64 + d * 32 + r32] = (bf16_t)(cvt_pk_bf16(o[d][r] * rli[r], 0.f) & 0xffffu); }
}

__device__ __forceinline__ void attn_na_mfma(const Frame& F, const Args& a, int layer, int unit) {
    unsigned char* ws = a.ws; const bf16_t* Qc = (const bf16_t*)(ws + WS_R1); const bf16_t* Kc = Qc + (size_t)NTOK * DM; const bf16_t* Vt = Kc + (size_t)NTOK * DM; bf16_t* O = (bf16_t*)(ws + WS_R3);
    const int rp = unit & 15, h = (unit >> 4) & 15, b = unit >> 8;
    const int r = rp * 2 + (F.wave >> 2), j = F.wave & 3, qi = F.lane & 15, g = F.lane >> 4, c = 16 * j + qi;
    const int r0 = min(max(r - 4, 0), 24), c0 = min(max(c - 8, 0), 48), cb = (j == 0) ? 0 : (j == 1) ? 8 : (j == 2) ? 24 : 32;
    const size_t bh = (size_t)(b * 16 + h);
    const float* relb = a.in[IN_RELB] + ((size_t)(layer >> 1) * 16 + h) * 465;
    const float LOG2E = 1.4426950408889634f;
    const bf16_t* qp = Qc + (bh * SEQ + r * 64 + c) * 64 + 8 * g;
    const bf16x8 qf0 = *(const bf16x8*)qp, qf1 = *(const bf16x8*)(qp + 32);
    f32x4 S[8][2];
#pragma unroll
    for (int i = 0; i < 8; ++i)
#pragma unroll
        for (int xb = 0; xb < 2; ++xb) { const bf16_t* kp = Kc + (bh * SEQ + (r0 + i) * 64 + cb + 16 * xb + qi) * 64 + 8 * g;
            const bf16x8 kf0 = *(const bf16x8*)kp, kf1 = *(const bf16x8*)(kp + 32);
            f32x4 z = (f32x4){0.f, 0.f, 0.f, 0.f};
            z = __builtin_amdgcn_mfma_f32_16x16x32_bf16(kf0, qf0, z, 0, 0, 0);
            z = __builtin_amdgcn_mfma_f32_16x16x32_bf16(kf1, qf1, z, 0, 0, 0);
            S[i][xb] = z; }
    float mx = -INFINITY;
#pragma unroll
    for (int i = 0; i < 8; ++i) { const float* brow = relb + (r0 + i - r + 7) * 31;
#pragma unroll
        for (int xb = 0; xb < 2; ++xb)
#pragma unroll
            for (int t = 0; t < 4; ++t) { const int kc = cb + 16 * xb + 4 * g + t; const bool valid = (kc >= c0) && (kc < c0 + 16); const int co = min(max(kc - c + 15, 0), 30);
                const float v = valid ? (S[i][xb][t] * 0.125f + brow[co]) * LOG2E : -INFINITY; S[i][xb][t] = v; mx = fmaxf(mx, v); } }
    mx = fmaxf(mx, __shfl_xor(mx, 16)); mx = fmaxf(mx, __shfl_xor(mx, 32));
    float sum = 0.f; bf16x8 pf[8];
#pragma unroll
    for (int i = 0; i < 8; ++i) { float pv[8];
#pragma unroll
        for (int xb = 0; xb < 2; ++xb)
#pragma unroll
            for (int t = 0; t < 4; ++t) { const float p = __builtin_amdgcn_exp2f(S[i][xb][t] - mx); pv[xb * 4 + t] = p; sum += p; }
        const u32x4 w = pack8(pv); pf[i] = *(const bf16x8*)&w; }
    sum += __shfl_xor(sum, 16); sum += __shfl_xor(sum, 32);
    const float inv = 1.0f / sum;
    f32x4 acc[4];
#pragma unroll
    for (int dvb = 0; dvb < 4; ++dvb) { acc[dvb] = (f32x4){0.f, 0.f, 0.f, 0.f};
        const bf16_t* vp = Vt + (bh * 64 + 16 * dvb + qi) * SEQ + r0 * 64 + cb + 4 * g;
#pragma unroll
        for (int i = 0; i < 8; ++i) { const u32x2 lo = *(const u32x2*)(vp + i * 64), hi2 = *(const u32x2*)(vp + i * 64 + 16);
            const u32x4 w = {lo.x, lo.y, hi2.x, hi2.y};
            acc[dvb] = __builtin_amdgcn_mfma_f32_16x16x32_bf16(*(const bf16x8*)&w, pf[i], acc[dvb], 0, 0, 0); } }
    bf16_t* op = O + ((size_t)b * SEQ + r * 64 + c) * DM + h * 64 + 4 * g;
#pragma unroll
    for (int dvb = 0; dvb < 4; ++dvb) { u32x2 w; w.x = cvt_pk_bf16(acc[dvb][0] * inv, acc[dvb][1] * inv); w.y = cvt_pk_bf16(acc[dvb][2] * inv, acc[dvb][3] * inv); *(u32x2*)(op + 16 * dvb) = w; }
}

constexpr int LDS_BYTES = 144 * 1024;
constexpr int MISC_OFF = g8::STAGE_BYTES;
constexpr int NPH_LAYER = 9, NPHASES = 1 + DEPTH * NPH_LAYER;

__global__ void __launch_bounds__(NTHREADS, 2) fwd_kernel(Args a) {
    extern __shared__ __attribute__((aligned(16))) unsigned char lds_raw[];
    Frame F; F.lds = (LAS unsigned char*)lds_raw; F.wave = __builtin_amdgcn_readfirstlane((int)threadIdx.x >> 6); F.tid = 0; F.lane = 0; F.G = gridDim.x; F.bid = blockIdx.x;
    unsigned char* ws = a.ws;
    volatile LAS unsigned* MISC = (volatile LAS unsigned*)(F.lds + MISC_OFF);
    { const Frame Fp = fresh(F); if (Fp.tid < 4) MISC[Fp.tid] = 0u; }
    __syncthreads();
    const bool one = (a.hi - a.lo) > 1;
    XcdBarrier bar; bar.bar = (unsigned*)(ws + WS_CTL); bar.x = 0; bar.st = MISC;
    if (one) { const Frame Fp = fresh(F); bar = xcd_barrier_post((unsigned*)(ws + WS_CTL), MISC, Fp.tid); }
#define IN(k) (a.lo <= (k) && (k) < a.hi)
#define SEAM(k) do { if (IN(k) && IN((k) + 1)) { const Frame Fb = fresh(F); xcd_barrier(bar, Fb.tid); } } while (0)

    if (IN(0)) { const Frame Fp = fresh(F); const Args ap = fresh(a); phase_prologue(Fp, ap); }
    SEAM(0);
#pragma unroll 1
    for (int layer = 0; layer < DEPTH; ++layer) {
        const int p0 = 1 + layer * NPH_LAYER, j = layer >> 1; const bool even = (layer & 1) == 0;
        if (IN(p0)) {
            const Frame Fp = fresh(F); const Args ap = fresh(a); unsigned char* w = ap.ws;
            phase_moe_weights(Fp, ap, layer);
            if (even) { g8::DenseSched S; S.init(w + WS_X, DM, (const bf16_t*)(w + WS_WIN) + (size_t)j * HLD * DM, DM, NTOK, HLD, Fp.G, Fp.bid);
                g8::EpiEvenIn E{(bf16_t*)(w + WS_R1), (bf16_t*)(w + WS_R2) + (size_t)NTOK * 1792, (float*)(w + WS_SSQ), (const float*)(w + WS_ROPEA), (const float*)(w + WS_ROPEB)}; g8::gemm_phase(Fp, DM, S, E); }
            else { g8::DenseSched S; S.init(w + WS_X, DM, (const bf16_t*)(w + WS_WQKV) + (size_t)j * 3072 * DM, DM, NTOK, 3072, Fp.G, Fp.bid);
#if NAIVE_NA
                g8::EpiPlain E{(bf16_t*)(w + WS_R1), 3072}; g8::gemm_phase(Fp, DM, S, E); }
#else
                g8::EpiQKV E{(bf16_t*)(w + WS_R1), (bf16_t*)(w + WS_R1) + (size_t)NTOK * DM, (bf16_t*)(w + WS_R1) + (size_t)2 * NTOK * DM}; g8::gemm_phase(Fp, DM, S, E); }
#endif
        }
        SEAM(p0);
        if (IN(p0 + 1) && even) {
            const Frame Fp = fresh(F); const Args ap = fresh(a); unsigned char* w = ap.ws;
            { g8::DenseSched S; S.init((bf16_t*)(w + WS_R1) + 1536, HLD, (const bf16_t*)(w + WS_WUQ) + (size_t)j * 768 * 256, 256, NTOK, 768, Fp.G, Fp.bid);
              g8::EpiMla<0> E{(bf16_t*)(w + WS_R2), (const float*)(w + WS_SSQ)}; g8::gemm_phase(Fp, 256, S, E); }
            const Frame Fq = fresh(F);
            { g8::DenseSched S; S.init((bf16_t*)(w + WS_R1) + 1792, HLD, (const bf16_t*)(w + WS_WUKV) + (size_t)j * 1024 * 256, 256, NTOK, 1024, Fq.G, Fq.bid);
              g8::EpiMla<1> E{(bf16_t*)(w + WS_R2) + (size_t)NTOK * 768, (const float*)(w + WS_SSQ)}; g8::gemm_phase(Fq, 256, S, E); }
        }
        SEAM(p0 + 1);
        if (IN(p0 + 2)) {
            const Frame Fp = fresh(F); const Args ap = fresh(a);
#if NAIVE_ATTN
            if (even) { for (int u = Fp.bid; u < NBATCH * 4 * 8; u += Fp.G) attn_diff_naive(Fp, ap, layer, u);
                        for (int u = Fp.bid; u < NBATCH * 8 * 4; u += Fp.G) attn_mla_naive(Fp, ap, u); }
#else
            if (even) { for (int u = Fp.bid; u < NBATCH * 4 * 8; u += Fp.G) attn_diff_mfma(Fp, ap, layer, u);
                        for (int u = Fp.bid; u < NBATCH * 8 * 8; u += Fp.G) attn_mla_mfma(Fp, ap, u); }
#endif
#if NAIVE_NA
            if (!even) { for (int u = Fp.bid; u < NBATCH * 32 * 2; u += Fp.G) attn_na_naive(Fp, ap, layer, u); }
#else
            if (!even) { for (int u = Fp.bid; u < NBATCH * 16 * 16; u += Fp.G) attn_na_mfma(Fp, ap, layer, u); }
#endif
            __syncthreads();
        }
        SEAM(p0 + 2);
        if (IN(p0 + 3)) {
            const Frame Fp = fresh(F); const Args ap = fresh(a); unsigned char* w = ap.ws;
            g8::DenseSched S; S.init(w + WS_R3, DM, (const bf16_t*)(w + (even ? WS_WOE : WS_WOO)) + (size_t)j * DM * DM, DM, NTOK, DM, Fp.G, Fp.bid);
            g8::EpiPlain E{(bf16_t*)(w + WS_R1), DM}; g8::gemm_phase(Fp, DM, S, E);
        }
        SEAM(p0 + 3);
        if (IN(p0 + 4)) { const Frame Fp = fresh(F); const Args ap = fresh(a); phase_ln<0>(Fp, ap, layer, false); }
        SEAM(p0 + 4);
        if (IN(p0 + 5)) { const Frame Fp = fresh(F); const Args ap = fresh(a); phase_scatter(Fp, ap); }
        SEAM(p0 + 5);
        if (IN(p0 + 6)) {
            const Frame Fp = fresh(F); const Args ap = fresh(a); unsigned char* w = ap.ws;
            g8::MoeSched<true> S; S.A = (const char*)(w + WS_X); S.Wt = (const char*)(w + WS_W13); S.tile = (const int*)(w + WS_TILE); S.slot_tok = (const int*)(w + WS_SLOT_TOK);
            S.lda2 = DM * 2; S.K2 = DM * 2; S.wstride = (size_t)1024 * 1024 * 2; S.T = S.tile[0]; S.G = Fp.G; S.c = Fp.bid;
            g8::EpiMoe1 E{(bf16_t*)(w + WS_R1)}; g8::gemm_phase(Fp, DM, S, E);
        }
        SEAM(p0 + 6);
        if (IN(p0 + 7)) {
            const Frame Fp = fresh(F); const Args ap = fresh(a); unsigned char* w = ap.ws;
            g8::MoeSched<false> S; S.A = (const char*)(w + WS_R1); S.Wt = (const char*)(w + WS_W2); S.tile = (const int*)(w + WS_TILE); S.slot_tok = (const int*)(w + WS_SLOT_TOK);
            S.lda2 = DEXP * 2; S.K2 = DEXP * 2; S.wstride = (size_t)1024 * 512 * 2; S.T = S.tile[0]; S.G = Fp.G; S.c = Fp.bid;
            g8::EpiMoe2 E{(bf16_t*)(w + WS_R2), (const float*)(w + WS_SLOT_G), (const int*)(w + WS_SLOT_DST)}; g8::gemm_phase(Fp, DEXP, S, E);
        }
        SEAM(p0 + 7);
        if (IN(p0 + 8)) { const Frame Fp = fresh(F); const Args ap = fresh(a); phase_ln<1>(Fp, ap, layer, layer == DEPTH - 1); }
        SEAM(p0 + 8);
    }
#undef IN
#undef SEAM
}

extern "C" void kernel_launch(void* const* d_in, const int* in_sizes, int n_in, void* d_out, int out_size, void* d_ws, size_t ws_size, hipStream_t stream) {
    static int grid = 0;
    if (grid == 0) {
        if (n_in != 26 || in_sizes[0] != NTOK * DM || out_size != NTOK * DM || ws_size < WS_END) {
            fprintf(stderr, "kernel_launch: unexpected shapes / workspace (n_in %d, in0 %d, out %d, ws %zu, need %zu)\n", n_in, n_in > 0 ? in_sizes[0] : -1, out_size, ws_size, (size_t)WS_END); grid = -1; return; }
        int dev = 0, cus = 0, per_cu = 0;
        if (hipGetDevice(&dev) != hipSuccess || hipDeviceGetAttribute(&cus, hipDeviceAttributeMultiprocessorCount, dev) != hipSuccess) { grid = -1; return; }
        if (hipFuncSetAttribute((const void*)fwd_kernel, hipFuncAttributeMaxDynamicSharedMemorySize, LDS_BYTES) != hipSuccess) { fprintf(stderr, "kernel_launch: hipFuncSetAttribute failed\n"); grid = -1; return; }
        if (hipOccupancyMaxActiveBlocksPerMultiprocessor(&per_cu, (const void*)fwd_kernel, NTHREADS, LDS_BYTES) != hipSuccess || per_cu < 1) fprintf(stderr, "kernel_launch: occupancy query reports %d\n", per_cu);
        (void)hipGetLastError();
        grid = cus;
    }
    if (grid < 0) return;
    (void)hipMemsetAsync((char*)d_ws + WS_CTL, 0, 64 * 1024, stream);
    Args a{};
    for (int i = 0; i < 26; ++i) a.in[i] = (const float*)d_in[i];
    a.out = (float*)d_out; a.ws = (unsigned char*)d_ws;
#if MK_ONE_LAUNCH
    a.lo = 0; a.hi = NPHASES;
    hipLaunchKernelGGL(fwd_kernel, dim3(grid), dim3(NTHREADS), LDS_BYTES, stream, a);
#else
    for (int p = 0; p < NPHASES; ++p) {
        if (p >= 1 && ((p - 1) % NPH_LAYER) == 1 && (((p - 1) / NPH_LAYER) & 1)) continue;
        a.lo = p; a.hi = p + 1;
        hipLaunchKernelGGL(fwd_kernel, dim3(grid), dim3(NTHREADS), LDS_BYTES, stream, a);
    }
#endif
}
```

```cpp
#include <hip/hip_runtime.h>
#include <cstdio>
#include <cstdint>

#ifndef NAIVE_ATTN
#define NAIVE_ATTN 0
#endif
#ifndef NAIVE_NA
#define NAIVE_NA 0
#endif
#ifndef REP_MASK
#define REP_MASK 0
#endif
#define REPEAT(k) _Pragma("unroll 1") for (int rep_ = 0; rep_ < 1 + ((REP_MASK >> (k)) & 1); ++rep_)
#ifndef MK_ONE_LAUNCH
#define MK_ONE_LAUNCH 1
#endif

typedef unsigned short bf16_t;
typedef short bf16x8 __attribute__((ext_vector_type(8)));
typedef float f32x4 __attribute__((ext_vector_type(4)));
typedef float f32x2 __attribute__((ext_vector_type(2)));
typedef unsigned u32x4 __attribute__((ext_vector_type(4)));
typedef unsigned u32x2 __attribute__((ext_vector_type(2)));
#define LAS __attribute__((address_space(3)))

constexpr int NTOK = 65536, DM = 1024, SEQ = 2048, NBATCH = 32, DEPTH = 4;
constexpr int EVEN_IN = 1952, HLD = 2048;
constexpr int NEXP = 32, DEXP = 512;
constexpr int MAXTILES = NTOK * 2 / 256 + NEXP;
constexpr int MAXSLOTS = MAXTILES * 256;
constexpr float DN_ALPHA = 1.681792830507429f;
constexpr float LN_EPS = 1e-5f, RMS_EPS = 1e-6f;
constexpr int NTHREADS = 512;

constexpr size_t MiB = 1024ull * 1024ull;
constexpr size_t WS_CTL = 0;
constexpr size_t WS_LAM = 48 * 1024;
constexpr size_t WS_ROPEA = 64 * 1024;
constexpr size_t WS_ROPEB = WS_ROPEA + 128 * 1024;
constexpr size_t WS_WR = WS_ROPEB + 256 * 1024;
constexpr size_t WS_ROUTE = WS_WR + 832 * 1024;
constexpr size_t WS_CNT = WS_ROUTE + 1 * MiB;
constexpr size_t WS_TILE = WS_CNT + 32 * 1024;
constexpr size_t WS_SLOT_TOK = WS_TILE + 4 * 1024;
constexpr size_t WS_SLOT_G = WS_SLOT_TOK + 576 * 1024;
constexpr size_t WS_SLOT_DST = WS_SLOT_G + 576 * 1024;
constexpr size_t WS_SSQ = WS_SLOT_DST + 576 * 1024;
constexpr size_t WS_WIN = 6 * MiB;
constexpr size_t WS_WUQ = WS_WIN + 8 * MiB;
constexpr size_t WS_WUKV = WS_WUQ + 1 * MiB;
constexpr size_t WS_WOE = WS_WUKV + 1 * MiB;
constexpr size_t WS_WQKV = WS_WOE + 4 * MiB;
constexpr size_t WS_WOO = WS_WQKV + 12 * MiB;
constexpr size_t WS_W13 = 36 * MiB;
constexpr size_t WS_W2 = WS_W13 + 64 * MiB;
constexpr size_t WS_X = WS_W2 + 32 * MiB;
constexpr size_t WS_R1 = WS_X + 128 * MiB;
constexpr size_t WS_R2 = WS_R1 + 384 * MiB;
constexpr size_t WS_R3 = WS_R2 + 228 * MiB;
constexpr size_t WS_END = WS_R3 + 128 * MiB;
static_assert(WS_SSQ + 2 * MiB <= WS_WIN, "misc region");
static_assert(WS_WOO + 4 * MiB <= WS_W13, "small weights region");

__device__ __forceinline__ unsigned cvt_pk_bf16(float lo, float hi) { unsigned r; asm volatile("v_cvt_pk_bf16_f32 %0, %1, %2" : "=v"(r) : "v"(lo), "v"(hi)); return r; }
__device__ __forceinline__ float bf_lo(unsigned w) { return __uint_as_float(w << 16); }
__device__ __forceinline__ float bf_hi(unsigned w) { return __uint_as_float(w & 0xffff0000u); }
__device__ __forceinline__ float bf2f(bf16_t b) { return __uint_as_float(((unsigned)b) << 16); }
__device__ __forceinline__ void unpack8(const u32x4 w, float (&f)[8]) {
    f[0] = bf_lo(w.x); f[1] = bf_hi(w.x); f[2] = bf_lo(w.y); f[3] = bf_hi(w.y); f[4] = bf_lo(w.z); f[5] = bf_hi(w.z); f[6] = bf_lo(w.w); f[7] = bf_hi(w.w); }
__device__ __forceinline__ u32x4 pack8(const float (&f)[8]) { u32x4 w; w.x = cvt_pk_bf16(f[0], f[1]); w.y = cvt_pk_bf16(f[2], f[3]); w.z = cvt_pk_bf16(f[4], f[5]); w.w = cvt_pk_bf16(f[6], f[7]); return w; }
__device__ __forceinline__ float wave_sum(float v) {
#pragma unroll
    for (int o = 32; o >= 1; o >>= 1) v += __shfl_xor(v, o);
    return v; }

struct Frame { LAS unsigned char* lds; int tid, lane, wave, G, bid; };
#define XB_TMO      128
#define XB_XCNT(j)  (256  + 64 * (j))
#define XB_XSUB(j)  (1280 + 64 * (j))
#define XB_XGEN(j)  (2304 + 64 * (j))
#define XB_TOP      3328
#define XB_TOPGEN   3392
#define XCD_BAR_WORDS 3456
#define XB_SPIN_CAP (1u << 21)
__device__ __forceinline__ unsigned xb_ld(unsigned* p)              { return __hip_atomic_load(p, __ATOMIC_RELAXED, __HIP_MEMORY_SCOPE_AGENT); }
__device__ __forceinline__ unsigned xb_add(unsigned* p, unsigned v) { return __hip_atomic_fetch_add(p, v, __ATOMIC_RELAXED, __HIP_MEMORY_SCOPE_AGENT); }
__device__ __forceinline__ unsigned xb_xcc_id() { return (unsigned)__builtin_amdgcn_s_getreg((3 << 11) | 20) & 0xFu; }
#define XB_SPIN(cond, bar) do { unsigned _sp = 0; while (cond) { __builtin_amdgcn_s_sleep(1); \
    if ((++_sp & 255u) == 0u) { if (xb_ld(&(bar)[XB_TMO])) break; if (_sp > XB_SPIN_CAP) { atomicAdd(&(bar)[XB_TMO], 1u); break; } } } } while (0)
struct XcdBarrier { unsigned* bar; unsigned x; volatile LAS unsigned* st; };
__device__ __forceinline__ XcdBarrier xcd_barrier_post(unsigned* bar, volatile LAS unsigned* st, int tid) {
    XcdBarrier b; b.bar = bar; b.x = xb_xcc_id(); b.st = st;
    if (tid == 0) (void)xb_add(&bar[XB_XCNT(b.x)], 1u);
    return b;
}
__device__ __forceinline__ void xcd_barrier_complete(unsigned* bar, unsigned x, unsigned& nloc, unsigned& nx) {
    const unsigned G = gridDim.x * gridDim.y * gridDim.z;
    unsigned sum, cnt, mine, sp = 0u;
    for (;;) {
        sum = 0u; cnt = 0u; mine = 0u;
#pragma unroll
        for (unsigned j = 0; j < 16; ++j) { const unsigned c = xb_ld(&bar[XB_XCNT(j)]); sum += c; cnt += (c > 0u) ? 1u : 0u; mine = (j == x) ? c : mine; }
        if (sum == G) break;
        __builtin_amdgcn_s_sleep(1);
        if ((++sp & 255u) == 0u) { if (xb_ld(&bar[XB_TMO])) break; if (sp > XB_SPIN_CAP) { atomicAdd(&bar[XB_TMO], 1u); break; } }
    }
    nloc = mine > 0u ? mine : 1u; nx = cnt > 0u ? cnt : 1u;
}
__device__ __forceinline__ void xcd_barrier(const XcdBarrier& b, int tid) {
    asm volatile("s_waitcnt vmcnt(0)" ::: "memory");
    __syncthreads();
    if (tid == 0) {
        unsigned* bar = b.bar; unsigned bx = b.x; asm volatile("" : "+s"(bx));
        __builtin_amdgcn_s_waitcnt(0);
        unsigned nloc = b.st[0], nx = b.st[1];
        if (nloc == 0u) { xcd_barrier_complete(bar, bx, nloc, nx); b.st[0] = nloc; b.st[1] = nx; }
        const unsigned old = xb_add(&bar[XB_XSUB(bx)], 1u);
        const unsigned gen = old / nloc;
        if (old + 1u == (gen + 1u) * nloc) {
            __builtin_amdgcn_fence(__ATOMIC_RELEASE, "agent");
            asm volatile("s_waitcnt vmcnt(0)" ::: "memory");
            const unsigned og = xb_add(&bar[XB_TOP], 1u);
            const unsigned tg = og / nx;
            if (og + 1u == (tg + 1u) * nx) xb_add(&bar[XB_TOPGEN], 1u);
            else XB_SPIN(xb_ld(&bar[XB_TOPGEN]) == tg, bar);
            __builtin_amdgcn_fence(__ATOMIC_ACQUIRE, "agent");
            xb_add(&bar[XB_XGEN(bx)], 1u);
            asm volatile("s_waitcnt vmcnt(0)" ::: "memory");
        } else {
            XB_SPIN(xb_ld(&bar[XB_XGEN(bx)]) == gen, bar);
            __builtin_amdgcn_fence(__ATOMIC_ACQUIRE, "agent");
            asm volatile("s_waitcnt vmcnt(0)" ::: "memory");
        }
    }
    __syncthreads();
}

namespace g8 {
constexpr int BM = 256, BK = 64, HALF = 128, HTB = HALF * BK * 2, STAGE_BYTES = 8 * HTB, NXCD = 8, WGM = 8;
__device__ __forceinline__ int lds_byte(int r, int c) { const int st = (r >> 4) * 2 + (c >> 5), rr = r & 15, cc = c & 31, ob = rr * 64 + cc * 2; return st * 1024 + (ob ^ (((ob >> 9) & 1) << 5)); }
__device__ __forceinline__ void stage_rc(int b, int& R, int& C) { const int st = b / 1024, sb = b % 1024, swz = sb ^ (((sb >> 9) & 1) << 5); R = (st >> 1) * 16 + swz / 64; C = (st & 1) * 32 + (swz % 64) / 2; }
__device__ __forceinline__ int perm32(int rho) { const int n = rho >> 4, i = rho & 15; return 8 * (i >> 2) + 4 * n + (i & 3); }

struct Unit { const char* A; const char* B; int row0, pm, pn, e; };
typedef f32x4 Acc[2][2][4][2];

struct DenseSched {
    const char* A; const char* Bt; unsigned lda2; int K2; int nM, nN, nwg, G, c;
    __device__ __forceinline__ void init(const void* A_, int lda, const void* Bt_, int K, int M, int N, int G_, int c_) { A = (const char*)A_; Bt = (const char*)Bt_; lda2 = (unsigned)lda * 2u; K2 = K * 2; nM = M / BM; nN = N / BM; nwg = nM * nN; G = G_; c = c_; }
    __device__ __forceinline__ bool next(int i, Unit& u) const {
        const long L = (long)i * G + c; if (L >= nwg) return false;
        int wgid = (int)L; { const int q = nwg / NXCD, r = nwg % NXCD, xcd = wgid % NXCD, off = wgid / NXCD; wgid = (xcd < r ? xcd * (q + 1) : r * (q + 1) + (xcd - r) * q) + off; }
        const int nig = WGM * nN, gid = wgid / nig, fm = gid * WGM, gsz = (nM - fm) < WGM ? (nM - fm) : WGM;
        u.pm = fm + ((wgid % nig) % gsz); u.pn = (wgid % nig) / gsz; u.row0 = u.pm * BM; u.e = 0;
        u.A = A + (size_t)u.row0 * lda2; u.B = Bt + (size_t)u.pn * BM * K2; return true;
    }
    static constexpr bool GATHER = false;
    __device__ __forceinline__ unsigned rowoff(const Unit&, int r) const { return (unsigned)r * lda2; }
};
template <bool GATHER_> struct MoeSched {
    const char* A; const char* Wt; const int* tile; const int* slot_tok; unsigned lda2; int K2; size_t wstride; int T, G, c;
    __device__ __forceinline__ bool next(int i, Unit& u) const {
        const int L = i * G + c; if (L >= T * 4) return false;
        const int t = L >> 2; u.pn = L & 3; u.pm = t; u.row0 = t * BM; u.e = tile[1 + t];
        u.A = GATHER_ ? A : A + (size_t)u.row0 * lda2; u.B = Wt + (size_t)u.e * wstride + (size_t)u.pn * BM * K2; return true;
    }
    static constexpr bool GATHER = GATHER_;
    __device__ __forceinline__ unsigned rowoff(const Unit& u, int r) const { return GATHER_ ? (unsigned)slot_tok[u.row0 + r] * lda2 : (unsigned)r * lda2; }
};

template <class Epi, class Sched>
__device__ __forceinline__ void gemm_phase(const Frame& F, const int K_, const Sched& S, const Epi& E) {
    LAS unsigned char* lds = F.lds;
    int K = K_; asm volatile("" : "+s"(K));
    const int tid = F.tid, wid = __builtin_amdgcn_readfirstlane(tid >> 6), lane = tid & 63, wr = wid >> 2, wc = wid & 3, fr = lane & 15, fq = lane >> 4;
    const int nt = K / BK;
    int RA[2]; unsigned CA[2], voffB[2];
#pragma unroll
    for (int i = 0; i < 2; ++i) { int R, C; stage_rc(tid * 16 + i * 8192, R, C); const int Rb = (R & ~31) + perm32(R & 31);
        RA[i] = R; CA[i] = (unsigned)C * 2u; voffB[i] = (unsigned)(Rb * K + C) * 2u; }
    const size_t kstep = (size_t)(BK * 2);
    const size_t hstepB = (size_t)HALF * K * 2;
    size_t hstepA = 0; if constexpr (!Sched::GATHER) hstepA = (size_t)S.rowoff(Unit{}, HALF);
    const unsigned ldsw = (unsigned)wid * 1024u;
    const int aoff = lds_byte(wr * 64 + fr, fq * 8), boff = lds_byte(wc * 32 + fr, fq * 8);
#define G8_SA(b, h) (((b) * 2 + (h)) * HTB)
#define G8_SB(b, h) ((4 + (b) * 2 + (h)) * HTB)
#define G8_STAGE(bufoff, gbase, voff) do { _Pragma("unroll") for (int _i = 0; _i < 2; ++_i) \
        __builtin_amdgcn_global_load_lds((const unsigned*)((const char*)(gbase) + (voff)[_i]), (LAS unsigned*)(lds + (bufoff) + ldsw + _i * 8192), 16, 0, 0); } while (0)
#define G8_STA(bufoff, gbase, h, V0, V1) do { if constexpr (Sched::GATHER) { if (h) G8_STAGE(bufoff, gbase, V1); else G8_STAGE(bufoff, gbase, V0); } else { G8_STAGE(bufoff, (gbase) + (h) * hstepA, vA0); } } while (0)
#define G8_LDA(dst, b, h) do { _Pragma("unroll") for (int m = 0; m < 4; ++m) _Pragma("unroll") for (int k = 0; k < 2; ++k) dst[m][k] = *(const LAS bf16x8*)(lds + G8_SA(b, h) + aoff + m * 2048 + k * 1024); } while (0)
#define G8_LDB(dst, b, h) do { _Pragma("unroll") for (int n = 0; n < 2; ++n) _Pragma("unroll") for (int k = 0; k < 2; ++k) dst[n][k] = *(const LAS bf16x8*)(lds + G8_SB(b, h) + boff + n * 2048 + k * 1024); } while (0)
#define G8_MMA(ai, bj, At, Bt) do { __builtin_amdgcn_s_setprio(1); _Pragma("unroll") for (int m = 0; m < 4; ++m) _Pragma("unroll") for (int n = 0; n < 2; ++n) _Pragma("unroll") for (int k = 0; k < 2; ++k) \
        acc[ai][bj][m][n] = __builtin_amdgcn_mfma_f32_16x16x32_bf16(Bt[n][k], At[m][k], acc[ai][bj][m][n], 0, 0, 0); __builtin_amdgcn_s_setprio(0); } while (0)
#define G8_WAIT_V(n) asm volatile("s_waitcnt vmcnt(" #n ")" ::: "memory")
#define G8_WAIT_L(n) asm volatile("s_waitcnt lgkmcnt(" #n ")" ::: "memory")
#define G8_BAR __builtin_amdgcn_s_barrier()
#define G8_SCHED __builtin_amdgcn_sched_barrier(0)
    Unit cur, nxt; int ui = 0;
    if (!S.next(0, cur)) return;
    Acc acc;
#pragma unroll
    for (int a = 0; a < 2; ++a)
#pragma unroll
        for (int b = 0; b < 2; ++b)
#pragma unroll
            for (int m = 0; m < 4; ++m)
#pragma unroll
                for (int n = 0; n < 2; ++n) acc[a][b][m][n] = (f32x4){0.f, 0.f, 0.f, 0.f};
    bf16x8 At[4][2], B0[2][2], B1[2][2];
    unsigned vA0[2], vA1[2], nA0[2], nA1[2];
#pragma unroll
    for (int i = 0; i < 2; ++i) { vA0[i] = S.rowoff(cur, RA[i]) + CA[i]; vA1[i] = S.rowoff(cur, HALF + RA[i]) + CA[i]; }
    const char* cA = cur.A; const char* cB = cur.B;
    G8_STAGE(G8_SB(0, 0), cB, voffB); G8_STA(G8_SA(0, 0), cA, 0, vA0, vA1); G8_STAGE(G8_SB(0, 1), cB + hstepB, voffB); G8_STA(G8_SA(0, 1), cA, 1, vA0, vA1);
    if (wr == 1) G8_BAR;
    G8_WAIT_V(4); G8_BAR;
    G8_STAGE(G8_SB(1, 0), cB + kstep, voffB); G8_STA(G8_SA(1, 0), cA + kstep, 0, vA0, vA1); G8_STAGE(G8_SB(1, 1), cB + hstepB + kstep, voffB);
    G8_WAIT_V(6); G8_BAR;
    for (;;) {
        const bool has_next = S.next(ui + 1, nxt);
        const char* nAp = has_next ? nxt.A : cA; const char* nBp = has_next ? nxt.B : cB;
#pragma unroll
        for (int i = 0; i < 2; ++i) { nA0[i] = has_next ? S.rowoff(nxt, RA[i]) + CA[i] : vA0[i]; nA1[i] = has_next ? S.rowoff(nxt, HALF + RA[i]) + CA[i] : vA1[i]; }
        for (int t = 0; t < nt; t += 2) {
            const bool last = (t == nt - 2);
            const char* a1 = cA + (size_t)(t + 1) * kstep;
            const char* a2 = last ? nAp : cA + (size_t)(t + 2) * kstep; const char* b2 = last ? nBp : cB + (size_t)(t + 2) * kstep;
            const char* a3 = a2 + kstep; const char* b3 = b2 + kstep;
            unsigned w0[2], w1[2];
#pragma unroll
            for (int i = 0; i < 2; ++i) { w0[i] = last ? nA0[i] : vA0[i]; w1[i] = last ? nA1[i] : vA1[i]; }
            G8_LDB(B0, 0, 0); G8_SCHED; G8_LDA(At, 0, 0); G8_STA(G8_SA(1, 1), a1, 1, vA0, vA1);
            G8_WAIT_L(8); G8_BAR; G8_WAIT_L(0); G8_MMA(0, 0, At, B0); G8_BAR; G8_SCHED;
            G8_LDB(B1, 0, 1); G8_STAGE(G8_SB(0, 0), b2, voffB);
            G8_BAR; G8_WAIT_L(0); G8_MMA(0, 1, At, B1); G8_BAR;
            G8_LDA(At, 0, 1); G8_STA(G8_SA(0, 0), a2, 0, w0, w1);
            G8_BAR; G8_WAIT_L(0); G8_MMA(1, 0, At, B0); G8_BAR; G8_SCHED;
            G8_STAGE(G8_SB(0, 1), b2 + hstepB, voffB);
            G8_WAIT_V(6); G8_BAR; G8_MMA(1, 1, At, B1); G8_BAR;
            G8_LDB(B0, 1, 0); G8_SCHED; G8_LDA(At, 1, 0); G8_STA(G8_SA(0, 1), a2, 1, w0, w1);
            G8_WAIT_L(8); G8_BAR; G8_WAIT_L(0); G8_MMA(0, 0, At, B0); G8_BAR; G8_SCHED;
            G8_LDB(B1, 1, 1); G8_STAGE(G8_SB(1, 0), b3, voffB);
            G8_BAR; G8_WAIT_L(0); G8_MMA(0, 1, At, B1); G8_BAR;
            G8_LDA(At, 1, 1); G8_STA(G8_SA(1, 0), a3, 0, w0, w1);
            G8_BAR; G8_WAIT_L(0); G8_MMA(1, 0, At, B0); G8_BAR; G8_SCHED;
            G8_STAGE(G8_SB(1, 1), b3 + hstepB, voffB);
            G8_WAIT_V(6); G8_BAR; G8_MMA(1, 1, At, B1); G8_BAR;
        }
        E(acc, cur, wr, wc, fr, fq);
        if (!has_next) break;
#pragma unroll
        for (int a = 0; a < 2; ++a)
#pragma unroll
            for (int b = 0; b < 2; ++b)
#pragma unroll
                for (int m = 0; m < 4; ++m)
#pragma unroll
                    for (int n = 0; n < 2; ++n) acc[a][b][m][n] = (f32x4){0.f, 0.f, 0.f, 0.f};
        cur = nxt; cA = nAp; cB = nBp; ++ui;
#pragma unroll
        for (int i = 0; i < 2; ++i) { vA0[i] = nA0[i]; vA1[i] = nA1[i]; }
    }
    G8_WAIT_V(0);
    if (wr == 0) G8_BAR;
    G8_BAR;
#undef G8_SA
#undef G8_SB
#undef G8_STAGE
#undef G8_STA
#undef G8_LDA
#undef G8_LDB
#undef G8_MMA
#undef G8_WAIT_V
#undef G8_WAIT_L
#undef G8_BAR
#undef G8_SCHED
}

__device__ __forceinline__ u32x4 pack_acc8(const f32x4 v0, const f32x4 v1) { u32x4 w; w.x = cvt_pk_bf16(v0[0], v0[1]); w.y = cvt_pk_bf16(v0[2], v0[3]); w.z = cvt_pk_bf16(v1[0], v1[1]); w.w = cvt_pk_bf16(v1[2], v1[3]); return w; }

struct EpiPlain {
    bf16_t* O; int ldc;
    __device__ __forceinline__ void operator()(Acc& acc, const Unit& u, int wr, int wc, int fr, int fq) const {
        const int row0 = u.pm * BM + wr * 64 + fr, col0 = u.pn * BM + wc * 32 + 8 * fq;
#pragma unroll
        for (int ai = 0; ai < 2; ++ai)
#pragma unroll
            for (int m = 0; m < 4; ++m) { bf16_t* rowp = O + (size_t)(row0 + ai * HALF + m * 16) * ldc + col0;
#pragma unroll
                for (int bj = 0; bj < 2; ++bj) *(u32x4*)(rowp + bj * HALF) = pack_acc8(acc[ai][bj][m][0], acc[ai][bj][m][1]); }
    }
};

struct EpiQKV {
    bf16_t* Qc; bf16_t* Kc; bf16_t* Vt;
    __device__ __forceinline__ void operator()(Acc& acc, const Unit& u, int wr, int wc, int fr, int fq) const {
        const int which = u.pn >> 2, tok0 = u.pm * BM + wr * 64 + fr;
        const int b = tok0 >> 11;
#pragma unroll
        for (int ai = 0; ai < 2; ++ai)
#pragma unroll
            for (int m = 0; m < 4; ++m) { const int s = (tok0 + ai * HALF + m * 16) & (SEQ - 1);
#pragma unroll
                for (int bj = 0; bj < 2; ++bj) { const int h = (u.pn & 3) * 4 + 2 * bj + (wc >> 1), d0 = (wc & 1) * 32 + 8 * fq;
                    if (which < 2) { bf16_t* dst = (which == 0 ? Qc : Kc) + ((size_t)(b * 16 + h) * SEQ + s) * 64 + d0;
                        *(u32x4*)dst = pack_acc8(acc[ai][bj][m][0], acc[ai][bj][m][1]); }
                    else { bf16_t* dst = Vt + (((size_t)(b * 16 + h) * (SEQ / 8) + (s >> 3)) * 64 + d0) * 8 + (s & 7);
#pragma unroll
                        for (int n = 0; n < 2; ++n)
#pragma unroll
                            for (int jj = 0; jj < 4; ++jj) dst[(4 * n + jj) * 8] = (bf16_t)(cvt_pk_bf16(acc[ai][bj][m][n][jj], 0.f) & 0xffffu); } } }
    }
};

struct EpiEvenIn {
    bf16_t* H; bf16_t* KR; float* ssq; const float* ropeA; const float* ropeB;
    __device__ __forceinline__ void operator()(Acc& acc, const Unit& u, int wr, int wc, int fr, int fq) const {
        const int row0 = u.pm * BM + wr * 64 + fr, col0 = u.pn * BM + wc * 32 + 8 * fq;
        if (u.pn < 4 && (wc & 1) == 0) {
#pragma unroll
            for (int ai = 0; ai < 2; ++ai)
#pragma unroll
                for (int m = 0; m < 4; ++m) { const int pos = (row0 + ai * HALF + m * 16) & (SEQ - 1);
                    const f32x4 c0 = *(const f32x4*)(ropeA + pos * 8), c1 = *(const f32x4*)(ropeA + pos * 8 + 4);
                    const f32x4 s0 = *(const f32x4*)(ropeA + SEQ * 8 + pos * 8), s1 = *(const f32x4*)(ropeA + SEQ * 8 + pos * 8 + 4);
#pragma unroll
                    for (int bj = 0; bj < 2; ++bj)
#pragma unroll
                        for (int n = 0; n < 2; ++n) { const f32x4 own = acc[ai][bj][m][n]; f32x4 oth;
#pragma unroll
                            for (int j = 0; j < 4; ++j) oth[j] = __shfl_xor(own[j], 16);
                            const f32x4 cs = n ? c1 : c0, sn = n ? s1 : s0;
                            if (fq == 0) acc[ai][bj][m][n] = own * cs - oth * sn;
                            else if (fq == 1) acc[ai][bj][m][n] = own * cs + oth * sn; } }
        }
        if (u.pn >= 6) {
#pragma unroll
            for (int ai = 0; ai < 2; ++ai)
#pragma unroll
                for (int m = 0; m < 4; ++m) { float s = 0.f;
#pragma unroll
                    for (int bj = 0; bj < 2; ++bj) if (u.pn == 6 || bj == 0)
#pragma unroll
                        for (int n = 0; n < 2; ++n) { const f32x4 x = acc[ai][bj][m][n]; s += (x[0] * x[0] + x[1] * x[1]) + (x[2] * x[2] + x[3] * x[3]); }
                    s += __shfl_xor(s, 16); s += __shfl_xor(s, 32);
                    if (fq == 0) ssq[(size_t)(row0 + ai * HALF + m * 16) * 8 + (u.pn == 6 ? 0 : 4) + wc] = s; }
        }
        if (u.pn == 7 && wc == 0) {
#pragma unroll
            for (int ai = 0; ai < 2; ++ai)
#pragma unroll
                for (int m = 0; m < 4; ++m) { const int row = row0 + ai * HALF + m * 16, pos = row & (SEQ - 1); f32x4 o[2];
#pragma unroll
                    for (int n = 0; n < 2; ++n) { const f32x4 own = acc[ai][1][m][n]; f32x4 oth;
#pragma unroll
                        for (int j = 0; j < 4; ++j) oth[j] = __shfl_xor(own[j], 32);
                        const int i0 = 8 * (fq & 1) + 4 * n;
                        const f32x4 cs = *(const f32x4*)(ropeB + pos * 16 + i0), sn = *(const f32x4*)(ropeB + SEQ * 16 + pos * 16 + i0);
                        o[n] = (fq < 2) ? own * cs - oth * sn : own * cs + oth * sn; }
                    *(u32x4*)(KR + (size_t)row * 32 + 8 * fq) = pack_acc8(o[0], o[1]); }
        }
#pragma unroll
        for (int ai = 0; ai < 2; ++ai)
#pragma unroll
            for (int m = 0; m < 4; ++m) { bf16_t* rowp = H + (size_t)(row0 + ai * HALF + m * 16) * HLD + col0;
#pragma unroll
                for (int bj = 0; bj < 2; ++bj) *(u32x4*)(rowp + bj * HALF) = pack_acc8(acc[ai][bj][m][0], acc[ai][bj][m][1]); }
    }
};

template <int MODE> struct EpiMla {
    bf16_t* O; const float* ssq;
    __device__ __forceinline__ void operator()(Acc& acc, const Unit& u, int wr, int wc, int fr, int fq) const {
        const int row0 = u.pm * BM + wr * 64 + fr, col0 = u.pn * BM + wc * 32 + 8 * fq;
        constexpr int ldc = MODE == 0 ? 768 : 1024;
#pragma unroll
        for (int ai = 0; ai < 2; ++ai)
#pragma unroll
            for (int m = 0; m < 4; ++m) { const int row = row0 + ai * HALF + m * 16;
                const f32x4 p = *(const f32x4*)(ssq + (size_t)row * 8 + (MODE == 0 ? 0 : 4));
                const float rstd = 1.0f / sqrtf(((p[0] + p[1]) + (p[2] + p[3])) * (MODE == 0 ? 1.0f / 256.0f : 1.0f / 128.0f) + RMS_EPS);
                bf16_t* rowp = O + (size_t)row * ldc + col0;
#pragma unroll
                for (int bj = 0; bj < 2; ++bj) *(u32x4*)(rowp + bj * HALF) = pack_acc8(acc[ai][bj][m][0] * rstd, acc[ai][bj][m][1] * rstd);
                asm volatile("" ::: "memory"); }
    }
};

struct EpiMoe1 {
    bf16_t* Hdn;
    __device__ __forceinline__ void operator()(Acc& acc, const Unit& u, int wr, int wc, int fr, int fq) const {
        const int row0 = u.row0 + wr * 64 + fr, col0 = u.pn * 128 + wc * 32 + 8 * fq;
#pragma unroll
        for (int ai = 0; ai < 2; ++ai)
#pragma unroll
            for (int m = 0; m < 4; ++m) { f32x4 h[2];
#pragma unroll
                for (int n = 0; n < 2; ++n)
#pragma unroll
                    for (int j = 0; j < 4; ++j) { const float g = acc[ai][0][m][n][j], up = acc[ai][1][m][n][j]; h[n][j] = g / (1.0f + __expf(-g)) * up; }
                *(u32x4*)(Hdn + (size_t)(row0 + ai * HALF + m * 16) * DEXP + col0) = pack_acc8(h[0], h[1]); }
    }
};
struct EpiMoe2 {
    bf16_t* Y; const float* slot_g; const int* slot_dst;
    __device__ __forceinline__ void operator()(Acc& acc, const Unit& u, int wr, int wc, int fr, int fq) const {
        const int row0 = u.row0 + wr * 64 + fr, col0 = u.pn * BM + wc * 32 + 8 * fq;
#pragma unroll
        for (int ai = 0; ai < 2; ++ai)
#pragma unroll
            for (int m = 0; m < 4; ++m) { const int slot = row0 + ai * HALF + m * 16; const int dst = slot_dst[slot]; const float g = slot_g[slot];
                if (dst >= 0) { bf16_t* rowp = Y + (size_t)dst * DM + col0;
#pragma unroll
                    for (int bj = 0; bj < 2; ++bj) *(u32x4*)(rowp + bj * HALF) = pack_acc8(acc[ai][bj][m][0] * g, acc[ai][bj][m][1] * g); } }
    }
};
}

struct Args { const float* in[26]; float* out; unsigned char* ws; int lo, hi; };
enum { IN_X = 0, IN_EWIN, IN_LQ1, IN_LK1, IN_LQ2, IN_LK2, IN_SUBLN, IN_QNG, IN_WUQ, IN_KVNG, IN_WUKV, IN_EWO, IN_OWQKV, IN_RELB, IN_OWO,
       IN_LN1G, IN_LN1B, IN_LN2G, IN_LN2B, IN_WRG, IN_BRG, IN_WRE, IN_BRE, IN_WG, IN_WU, IN_WD };

__device__ __forceinline__ Frame fresh(const Frame& F) { Frame R = F; int wv = F.wave, g = F.G, b = F.bid; asm volatile("" : "+s"(wv), "+s"(g), "+s"(b));
    int ln = (int)__builtin_amdgcn_mbcnt_hi(~0u, __builtin_amdgcn_mbcnt_lo(~0u, 0u)); asm volatile("" : "+v"(ln));
    __builtin_assume(ln >= 0 && ln < 64); __builtin_assume(wv >= 0 && wv < NTHREADS / 64); __builtin_assume(g > 0 && g <= 1024); __builtin_assume(b >= 0 && b < g);
    R.tid = wv * 64 + ln; R.lane = ln; R.wave = wv; R.G = g; R.bid = b; return R; }
__device__ __forceinline__ Args fresh(const Args& a) { Args r = a; unsigned char* w = a.ws; asm volatile("" : "+s"(w)); r.ws = w; return r; }

__device__ __forceinline__ void tr_tile(const Frame& F, const float* src, int ldsrc, int Kv, int Nv, int k0, int n0, bf16_t* dst, int lddst, int rowmap, const float* scale) {
    LAS float* T = (LAS float*)F.lds;
    __syncthreads();
#pragma unroll
    for (int it = 0; it < 8; ++it) { const int e = it * NTHREADS + F.tid, i = e >> 6, j = e & 63; const int k = k0 + i, n = n0 + j;
        float v = 0.f; if (k < Kv && n < Nv) { v = src[(size_t)k * ldsrc + n]; if (scale) v *= scale[k]; }
        T[i * 65 + j] = v; }
    __syncthreads();
    {
        const int j = F.tid >> 3, i0 = (F.tid & 7) * 8; float f[8];
#pragma unroll
        for (int q = 0; q < 8; ++q) f[q] = T[(i0 + q) * 65 + j];
        int n = n0 + j; if (rowmap) n = (n >> 7) * 256 + (n & 127) + (rowmap == 2 ? 128 : 0);
        *(u32x4*)(dst + (size_t)n * lddst + k0 + i0) = pack8(f); }
}
__device__ __forceinline__ void tr_matrix(const Frame& F, int& cursor, const float* src, int ldsrc, int Kv, int Nv, int Kp, int Np, bf16_t* dst, int lddst, int rowmap, const float* scale) {
    const int tk = Kp / 64, tn = Np / 64, ntile = tk * tn;
    int first = (F.bid - cursor % F.G + F.G) % F.G;
    for (int t = first; t < ntile; t += F.G) tr_tile(F, src, ldsrc, Kv, Nv, (t / tn) * 64, (t % tn) * 64, dst, lddst, rowmap, scale);
    cursor += ntile;
}

__device__ __forceinline__ void phase_prologue(const Frame& F, const Args& a) {
    unsigned char* ws = a.ws;
    { const float* x = a.in[IN_X]; bf16_t* X = (bf16_t*)(ws + WS_X); const size_t n8 = (size_t)NTOK * DM / 8;
      for (size_t i = (size_t)F.bid * NTHREADS + F.tid; i < n8; i += (size_t)F.G * NTHREADS) { const f32x4 v0 = *(const f32x4*)(x + i * 8), v1 = *(const f32x4*)(x + i * 8 + 4); *(u32x4*)(X + i * 8) = g8::pack_acc8(v0, v1); } }
    { float* ra = (float*)(ws + WS_ROPEA); float* rb = (float*)(ws + WS_ROPEB);
      for (int i = F.bid * NTHREADS + F.tid; i < SEQ * 8; i += F.G * NTHREADS) { const int pos = i >> 3, f = i & 7; const float inv = powf(500000.0f, -(float)(2 * f) / 16.0f); const float ang = (float)pos * inv; ra[i] = cosf(ang); ra[SEQ * 8 + i] = sinf(ang); }
      for (int i = F.bid * NTHREADS + F.tid; i < SEQ * 16; i += F.G * NTHREADS) { const int pos = i >> 4, f = i & 15; const float inv = powf(500000.0f, -(float)(2 * f) / 32.0f); const float ang = (float)pos * inv; rb[i] = cosf(ang); rb[SEQ * 16 + i] = sinf(ang); } }
    { float* wr = (float*)(ws + WS_WR); const float* wrg = a.in[IN_WRG]; const float* wre = a.in[IN_WRE];
      for (int i = F.bid * NTHREADS + F.tid; i < DEPTH * 48 * DM; i += F.G * NTHREADS) { const int l = i / (48 * DM), r = i % (48 * DM), j = r / DM, k = r % DM;
          wr[i] = j < 4 ? wrg[((size_t)l * DM + k) * 4 + j] : j < 36 ? wre[((size_t)l * DM + k) * 32 + (j - 4)] : 0.f; } }
    if (F.bid == 0 && F.tid < 2) { const int jl = F.tid; float d1 = 0.f, d2 = 0.f;
        for (int i = 0; i < 64; ++i) { d1 += a.in[IN_LQ1][jl * 64 + i] * a.in[IN_LK1][jl * 64 + i]; d2 += a.in[IN_LQ2][jl * 64 + i] * a.in[IN_LK2][jl * 64 + i]; }
        const float lambda_init = 0.8f - 0.6f * expf(-0.3f * (float)(2 * jl));
        ((float*)(ws + WS_LAM))[jl] = expf(d1) - expf(d2) + lambda_init; }
    int cur = 0;
    for (int l = 0; l < 2; ++l) {
        tr_matrix(F, cur, a.in[IN_EWIN] + (size_t)l * DM * EVEN_IN, EVEN_IN, DM, EVEN_IN, DM, HLD, (bf16_t*)(ws + WS_WIN) + (size_t)l * HLD * DM, DM, 0, nullptr);
        tr_matrix(F, cur, a.in[IN_WUQ] + (size_t)l * 256 * 768, 768, 256, 768, 256, 768, (bf16_t*)(ws + WS_WUQ) + (size_t)l * 768 * 256, 256, 0, a.in[IN_QNG] + l * 256);
        tr_matrix(F, cur, a.in[IN_WUKV] + (size_t)l * 128 * 1024, 1024, 128, 1024, 256, 1024, (bf16_t*)(ws + WS_WUKV) + (size_t)l * 1024 * 256, 256, 0, a.in[IN_KVNG] + l * 128);
        tr_matrix(F, cur, a.in[IN_EWO] + (size_t)l * DM * DM, DM, DM, DM, DM, DM, (bf16_t*)(ws + WS_WOE) + (size_t)l * DM * DM, DM, 0, nullptr);
        tr_matrix(F, cur, a.in[IN_OWQKV] + (size_t)l * DM * 3072, 3072, DM, 3072, DM, 3072, (bf16_t*)(ws + WS_WQKV) + (size_t)l * 3072 * DM, DM, 0, nullptr);
        tr_matrix(F, cur, a.in[IN_OWO] + (size_t)l * DM * DM, DM, DM, DM, DM, DM, (bf16_t*)(ws + WS_WOO) + (size_t)l * DM * DM, DM, 0, nullptr);
    }
    __syncthreads();
}
__device__ __forceinline__ void phase_moe_weights(const Frame& F, const Args& a, int layer) {
    unsigned char* ws = a.ws; int cur = 0;
    for (int e = 0; e < NEXP; ++e) {
        const size_t so = ((size_t)layer * NEXP + e) * DM * DEXP;
        tr_matrix(F, cur, a.in[IN_WG] + so, DEXP, DM, DEXP, DM, DEXP, (bf16_t*)(ws + WS_W13) + (size_t)e * 1024 * 1024, DM, 1, nullptr);
        tr_matrix(F, cur, a.in[IN_WU] + so, DEXP, DM, DEXP, DM, DEXP, (bf16_t*)(ws + WS_W13) + (size_t)e * 1024 * 1024, DM, 2, nullptr);
        tr_matrix(F, cur, a.in[IN_WD] + so, DM, DEXP, DM, DEXP, DM, (bf16_t*)(ws + WS_W2) + (size_t)e * 1024 * 512, DEXP, 0, nullptr);
    }
    __syncthreads();
}

template <int MODE>
__device__ __forceinline__ void phase_ln(const Frame& F, const Args& a, int layer, bool last_layer) {
    unsigned char* ws = a.ws;
    bf16_t* X = (bf16_t*)(ws + WS_X);
    const bf16_t* Ra = MODE == 0 ? (const bf16_t*)(ws + WS_R1) : (const bf16_t*)(ws + WS_R2);
    const float* gam = a.in[MODE == 0 ? IN_LN1G : IN_LN2G] + layer * DM; const float* bet = a.in[MODE == 0 ? IN_LN1B : IN_LN2B] + layer * DM;
    const float* WR = (const float*)(ws + WS_WR) + (size_t)layer * 36 * DM;
    LAS int* hist = (LAS int*)F.lds;
    for (int chunk = F.bid; chunk < NTOK / 256; chunk += F.G) {
        if (MODE == 0) { __syncthreads(); if (F.tid < NEXP) hist[F.tid] = 0; __syncthreads(); }
        for (int rr = F.wave; rr < 256; rr += NTHREADS / 64) {
            const int row = chunk * 256 + rr; float y[16];
#pragma unroll
            for (int hh = 0; hh < 2; ++hh) { const int c = hh * 512 + F.lane * 8; float xv[8], rv[8];
                unpack8(*(const u32x4*)(X + (size_t)row * DM + c), xv);
                if (MODE == 0) unpack8(*(const u32x4*)(Ra + (size_t)row * DM + c), rv);
                else { float r0[8], r1[8]; unpack8(*(const u32x4*)(Ra + (size_t)row * 2 * DM + c), r0); unpack8(*(const u32x4*)(Ra + (size_t)row * 2 * DM + DM + c), r1);
#pragma unroll
                    for (int q = 0; q < 8; ++q) rv[q] = r0[q] + r1[q]; }
#pragma unroll
                for (int q = 0; q < 8; ++q) y[hh * 8 + q] = DN_ALPHA * xv[q] + rv[q]; }
            float s = 0.f;
#pragma unroll
            for (int q = 0; q < 16; ++q) s += y[q];
            const float mean = wave_sum(s) * (1.0f / DM);
            float v = 0.f;
#pragma unroll
            for (int q = 0; q < 16; ++q) { const float d = y[q] - mean; v += d * d; }
            const float rstd = 1.0f / sqrtf(wave_sum(v) * (1.0f / DM) + LN_EPS);
#pragma unroll
            for (int hh = 0; hh < 2; ++hh) { const int c = hh * 512 + F.lane * 8;
                const f32x4 g0 = *(const f32x4*)(gam + c), g1 = *(const f32x4*)(gam + c + 4), b0 = *(const f32x4*)(bet + c), b1 = *(const f32x4*)(bet + c + 4);
#pragma unroll
                for (int q = 0; q < 4; ++q) { y[hh * 8 + q] = (y[hh * 8 + q] - mean) * rstd * g0[q] + b0[q]; y[hh * 8 + 4 + q] = (y[hh * 8 + 4 + q] - mean) * rstd * g1[q] + b1[q]; } }
            if (MODE == 1 && last_layer) {
#pragma unroll
                for (int hh = 0; hh < 2; ++hh) { float* o = a.out + (size_t)row * DM + hh * 512 + F.lane * 8;
                    *(f32x4*)o = (f32x4){y[hh * 8], y[hh * 8 + 1], y[hh * 8 + 2], y[hh * 8 + 3]}; *(f32x4*)(o + 4) = (f32x4){y[hh * 8 + 4], y[hh * 8 + 5], y[hh * 8 + 6], y[hh * 8 + 7]}; }
            } else {
#pragma unroll
                for (int hh = 0; hh < 2; ++hh) { float t8[8];
#pragma unroll
                    for (int q = 0; q < 8; ++q) t8[q] = y[hh * 8 + q];
                    *(u32x4*)(X + (size_t)row * DM + hh * 512 + F.lane * 8) = pack8(t8); }
            }
            if (MODE == 0) {
                float mine = 0.f;
#pragma unroll 2
                for (int j = 0; j < 36; ++j) { float p = 0.f;
#pragma unroll
                    for (int hh = 0; hh < 2; ++hh) { const float* w = WR + (size_t)j * DM + hh * 512 + F.lane * 8; const f32x4 w0 = *(const f32x4*)w, w1 = *(const f32x4*)(w + 4);
#pragma unroll
                        for (int q = 0; q < 4; ++q) { p += y[hh * 8 + q] * w0[q]; p += y[hh * 8 + 4 + q] * w1[q]; } }
                    p = wave_sum(p); mine = (F.lane == j) ? p : mine; }
                { const float* brg = a.in[IN_BRG] + layer * 4; const float* bre = a.in[IN_BRE] + layer * 32;
                  mine += (F.lane < 4) ? brg[F.lane] : (F.lane < 36 ? bre[F.lane - 4] : 0.f); }
                float lg[4];
#pragma unroll
                for (int j = 0; j < 4; ++j) lg[j] = __shfl(mine, j);
                int grp = 0; float gm = lg[0];
#pragma unroll
                for (int j = 1; j < 4; ++j) if (lg[j] > gm) { gm = lg[j]; grp = j; }
                float gs = 0.f;
#pragma unroll
                for (int j = 0; j < 4; ++j) gs += __expf(lg[j] - gm);
                const float gw = 1.0f / gs;
                float le[8];
#pragma unroll
                for (int i = 0; i < 8; ++i) le[i] = __shfl(mine, 4 + grp * 8 + i);
                int i1 = 0; float m1 = le[0];
#pragma unroll
                for (int i = 1; i < 8; ++i) if (le[i] > m1) { m1 = le[i]; i1 = i; }
                int i2 = -1; float m2 = -3.0e38f;
#pragma unroll
                for (int i = 0; i < 8; ++i) if (i != i1 && le[i] > m2) { m2 = le[i]; i2 = i; }
                const float e2 = __expf(m2 - m1), den = 1.0f / (1.0f + e2);
                if (F.lane == 0) {
                    const int e0 = grp * 8 + i1, e1 = grp * 8 + i2;
                    int* ri = (int*)(ws + WS_ROUTE) + (size_t)row * 4; ri[0] = e0; ri[1] = e1; ((float*)ri)[2] = den * gw; ((float*)ri)[3] = e2 * den * gw;
                    atomicAdd((int*)&hist[e0], 1); atomicAdd((int*)&hist[e1], 1);
                }
            }
        }
        if (MODE == 0) { __syncthreads(); if (F.tid < NEXP) ((int*)(ws + WS_CNT))[chunk * NEXP + F.tid] = hist[F.tid]; }
    }
    __syncthreads();
}

__device__ __forceinline__ void phase_ln1_router(const Frame& F, const Args& a, int layer) {
    unsigned char* ws = a.ws;
    bf16_t* X = (bf16_t*)(ws + WS_X); const bf16_t* Ra = (const bf16_t*)(ws + WS_R1);
    const float* gam = a.in[IN_LN1G] + layer * DM; const float* bet = a.in[IN_LN1B] + layer * DM;
    const float* WR = (const float*)(ws + WS_WR) + (size_t)layer * 48 * DM;
    LAS int* hist = (LAS int*)F.lds; LAS float* Lg = (LAS float*)(F.lds + 1024) + F.wave * (16 * 48);
    const int r = F.lane & 15, g = F.lane >> 4;
    for (int chunk = F.bid; chunk < NTOK / 256; chunk += F.G) {
        __syncthreads(); if (F.tid < NEXP) hist[F.tid] = 0; __syncthreads();
#pragma unroll 1
        for (int grp = 0; grp < 2; ++grp) {
            const int row = chunk * 256 + F.wave * 32 + grp * 16 + r;
            const bf16_t* xp = X + (size_t)row * DM + 8 * g; const bf16_t* mp = Ra + (size_t)row * DM + 8 * g;
            float s = 0.f, ss = 0.f;
#pragma unroll 8
            for (int kk = 0; kk < 32; ++kk) { float xv[8], mv[8]; unpack8(*(const u32x4*)(xp + 32 * kk), xv); unpack8(*(const u32x4*)(mp + 32 * kk), mv);
#pragma unroll
                for (int q = 0; q < 8; ++q) { const float y = DN_ALPHA * xv[q] + mv[q]; s += y; ss += y * y; } }
            s += __shfl_xor(s, 16); s += __shfl_xor(s, 32); ss += __shfl_xor(ss, 16); ss += __shfl_xor(ss, 32);
            const float mean = s * (1.0f / DM), var = fmaxf(ss * (1.0f / DM) - mean * mean, 0.f), rstd = 1.0f / sqrtf(var + LN_EPS);
            f32x4 acc[3];
#pragma unroll
            for (int nb = 0; nb < 3; ++nb) acc[nb] = (f32x4){0.f, 0.f, 0.f, 0.f};
#pragma unroll 2
            for (int kk = 0; kk < 32; ++kk) { float xv[8], mv[8], y[8]; unpack8(*(const u32x4*)(xp + 32 * kk), xv); unpack8(*(const u32x4*)(mp + 32 * kk), mv);
                const int c = 32 * kk + 8 * g;
                const f32x4 g0 = *(const f32x4*)(gam + c), g1 = *(const f32x4*)(gam + c + 4), b0 = *(const f32x4*)(bet + c), b1 = *(const f32x4*)(bet + c + 4);
#pragma unroll
                for (int q = 0; q < 4; ++q) { y[q] = (DN_ALPHA * xv[q] + mv[q] - mean) * rstd * g0[q] + b0[q]; y[4 + q] = (DN_ALPHA * xv[4 + q] + mv[4 + q] - mean) * rstd * g1[q] + b1[q]; }
                *(u32x4*)(X + (size_t)row * DM + c) = pack8(y);
#pragma unroll
                for (int nb = 0; nb < 3; ++nb) { const float* wp = WR + (size_t)(16 * nb + r) * DM + c; const f32x4 w0 = *(const f32x4*)wp, w1 = *(const f32x4*)(wp + 4);
#pragma unroll
                    for (int q = 0; q < 4; ++q) acc[nb] = __builtin_amdgcn_mfma_f32_16x16x4f32(y[q], w0[q], acc[nb], 0, 0, 0);
#pragma unroll
                    for (int q = 0; q < 4; ++q) acc[nb] = __builtin_amdgcn_mfma_f32_16x16x4f32(y[4 + q], w1[q], acc[nb], 0, 0, 0); } }
#pragma unroll
            for (int nb = 0; nb < 3; ++nb)
#pragma unroll
                for (int t = 0; t < 4; ++t) Lg[(4 * g + t) * 48 + 16 * nb + r] = acc[nb][t];
            asm volatile("s_waitcnt lgkmcnt(0)" ::: "memory");
            if (F.lane < 16) {
                const LAS float* L = Lg + r * 48; const float* brg = a.in[IN_BRG] + layer * 4; const float* bre = a.in[IN_BRE] + layer * 32;
                float lg[4];
#pragma unroll
                for (int q = 0; q < 4; ++q) lg[q] = L[q] + brg[q];
                int grpi = 0; float gm = lg[0];
#pragma unroll
                for (int q = 1; q < 4; ++q) if (lg[q] > gm) { gm = lg[q]; grpi = q; }
                float gs = 0.f;
#pragma unroll
                for (int q = 0; q < 4; ++q) gs += __expf(lg[q] - gm);
                const float gw = 1.0f / gs;
                float le[8];
#pragma unroll
                for (int i = 0; i < 8; ++i) le[i] = L[4 + grpi * 8 + i] + bre[grpi * 8 + i];
                int i1 = 0; float m1 = le[0];
#pragma unroll
                for (int i = 1; i < 8; ++i) if (le[i] > m1) { m1 = le[i]; i1 = i; }
                int i2 = -1; float m2 = -3.0e38f;
#pragma unroll
                for (int i = 0; i < 8; ++i) if (i != i1 && le[i] > m2) { m2 = le[i]; i2 = i; }
                const float e2 = __expf(m2 - m1), den = 1.0f / (1.0f + e2);
                const int e0 = grpi * 8 + i1, e1 = grpi * 8 + i2;
                int* ri = (int*)(ws + WS_ROUTE) + (size_t)row * 4; ri[0] = e0; ri[1] = e1; ((float*)ri)[2] = den * gw; ((float*)ri)[3] = e2 * den * gw;
                atomicAdd((int*)&hist[e0], 1); atomicAdd((int*)&hist[e1], 1);
            }
            asm volatile("s_waitcnt lgkmcnt(0)" ::: "memory");
        }
        __syncthreads(); if (F.tid < NEXP) ((int*)(ws + WS_CNT))[chunk * NEXP + F.tid] = hist[F.tid];
    }
    __syncthreads();
}

__device__ __forceinline__ void phase_scatter(const Frame& F, const Args& a) {
    unsigned char* ws = a.ws;
    const int* cnt = (const int*)(ws + WS_CNT); int* tile = (int*)(ws + WS_TILE);
    int* slot_tok = (int*)(ws + WS_SLOT_TOK); float* slot_g = (float*)(ws + WS_SLOT_G); int* slot_dst = (int*)(ws + WS_SLOT_DST);
    LAS int* C = (LAS int*)F.lds;
    LAS int* total = C + 256 * NEXP;
    LAS int* tstart = total + NEXP;
    LAS int* base = tstart + NEXP + 1;
    LAS int* el = base + NEXP;
    __syncthreads();
    for (int i = F.tid; i < 256 * NEXP; i += NTHREADS) C[i] = cnt[i];
    __syncthreads();
    if (F.tid < NEXP) { int s = 0; for (int c = 0; c < 256; ++c) s += C[c * NEXP + F.tid]; total[F.tid] = s; }
    __syncthreads();
    if (F.tid == 0) { int t = 0; for (int e = 0; e < NEXP; ++e) { tstart[e] = t; t += (total[e] + 255) >> 8; } tstart[NEXP] = t; }
    __syncthreads();
    const int T = tstart[NEXP];
    if (F.bid == 0) { if (F.tid == 0) tile[0] = T; for (int e = 0; e < NEXP; ++e) for (int t = tstart[e] + F.tid; t < tstart[e + 1]; t += NTHREADS) tile[1 + t] = e; }
    for (int e = F.bid; e < NEXP; e += F.G) { const int s0 = tstart[e] * 256 + total[e], s1 = tstart[e + 1] * 256;
        for (int s = s0 + F.tid; s < s1; s += NTHREADS) { slot_tok[s] = 0; slot_g[s] = 0.f; slot_dst[s] = -1; } }
    for (int chunk = F.bid; chunk < NTOK / 256; chunk += F.G) {
        __syncthreads();
        if (F.tid < NEXP) { int s = 0; for (int c = 0; c < chunk; ++c) s += C[c * NEXP + F.tid]; base[F.tid] = tstart[F.tid] * 256 + s; }
        const int tok = chunk * 256 + (F.tid >> 1), k = F.tid & 1;
        const int* ri = (const int*)(ws + WS_ROUTE) + (size_t)tok * 4;
        const int e = ri[k]; const float g = ((const float*)ri)[2 + k];
        el[F.tid] = e;
        __syncthreads();
        int rank = 0;
        for (int q = 0; q < F.tid; ++q) rank += (el[q] == e) ? 1 : 0;
        const int slot = base[e] + rank;
        slot_tok[slot] = tok; slot_g[slot] = g; slot_dst[slot] = tok * 2 + k;
    }
    __syncthreads();
}

template <int DQK, int VP>
__device__ __forceinline__ void attn_keys64(const LAS float* Ks, const LAS float* Vs, const float (&q)[DQK], float (&o)[64], float& m, float& l, const float sc) {
#pragma unroll 1
    for (int jj = 0; jj < 64; ++jj) {
        float acc = 0.f; const LAS float* kr = Ks + jj * DQK;
#pragma unroll
        for (int d = 0; d < DQK; d += 4) { const f32x4 kv = *(const LAS f32x4*)(kr + d); acc += q[d] * kv[0] + q[d + 1] * kv[1] + q[d + 2] * kv[2] + q[d + 3] * kv[3]; }
        const float s = acc * sc, mx = fmaxf(m, s), corr = __builtin_amdgcn_exp2f(m - mx), p = __builtin_amdgcn_exp2f(s - mx);
        m = mx; l = l * corr + p; const LAS float* vr = Vs + jj * VP;
#pragma unroll
        for (int e = 0; e < 64; e += 4) { const f32x4 vv = *(const LAS f32x4*)(vr + e); o[e] = o[e] * corr + p * vv[0]; o[e + 1] = o[e + 1] * corr + p * vv[1]; o[e + 2] = o[e + 2] * corr + p * vv[2]; o[e + 3] = o[e + 3] * corr + p * vv[3]; }
    }
}
__device__ __forceinline__ void stage8(LAS float* dst, const bf16_t* src) { float f[8]; unpack8(*(const u32x4*)src, f); *(LAS f32x4*)dst = (f32x4){f[0], f[1], f[2], f[3]}; *(LAS f32x4*)(dst + 4) = (f32x4){f[4], f[5], f[6], f[7]}; }

__device__ __forceinline__ void attn_diff_naive(const Frame& F, const Args& a, int layer, int unit) {
    unsigned char* ws = a.ws; const bf16_t* H = (const bf16_t*)(ws + WS_R1); bf16_t* O = (bf16_t*)(ws + WS_R3); float* TS = (float*)(ws + WS_R1 + 256 * MiB);
    const int j = layer >> 1; const float lambda_init = 0.8f - 0.6f * expf(-0.3f * (float)layer);
    float d1 = 0.f, d2 = 0.f;
    for (int i = 0; i < 64; ++i) { d1 += a.in[IN_LQ1][j * 64 + i] * a.in[IN_LK1][j * 64 + i]; d2 += a.in[IN_LQ2][j * 64 + i] * a.in[IN_LK2][j * 64 + i]; }
    const float lam = expf(d1) - expf(d2) + lambda_init;
    const int qb = unit & 7, h = (unit >> 3) & 3, b = unit >> 5;
    const int ql = (F.tid & 31) + 32 * (F.tid >> 6), half = (F.tid >> 5) & 1;
    const size_t row = (size_t)b * SEQ + qb * 256 + ql;
    LAS float* Ks = (LAS float*)F.lds; LAS float* Vs = Ks + 64 * 64;
    const float sc = 0.125f * 1.4426950408889634f;
    float* stash = TS + row * 512 + h * 128 + half * 64;
#pragma unroll 1
    for (int st = 0; st < 2; ++st) {
        float o[64], q[64];
#pragma unroll
        for (int d = 0; d < 64; d += 8) { float f[8]; unpack8(*(const u32x4*)(H + row * HLD + h * 128 + st * 64 + d), f);
#pragma unroll
            for (int t = 0; t < 8; ++t) q[d + t] = f[t]; }
        float m = -INFINITY, l = 0.f;
#pragma unroll
        for (int e = 0; e < 64; ++e) o[e] = 0.f;
#pragma unroll 1
        for (int kt = 0; kt < SEQ / 64; ++kt) {
            __syncthreads();
            { const int key = F.tid >> 3, d8 = (F.tid & 7) * 8; const size_t krow = (size_t)b * SEQ + kt * 64 + key;
              stage8(Ks + key * 64 + d8, H + krow * HLD + 512 + h * 128 + st * 64 + d8);
              stage8(Vs + key * 128 + d8, H + krow * HLD + 1024 + h * 128 + d8); stage8(Vs + key * 128 + 64 + d8, H + krow * HLD + 1024 + h * 128 + 64 + d8); }
            __syncthreads();
            attn_keys64<64, 128>(Ks, Vs + half * 64, q, o, m, l, sc);
        }
        const float inv = 1.0f / l;
        if (st == 0) {
#pragma unroll
            for (int e = 0; e < 64; e += 4) *(f32x4*)(stash + e) = (f32x4){o[e] * inv, o[e + 1] * inv, o[e + 2] * inv, o[e + 3] * inv};
        } else {
            float ss = 0.f;
#pragma unroll
            for (int e = 0; e < 64; e += 4) { const f32x4 p0 = *(const f32x4*)(stash + e);
#pragma unroll
                for (int t = 0; t < 4; ++t) { o[e + t] = p0[t] - lam * (o[e + t] * inv); ss += o[e + t] * o[e + t]; } }
            ss += __shfl_xor(ss, 32);
            const float rs = 1.0f / sqrtf(ss * (1.0f / 128.0f) + RMS_EPS) * (1.0f - lambda_init);
            const float* g = a.in[IN_SUBLN] + j * 128 + half * 64;
#pragma unroll
            for (int e = 0; e < 64; e += 8) { float t8[8];
#pragma unroll
                for (int t = 0; t < 8; ++t) t8[t] = o[e + t] * rs * g[e + t];
                *(u32x4*)(O + row * DM + h * 128 + half * 64 + e) = pack8(t8); }
        }
    }
}
__device__ __forceinline__ void attn_mla_naive(const Frame& F, const Args& a, int unit) {
    unsigned char* ws = a.ws; const bf16_t* QB = (const bf16_t*)(ws + WS_R2); const bf16_t* KVB = QB + (size_t)NTOK * 768; const bf16_t* KR = KVB + (size_t)NTOK * 1024; bf16_t* O = (bf16_t*)(ws + WS_R3);
    const int qb = unit & 3, h = (unit >> 2) & 7, b = unit >> 5;
    const size_t row = (size_t)b * SEQ + qb * 512 + F.tid;
    LAS float* Ks = (LAS float*)F.lds; LAS float* Vs = Ks + 64 * 96;
    const float sc = 0.10206207261596575f * 1.4426950408889634f;
    float q[96], o[64];
#pragma unroll
    for (int d = 0; d < 96; d += 8) { float f[8]; unpack8(*(const u32x4*)(QB + row * 768 + h * 96 + d), f);
#pragma unroll
        for (int t = 0; t < 8; ++t) q[d + t] = f[t]; }
    { const float* rb = (const float*)(ws + WS_ROPEB); const int pos = (int)(row & (SEQ - 1));
#pragma unroll
      for (int i = 0; i < 16; i += 4) { const f32x4 cs = *(const f32x4*)(rb + pos * 16 + i), sn = *(const f32x4*)(rb + SEQ * 16 + pos * 16 + i);
#pragma unroll
          for (int t = 0; t < 4; ++t) { const float x1 = q[64 + i + t], x2 = q[80 + i + t]; q[64 + i + t] = x1 * cs[t] - x2 * sn[t]; q[80 + i + t] = x2 * cs[t] + x1 * sn[t]; } } }
    float m = -INFINITY, l = 0.f;
#pragma unroll
    for (int e = 0; e < 64; ++e) o[e] = 0.f;
#pragma unroll 1
    for (int kt = 0; kt < SEQ / 64; ++kt) {
        __syncthreads();
        { const int key = F.tid >> 3, d8 = (F.tid & 7) * 8; const size_t krow = (size_t)b * SEQ + kt * 64 + key;
          stage8(Ks + key * 96 + d8, KVB + krow * 1024 + h * 128 + d8);
          stage8(Vs + key * 64 + d8, KVB + krow * 1024 + h * 128 + 64 + d8);
          if (F.tid < 256) { const int key2 = F.tid >> 2, r8 = (F.tid & 3) * 8; stage8(Ks + key2 * 96 + 64 + r8, KR + ((size_t)b * SEQ + kt * 64 + key2) * 32 + r8); } }
        __syncthreads();
        attn_keys64<96, 64>(Ks, Vs, q, o, m, l, sc);
    }
    const float inv = 1.0f / l;
#pragma unroll
    for (int e = 0; e < 64; e += 8) { float t8[8];
#pragma unroll
        for (int t = 0; t < 8; ++t) t8[t] = o[e + t] * inv;
        *(u32x4*)(O + row * DM + 512 + h * 64 + e) = pack8(t8); }
}
__device__ __forceinline__ void attn_na_naive(const Frame& F, const Args& a, int layer, int unit) {
    unsigned char* ws = a.ws; const bf16_t* QKV = (const bf16_t*)(ws + WS_R1); bf16_t* O = (bf16_t*)(ws + WS_R3);
    const float* relb = a.in[IN_RELB] + (size_t)(layer >> 1) * 16 * 15 * 31;
    const int hh = unit & 1, r = (unit >> 1) & 31, b = unit >> 6;
    const int c = F.tid & 63, h = hh * 8 + (F.tid >> 6);
    const int r0 = min(max(r - 4, 0), 24), c0 = min(max(c - 8, 0), 48);
    const size_t row = (size_t)b * SEQ + r * 64 + c;
    const float LOG2E = 1.4426950408889634f;
    float q[64], o[64];
#pragma unroll
    for (int d = 0; d < 64; d += 8) { float f[8]; unpack8(*(const u32x4*)(QKV + row * 3072 + h * 64 + d), f);
#pragma unroll
        for (int t = 0; t < 8; ++t) q[d + t] = f[t]; }
    float m = -INFINITY, l = 0.f;
#pragma unroll
    for (int e = 0; e < 64; ++e) o[e] = 0.f;
#pragma unroll 1
    for (int ij = 0; ij < 128; ++ij) {
        const int i = ij >> 4, jj = ij & 15;
        const size_t krow = (size_t)b * SEQ + (r0 + i) * 64 + c0 + jj;
        const float bias = relb[((size_t)h * 15 + (r0 + i - r + 7)) * 31 + (c0 + jj - c + 15)];
        float acc = 0.f; const bf16_t* kp = QKV + krow * 3072 + 1024 + h * 64;
#pragma unroll
        for (int d = 0; d < 64; d += 8) { float f[8]; unpack8(*(const u32x4*)(kp + d), f);
#pragma unroll
            for (int t = 0; t < 8; ++t) acc += q[d + t] * f[t]; }
        const float s = (acc * 0.125f + bias) * LOG2E, mx = fmaxf(m, s), corr = __builtin_amdgcn_exp2f(m - mx), p = __builtin_amdgcn_exp2f(s - mx);
        m = mx; l = l * corr + p; const bf16_t* vp = kp + 1024;
#pragma unroll
        for (int e = 0; e < 64; e += 8) { float f[8]; unpack8(*(const u32x4*)(vp + e), f);
#pragma unroll
            for (int t = 0; t < 8; ++t) o[e + t] = o[e + t] * corr + p * f[t]; }
    }
    const float inv = 1.0f / l;
#pragma unroll
    for (int e = 0; e < 64; e += 8) { float t8[8];
#pragma unroll
        for (int t = 0; t < 8; ++t) t8[t] = o[e + t] * inv;
        *(u32x4*)(O + row * DM + h * 64 + e) = pack8(t8); }
}

namespace fa {
typedef float f32x16 __attribute__((ext_vector_type(16)));
typedef short s16x4 __attribute__((ext_vector_type(4)));
#define FA_SBAR() __builtin_amdgcn_sched_barrier(0)
__device__ __forceinline__ int crow(int r, int hi) { return (r & 3) + 8 * (r >> 2) + 4 * hi; }
constexpr float THR = 8.f;
template <int SCALE_E6> __device__ __forceinline__ void partialSM(f32x16& p0, f32x16& p1, float& m_reg, float& mn, float& alpha) {
    constexpr float SCALE = SCALE_E6 * 1e-6f, C = SCALE * 1.4426950408889634f;
    float pmax = p0[0];
#pragma unroll
    for (int r = 1; r < 16; ++r) pmax = fmaxf(pmax, p0[r]);
#pragma unroll
    for (int r = 0; r < 16; ++r) pmax = fmaxf(pmax, p1[r]);
    { auto rr = __builtin_amdgcn_permlane32_swap(__float_as_uint(pmax), __float_as_uint(pmax), false, false); pmax = fmaxf(__uint_as_float(rr[0]), __uint_as_float(rr[1])); }
    if (__builtin_expect(__all(pmax - m_reg <= THR / SCALE), 1)) { mn = m_reg; alpha = 1.f; }
    else { mn = fmaxf(m_reg, pmax); alpha = __builtin_amdgcn_exp2f((m_reg - mn) * C); m_reg = mn; }
    const float mnC = -mn * C;
#pragma unroll
    for (int r = 0; r < 16; ++r) p0[r] = fmaf(p0[r], C, mnC);
#pragma unroll
    for (int r = 0; r < 16; ++r) p1[r] = fmaf(p1[r], C, mnC);
#pragma unroll
    for (int r = 0; r < 16; ++r) p0[r] = __builtin_amdgcn_exp2f(p0[r]);
}
__device__ __forceinline__ void finishSM(f32x16& p0, f32x16& p1, float alpha, float& l_reg, bf16x8& pa0, bf16x8& pa1, bf16x8& pa2, bf16x8& pa3) {
#pragma unroll
    for (int r = 0; r < 16; ++r) p1[r] = __builtin_amdgcn_exp2f(p1[r]);
    float ps = 0;
#pragma unroll
    for (int r = 0; r < 16; ++r) ps += p0[r];
#pragma unroll
    for (int r = 0; r < 16; ++r) ps += p1[r];
    { auto rr = __builtin_amdgcn_permlane32_swap(__float_as_uint(ps), __float_as_uint(ps), false, false); ps = __uint_as_float(rr[0]) + __uint_as_float(rr[1]); }
    l_reg = l_reg * alpha + ps;
#define FA_PK4(P, BASE, OUT) do { unsigned a0 = cvt_pk_bf16(P[BASE + 0], P[BASE + 1]), a1 = cvt_pk_bf16(P[BASE + 2], P[BASE + 3]);   \
    unsigned b0 = cvt_pk_bf16(P[BASE + 4], P[BASE + 5]), b1 = cvt_pk_bf16(P[BASE + 6], P[BASE + 7]);                              \
    auto r0 = __builtin_amdgcn_permlane32_swap(a0, b0, false, false); auto r1 = __builtin_amdgcn_permlane32_swap(a1, b1, false, false); \
    u32x4 w = {r0[0], r1[0], r0[1], r1[1]}; OUT = *reinterpret_cast<bf16x8*>(&w); } while (0)
    FA_PK4(p0, 0, pa0); FA_PK4(p0, 8, pa1); FA_PK4(p1, 0, pa2); FA_PK4(p1, 8, pa3);
#undef FA_PK4
}
template <int NKS> __device__ __forceinline__ void qkt(f32x16& p0, f32x16& p1, const LAS char* Ks, const bf16x8 (&qr)[NKS], int r32, int hi) {
    p0 = f32x16{}; p1 = f32x16{};
#pragma unroll
    for (int d0 = 0; d0 < NKS; ++d0) {
        const bf16x8 b0 = *(const LAS bf16x8*)(Ks + ((2 * d0 + hi) * 64 + r32) * 16);
        const bf16x8 b1 = *(const LAS bf16x8*)(Ks + ((2 * d0 + hi) * 64 + 32 + r32) * 16);
        p0 = __builtin_amdgcn_mfma_f32_32x32x16_bf16(b0, qr[d0], p0, 0, 0, 0);
        p1 = __builtin_amdgcn_mfma_f32_32x32x16_bf16(b1, qr[d0], p1, 0, 0, 0); }
}
template <int NCB> __device__ __forceinline__ int v_st(int k, int c) { const int kk = (k & ~0xC) | ((k & 4) << 1) | ((k & 8) >> 1); return ((kk >> 3) * NCB + (c >> 5)) * 512 + ((kk & 7) * 32 + (c & 31)) * 2; }
__device__ __forceinline__ int v_rd_base(int lane) { return ((lane & 3) << 3) | (((lane >> 2) & 3) << 6) | (((lane >> 4) & 1) << 5) | (((lane >> 5) & 1) << 8); }
template <int NCB> constexpr int v_rd_off(int d0, int ks, int half) { return d0 * 512 + ks * (NCB * 1024) + half * (NCB * 512); }
template <int OFF> __device__ __forceinline__ s16x4 tr_read(int vb) { s16x4 r; asm volatile("ds_read_b64_tr_b16 %0, %1 offset:%2" : "=&v"(r) : "v"(vb), "i"(OFF) : "memory"); return r; }
template <int D0, int NCB> __device__ __forceinline__ void pv_one(f32x16& od, int vb, bf16x8 pa0, bf16x8 pa1, bf16x8 pa2, bf16x8 pa3) {
    const s16x4 l0 = tr_read<v_rd_off<NCB>(D0, 0, 0)>(vb), h0 = tr_read<v_rd_off<NCB>(D0, 0, 1)>(vb), l1 = tr_read<v_rd_off<NCB>(D0, 1, 0)>(vb), h1 = tr_read<v_rd_off<NCB>(D0, 1, 1)>(vb);
    const s16x4 l2 = tr_read<v_rd_off<NCB>(D0, 2, 0)>(vb), h2 = tr_read<v_rd_off<NCB>(D0, 2, 1)>(vb), l3 = tr_read<v_rd_off<NCB>(D0, 3, 0)>(vb), h3 = tr_read<v_rd_off<NCB>(D0, 3, 1)>(vb);
    asm volatile("s_waitcnt lgkmcnt(0)" ::: "memory"); FA_SBAR();
#define FA_PK(L, H) (bf16x8){L[0], L[1], L[2], L[3], H[0], H[1], H[2], H[3]}
    od = __builtin_amdgcn_mfma_f32_32x32x16_bf16(pa0, FA_PK(l0, h0), od, 0, 0, 0);
    od = __builtin_amdgcn_mfma_f32_32x32x16_bf16(pa1, FA_PK(l1, h1), od, 0, 0, 0);
    od = __builtin_amdgcn_mfma_f32_32x32x16_bf16(pa2, FA_PK(l2, h2), od, 0, 0, 0);
    od = __builtin_amdgcn_mfma_f32_32x32x16_bf16(pa3, FA_PK(l3, h3), od, 0, 0, 0);
#undef FA_PK
}
template <int NCB> __device__ __forceinline__ void pv_all(f32x16 (&o)[NCB], int vb, bf16x8 pa0, bf16x8 pa1, bf16x8 pa2, bf16x8 pa3) {
    pv_one<0, NCB>(o[0], vb, pa0, pa1, pa2, pa3); pv_one<1, NCB>(o[1], vb, pa0, pa1, pa2, pa3);
    if constexpr (NCB == 4) { pv_one<2, NCB>(o[2], vb, pa0, pa1, pa2, pa3); pv_one<3, NCB>(o[3], vb, pa0, pa1, pa2, pa3); }
}

template <int DQK, int DV, int SCALE_E6, int SDEPTH>
__device__ __forceinline__ void attn_stream(const Frame& F, const bf16_t* __restrict__ Qb, int LDQ, const bf16_t* __restrict__ Kh, int LDK, const bf16_t* __restrict__ KRh, const bf16_t* __restrict__ Vh, int LDV,
                                            const float* ropeB, int qpos0, f32x16 (&o)[DV / 32], float (&rli)[16]) {
    constexpr int NKS = DQK / 16, NCB = DV / 32, SHM_K = 64 * DQK * 2, SHM_V = 64 * DV * 2;
    const int tid = F.tid, wid = F.wave, lane = F.lane, r32 = lane & 31, hi = lane >> 5;
    LAS char* V_lds = (LAS char*)F.lds; LAS char* K_lds = V_lds + 2 * SHM_V;
    LAS float* wsl = (LAS float*)(K_lds + 2 * SHM_K) + wid * 64; LAS float* li_l = wsl; LAS float* al_l = wsl + 32;
    float m_reg = -1e30f, l_reg = 0.f; bf16x8 qr[NKS];
#pragma unroll
    for (int d = 0; d < NCB; ++d) o[d] = f32x16{};
    const bf16_t* Qw = Qb + (size_t)(wid * 32 + r32) * LDQ + hi * 8;
#pragma unroll
    for (int d0 = 0; d0 < NKS; ++d0) qr[d0] = *(const bf16x8*)(Qw + d0 * 16);
    if constexpr (DQK == 96) {
        const int pos = qpos0 + wid * 32 + r32; float x1[8], x2[8];
        unpack8(*(const u32x4*)&qr[4], x1); unpack8(*(const u32x4*)&qr[5], x2);
        const float* cp = ropeB + pos * 16 + 8 * hi; const float* sp = ropeB + SEQ * 16 + pos * 16 + 8 * hi;
#pragma unroll
        for (int jj = 0; jj < 8; ++jj) { const float c = cp[jj], sn = sp[jj], a = x1[jj], b = x2[jj]; x1[jj] = a * c - b * sn; x2[jj] = b * c + a * sn; }
        u32x4 w1 = pack8(x1), w2 = pack8(x2); qr[4] = *(bf16x8*)&w1; qr[5] = *(bf16x8*)&w2;
    }
    const int krow = (tid & 7) + 8 * (tid >> 6), kcs = (tid >> 3) & 7;
    const int rrow = (tid & 7) + 8 * ((tid >> 5) & 7), rcs = (tid >> 3) & 3;
    const int vr0 = (DV == 128) ? (tid >> 4) : (tid >> 3), vc = (DV == 128) ? (tid & 15) * 8 : (tid & 7) * 8;
    const int vst0 = v_st<NCB>(vr0, vc), vst1 = v_st<NCB>(32 + vr0, vc);
    const int vb0 = (int)(uintptr_t)V_lds + v_rd_base(lane);
    struct Slot { bf16x8 k0, kr, v0, v1; } sl[SDEPTH];
    constexpr int SE = 0, SO = SDEPTH - 1;
#define FA_SLOAD(i, key0) do { sl[i].k0 = *(const bf16x8*)(Kh + (size_t)((key0) + krow) * LDK + kcs * 8); \
        if constexpr (DQK == 96) sl[i].kr = *(const bf16x8*)(KRh + (size_t)((key0) + rrow) * 32 + rcs * 8); \
        sl[i].v0 = *(const bf16x8*)(Vh + (size_t)((key0) + vr0) * LDV + vc); \
        if constexpr (DV == 128) sl[i].v1 = *(const bf16x8*)(Vh + (size_t)((key0) + 32 + vr0) * LDV + vc); } while (0)
#define FA_SWRITE(b, i) do { *(LAS bf16x8*)(K_lds + (b) * SHM_K + (kcs * 64 + krow) * 16) = sl[i].k0; \
        if constexpr (DQK == 96) { if (tid < 256) *(LAS bf16x8*)(K_lds + (b) * SHM_K + ((8 + rcs) * 64 + rrow) * 16) = sl[i].kr; } \
        *(LAS bf16x8*)(V_lds + (b) * SHM_V + vst0) = sl[i].v0; \
        if constexpr (DV == 128) *(LAS bf16x8*)(V_lds + (b) * SHM_V + vst1) = sl[i].v1; } while (0)
#define FA_SWAIT() do { if constexpr (SDEPTH == 2) asm volatile("s_waitcnt vmcnt(3)" ::: "memory"); else asm volatile("s_waitcnt vmcnt(0)" ::: "memory"); } while (0)
#define FA_RESC(a) do { if (__any((a) < 1.f)) { if (hi == 0) al_l[r32] = (a); asm volatile("s_waitcnt lgkmcnt(0)" ::: "memory"); \
        _Pragma("unroll") for (int d = 0; d < NCB; ++d) _Pragma("unroll") for (int r = 0; r < 16; ++r) o[d][r] *= al_l[crow(r, hi)]; } } while (0)
    f32x16 pA0, pA1, pB0, pB1; float mnA, mnB, alA, alB; bf16x8 pa0, pa1, pa2, pa3; constexpr int NT = SEQ / 64;
    FA_SLOAD(SE, 0); asm volatile("s_waitcnt vmcnt(0)" ::: "memory"); FA_SWRITE(0, SE); __syncthreads();
    qkt<NKS>(pA0, pA1, K_lds, qr, r32, hi); partialSM<SCALE_E6>(pA0, pA1, m_reg, mnA, alA);
    FA_SLOAD(SO, 64); if constexpr (SDEPTH == 2) FA_SLOAD(SE, 128);
    FA_SWAIT(); FA_SWRITE(1, SO); __syncthreads();
#pragma unroll 1
    for (int j = 1; j + 1 < NT; j += 2) {
        FA_SBAR(); qkt<NKS>(pB0, pB1, K_lds + SHM_K, qr, r32, hi);
        finishSM(pA0, pA1, alA, l_reg, pa0, pa1, pa2, pa3); FA_SBAR();
        FA_SLOAD(SO, (j + SDEPTH) * 64); FA_SBAR();
        pv_all<NCB>(o, vb0, pa0, pa1, pa2, pa3); partialSM<SCALE_E6>(pB0, pB1, m_reg, mnB, alB);
        __syncthreads(); FA_SWAIT(); FA_SWRITE(0, SE);
        FA_RESC(alB); __syncthreads();
        FA_SBAR(); qkt<NKS>(pA0, pA1, K_lds, qr, r32, hi);
        finishSM(pB0, pB1, alB, l_reg, pa0, pa1, pa2, pa3); FA_SBAR();
        if (SDEPTH == 1 || j + 3 < NT) FA_SLOAD(SE, (j + 1 + SDEPTH) * 64); FA_SBAR();
        pv_all<NCB>(o, vb0 + SHM_V, pa0, pa1, pa2, pa3); partialSM<SCALE_E6>(pA0, pA1, m_reg, mnA, alA);
        __syncthreads(); FA_SWAIT(); FA_SWRITE(1, SO);
        FA_RESC(alA); __syncthreads();
    }
    FA_SBAR(); qkt<NKS>(pB0, pB1, K_lds + SHM_K, qr, r32, hi);
    finishSM(pA0, pA1, alA, l_reg, pa0, pa1, pa2, pa3); FA_SBAR();
    pv_all<NCB>(o, vb0, pa0, pa1, pa2, pa3); partialSM<SCALE_E6>(pB0, pB1, m_reg, mnB, alB);
    __syncthreads(); FA_RESC(alB);
    finishSM(pB0, pB1, alB, l_reg, pa0, pa1, pa2, pa3); FA_SBAR();
    pv_all<NCB>(o, vb0 + SHM_V, pa0, pa1, pa2, pa3);
    if (hi == 0) li_l[r32] = l_reg;
    asm volatile("s_waitcnt lgkmcnt(0)" ::: "memory");
#pragma unroll
    for (int r = 0; r < 16; ++r) rli[r] = __builtin_amdgcn_rcpf(li_l[crow(r, hi)]);
#undef FA_SLOAD
#undef FA_SWRITE
#undef FA_SWAIT
#undef FA_RESC
}
}

__device__ __forceinline__ void attn_diff_mfma(const Frame& F, const Args& a, int layer, int unit) {
    unsigned char* ws = a.ws; const bf16_t* H = (const bf16_t*)(ws + WS_R1); bf16_t* O = (bf16_t*)(ws + WS_R3); float* TS = (float*)(ws + WS_R1 + 256 * MiB);
    const int jl = layer >> 1; const float lambda_init = 0.8f - 0.6f * expf(-0.3f * (float)layer);
    const float lam = ((const float*)(ws + WS_LAM))[jl];
    const int qb = unit & 7, h = (unit >> 3) & 3, b = unit >> 5;
    const size_t row0 = (size_t)b * SEQ + qb * 256, key0 = (size_t)b * SEQ;
#pragma unroll 1
    for (int st = 0; st < 2; ++st) {
        fa::f32x16 o[4]; float rli[16];
        __syncthreads();
        const Frame Fs = fresh(F);
        float* stash = TS + ((size_t)unit * NTHREADS + Fs.tid) * 64;
        fa::attn_stream<64, 128, 125000, 2>(Fs, H + row0 * HLD + h * 128 + st * 64, HLD, H + key0 * HLD + 512 + h * 128 + st * 64, HLD, nullptr, H + key0 * HLD + 1024 + h * 128, HLD, nullptr, 0, o, rli);
        const Frame Fe = fresh(F); const int r32 = Fe.lane & 31, hi = Fe.lane >> 5;
        if (st == 0) {
#pragma unroll
            for (int d = 0; d < 4; ++d)
#pragma unroll
                for (int r = 0; r < 16; r += 4) *(f32x4*)(stash + d * 16 + r) = (f32x4){o[d][r] * rli[r], o[d][r + 1] * rli[r + 1], o[d][r + 2] * rli[r + 2], o[d][r + 3] * rli[r + 3]};
        } else {
            float ss[16];
#pragma unroll
            for (int r = 0; r < 16; ++r) ss[r] = 0.f;
#pragma unroll
            for (int d = 0; d < 4; ++d)
#pragma unroll
                for (int r = 0; r < 16; r += 4) { const f32x4 p0 = *(const f32x4*)(stash + d * 16 + r);
#pragma unroll
                    for (int t = 0; t < 4; ++t) { const float v = p0[t] - lam * (o[d][r + t] * rli[r + t]); o[d][r + t] = v; ss[r + t] += v * v; } }
#pragma unroll
            for (int r = 0; r < 16; ++r) { float v = ss[r]; v += __shfl_xor(v, 1); v += __shfl_xor(v, 2); v += __shfl_xor(v, 4); v += __shfl_xor(v, 8); v += __shfl_xor(v, 16);
                ss[r] = 1.0f / sqrtf(v * (1.0f / 128.0f) + RMS_EPS) * (1.0f - lambda_init); }
            const float* g = a.in[IN_SUBLN] + jl * 128;
#pragma unroll
            for (int d = 0; d < 4; ++d) { const float gd = g[d * 32 + r32];
#pragma unroll
                for (int r = 0; r < 16; ++r) { const size_t row = row0 + Fe.wave * 32 + fa::crow(r, hi);
                    O[row * DM + h * 128 + d * 32 + r32] = (bf16_t)(cvt_pk_bf16(o[d][r] * ss[r] * gd, 0.f) & 0xffffu); } }
        }
    }
}
__device__ __forceinline__ void attn_mla_mfma(const Frame& F, const Args& a, int unit) {
    unsigned char* ws = a.ws; const bf16_t* QB = (const bf16_t*)(ws + WS_R2); const bf16_t* KVB = QB + (size_t)NTOK * 768; const bf16_t* KR = KVB + (size_t)NTOK * 1024; bf16_t* O = (bf16_t*)(ws + WS_R3);
    const int qb = unit & 7, h = (unit >> 3) & 7, b = unit >> 6;
    const size_t row0 = (size_t)b * SEQ + qb * 256, key0 = (size_t)b * SEQ;
    fa::f32x16 o[2]; float rli[16];
    __syncthreads();
    const Frame Fs = fresh(F);
    fa::attn_stream<96, 64, 102062, 2>(Fs, QB + row0 * 768 + h * 96, 768, KVB + key0 * 1024 + h * 128, 1024, KR + key0 * 32, KVB + key0 * 1024 + h * 128 + 64, 1024, (const float*)(ws + WS_ROPEB), qb * 256, o, rli);
    const Frame Fe = fresh(F); const int r32 = Fe.lane & 31, hi = Fe.lane >> 5;
#pragma unroll
    for (int d = 0; d < 2; ++d)
#pragma unroll
        for (int r = 0; r < 16; ++r) { const size_t row = row0 + Fe.wave * 32 + fa::crow(r, hi);
            O[row * DM + 512 + h * 64 + d * 32 + r32] = (bf16_t)(cvt_pk_bf16(o[d][r] * rli[r], 0.f) & 0xffffu); }
}

constexpr int NA_KSTR = 580;
constexpr int NA_VOFF = 8 * NA_KSTR * 16;
constexpr int NA_BOFF = NA_VOFF + 72 * 64 * 16;
__device__ __forceinline__ void attn_na_lds(const Frame& F, const Args& a, int layer, int unit) {
    unsigned char* ws = a.ws; const bf16_t* Qc = (const bf16_t*)(ws + WS_R1); const bf16_t* Kc = Qc + (size_t)NTOK * DM; const bf16_t* Vt = Kc + (size_t)NTOK * DM; bf16_t* O = (bf16_t*)(ws + WS_R3);
    const int rp = unit & 15, h = (unit >> 4) & 15, b = unit >> 8;
    const int ra = rp * 2, r0a = min(max(ra - 4, 0), 24);
    const size_t bh = (size_t)(b * 16 + h);
    LAS char* lds = (LAS char*)F.lds; LAS float* bl = (LAS float*)(lds + NA_BOFF);
    __syncthreads();
    {
        const bf16_t* kg = Kc + (bh * SEQ + r0a * 64) * 64; const bf16_t* vg = Vt + (bh * (SEQ / 8) + r0a * 8) * 64 * 8;
        const int kk = (F.tid & 7) + 8 * (F.tid >> 6), cs = (F.tid >> 3) & 7;
        u32x4 kv[9], vv[9];
#pragma unroll
        for (int i = 0; i < 9; ++i) { kv[i] = *(const u32x4*)(kg + (size_t)(64 * i + kk) * 64 + cs * 8); vv[i] = *(const u32x4*)(vg + (size_t)(F.tid + NTHREADS * i) * 8); }
#pragma unroll
        for (int i = 0; i < 9; ++i) { *(LAS u32x4*)(lds + (cs * NA_KSTR + 64 * i + kk) * 16) = kv[i]; *(LAS u32x4*)(lds + NA_VOFF + (F.tid + NTHREADS * i) * 16) = vv[i]; }
        const float* relb = a.in[IN_RELB] + ((size_t)(layer >> 1) * 16 + h) * 465;
        if (F.tid < 465) bl[F.tid] = relb[F.tid];
    }
    __syncthreads();
    const int r = ra + (F.wave >> 2), j = F.wave & 3, qi = F.lane & 15, g = F.lane >> 4, c = 16 * j + qi;
    const int r0 = min(max(r - 4, 0), 24), d = r0 - r0a, c0 = min(max(c - 8, 0), 48), cb = (j == 0) ? 0 : (j == 1) ? 8 : (j == 2) ? 24 : 32;
    const float LOG2E = 1.4426950408889634f;
    const bf16_t* qp = Qc + (bh * SEQ + r * 64 + c) * 64 + 8 * g;
    const bf16x8 qf0 = *(const bf16x8*)qp, qf1 = *(const bf16x8*)(qp + 32);
    const int kx = 8 * (qi >> 2) + (qi & 3);
    const LAS char* kbase = lds + ((g * NA_KSTR) + d * 64 + cb + kx) * 16;
    f32x4 S[8][2];
#pragma unroll
    for (int i = 0; i < 8; ++i)
#pragma unroll
        for (int xb = 0; xb < 2; ++xb) { const LAS char* kp = kbase + (i * 64 + 4 * xb) * 16;
            const bf16x8 kf0 = *(const LAS bf16x8*)kp, kf1 = *(const LAS bf16x8*)(kp + 4 * NA_KSTR * 16);
            f32x4 z = (f32x4){0.f, 0.f, 0.f, 0.f};
            z = __builtin_amdgcn_mfma_f32_16x16x32_bf16(kf0, qf0, z, 0, 0, 0);
            z = __builtin_amdgcn_mfma_f32_16x16x32_bf16(kf1, qf1, z, 0, 0, 0);
            S[i][xb] = z; }
    float mx = -INFINITY;
#pragma unroll
    for (int i = 0; i < 8; ++i) { const LAS float* brow = bl + (r0 + i - r + 7) * 31;
#pragma unroll
        for (int xb = 0; xb < 2; ++xb)
#pragma unroll
            for (int t = 0; t < 4; ++t) { const int kc = cb + 8 * g + 4 * xb + t; const bool valid = (kc >= c0) && (kc < c0 + 16); const int co = min(max(kc - c + 15, 0), 30);
                const float v = valid ? (S[i][xb][t] * 0.125f + brow[co]) * LOG2E : -INFINITY; S[i][xb][t] = v; mx = fmaxf(mx, v); } }
    mx = fmaxf(mx, __shfl_xor(mx, 16)); mx = fmaxf(mx, __shfl_xor(mx, 32));
    float sum = 0.f; bf16x8 pf[8];
#pragma unroll
    for (int i = 0; i < 8; ++i) { float pv[8];
#pragma unroll
        for (int xb = 0; xb < 2; ++xb)
#pragma unroll
            for (int t = 0; t < 4; ++t) { const float p = __builtin_amdgcn_exp2f(S[i][xb][t] - mx); pv[xb * 4 + t] = p; sum += p; }
        const u32x4 w = pack8(pv); pf[i] = *(const bf16x8*)&w; }
    sum += __shfl_xor(sum, 16); sum += __shfl_xor(sum, 32);
    const float inv = 1.0f / sum;
    f32x4 acc[4];
    const LAS char* vbase = lds + NA_VOFF + ((d * 8 + (cb >> 3) + g) * 64 + qi) * 16;
#pragma unroll
    for (int dvb = 0; dvb < 4; ++dvb) { acc[dvb] = (f32x4){0.f, 0.f, 0.f, 0.f};
#pragma unroll
        for (int i = 0; i < 8; ++i) { const bf16x8 vf = *(const LAS bf16x8*)(vbase + (i * 8 * 64 + 16 * dvb) * 16);
            acc[dvb] = __builtin_amdgcn_mfma_f32_16x16x32_bf16(vf, pf[i], acc[dvb], 0, 0, 0); } }
    bf16_t* op = O + ((size_t)b * SEQ + r * 64 + c) * DM + h * 64 + 4 * g;
#pragma unroll
    for (int dvb = 0; dvb < 4; ++dvb) { u32x2 w; w.x = cvt_pk_bf16(acc[dvb][0] * inv, acc[dvb][1] * inv); w.y = cvt_pk_bf16(acc[dvb][2] * inv, acc[dvb][3] * inv); *(u32x2*)(op + 16 * dvb) = w; }
}

constexpr int LDS_BYTES = 160 * 1024;
constexpr int MISC_OFF = LDS_BYTES - 256;
static_assert(NA_BOFF + 2048 <= MISC_OFF, "neighbourhood attention LDS image");
constexpr int NPH_LAYER = 9, NPHASES = 1 + DEPTH * NPH_LAYER;

__global__ void __launch_bounds__(NTHREADS, 2) fwd_kernel(Args a) {
    extern __shared__ __attribute__((aligned(16))) unsigned char lds_raw[];
    Frame F; F.lds = (LAS unsigned char*)lds_raw; F.wave = __builtin_amdgcn_readfirstlane((int)threadIdx.x >> 6); F.tid = 0; F.lane = 0; F.G = gridDim.x; F.bid = blockIdx.x;
    unsigned char* ws = a.ws;
    volatile LAS unsigned* MISC = (volatile LAS unsigned*)(F.lds + MISC_OFF);
    { const Frame Fp = fresh(F); if (Fp.tid < 4) MISC[Fp.tid] = 0u; }
    __syncthreads();
    const bool one = (a.hi - a.lo) > 1;
    XcdBarrier bar; bar.bar = (unsigned*)(ws + WS_CTL); bar.x = 0; bar.st = MISC;
    if (one) { const Frame Fp = fresh(F); bar = xcd_barrier_post((unsigned*)(ws + WS_CTL), MISC, Fp.tid); }
#define IN(k) (a.lo <= (k) && (k) < a.hi)
#define SEAM(k) do { if (IN(k) && IN((k) + 1)) { const Frame Fb = fresh(F); xcd_barrier(bar, Fb.tid); } } while (0)

    if (IN(0)) REPEAT(0) { const Frame Fp = fresh(F); const Args ap = fresh(a); phase_prologue(Fp, ap); }
    SEAM(0);
#pragma unroll 1
    for (int layer = 0; layer < DEPTH; ++layer) {
        const int p0 = 1 + layer * NPH_LAYER, j = layer >> 1; const bool even = (layer & 1) == 0;
        if (IN(p0)) {
            const Frame Fp = fresh(F); const Args ap = fresh(a); unsigned char* w = ap.ws;
            REPEAT(1) phase_moe_weights(Fp, ap, layer);
            REPEAT(2)
            if (even) { g8::DenseSched S; S.init(w + WS_X, DM, (const bf16_t*)(w + WS_WIN) + (size_t)j * HLD * DM, DM, NTOK, HLD, Fp.G, Fp.bid);
                g8::EpiEvenIn E{(bf16_t*)(w + WS_R1), (bf16_t*)(w + WS_R2) + (size_t)NTOK * 1792, (float*)(w + WS_SSQ), (const float*)(w + WS_ROPEA), (const float*)(w + WS_ROPEB)}; g8::gemm_phase(Fp, DM, S, E); }
            else { g8::DenseSched S; S.init(w + WS_X, DM, (const bf16_t*)(w + WS_WQKV) + (size_t)j * 3072 * DM, DM, NTOK, 3072, Fp.G, Fp.bid);
#if NAIVE_NA
                g8::EpiPlain E{(bf16_t*)(w + WS_R1), 3072}; g8::gemm_phase(Fp, DM, S, E); }
#else
                g8::EpiQKV E{(bf16_t*)(w + WS_R1), (bf16_t*)(w + WS_R1) + (size_t)NTOK * DM, (bf16_t*)(w + WS_R1) + (size_t)2 * NTOK * DM}; g8::gemm_phase(Fp, DM, S, E); }
#endif
        }
        SEAM(p0);
        if (IN(p0 + 1) && even) REPEAT(3) {
            const Frame Fp = fresh(F); const Args ap = fresh(a); unsigned char* w = ap.ws;
            { g8::DenseSched S; S.init((bf16_t*)(w + WS_R1) + 1536, HLD, (const bf16_t*)(w + WS_WUQ) + (size_t)j * 768 * 256, 256, NTOK, 768, Fp.G, Fp.bid);
              g8::EpiMla<0> E{(bf16_t*)(w + WS_R2), (const float*)(w + WS_SSQ)}; g8::gemm_phase(Fp, 256, S, E); }
            const Frame Fq = fresh(F);
            { g8::DenseSched S; S.init((bf16_t*)(w + WS_R1) + 1792, HLD, (const bf16_t*)(w + WS_WUKV) + (size_t)j * 1024 * 256, 256, NTOK, 1024, Fq.G, Fq.bid);
              g8::EpiMla<1> E{(bf16_t*)(w + WS_R2) + (size_t)NTOK * 768, (const float*)(w + WS_SSQ)}; g8::gemm_phase(Fq, 256, S, E); }
        }
        SEAM(p0 + 1);
        if (IN(p0 + 2)) {
            const Frame Fp = fresh(F); const Args ap = fresh(a);
#if NAIVE_ATTN
            if (even) { for (int u = Fp.bid; u < NBATCH * 4 * 8; u += Fp.G) attn_diff_naive(Fp, ap, layer, u);
                        for (int u = Fp.bid; u < NBATCH * 8 * 4; u += Fp.G) attn_mla_naive(Fp, ap, u); }
#else
            if (even) REPEAT(4) { for (int u = Fp.bid; u < NBATCH * 4 * 8; u += Fp.G) attn_diff_mfma(Fp, ap, layer, u);
                        for (int u = Fp.bid; u < NBATCH * 8 * 8; u += Fp.G) attn_mla_mfma(Fp, ap, u); }
#endif
#if NAIVE_NA
            if (!even) { for (int u = Fp.bid; u < NBATCH * 32 * 2; u += Fp.G) attn_na_naive(Fp, ap, layer, u); }
#else
            if (!even) REPEAT(5) { for (int u = Fp.bid; u < NBATCH * 16 * 16; u += Fp.G) attn_na_lds(Fp, ap, layer, u); }
#endif
            __syncthreads();
        }
        SEAM(p0 + 2);
        if (IN(p0 + 3)) REPEAT(6) {
            const Frame Fp = fresh(F); const Args ap = fresh(a); unsigned char* w = ap.ws;
            g8::DenseSched S; S.init(w + WS_R3, DM, (const bf16_t*)(w + (even ? WS_WOE : WS_WOO)) + (size_t)j * DM * DM, DM, NTOK, DM, Fp.G, Fp.bid);
            g8::EpiPlain E{(bf16_t*)(w + WS_R1), DM}; g8::gemm_phase(Fp, DM, S, E);
        }
        SEAM(p0 + 3);
        if (IN(p0 + 4)) { const Frame Fp = fresh(F); const Args ap = fresh(a); phase_ln1_router(Fp, ap, layer); }
        SEAM(p0 + 4);
        if (IN(p0 + 5)) REPEAT(7) { const Frame Fp = fresh(F); const Args ap = fresh(a); phase_scatter(Fp, ap); }
        SEAM(p0 + 5);
        if (IN(p0 + 6)) REPEAT(8) {
            const Frame Fp = fresh(F); const Args ap = fresh(a); unsigned char* w = ap.ws;
            g8::MoeSched<true> S; S.A = (const char*)(w + WS_X); S.Wt = (const char*)(w + WS_W13); S.tile = (const int*)(w + WS_TILE); S.slot_tok = (const int*)(w + WS_SLOT_TOK);
            S.lda2 = DM * 2; S.K2 = DM * 2; S.wstride = (size_t)1024 * 1024 * 2; S.T = S.tile[0]; S.G = Fp.G; S.c = Fp.bid;
            g8::EpiMoe1 E{(bf16_t*)(w + WS_R1)}; g8::gemm_phase(Fp, DM, S, E);
        }
        SEAM(p0 + 6);
        if (IN(p0 + 7)) REPEAT(9) {
            const Frame Fp = fresh(F); const Args ap = fresh(a); unsigned char* w = ap.ws;
            g8::MoeSched<false> S; S.A = (const char*)(w + WS_R1); S.Wt = (const char*)(w + WS_W2); S.tile = (const int*)(w + WS_TILE); S.slot_tok = (const int*)(w + WS_SLOT_TOK);
            S.lda2 = DEXP * 2; S.K2 = DEXP * 2; S.wstride = (size_t)1024 * 512 * 2; S.T = S.tile[0]; S.G = Fp.G; S.c = Fp.bid;
            g8::EpiMoe2 E{(bf16_t*)(w + WS_R2), (const float*)(w + WS_SLOT_G), (const int*)(w + WS_SLOT_DST)}; g8::gemm_phase(Fp, DEXP, S, E);
        }
        SEAM(p0 + 7);
        if (IN(p0 + 8)) { const Frame Fp = fresh(F); const Args ap = fresh(a); phase_ln<1>(Fp, ap, layer, layer == DEPTH - 1); }
        SEAM(p0 + 8);
    }
#undef IN
#undef SEAM
}

extern "C" void kernel_launch(void* const* d_in, const int* in_sizes, int n_in, void* d_out, int out_size, void* d_ws, size_t ws_size, hipStream_t stream) {
    static int grid = 0;
    if (grid == 0) {
        if (n_in != 26 || in_sizes[0] != NTOK * DM || out_size != NTOK * DM || ws_size < WS_END) {
            fprintf(stderr, "kernel_launch: unexpected shapes / workspace (n_in %d, in0 %d, out %d, ws %zu, need %zu)\n", n_in, n_in > 0 ? in_sizes[0] : -1, out_size, ws_size, (size_t)WS_END); grid = -1; return; }
        int dev = 0, cus = 0, per_cu = 0;
        if (hipGetDevice(&dev) != hipSuccess || hipDeviceGetAttribute(&cus, hipDeviceAttributeMultiprocessorCount, dev) != hipSuccess) { grid = -1; return; }
        if (hipFuncSetAttribute((const void*)fwd_kernel, hipFuncAttributeMaxDynamicSharedMemorySize, LDS_BYTES) != hipSuccess) { fprintf(stderr, "kernel_launch: hipFuncSetAttribute failed\n"); grid = -1; return; }
        if (hipOccupancyMaxActiveBlocksPerMultiprocessor(&per_cu, (const void*)fwd_kernel, NTHREADS, LDS_BYTES) != hipSuccess || per_cu < 1) fprintf(stderr, "kernel_launch: occupancy query reports %d\n", per_cu);
        (void)hipGetLastError();
        grid = cus;
    }
    if (grid < 0) return;
    (void)hipMemsetAsync((char*)d_ws + WS_CTL, 0, 64 * 1024, stream);
    Args a{};
    for (int i = 0; i < 26; ++i) a.in[i] = (const float*)d_in[i];
    a.out = (float*)d_out; a.ws = (unsigned char*)d_ws;
#if MK_ONE_LAUNCH
    a.lo = 0; a.hi = NPHASES;
    hipLaunchKernelGGL(fwd_kernel, dim3(grid), dim3(NTHREADS), LDS_BYTES, stream, a);
#else
    for (int p = 0; p < NPHASES; ++p) {
        if (p >= 1 && ((p - 1) % NPH_LAYER) == 1 && (((p - 1) / NPH_LAYER) & 1)) continue;
        a.lo = p; a.hi = p + 1;
        hipLaunchKernelGGL(fwd_kernel, dim3(grid), dim3(NTHREADS), LDS_BYTES, stream, a);
    }
#endif
}
```

```cpp
#include <hip/hip_runtime.h>
#include <cstdio>
#include <cstdint>

#ifndef NAIVE_ATTN
#define NAIVE_ATTN 0
#endif
#ifndef NAIVE_NA
#define NAIVE_NA 0
#endif
#ifndef REP_MASK
#define REP_MASK 0
#endif
#define REPEAT(k) _Pragma("unroll 1") for (int rep_ = 0; rep_ < 1 + ((REP_MASK >> (k)) & 1); ++rep_)
#ifndef MK_ONE_LAUNCH
#define MK_ONE_LAUNCH 1
#endif

typedef unsigned short bf16_t;
typedef short bf16x8 __attribute__((ext_vector_type(8)));
typedef float f32x4 __attribute__((ext_vector_type(4)));
typedef float f32x2 __attribute__((ext_vector_type(2)));
typedef unsigned u32x4 __attribute__((ext_vector_type(4)));
typedef unsigned u32x2 __attribute__((ext_vector_type(2)));
#define LAS __attribute__((address_space(3)))

constexpr int NTOK = 65536, DM = 1024, SEQ = 2048, NBATCH = 32, DEPTH = 4;
constexpr int EVEN_IN = 1952, HLD = 2048;
constexpr int NEXP = 32, DEXP = 512;
constexpr int MAXTILES = NTOK * 2 / 256 + NEXP;
constexpr int MAXSLOTS = MAXTILES * 256;
constexpr float DN_ALPHA = 1.681792830507429f;
constexpr float LN_EPS = 1e-5f, RMS_EPS = 1e-6f;
constexpr int NTHREADS = 512;

constexpr size_t MiB = 1024ull * 1024ull;
constexpr size_t WS_CTL = 0;
constexpr size_t WS_LAM = 48 * 1024;
constexpr size_t WS_ROPEA = 64 * 1024;
constexpr size_t WS_ROPEB = WS_ROPEA + 128 * 1024;
constexpr size_t WS_WR = WS_ROPEB + 256 * 1024;
constexpr size_t WS_ROUTE = WS_WR + 832 * 1024;
constexpr size_t WS_CNT = WS_ROUTE + 1 * MiB;
constexpr size_t WS_TILE = WS_CNT + 32 * 1024;
constexpr size_t WS_SLOT_TOK = WS_TILE + 4 * 1024;
constexpr size_t WS_SLOT_G = WS_SLOT_TOK + 576 * 1024;
constexpr size_t WS_SLOT_DST = WS_SLOT_G + 576 * 1024;
constexpr size_t WS_SSQ = WS_SLOT_DST + 576 * 1024;
constexpr size_t WS_WIN = 6 * MiB;
constexpr size_t WS_WUQ = WS_WIN + 8 * MiB;
constexpr size_t WS_WUKV = WS_WUQ + 1 * MiB;
constexpr size_t WS_WOE = WS_WUKV + 1 * MiB;
constexpr size_t WS_WQKV = WS_WOE + 4 * MiB;
constexpr size_t WS_WOO = WS_WQKV + 12 * MiB;
constexpr size_t WS_W13 = 36 * MiB;
constexpr size_t WS_W2 = WS_W13 + 64 * MiB;
constexpr size_t WS_X = WS_W2 + 32 * MiB;
constexpr size_t WS_R1 = WS_X + 128 * MiB;
constexpr size_t WS_R2 = WS_R1 + 384 * MiB;
constexpr size_t WS_R3 = WS_R2 + 228 * MiB;
constexpr size_t WS_END = WS_R3 + 128 * MiB;
static_assert(WS_SSQ + 2 * MiB <= WS_WIN, "misc region");
static_assert(WS_WOO + 4 * MiB <= WS_W13, "small weights region");

__device__ __forceinline__ unsigned cvt_pk_bf16(float lo, float hi) { unsigned r; asm volatile("v_cvt_pk_bf16_f32 %0, %1, %2" : "=v"(r) : "v"(lo), "v"(hi)); return r; }
__device__ __forceinline__ float bf_lo(unsigned w) { return __uint_as_float(w << 16); }
__device__ __forceinline__ float bf_hi(unsigned w) { return __uint_as_float(w & 0xffff0000u); }
__device__ __forceinline__ float bf2f(bf16_t b) { return __uint_as_float(((unsigned)b) << 16); }
__device__ __forceinline__ void unpack8(const u32x4 w, float (&f)[8]) {
    f[0] = bf_lo(w.x); f[1] = bf_hi(w.x); f[2] = bf_lo(w.y); f[3] = bf_hi(w.y); f[4] = bf_lo(w.z); f[5] = bf_hi(w.z); f[6] = bf_lo(w.w); f[7] = bf_hi(w.w); }
__device__ __forceinline__ u32x4 pack8(const float (&f)[8]) { u32x4 w; w.x = cvt_pk_bf16(f[0], f[1]); w.y = cvt_pk_bf16(f[2], f[3]); w.z = cvt_pk_bf16(f[4], f[5]); w.w = cvt_pk_bf16(f[6], f[7]); return w; }
__device__ __forceinline__ float wave_sum(float v) {
#pragma unroll
    for (int o = 32; o >= 1; o >>= 1) v += __shfl_xor(v, o);
    return v; }

struct Frame { LAS unsigned char* lds; int tid, lane, wave, G, bid; };
#define XB_TMO      128
#define XB_XCNT(j)  (256  + 64 * (j))
#define XB_XSUB(j)  (1280 + 64 * (j))
#define XB_XGEN(j)  (2304 + 64 * (j))
#define XB_TOP      3328
#define XB_TOPGEN   3392
#define XCD_BAR_WORDS 3456
#define XB_SPIN_CAP (1u << 21)
__device__ __forceinline__ unsigned xb_ld(unsigned* p)              { return __hip_atomic_load(p, __ATOMIC_RELAXED, __HIP_MEMORY_SCOPE_AGENT); }
__device__ __forceinline__ unsigned xb_add(unsigned* p, unsigned v) { return __hip_atomic_fetch_add(p, v, __ATOMIC_RELAXED, __HIP_MEMORY_SCOPE_AGENT); }
__device__ __forceinline__ unsigned xb_xcc_id() { return (unsigned)__builtin_amdgcn_s_getreg((3 << 11) | 20) & 0xFu; }
#define XB_SPIN(cond, bar) do { unsigned _sp = 0; while (cond) { __builtin_amdgcn_s_sleep(1); \
    if ((++_sp & 255u) == 0u) { if (xb_ld(&(bar)[XB_TMO])) break; if (_sp > XB_SPIN_CAP) { atomicAdd(&(bar)[XB_TMO], 1u); break; } } } } while (0)
struct XcdBarrier { unsigned* bar; unsigned x; volatile LAS unsigned* st; };
__device__ __forceinline__ XcdBarrier xcd_barrier_post(unsigned* bar, volatile LAS unsigned* st, int tid) {
    XcdBarrier b; b.bar = bar; b.x = xb_xcc_id(); b.st = st;
    if (tid == 0) (void)xb_add(&bar[XB_XCNT(b.x)], 1u);
    return b;
}
__device__ __forceinline__ void xcd_barrier_complete(unsigned* bar, unsigned x, unsigned& nloc, unsigned& nx) {
    const unsigned G = gridDim.x * gridDim.y * gridDim.z;
    unsigned sum, cnt, mine, sp = 0u;
    for (;;) {
        sum = 0u; cnt = 0u; mine = 0u;
#pragma unroll
        for (unsigned j = 0; j < 16; ++j) { const unsigned c = xb_ld(&bar[XB_XCNT(j)]); sum += c; cnt += (c > 0u) ? 1u : 0u; mine = (j == x) ? c : mine; }
        if (sum == G) break;
        __builtin_amdgcn_s_sleep(1);
        if ((++sp & 255u) == 0u) { if (xb_ld(&bar[XB_TMO])) break; if (sp > XB_SPIN_CAP) { atomicAdd(&bar[XB_TMO], 1u); break; } }
    }
    nloc = mine > 0u ? mine : 1u; nx = cnt > 0u ? cnt : 1u;
}
__device__ __forceinline__ void xcd_barrier(const XcdBarrier& b, int tid) {
    asm volatile("s_waitcnt vmcnt(0)" ::: "memory");
    __syncthreads();
    if (tid == 0) {
        unsigned* bar = b.bar; unsigned bx = b.x; asm volatile("" : "+s"(bx));
        __builtin_amdgcn_s_waitcnt(0);
        unsigned nloc = b.st[0], nx = b.st[1];
        if (nloc == 0u) { xcd_barrier_complete(bar, bx, nloc, nx); b.st[0] = nloc; b.st[1] = nx; }
        const unsigned old = xb_add(&bar[XB_XSUB(bx)], 1u);
        const unsigned gen = old / nloc;
        if (old + 1u == (gen + 1u) * nloc) {
            __builtin_amdgcn_fence(__ATOMIC_RELEASE, "agent");
            asm volatile("s_waitcnt vmcnt(0)" ::: "memory");
            const unsigned og = xb_add(&bar[XB_TOP], 1u);
            const unsigned tg = og / nx;
            if (og + 1u == (tg + 1u) * nx) xb_add(&bar[XB_TOPGEN], 1u);
            else XB_SPIN(xb_ld(&bar[XB_TOPGEN]) == tg, bar);
            __builtin_amdgcn_fence(__ATOMIC_ACQUIRE, "agent");
            xb_add(&bar[XB_XGEN(bx)], 1u);
            asm volatile("s_waitcnt vmcnt(0)" ::: "memory");
        } else {
            XB_SPIN(xb_ld(&bar[XB_XGEN(bx)]) == gen, bar);
            __builtin_amdgcn_fence(__ATOMIC_ACQUIRE, "agent");
            asm volatile("s_waitcnt vmcnt(0)" ::: "memory");
        }
    }
    __syncthreads();
}

namespace g8 {
constexpr int BM = 256, BK = 64, HALF = 128, HTB = HALF * BK * 2, STAGE_BYTES = 8 * HTB, NXCD = 8, WGM = 8;
__device__ __forceinline__ int lds_byte(int r, int c) { const int st = (r >> 4) * 2 + (c >> 5), rr = r & 15, cc = c & 31, ob = rr * 64 + cc * 2; return st * 1024 + (ob ^ (((ob >> 9) & 1) << 5)); }
__device__ __forceinline__ void stage_rc(int b, int& R, int& C) { const int st = b / 1024, sb = b % 1024, swz = sb ^ (((sb >> 9) & 1) << 5); R = (st >> 1) * 16 + swz / 64; C = (st & 1) * 32 + (swz % 64) / 2; }
__device__ __forceinline__ int perm32(int rho) { const int n = rho >> 4, i = rho & 15; return 8 * (i >> 2) + 4 * n + (i & 3); }

struct Unit { const char* A; const char* B; int row0, pm, pn, e; };
typedef f32x4 Acc[2][2][4][2];

struct DenseSched {
    const char* A; const char* Bt; unsigned lda2; int K2; int nM, nN, nwg, G, c; int rep = 1;
    __device__ __forceinline__ void init(const void* A_, int lda, const void* Bt_, int K, int M, int N, int G_, int c_) { A = (const char*)A_; Bt = (const char*)Bt_; lda2 = (unsigned)lda * 2u; K2 = K * 2; nM = M / BM; nN = N / BM; nwg = nM * nN; G = G_; c = c_; }
    __device__ __forceinline__ bool next(int i, Unit& u) const {
        long L = (long)i * G + c; if (L >= (long)nwg * rep) return false;
        if (rep > 1) L %= nwg;
        int wgid = (int)L; { const int q = nwg / NXCD, r = nwg % NXCD, xcd = wgid % NXCD, off = wgid / NXCD; wgid = (xcd < r ? xcd * (q + 1) : r * (q + 1) + (xcd - r) * q) + off; }
        const int nig = WGM * nN, gid = wgid / nig, fm = gid * WGM, gsz = (nM - fm) < WGM ? (nM - fm) : WGM;
        u.pm = fm + ((wgid % nig) % gsz); u.pn = (wgid % nig) / gsz; u.row0 = u.pm * BM; u.e = 0;
        u.A = A + (size_t)u.row0 * lda2; u.B = Bt + (size_t)u.pn * BM * K2; return true;
    }
    static constexpr bool GATHER = false;
    __device__ __forceinline__ unsigned rowoff(const Unit&, int r) const { return (unsigned)r * lda2; }
};
template <bool GATHER_> struct MoeSched {
    const char* A; const char* Wt; const int* tile; const int* slot_tok; unsigned lda2; int K2; size_t wstride; int T, G, c;
    __device__ __forceinline__ bool next(int i, Unit& u) const {
        int t, pnn;
        if ((G & 31) == 0) { const int x = c & 7, sl = c >> 3, per = G >> 5; t = i * (G >> 2) + x * per + (sl >> 2); pnn = sl & 3; }
        else { const int L = i * G + c; t = L >> 2; pnn = L & 3; }
        if (t >= T) return false;
        u.pn = pnn; u.pm = t; u.row0 = t * BM; u.e = tile[1 + t];
        u.A = GATHER_ ? A : A + (size_t)u.row0 * lda2; u.B = Wt + (size_t)u.e * wstride + (size_t)u.pn * BM * K2; return true;
    }
    static constexpr bool GATHER = GATHER_;
    __device__ __forceinline__ unsigned rowoff(const Unit& u, int r) const { return GATHER_ ? (unsigned)slot_tok[u.row0 + r] * lda2 : (unsigned)r * lda2; }
};

template <class Epi, class Sched>
__device__ __forceinline__ void gemm_phase(const Frame& F, const int K_, const Sched& S, const Epi& E) {
    LAS unsigned char* lds = F.lds;
    int K = K_; asm volatile("" : "+s"(K));
    const int tid = F.tid, wid = __builtin_amdgcn_readfirstlane(tid >> 6), lane = tid & 63, wr = wid >> 2, wc = wid & 3, fr = lane & 15, fq = lane >> 4;
    const int nt = K / BK;
    int RA[2]; unsigned CA[2], voffB[2];
#pragma unroll
    for (int i = 0; i < 2; ++i) { int R, C; stage_rc(tid * 16 + i * 8192, R, C); const int Rb = (R & ~31) + perm32(R & 31);
        RA[i] = R; CA[i] = (unsigned)C * 2u; voffB[i] = (unsigned)(Rb * K + C) * 2u; }
    const size_t kstep = (size_t)(BK * 2);
    const size_t hstepB = (size_t)HALF * K * 2;
    size_t hstepA = 0; if constexpr (!Sched::GATHER) hstepA = (size_t)S.rowoff(Unit{}, HALF);
    const unsigned ldsw = (unsigned)wid * 1024u;
    const int aoff = lds_byte(wr * 64 + fr, fq * 8), boff = lds_byte(wc * 32 + fr, fq * 8);
#define G8_SA(b, h) (((b) * 2 + (h)) * HTB)
#define G8_SB(b, h) ((4 + (b) * 2 + (h)) * HTB)
#define G8_STAGE(bufoff, gbase, voff) do { _Pragma("unroll") for (int _i = 0; _i < 2; ++_i) \
        __builtin_amdgcn_global_load_lds((const unsigned*)((const char*)(gbase) + (voff)[_i]), (LAS unsigned*)(lds + (bufoff) + ldsw + _i * 8192), 16, 0, 0); } while (0)
#define G8_STA(bufoff, gbase, h, V0, V1) do { if constexpr (Sched::GATHER) { if (h) G8_STAGE(bufoff, gbase, V1); else G8_STAGE(bufoff, gbase, V0); } else { G8_STAGE(bufoff, (gbase) + (h) * hstepA, vA0); } } while (0)
#define G8_LDA(dst, b, h) do { _Pragma("unroll") for (int m = 0; m < 4; ++m) _Pragma("unroll") for (int k = 0; k < 2; ++k) dst[m][k] = *(const LAS bf16x8*)(lds + G8_SA(b, h) + aoff + m * 2048 + k * 1024); } while (0)
#define G8_LDB(dst, b, h) do { _Pragma("unroll") for (int n = 0; n < 2; ++n) _Pragma("unroll") for (int k = 0; k < 2; ++k) dst[n][k] = *(const LAS bf16x8*)(lds + G8_SB(b, h) + boff + n * 2048 + k * 1024); } while (0)
#define G8_MMA(ai, bj, At, Bt) do { __builtin_amdgcn_s_setprio(1); _Pragma("unroll") for (int m = 0; m < 4; ++m) _Pragma("unroll") for (int n = 0; n < 2; ++n) _Pragma("unroll") for (int k = 0; k < 2; ++k) \
        acc[ai][bj][m][n] = __builtin_amdgcn_mfma_f32_16x16x32_bf16(Bt[n][k], At[m][k], acc[ai][bj][m][n], 0, 0, 0); __builtin_amdgcn_s_setprio(0); } while (0)
#define G8_WAIT_V(n) asm volatile("s_waitcnt vmcnt(" #n ")" ::: "memory")
#define G8_WAIT_L(n) asm volatile("s_waitcnt lgkmcnt(" #n ")" ::: "memory")
#define G8_BAR __builtin_amdgcn_s_barrier()
#define G8_SCHED __builtin_amdgcn_sched_barrier(0)
    Unit cur, nxt; int ui = 0;
    if (!S.next(0, cur)) return;
    Acc acc;
#pragma unroll
    for (int a = 0; a < 2; ++a)
#pragma unroll
        for (int b = 0; b < 2; ++b)
#pragma unroll
            for (int m = 0; m < 4; ++m)
#pragma unroll
                for (int n = 0; n < 2; ++n) acc[a][b][m][n] = (f32x4){0.f, 0.f, 0.f, 0.f};
    bf16x8 At[4][2], B0[2][2], B1[2][2];
    unsigned vA0[2], vA1[2], nA0[2], nA1[2];
#pragma unroll
    for (int i = 0; i < 2; ++i) { vA0[i] = S.rowoff(cur, RA[i]) + CA[i]; vA1[i] = S.rowoff(cur, HALF + RA[i]) + CA[i]; }
    const char* cA = cur.A; const char* cB = cur.B;
    G8_STAGE(G8_SB(0, 0), cB, voffB); G8_STA(G8_SA(0, 0), cA, 0, vA0, vA1); G8_STAGE(G8_SB(0, 1), cB + hstepB, voffB); G8_STA(G8_SA(0, 1), cA, 1, vA0, vA1);
    if (wr == 1) G8_BAR;
    G8_WAIT_V(4); G8_BAR;
    G8_STAGE(G8_SB(1, 0), cB + kstep, voffB); G8_STA(G8_SA(1, 0), cA + kstep, 0, vA0, vA1); G8_STAGE(G8_SB(1, 1), cB + hstepB + kstep, voffB);
    G8_WAIT_V(6); G8_BAR;
    for (;;) {
        const bool has_next = S.next(ui + 1, nxt);
        const char* nAp = has_next ? nxt.A : cA; const char* nBp = has_next ? nxt.B : cB;
#pragma unroll
        for (int i = 0; i < 2; ++i) { nA0[i] = has_next ? S.rowoff(nxt, RA[i]) + CA[i] : vA0[i]; nA1[i] = has_next ? S.rowoff(nxt, HALF + RA[i]) + CA[i] : vA1[i]; }
        for (int t = 0; t < nt; t += 2) {
            const bool last = (t == nt - 2);
            const char* a1 = cA + (size_t)(t + 1) * kstep;
            const char* a2 = last ? nAp : cA + (size_t)(t + 2) * kstep; const char* b2 = last ? nBp : cB + (size_t)(t + 2) * kstep;
            const char* a3 = a2 + kstep; const char* b3 = b2 + kstep;
            unsigned w0[2], w1[2];
#pragma unroll
            for (int i = 0; i < 2; ++i) { w0[i] = last ? nA0[i] : vA0[i]; w1[i] = last ? nA1[i] : vA1[i]; }
            G8_LDB(B0, 0, 0); G8_SCHED; G8_LDA(At, 0, 0); G8_STA(G8_SA(1, 1), a1, 1, vA0, vA1);
            G8_WAIT_L(8); G8_BAR; G8_WAIT_L(0); G8_MMA(0, 0, At, B0); G8_BAR; G8_SCHED;
            G8_LDB(B1, 0, 1); G8_STAGE(G8_SB(0, 0), b2, voffB);
            G8_BAR; G8_WAIT_L(0); G8_MMA(0, 1, At, B1); G8_BAR;
            G8_LDA(At, 0, 1); G8_STA(G8_SA(0, 0), a2, 0, w0, w1);
            G8_BAR; G8_WAIT_L(0); G8_MMA(1, 0, At, B0); G8_BAR; G8_SCHED;
            G8_STAGE(G8_SB(0, 1), b2 + hstepB, voffB);
            G8_WAIT_V(6); G8_BAR; G8_MMA(1, 1, At, B1); G8_BAR;
            G8_LDB(B0, 1, 0); G8_SCHED; G8_LDA(At, 1, 0); G8_STA(G8_SA(0, 1), a2, 1, w0, w1);
            G8_WAIT_L(8); G8_BAR; G8_WAIT_L(0); G8_MMA(0, 0, At, B0); G8_BAR; G8_SCHED;
            G8_LDB(B1, 1, 1); G8_STAGE(G8_SB(1, 0), b3, voffB);
            G8_BAR; G8_WAIT_L(0); G8_MMA(0, 1, At, B1); G8_BAR;
            G8_LDA(At, 1, 1); G8_STA(G8_SA(1, 0), a3, 0, w0, w1);
            G8_BAR; G8_WAIT_L(0); G8_MMA(1, 0, At, B0); G8_BAR; G8_SCHED;
            G8_STAGE(G8_SB(1, 1), b3 + hstepB, voffB);
            G8_WAIT_V(6); G8_BAR; G8_MMA(1, 1, At, B1); G8_BAR;
        }
        E(acc, cur, wr, wc, fr, fq);
        if (!has_next) break;
#pragma unroll
        for (int a = 0; a < 2; ++a)
#pragma unroll
            for (int b = 0; b < 2; ++b)
#pragma unroll
                for (int m = 0; m < 4; ++m)
#pragma unroll
                    for (int n = 0; n < 2; ++n) acc[a][b][m][n] = (f32x4){0.f, 0.f, 0.f, 0.f};
        cur = nxt; cA = nAp; cB = nBp; ++ui;
#pragma unroll
        for (int i = 0; i < 2; ++i) { vA0[i] = nA0[i]; vA1[i] = nA1[i]; }
    }
    G8_WAIT_V(0);
    if (wr == 0) G8_BAR;
    G8_BAR;
#undef G8_SA
#undef G8_SB
#undef G8_STAGE
#undef G8_STA
#undef G8_LDA
#undef G8_LDB
#undef G8_MMA
#undef G8_WAIT_V
#undef G8_WAIT_L
#undef G8_BAR
#undef G8_SCHED
}

__device__ __forceinline__ u32x4 pack_acc8(const f32x4 v0, const f32x4 v1) { u32x4 w; w.x = cvt_pk_bf16(v0[0], v0[1]); w.y = cvt_pk_bf16(v0[2], v0[3]); w.z = cvt_pk_bf16(v1[0], v1[1]); w.w = cvt_pk_bf16(v1[2], v1[3]); return w; }

struct EpiPlain {
    bf16_t* O; int ldc;
    __device__ __forceinline__ void operator()(Acc& acc, const Unit& u, int wr, int wc, int fr, int fq) const {
        const int row0 = u.pm * BM + wr * 64 + fr, col0 = u.pn * BM + wc * 32 + 8 * fq;
#pragma unroll
        for (int ai = 0; ai < 2; ++ai)
#pragma unroll
            for (int m = 0; m < 4; ++m) { bf16_t* rowp = O + (size_t)(row0 + ai * HALF + m * 16) * ldc + col0;
#pragma unroll
                for (int bj = 0; bj < 2; ++bj) *(u32x4*)(rowp + bj * HALF) = pack_acc8(acc[ai][bj][m][0], acc[ai][bj][m][1]); }
    }
};

struct EpiQKV {
    bf16_t* Qc; bf16_t* Kc; bf16_t* Vt;
    __device__ __forceinline__ void operator()(Acc& acc, const Unit& u, int wr, int wc, int fr, int fq) const {
        const int which = u.pn >> 2, tok0 = u.pm * BM + wr * 64 + fr;
        const int b = tok0 >> 11;
#pragma unroll
        for (int ai = 0; ai < 2; ++ai)
#pragma unroll
            for (int m = 0; m < 4; ++m) { const int s = (tok0 + ai * HALF + m * 16) & (SEQ - 1);
#pragma unroll
                for (int bj = 0; bj < 2; ++bj) { const int h = (u.pn & 3) * 4 + 2 * bj + (wc >> 1), d0 = (wc & 1) * 32 + 8 * fq;
                    if (which < 2) { bf16_t* dst = (which == 0 ? Qc : Kc) + ((size_t)(b * 16 + h) * SEQ + s) * 64 + d0;
                        *(u32x4*)dst = pack_acc8(acc[ai][bj][m][0], acc[ai][bj][m][1]); }
                    else { bf16_t* dst = Vt + (((size_t)(b * 16 + h) * (SEQ / 8) + (s >> 3)) * 64 + d0) * 8 + (s & 7);
#pragma unroll
                        for (int n = 0; n < 2; ++n)
#pragma unroll
                            for (int jj = 0; jj < 4; ++jj) dst[(4 * n + jj) * 8] = (bf16_t)(cvt_pk_bf16(acc[ai][bj][m][n][jj], 0.f) & 0xffffu); } } }
    }
};

struct EpiResStats {
    const bf16_t* X; bf16_t* Yb; f32x2* stats;
    __device__ __forceinline__ void operator()(Acc& acc, const Unit& u, int wr, int wc, int fr, int fq) const {
        const int row0 = u.pm * BM + wr * 64 + fr, col0 = u.pn * BM + wc * 32 + 8 * fq;
#pragma unroll
        for (int ai = 0; ai < 2; ++ai)
#pragma unroll
            for (int m = 0; m < 4; ++m) { const int row = row0 + ai * HALF + m * 16; const size_t off = (size_t)row * DM + col0; float s1 = 0.f, s2 = 0.f;
#pragma unroll
                for (int bj = 0; bj < 2; ++bj) { float xv[8]; unpack8(*(const u32x4*)(X + off + bj * HALF), xv); f32x4 v[2];
#pragma unroll
                    for (int n = 0; n < 2; ++n)
#pragma unroll
                        for (int j = 0; j < 4; ++j) { const float y = DN_ALPHA * xv[4 * n + j] + acc[ai][bj][m][n][j]; v[n][j] = y; s1 += y; s2 += y * y; }
                    *(u32x4*)(Yb + off + bj * HALF) = pack_acc8(v[0], v[1]); }
                s1 += __shfl_xor(s1, 16); s1 += __shfl_xor(s1, 32); s2 += __shfl_xor(s2, 16); s2 += __shfl_xor(s2, 32);
                if (fq == 0) stats[(size_t)row * 16 + u.pn * 4 + wc] = (f32x2){s1, s2};
                asm volatile("" ::: "memory"); }
    }
};

struct EpiEvenIn {
    bf16_t* H; bf16_t* KR; float* ssq; const float* ropeA; const float* ropeB;
    __device__ __forceinline__ void operator()(Acc& acc, const Unit& u, int wr, int wc, int fr, int fq) const {
        const int row0 = u.pm * BM + wr * 64 + fr, col0 = u.pn * BM + wc * 32 + 8 * fq;
        if (u.pn < 4 && (wc & 1) == 0) {
#pragma unroll
            for (int ai = 0; ai < 2; ++ai)
#pragma unroll
                for (int m = 0; m < 4; ++m) { const int pos = (row0 + ai * HALF + m * 16) & (SEQ - 1);
                    const f32x4 c0 = *(const f32x4*)(ropeA + pos * 8), c1 = *(const f32x4*)(ropeA + pos * 8 + 4);
                    const f32x4 s0 = *(const f32x4*)(ropeA + SEQ * 8 + pos * 8), s1 = *(const f32x4*)(ropeA + SEQ * 8 + pos * 8 + 4);
#pragma unroll
                    for (int bj = 0; bj < 2; ++bj)
#pragma unroll
                        for (int n = 0; n < 2; ++n) { const f32x4 own = acc[ai][bj][m][n]; f32x4 oth;
#pragma unroll
                            for (int j = 0; j < 4; ++j) oth[j] = __shfl_xor(own[j], 16);
                            const f32x4 cs = n ? c1 : c0, sn = n ? s1 : s0;
                            if (fq == 0) acc[ai][bj][m][n] = own * cs - oth * sn;
                            else if (fq == 1) acc[ai][bj][m][n] = own * cs + oth * sn; } }
        }
        if (u.pn >= 6) {
#pragma unroll
            for (int ai = 0; ai < 2; ++ai)
#pragma unroll
                for (int m = 0; m < 4; ++m) { float s = 0.f;
#pragma unroll
                    for (int bj = 0; bj < 2; ++bj) if (u.pn == 6 || bj == 0)
#pragma unroll
                        for (int n = 0; n < 2; ++n) { const f32x4 x = acc[ai][bj][m][n]; s += (x[0] * x[0] + x[1] * x[1]) + (x[2] * x[2] + x[3] * x[3]); }
                    s += __shfl_xor(s, 16); s += __shfl_xor(s, 32);
                    if (fq == 0) ssq[(size_t)(row0 + ai * HALF + m * 16) * 8 + (u.pn == 6 ? 0 : 4) + wc] = s; }
        }
        if (u.pn == 7 && wc == 0) {
#pragma unroll
            for (int ai = 0; ai < 2; ++ai)
#pragma unroll
                for (int m = 0; m < 4; ++m) { const int row = row0 + ai * HALF + m * 16, pos = row & (SEQ - 1); f32x4 o[2];
#pragma unroll
                    for (int n = 0; n < 2; ++n) { const f32x4 own = acc[ai][1][m][n]; f32x4 oth;
#pragma unroll
                        for (int j = 0; j < 4; ++j) oth[j] = __shfl_xor(own[j], 32);
                        const int i0 = 8 * (fq & 1) + 4 * n;
                        const f32x4 cs = *(const f32x4*)(ropeB + pos * 16 + i0), sn = *(const f32x4*)(ropeB + SEQ * 16 + pos * 16 + i0);
                        o[n] = (fq < 2) ? own * cs - oth * sn : own * cs + oth * sn; }
                    *(u32x4*)(KR + (size_t)row * 32 + 8 * fq) = pack_acc8(o[0], o[1]); }
        }
#pragma unroll
        for (int ai = 0; ai < 2; ++ai)
#pragma unroll
            for (int m = 0; m < 4; ++m) { bf16_t* rowp = H + (size_t)(row0 + ai * HALF + m * 16) * HLD + col0;
#pragma unroll
                for (int bj = 0; bj < 2; ++bj) *(u32x4*)(rowp + bj * HALF) = pack_acc8(acc[ai][bj][m][0], acc[ai][bj][m][1]); }
    }
};

template <int MODE> struct EpiMla {
    bf16_t* O; const float* ssq;
    __device__ __forceinline__ void operator()(Acc& acc, const Unit& u, int wr, int wc, int fr, int fq) const {
        const int row0 = u.pm * BM + wr * 64 + fr, col0 = u.pn * BM + wc * 32 + 8 * fq;
        constexpr int ldc = MODE == 0 ? 768 : 1024;
#pragma unroll
        for (int ai = 0; ai < 2; ++ai)
#pragma unroll
            for (int m = 0; m < 4; ++m) { const int row = row0 + ai * HALF + m * 16;
                const f32x4 p = *(const f32x4*)(ssq + (size_t)row * 8 + (MODE == 0 ? 0 : 4));
                const float rstd = 1.0f / sqrtf(((p[0] + p[1]) + (p[2] + p[3])) * (MODE == 0 ? 1.0f / 256.0f : 1.0f / 128.0f) + RMS_EPS);
                bf16_t* rowp = O + (size_t)row * ldc + col0;
#pragma unroll
                for (int bj = 0; bj < 2; ++bj) *(u32x4*)(rowp + bj * HALF) = pack_acc8(acc[ai][bj][m][0] * rstd, acc[ai][bj][m][1] * rstd);
                asm volatile("" ::: "memory"); }
    }
};

struct EpiMoe1 {
    bf16_t* Hdn;
    __device__ __forceinline__ void operator()(Acc& acc, const Unit& u, int wr, int wc, int fr, int fq) const {
        const int row0 = u.row0 + wr * 64 + fr, col0 = u.pn * 128 + wc * 32 + 8 * fq;
#pragma unroll
        for (int ai = 0; ai < 2; ++ai)
#pragma unroll
            for (int m = 0; m < 4; ++m) { f32x4 h[2];
#pragma unroll
                for (int n = 0; n < 2; ++n)
#pragma unroll
                    for (int j = 0; j < 4; ++j) { const float g = acc[ai][0][m][n][j], up = acc[ai][1][m][n][j]; h[n][j] = g * __builtin_amdgcn_rcpf(1.0f + __builtin_amdgcn_exp2f(-1.4426950408889634f * g)) * up; }
                *(u32x4*)(Hdn + (size_t)(row0 + ai * HALF + m * 16) * DEXP + col0) = pack_acc8(h[0], h[1]); }
    }
};
struct EpiMoe2 {
    bf16_t* Y; const float* slot_g; const int* slot_dst;
    __device__ __forceinline__ void operator()(Acc& acc, const Unit& u, int wr, int wc, int fr, int fq) const {
        const int row0 = u.row0 + wr * 64 + fr, col0 = u.pn * BM + wc * 32 + 8 * fq;
#pragma unroll
        for (int ai = 0; ai < 2; ++ai)
#pragma unroll
            for (int m = 0; m < 4; ++m) { const int slot = row0 + ai * HALF + m * 16; const int dst = slot_dst[slot]; const float g = slot_g[slot];
                if (dst >= 0) { bf16_t* rowp = Y + (size_t)dst * DM + col0;
#pragma unroll
                    for (int bj = 0; bj < 2; ++bj) *(u32x4*)(rowp + bj * HALF) = pack_acc8(acc[ai][bj][m][0] * g, acc[ai][bj][m][1] * g); } }
    }
};
}

struct Args { const float* in[26]; float* out; unsigned char* ws; int lo, hi; };
enum { IN_X = 0, IN_EWIN, IN_LQ1, IN_LK1, IN_LQ2, IN_LK2, IN_SUBLN, IN_QNG, IN_WUQ, IN_KVNG, IN_WUKV, IN_EWO, IN_OWQKV, IN_RELB, IN_OWO,
       IN_LN1G, IN_LN1B, IN_LN2G, IN_LN2B, IN_WRG, IN_BRG, IN_WRE, IN_BRE, IN_WG, IN_WU, IN_WD };

__device__ __forceinline__ Frame fresh(const Frame& F) { Frame R = F; int wv = F.wave, g = F.G, b = F.bid; asm volatile("" : "+s"(wv), "+s"(g), "+s"(b));
    int ln = (int)__builtin_amdgcn_mbcnt_hi(~0u, __builtin_amdgcn_mbcnt_lo(~0u, 0u)); asm volatile("" : "+v"(ln));
    __builtin_assume(ln >= 0 && ln < 64); __builtin_assume(wv >= 0 && wv < NTHREADS / 64); __builtin_assume(g > 0 && g <= 1024); __builtin_assume(b >= 0 && b < g);
    R.tid = wv * 64 + ln; R.lane = ln; R.wave = wv; R.G = g; R.bid = b; return R; }
__device__ __forceinline__ Args fresh(const Args& a) { Args r = a; unsigned long long z = 0ull; asm volatile("" : "+s"(z)); r.ws = a.ws + z; return r; }

__device__ __forceinline__ void tr_tile(const Frame& F, const float* src, int ldsrc, int Kv, int Nv, int k0, int n0, bf16_t* dst, int lddst, int rowmap, const float* scale) {
    LAS float* T = (LAS float*)F.lds;
    __syncthreads();
#pragma unroll
    for (int it = 0; it < 8; ++it) { const int e = it * NTHREADS + F.tid, i = e >> 6, j = e & 63; const int k = k0 + i, n = n0 + j;
        float v = 0.f; if (k < Kv && n < Nv) { v = src[(size_t)k * ldsrc + n]; if (scale) v *= scale[k]; }
        T[i * 65 + j] = v; }
    __syncthreads();
    {
        const int j = F.tid >> 3, i0 = (F.tid & 7) * 8; float f[8];
#pragma unroll
        for (int q = 0; q < 8; ++q) f[q] = T[(i0 + q) * 65 + j];
        int n = n0 + j; if (rowmap) n = (n >> 7) * 256 + (n & 127) + (rowmap == 2 ? 128 : 0);
        *(u32x4*)(dst + (size_t)n * lddst + k0 + i0) = pack8(f); }
}
__device__ __forceinline__ void tr_matrix(const Frame& F, int& cursor, const float* src, int ldsrc, int Kv, int Nv, int Kp, int Np, bf16_t* dst, int lddst, int rowmap, const float* scale) {
    const int tk = Kp / 64, tn = Np / 64, ntile = tk * tn;
    int first = (F.bid - cursor % F.G + F.G) % F.G;
    for (int t = first; t < ntile; t += F.G) tr_tile(F, src, ldsrc, Kv, Nv, (t / tn) * 64, (t % tn) * 64, dst, lddst, rowmap, scale);
    cursor += ntile;
}

__device__ __forceinline__ void phase_prologue(const Frame& F, const Args& a) {
    unsigned char* ws = a.ws;
    { const float* x = a.in[IN_X]; bf16_t* X = (bf16_t*)(ws + WS_X); const size_t n8 = (size_t)NTOK * DM / 8;
      for (size_t i = (size_t)F.bid * NTHREADS + F.tid; i < n8; i += (size_t)F.G * NTHREADS) { const f32x4 v0 = *(const f32x4*)(x + i * 8), v1 = *(const f32x4*)(x + i * 8 + 4); *(u32x4*)(X + i * 8) = g8::pack_acc8(v0, v1); } }
    { float* ra = (float*)(ws + WS_ROPEA); float* rb = (float*)(ws + WS_ROPEB);
      for (int i = F.bid * NTHREADS + F.tid; i < SEQ * 8; i += F.G * NTHREADS) { const int pos = i >> 3, f = i & 7; const float inv = powf(500000.0f, -(float)(2 * f) / 16.0f); const float ang = (float)pos * inv; ra[i] = cosf(ang); ra[SEQ * 8 + i] = sinf(ang); }
      for (int i = F.bid * NTHREADS + F.tid; i < SEQ * 16; i += F.G * NTHREADS) { const int pos = i >> 4, f = i & 15; const float inv = powf(500000.0f, -(float)(2 * f) / 32.0f); const float ang = (float)pos * inv; rb[i] = cosf(ang); rb[SEQ * 16 + i] = sinf(ang); } }
    { bf16_t* wr = (bf16_t*)(ws + WS_WR); const float* wrg = a.in[IN_WRG]; const float* wre = a.in[IN_WRE];
      for (int i = F.bid * NTHREADS + F.tid; i < DEPTH * 48 * DM; i += F.G * NTHREADS) { const int l = i / (48 * DM), r = i % (48 * DM), j = r / DM, k = r % DM;
          const float w = j < 4 ? wrg[((size_t)l * DM + k) * 4 + j] : j < 36 ? wre[((size_t)l * DM + k) * 32 + (j - 4)] : 0.f;
          const unsigned hi = cvt_pk_bf16(w, 0.f) & 0xffffu; const float rem = w - __uint_as_float(hi << 16);
          wr[(size_t)l * 2 * 48 * DM + r] = (bf16_t)hi; wr[(size_t)l * 2 * 48 * DM + 48 * DM + r] = (bf16_t)(cvt_pk_bf16(rem, 0.f) & 0xffffu); } }
    if (F.bid == 0 && F.tid < 2) { const int jl = F.tid; float d1 = 0.f, d2 = 0.f;
        for (int i = 0; i < 64; ++i) { d1 += a.in[IN_LQ1][jl * 64 + i] * a.in[IN_LK1][jl * 64 + i]; d2 += a.in[IN_LQ2][jl * 64 + i] * a.in[IN_LK2][jl * 64 + i]; }
        const float lambda_init = 0.8f - 0.6f * expf(-0.3f * (float)(2 * jl));
        ((float*)(ws + WS_LAM))[jl] = expf(d1) - expf(d2) + lambda_init; }
    int cur = 0;
    for (int l = 0; l < 2; ++l) {
        tr_matrix(F, cur, a.in[IN_EWIN] + (size_t)l * DM * EVEN_IN, EVEN_IN, DM, EVEN_IN, DM, HLD, (bf16_t*)(ws + WS_WIN) + (size_t)l * HLD * DM, DM, 0, nullptr);
        tr_matrix(F, cur, a.in[IN_WUQ] + (size_t)l * 256 * 768, 768, 256, 768, 256, 768, (bf16_t*)(ws + WS_WUQ) + (size_t)l * 768 * 256, 256, 0, a.in[IN_QNG] + l * 256);
        tr_matrix(F, cur, a.in[IN_WUKV] + (size_t)l * 128 * 1024, 1024, 128, 1024, 256, 1024, (bf16_t*)(ws + WS_WUKV) + (size_t)l * 1024 * 256, 256, 0, a.in[IN_KVNG] + l * 128);
        tr_matrix(F, cur, a.in[IN_EWO] + (size_t)l * DM * DM, DM, DM, DM, DM, DM, (bf16_t*)(ws + WS_WOE) + (size_t)l * DM * DM, DM, 0, nullptr);
        tr_matrix(F, cur, a.in[IN_OWQKV] + (size_t)l * DM * 3072, 3072, DM, 3072, DM, 3072, (bf16_t*)(ws + WS_WQKV) + (size_t)l * 3072 * DM, DM, 0, nullptr);
        tr_matrix(F, cur, a.in[IN_OWO] + (size_t)l * DM * DM, DM, DM, DM, DM, DM, (bf16_t*)(ws + WS_WOO) + (size_t)l * DM * DM, DM, 0, nullptr);
    }
    __syncthreads();
}
__device__ __forceinline__ void tr_big(const Frame& F, const float* src, int ldsrc, int k0, int n0, bf16_t* dst, int lddst, int rowmap) {
    LAS float* T = (LAS float*)F.lds;
    f32x4 v[8];
#pragma unroll
    for (int it = 0; it < 8; ++it) { const int idx = it * NTHREADS + F.tid, i = idx >> 6, c4 = idx & 63; v[it] = *(const f32x4*)(src + (size_t)(k0 + i) * ldsrc + n0 + 4 * c4); }
    __syncthreads();
#pragma unroll
    for (int it = 0; it < 8; ++it) { const int idx = it * NTHREADS + F.tid, i = idx >> 6, c4 = idx & 63; *(LAS f32x4*)(T + i * 260 + 4 * c4) = v[it]; }
    __syncthreads();
    const int nn = F.tid & 255, kh = F.tid >> 8;
    int n = n0 + nn; if (rowmap) n = (n >> 7) * 256 + (n & 127) + (rowmap == 2 ? 128 : 0);
    bf16_t* dp = dst + (size_t)n * lddst + k0 + 32 * kh;
#pragma unroll
    for (int sg = 0; sg < 4; ++sg) { float f[8];
#pragma unroll
        for (int q = 0; q < 8; ++q) f[q] = T[(32 * kh + 8 * sg + q) * 260 + nn];
        *(u32x4*)(dp + 8 * sg) = pack8(f); }
}
__device__ __forceinline__ void tr_matrix_big(const Frame& F, int& cursor, const float* src, int ldsrc, int K, int N, bf16_t* dst, int lddst, int rowmap) {
    const int tk = K / 64, tn = N / 256, ntile = tk * tn;
    const int first = (F.bid - cursor % F.G + F.G) % F.G;
    for (int t = first; t < ntile; t += F.G) tr_big(F, src, ldsrc, (t / tn) * 64, (t % tn) * 256, dst, lddst, rowmap);
    cursor += ntile;
}
__device__ __forceinline__ void phase_moe_weights(const Frame& F, const Args& a, int layer) {
    unsigned char* ws = a.ws; int cur = 0;
    for (int e = 0; e < NEXP; ++e) {
        const size_t so = ((size_t)layer * NEXP + e) * DM * DEXP;
        tr_matrix_big(F, cur, a.in[IN_WG] + so, DEXP, DM, DEXP, (bf16_t*)(ws + WS_W13) + (size_t)e * 1024 * 1024, DM, 1);
        tr_matrix_big(F, cur, a.in[IN_WU] + so, DEXP, DM, DEXP, (bf16_t*)(ws + WS_W13) + (size_t)e * 1024 * 1024, DM, 2);
        tr_matrix_big(F, cur, a.in[IN_WD] + so, DM, DEXP, DM, (bf16_t*)(ws + WS_W2) + (size_t)e * 1024 * 512, DEXP, 0);
    }
    __syncthreads();
}

template <int MODE>
__device__ __forceinline__ void phase_ln(const Frame& F, const Args& a, int layer, bool last_layer) {
    unsigned char* ws = a.ws;
    bf16_t* X = (bf16_t*)(ws + WS_X);
    const bf16_t* Ra = MODE == 0 ? (const bf16_t*)(ws + WS_R1) : (const bf16_t*)(ws + WS_R2);
    const float* gam = a.in[MODE == 0 ? IN_LN1G : IN_LN2G] + layer * DM; const float* bet = a.in[MODE == 0 ? IN_LN1B : IN_LN2B] + layer * DM;
    const float* WR = (const float*)(ws + WS_WR) + (size_t)layer * 36 * DM;
    LAS int* hist = (LAS int*)F.lds;
    for (int chunk = F.bid; chunk < NTOK / 256; chunk += F.G) {
        if (MODE == 0) { __syncthreads(); if (F.tid < NEXP) hist[F.tid] = 0; __syncthreads(); }
        for (int rr = F.wave; rr < 256; rr += NTHREADS / 64) {
            const int row = chunk * 256 + rr; float y[16];
#pragma unroll
            for (int hh = 0; hh < 2; ++hh) { const int c = hh * 512 + F.lane * 8; float xv[8], rv[8];
                unpack8(*(const u32x4*)(X + (size_t)row * DM + c), xv);
                if (MODE == 0) unpack8(*(const u32x4*)(Ra + (size_t)row * DM + c), rv);
                else { float r0[8], r1[8]; unpack8(*(const u32x4*)(Ra + (size_t)row * 2 * DM + c), r0); unpack8(*(const u32x4*)(Ra + (size_t)row * 2 * DM + DM + c), r1);
#pragma unroll
                    for (int q = 0; q < 8; ++q) rv[q] = r0[q] + r1[q]; }
#pragma unroll
                for (int q = 0; q < 8; ++q) y[hh * 8 + q] = DN_ALPHA * xv[q] + rv[q]; }
            float s = 0.f;
#pragma unroll
            for (int q = 0; q < 16; ++q) s += y[q];
            const float mean = wave_sum(s) * (1.0f / DM);
            float v = 0.f;
#pragma unroll
            for (int q = 0; q < 16; ++q) { const float d = y[q] - mean; v += d * d; }
            const float rstd = 1.0f / sqrtf(wave_sum(v) * (1.0f / DM) + LN_EPS);
#pragma unroll
            for (int hh = 0; hh < 2; ++hh) { const int c = hh * 512 + F.lane * 8;
                const f32x4 g0 = *(const f32x4*)(gam + c), g1 = *(const f32x4*)(gam + c + 4), b0 = *(const f32x4*)(bet + c), b1 = *(const f32x4*)(bet + c + 4);
#pragma unroll
                for (int q = 0; q < 4; ++q) { y[hh * 8 + q] = (y[hh * 8 + q] - mean) * rstd * g0[q] + b0[q]; y[hh * 8 + 4 + q] = (y[hh * 8 + 4 + q] - mean) * rstd * g1[q] + b1[q]; } }
            if (MODE == 1 && last_layer) {
#pragma unroll
                for (int hh = 0; hh < 2; ++hh) { float* o = a.out + (size_t)row * DM + hh * 512 + F.lane * 8;
                    *(f32x4*)o = (f32x4){y[hh * 8], y[hh * 8 + 1], y[hh * 8 + 2], y[hh * 8 + 3]}; *(f32x4*)(o + 4) = (f32x4){y[hh * 8 + 4], y[hh * 8 + 5], y[hh * 8 + 6], y[hh * 8 + 7]}; }
            } else {
#pragma unroll
                for (int hh = 0; hh < 2; ++hh) { float t8[8];
#pragma unroll
                    for (int q = 0; q < 8; ++q) t8[q] = y[hh * 8 + q];
                    *(u32x4*)(X + (size_t)row * DM + hh * 512 + F.lane * 8) = pack8(t8); }
            }
            if (MODE == 0) {
                float mine = 0.f;
#pragma unroll 2
                for (int j = 0; j < 36; ++j) { float p = 0.f;
#pragma unroll
                    for (int hh = 0; hh < 2; ++hh) { const float* w = WR + (size_t)j * DM + hh * 512 + F.lane * 8; const f32x4 w0 = *(const f32x4*)w, w1 = *(const f32x4*)(w + 4);
#pragma unroll
                        for (int q = 0; q < 4; ++q) { p += y[hh * 8 + q] * w0[q]; p += y[hh * 8 + 4 + q] * w1[q]; } }
                    p = wave_sum(p); mine = (F.lane == j) ? p : mine; }
                { const float* brg = a.in[IN_BRG] + layer * 4; const float* bre = a.in[IN_BRE] + layer * 32;
                  mine += (F.lane < 4) ? brg[F.lane] : (F.lane < 36 ? bre[F.lane - 4] : 0.f); }
                float lg[4];
#pragma unroll
                for (int j = 0; j < 4; ++j) lg[j] = __shfl(mine, j);
                int grp = 0; float gm = lg[0];
#pragma unroll
                for (int j = 1; j < 4; ++j) if (lg[j] > gm) { gm = lg[j]; grp = j; }
                float gs = 0.f;
#pragma unroll
                for (int j = 0; j < 4; ++j) gs += __expf(lg[j] - gm);
                const float gw = 1.0f / gs;
                float le[8];
#pragma unroll
                for (int i = 0; i < 8; ++i) le[i] = __shfl(mine, 4 + grp * 8 + i);
                int i1 = 0; float m1 = le[0];
#pragma unroll
                for (int i = 1; i < 8; ++i) if (le[i] > m1) { m1 = le[i]; i1 = i; }
                int i2 = -1; float m2 = -3.0e38f;
#pragma unroll
                for (int i = 0; i < 8; ++i) if (i != i1 && le[i] > m2) { m2 = le[i]; i2 = i; }
                const float e2 = __expf(m2 - m1), den = 1.0f / (1.0f + e2);
                if (F.lane == 0) {
                    const int e0 = grp * 8 + i1, e1 = grp * 8 + i2;
                    int* ri = (int*)(ws + WS_ROUTE) + (size_t)row * 4; ri[0] = e0; ri[1] = e1; ((float*)ri)[2] = den * gw; ((float*)ri)[3] = e2 * den * gw;
                    atomicAdd((int*)&hist[e0], 1); atomicAdd((int*)&hist[e1], 1);
                }
            }
        }
        if (MODE == 0) { __syncthreads(); if (F.tid < NEXP) ((int*)(ws + WS_CNT))[chunk * NEXP + F.tid] = hist[F.tid]; }
    }
    __syncthreads();
}

__device__ __forceinline__ void phase_ln1_router(const Frame& F, const Args& a, int layer) {
    unsigned char* ws = a.ws;
    bf16_t* X = (bf16_t*)(ws + WS_X); const bf16_t* Yb = (const bf16_t*)(ws + WS_R1); const f32x4* stats = (const f32x4*)(ws + WS_R2);
    const float* gam = a.in[IN_LN1G] + layer * DM; const float* bet = a.in[IN_LN1B] + layer * DM;
    const bf16_t* WRh = (const bf16_t*)(ws + WS_WR) + (size_t)layer * 2 * 48 * DM; const bf16_t* WRl = WRh + 48 * DM;
    LAS int* hist = (LAS int*)F.lds; LAS float* Lg = (LAS float*)(F.lds + 1024) + F.wave * (16 * 48);
    const int r = F.lane & 15, g = F.lane >> 4;
    for (int chunk = F.bid; chunk < NTOK / 256; chunk += F.G) {
        __syncthreads(); if (F.tid < NEXP) hist[F.tid] = 0; __syncthreads();
#pragma unroll 1
        for (int grp = 0; grp < 2; ++grp) {
            const int row = chunk * 256 + F.wave * 32 + grp * 16 + r;
            const bf16_t* yp = Yb + (size_t)row * DM + 8 * g;
            const f32x4 q0 = stats[(size_t)row * 8 + 2 * g], q1 = stats[(size_t)row * 8 + 2 * g + 1];
            float s = (q0[0] + q0[2]) + (q1[0] + q1[2]), ss = (q0[1] + q0[3]) + (q1[1] + q1[3]);
            s += __shfl_xor(s, 16); s += __shfl_xor(s, 32); ss += __shfl_xor(ss, 16); ss += __shfl_xor(ss, 32);
            const float mean = s * (1.0f / DM), var = fmaxf(ss * (1.0f / DM) - mean * mean, 0.f), rstd = 1.0f / sqrtf(var + LN_EPS);
            f32x4 acc[3];
#pragma unroll
            for (int nb = 0; nb < 3; ++nb) acc[nb] = (f32x4){0.f, 0.f, 0.f, 0.f};
#pragma unroll 4
            for (int kk = 0; kk < 32; ++kk) { float yv[8], y[8], lo[8]; unpack8(*(const u32x4*)(yp + 32 * kk), yv);
                const int c = 32 * kk + 8 * g;
                const f32x4 g0 = *(const f32x4*)(gam + c), g1 = *(const f32x4*)(gam + c + 4), b0 = *(const f32x4*)(bet + c), b1 = *(const f32x4*)(bet + c + 4);
#pragma unroll
                for (int q = 0; q < 4; ++q) { y[q] = (yv[q] - mean) * rstd * g0[q] + b0[q]; y[4 + q] = (yv[4 + q] - mean) * rstd * g1[q] + b1[q]; }
                const u32x4 hw = pack8(y); *(u32x4*)(X + (size_t)row * DM + c) = hw;
                { float hf[8]; unpack8(hw, hf);
#pragma unroll
                  for (int q = 0; q < 8; ++q) lo[q] = y[q] - hf[q]; }
                const u32x4 lw = pack8(lo); const bf16x8 ah = *(const bf16x8*)&hw, al = *(const bf16x8*)&lw;
#pragma unroll
                for (int nb = 0; nb < 3; ++nb) { const bf16x8 bh = *(const bf16x8*)(WRh + (size_t)(16 * nb + r) * DM + c), blo = *(const bf16x8*)(WRl + (size_t)(16 * nb + r) * DM + c);
                    acc[nb] = __builtin_amdgcn_mfma_f32_16x16x32_bf16(ah, bh, acc[nb], 0, 0, 0);
                    acc[nb] = __builtin_amdgcn_mfma_f32_16x16x32_bf16(al, bh, acc[nb], 0, 0, 0);
                    acc[nb] = __builtin_amdgcn_mfma_f32_16x16x32_bf16(ah, blo, acc[nb], 0, 0, 0); } }
#pragma unroll
            for (int nb = 0; nb < 3; ++nb)
#pragma unroll
                for (int t = 0; t < 4; ++t) Lg[(4 * g + t) * 48 + 16 * nb + r] = acc[nb][t];
            asm volatile("s_waitcnt lgkmcnt(0)" ::: "memory");
            if (F.lane < 16) {
                const LAS float* L = Lg + r * 48; const float* brg = a.in[IN_BRG] + layer * 4; const float* bre = a.in[IN_BRE] + layer * 32;
                float lg[4];
#pragma unroll
                for (int q = 0; q < 4; ++q) lg[q] = L[q] + brg[q];
                int grpi = 0; float gm = lg[0];
#pragma unroll
                for (int q = 1; q < 4; ++q) if (lg[q] > gm) { gm = lg[q]; grpi = q; }
                float gs = 0.f;
#pragma unroll
                for (int q = 0; q < 4; ++q) gs += __expf(lg[q] - gm);
                const float gw = 1.0f / gs;
                float le[8];
#pragma unroll
                for (int i = 0; i < 8; ++i) le[i] = L[4 + grpi * 8 + i] + bre[grpi * 8 + i];
                int i1 = 0; float m1 = le[0];
#pragma unroll
                for (int i = 1; i < 8; ++i) if (le[i] > m1) { m1 = le[i]; i1 = i; }
                int i2 = -1; float m2 = -3.0e38f;
#pragma unroll
                for (int i = 0; i < 8; ++i) if (i != i1 && le[i] > m2) { m2 = le[i]; i2 = i; }
                const float e2 = __expf(m2 - m1), den = 1.0f / (1.0f + e2);
                const int e0 = grpi * 8 + i1, e1 = grpi * 8 + i2;
                int* ri = (int*)(ws + WS_ROUTE) + (size_t)row * 4; ri[0] = e0; ri[1] = e1; ((float*)ri)[2] = den * gw; ((float*)ri)[3] = e2 * den * gw;
                atomicAdd((int*)&hist[e0], 1); atomicAdd((int*)&hist[e1], 1);
            }
            asm volatile("s_waitcnt lgkmcnt(0)" ::: "memory");
        }
        __syncthreads(); if (F.tid < NEXP) ((int*)(ws + WS_CNT))[chunk * NEXP + F.tid] = hist[F.tid];
    }
    __syncthreads();
}

__device__ __forceinline__ void phase_ln2(const Frame& F, const Args& a, int layer, bool last_layer, bool dry = false) {
    unsigned char* ws = a.ws;
    bf16_t* X = (bf16_t*)(ws + WS_X); bf16_t* XO = dry ? (bf16_t*)(ws + WS_R1) : X; const bf16_t* Y = (const bf16_t*)(ws + WS_R2);
    LAS float* gl = (LAS float*)F.lds; LAS float* bl = gl + DM;
    __syncthreads();
    for (int i = F.tid; i < DM; i += NTHREADS) { gl[i] = a.in[IN_LN2G][layer * DM + i]; bl[i] = a.in[IN_LN2B][layer * DM + i]; }
    __syncthreads();
    const int r = F.lane & 7, g = F.lane >> 3;
    const LAS float* gam = gl + 8 * g; const LAS float* bet = bl + 8 * g;
#pragma unroll 1
    for (int blk = F.bid * (NTHREADS / 64) + F.wave; blk < NTOK / 8; blk += F.G * (NTHREADS / 64)) {
        const int row = blk * 8 + r;
        const bf16_t* xp = X + (size_t)row * DM + 8 * g; const bf16_t* y0p = Y + (size_t)row * 2 * DM + 8 * g; const bf16_t* y1p = y0p + DM;
        float y[128];
#pragma unroll
        for (int kk = 0; kk < 16; ++kk) { float xv[8], u0[8], u1[8]; unpack8(*(const u32x4*)(xp + 64 * kk), xv); unpack8(*(const u32x4*)(y0p + 64 * kk), u0); unpack8(*(const u32x4*)(y1p + 64 * kk), u1);
#pragma unroll
            for (int q = 0; q < 8; ++q) y[8 * kk + q] = DN_ALPHA * xv[q] + (u0[q] + u1[q]);
            if ((kk & 3) == 3) {
#pragma unroll
                for (int k2 = kk - 3; k2 <= kk; ++k2) asm volatile("" : "+v"(y[8 * k2]), "+v"(y[8 * k2 + 1]), "+v"(y[8 * k2 + 2]), "+v"(y[8 * k2 + 3]), "+v"(y[8 * k2 + 4]), "+v"(y[8 * k2 + 5]), "+v"(y[8 * k2 + 6]), "+v"(y[8 * k2 + 7]) :: "memory"); } }
        float s = 0.f;
#pragma unroll
        for (int q = 0; q < 128; ++q) s += y[q];
        s += __shfl_xor(s, 8); s += __shfl_xor(s, 16); s += __shfl_xor(s, 32);
        const float mean = s * (1.0f / DM);
        float v = 0.f;
#pragma unroll
        for (int q = 0; q < 128; ++q) { const float dlt = y[q] - mean; v += dlt * dlt; }
        v += __shfl_xor(v, 8); v += __shfl_xor(v, 16); v += __shfl_xor(v, 32);
        const float rstd = 1.0f / sqrtf(v * (1.0f / DM) + LN_EPS);
#pragma unroll
        for (int kk = 0; kk < 16; ++kk) { const int c = 64 * kk + 8 * g; float o8[8];
            const f32x4 g0 = *(const LAS f32x4*)(gam + 64 * kk), g1 = *(const LAS f32x4*)(gam + 64 * kk + 4), b0 = *(const LAS f32x4*)(bet + 64 * kk), b1 = *(const LAS f32x4*)(bet + 64 * kk + 4);
#pragma unroll
            for (int q = 0; q < 4; ++q) { o8[q] = (y[8 * kk + q] - mean) * rstd * g0[q] + b0[q]; o8[4 + q] = (y[8 * kk + 4 + q] - mean) * rstd * g1[q] + b1[q]; }
            if (last_layer) { float* o = a.out + (size_t)row * DM + c; *(f32x4*)o = (f32x4){o8[0], o8[1], o8[2], o8[3]}; *(f32x4*)(o + 4) = (f32x4){o8[4], o8[5], o8[6], o8[7]}; }
            else *(u32x4*)(XO + (size_t)row * DM + c) = pack8(o8);
            if (kk & 1) asm volatile("" ::: "memory"); }
    }
}

__device__ __forceinline__ void phase_scatter(const Frame& F, const Args& a) {
    unsigned char* ws = a.ws;
    const int* cnt = (const int*)(ws + WS_CNT); int* tile = (int*)(ws + WS_TILE);
    int* slot_tok = (int*)(ws + WS_SLOT_TOK); float* slot_g = (float*)(ws + WS_SLOT_G); int* slot_dst = (int*)(ws + WS_SLOT_DST);
    LAS int* C = (LAS int*)F.lds;
    LAS int* total = C + 256 * NEXP;
    LAS int* tstart = total + NEXP;
    LAS int* base = tstart + NEXP + 1;
    LAS int* el = base + NEXP;
    __syncthreads();
    for (int i = F.tid; i < 256 * NEXP; i += NTHREADS) C[i] = cnt[i];
    __syncthreads();
    if (F.tid < NEXP) { int s = 0; for (int c = 0; c < 256; ++c) s += C[c * NEXP + F.tid]; total[F.tid] = s; }
    __syncthreads();
    if (F.tid == 0) { int t = 0; for (int e = 0; e < NEXP; ++e) { tstart[e] = t; t += (total[e] + 255) >> 8; } tstart[NEXP] = t; }
    __syncthreads();
    const int T = tstart[NEXP];
    if (F.bid == 0) { if (F.tid == 0) tile[0] = T; for (int e = 0; e < NEXP; ++e) for (int t = tstart[e] + F.tid; t < tstart[e + 1]; t += NTHREADS) tile[1 + t] = e; }
    for (int e = F.bid; e < NEXP; e += F.G) { const int s0 = tstart[e] * 256 + total[e], s1 = tstart[e + 1] * 256;
        for (int s = s0 + F.tid; s < s1; s += NTHREADS) { slot_tok[s] = 0; slot_g[s] = 0.f; slot_dst[s] = -1; } }
    for (int chunk = F.bid; chunk < NTOK / 256; chunk += F.G) {
        __syncthreads();
        if (F.tid < NEXP) { int s = 0; for (int c = 0; c < chunk; ++c) s += C[c * NEXP + F.tid]; base[F.tid] = tstart[F.tid] * 256 + s; }
        const int tok = chunk * 256 + (F.tid >> 1), k = F.tid & 1;
        const int* ri = (const int*)(ws + WS_ROUTE) + (size_t)tok * 4;
        const int e = ri[k]; const float g = ((const float*)ri)[2 + k];
        el[F.tid] = e;
        __syncthreads();
        int rank = 0;
        for (int q = 0; q < F.tid; ++q) rank += (el[q] == e) ? 1 : 0;
        const int slot = base[e] + rank;
        slot_tok[slot] = tok; slot_g[slot] = g; slot_dst[slot] = tok * 2 + k;
    }
    __syncthreads();
}

template <int DQK, int VP>
__device__ __forceinline__ void attn_keys64(const LAS float* Ks, const LAS float* Vs, const float (&q)[DQK], float (&o)[64], float& m, float& l, const float sc) {
#pragma unroll 1
    for (int jj = 0; jj < 64; ++jj) {
        float acc = 0.f; const LAS float* kr = Ks + jj * DQK;
#pragma unroll
        for (int d = 0; d < DQK; d += 4) { const f32x4 kv = *(const LAS f32x4*)(kr + d); acc += q[d] * kv[0] + q[d + 1] * kv[1] + q[d + 2] * kv[2] + q[d + 3] * kv[3]; }
        const float s = acc * sc, mx = fmaxf(m, s), corr = __builtin_amdgcn_exp2f(m - mx), p = __builtin_amdgcn_exp2f(s - mx);
        m = mx; l = l * corr + p; const LAS float* vr = Vs + jj * VP;
#pragma unroll
        for (int e = 0; e < 64; e += 4) { const f32x4 vv = *(const LAS f32x4*)(vr + e); o[e] = o[e] * corr + p * vv[0]; o[e + 1] = o[e + 1] * corr + p * vv[1]; o[e + 2] = o[e + 2] * corr + p * vv[2]; o[e + 3] = o[e + 3] * corr + p * vv[3]; }
    }
}
__device__ __forceinline__ void stage8(LAS float* dst, const bf16_t* src) { float f[8]; unpack8(*(const u32x4*)src, f); *(LAS f32x4*)dst = (f32x4){f[0], f[1], f[2], f[3]}; *(LAS f32x4*)(dst + 4) = (f32x4){f[4], f[5], f[6], f[7]}; }

__device__ __forceinline__ void attn_diff_naive(const Frame& F, const Args& a, int layer, int unit) {
    unsigned char* ws = a.ws; const bf16_t* H = (const bf16_t*)(ws + WS_R1); bf16_t* O = (bf16_t*)(ws + WS_R3); float* TS = (float*)(ws + WS_R1 + 256 * MiB);
    const int j = layer >> 1; const float lambda_init = 0.8f - 0.6f * expf(-0.3f * (float)layer);
    float d1 = 0.f, d2 = 0.f;
    for (int i = 0; i < 64; ++i) { d1 += a.in[IN_LQ1][j * 64 + i] * a.in[IN_LK1][j * 64 + i]; d2 += a.in[IN_LQ2][j * 64 + i] * a.in[IN_LK2][j * 64 + i]; }
    const float lam = expf(d1) - expf(d2) + lambda_init;
    const int qb = unit & 7, h = (unit >> 3) & 3, b = unit >> 5;
    const int ql = (F.tid & 31) + 32 * (F.tid >> 6), half = (F.tid >> 5) & 1;
    const size_t row = (size_t)b * SEQ + qb * 256 + ql;
    LAS float* Ks = (LAS float*)F.lds; LAS float* Vs = Ks + 64 * 64;
    const float sc = 0.125f * 1.4426950408889634f;
    float* stash = TS + row * 512 + h * 128 + half * 64;
#pragma unroll 1
    for (int st = 0; st < 2; ++st) {
        float o[64], q[64];
#pragma unroll
        for (int d = 0; d < 64; d += 8) { float f[8]; unpack8(*(const u32x4*)(H + row * HLD + h * 128 + st * 64 + d), f);
#pragma unroll
            for (int t = 0; t < 8; ++t) q[d + t] = f[t]; }
        float m = -INFINITY, l = 0.f;
#pragma unroll
        for (int e = 0; e < 64; ++e) o[e] = 0.f;
#pragma unroll 1
        for (int kt = 0; kt < SEQ / 64; ++kt) {
            __syncthreads();
            { const int key = F.tid >> 3, d8 = (F.tid & 7) * 8; const size_t krow = (size_t)b * SEQ + kt * 64 + key;
              stage8(Ks + key * 64 + d8, H + krow * HLD + 512 + h * 128 + st * 64 + d8);
              stage8(Vs + key * 128 + d8, H + krow * HLD + 1024 + h * 128 + d8); stage8(Vs + key * 128 + 64 + d8, H + krow * HLD + 1024 + h * 128 + 64 + d8); }
            __syncthreads();
            attn_keys64<64, 128>(Ks, Vs + half * 64, q, o, m, l, sc);
        }
        const float inv = 1.0f / l;
        if (st == 0) {
#pragma unroll
            for (int e = 0; e < 64; e += 4) *(f32x4*)(stash + e) = (f32x4){o[e] * inv, o[e + 1] * inv, o[e + 2] * inv, o[e + 3] * inv};
        } else {
            float ss = 0.f;
#pragma unroll
            for (int e = 0; e < 64; e += 4) { const f32x4 p0 = *(const f32x4*)(stash + e);
#pragma unroll
                for (int t = 0; t < 4; ++t) { o[e + t] = p0[t] - lam * (o[e + t] * inv); ss += o[e + t] * o[e + t]; } }
            ss += __shfl_xor(ss, 32);
            const float rs = 1.0f / sqrtf(ss * (1.0f / 128.0f) + RMS_EPS) * (1.0f - lambda_init);
            const float* g = a.in[IN_SUBLN] + j * 128 + half * 64;
#pragma unroll
            for (int e = 0; e < 64; e += 8) { float t8[8];
#pragma unroll
                for (int t = 0; t < 8; ++t) t8[t] = o[e + t] * rs * g[e + t];
                *(u32x4*)(O + row * DM + h * 128 + half * 64 + e) = pack8(t8); }
        }
    }
}
__device__ __forceinline__ void attn_mla_naive(const Frame& F, const Args& a, int unit) {
    unsigned char* ws = a.ws; const bf16_t* QB = (const bf16_t*)(ws + WS_R2); const bf16_t* KVB = QB + (size_t)NTOK * 768; const bf16_t* KR = KVB + (size_t)NTOK * 1024; bf16_t* O = (bf16_t*)(ws + WS_R3);
    const int qb = unit & 3, h = (unit >> 2) & 7, b = unit >> 5;
    const size_t row = (size_t)b * SEQ + qb * 512 + F.tid;
    LAS float* Ks = (LAS float*)F.lds; LAS float* Vs = Ks + 64 * 96;
    const float sc = 0.10206207261596575f * 1.4426950408889634f;
    float q[96], o[64];
#pragma unroll
    for (int d = 0; d < 96; d += 8) { float f[8]; unpack8(*(const u32x4*)(QB + row * 768 + h * 96 + d), f);
#pragma unroll
        for (int t = 0; t < 8; ++t) q[d + t] = f[t]; }
    { const float* rb = (const float*)(ws + WS_ROPEB); const int pos = (int)(row & (SEQ - 1));
#pragma unroll
      for (int i = 0; i < 16; i += 4) { const f32x4 cs = *(const f32x4*)(rb + pos * 16 + i), sn = *(const f32x4*)(rb + SEQ * 16 + pos * 16 + i);
#pragma unroll
          for (int t = 0; t < 4; ++t) { const float x1 = q[64 + i + t], x2 = q[80 + i + t]; q[64 + i + t] = x1 * cs[t] - x2 * sn[t]; q[80 + i + t] = x2 * cs[t] + x1 * sn[t]; } } }
    float m = -INFINITY, l = 0.f;
#pragma unroll
    for (int e = 0; e < 64; ++e) o[e] = 0.f;
#pragma unroll 1
    for (int kt = 0; kt < SEQ / 64; ++kt) {
        __syncthreads();
        { const int key = F.tid >> 3, d8 = (F.tid & 7) * 8; const size_t krow = (size_t)b * SEQ + kt * 64 + key;
          stage8(Ks + key * 96 + d8, KVB + krow * 1024 + h * 128 + d8);
          stage8(Vs + key * 64 + d8, KVB + krow * 1024 + h * 128 + 64 + d8);
          if (F.tid < 256) { const int key2 = F.tid >> 2, r8 = (F.tid & 3) * 8; stage8(Ks + key2 * 96 + 64 + r8, KR + ((size_t)b * SEQ + kt * 64 + key2) * 32 + r8); } }
        __syncthreads();
        attn_keys64<96, 64>(Ks, Vs, q, o, m, l, sc);
    }
    const float inv = 1.0f / l;
#pragma unroll
    for (int e = 0; e < 64; e += 8) { float t8[8];
#pragma unroll
        for (int t = 0; t < 8; ++t) t8[t] = o[e + t] * inv;
        *(u32x4*)(O + row * DM + 512 + h * 64 + e) = pack8(t8); }
}
__device__ __forceinline__ void attn_na_naive(const Frame& F, const Args& a, int layer, int unit) {
    unsigned char* ws = a.ws; const bf16_t* QKV = (const bf16_t*)(ws + WS_R1); bf16_t* O = (bf16_t*)(ws + WS_R3);
    const float* relb = a.in[IN_RELB] + (size_t)(layer >> 1) * 16 * 15 * 31;
    const int hh = unit & 1, r = (unit >> 1) & 31, b = unit >> 6;
    const int c = F.tid & 63, h = hh * 8 + (F.tid >> 6);
    const int r0 = min(max(r - 4, 0), 24), c0 = min(max(c - 8, 0), 48);
    const size_t row = (size_t)b * SEQ + r * 64 + c;
    const float LOG2E = 1.4426950408889634f;
    float q[64], o[64];
#pragma unroll
    for (int d = 0; d < 64; d += 8) { float f[8]; unpack8(*(const u32x4*)(QKV + row * 3072 + h * 64 + d), f);
#pragma unroll
        for (int t = 0; t < 8; ++t) q[d + t] = f[t]; }
    float m = -INFINITY, l = 0.f;
#pragma unroll
    for (int e = 0; e < 64; ++e) o[e] = 0.f;
#pragma unroll 1
    for (int ij = 0; ij < 128; ++ij) {
        const int i = ij >> 4, jj = ij & 15;
        const size_t krow = (size_t)b * SEQ + (r0 + i) * 64 + c0 + jj;
        const float bias = relb[((size_t)h * 15 + (r0 + i - r + 7)) * 31 + (c0 + jj - c + 15)];
        float acc = 0.f; const bf16_t* kp = QKV + krow * 3072 + 1024 + h * 64;
#pragma unroll
        for (int d = 0; d < 64; d += 8) { float f[8]; unpack8(*(const u32x4*)(kp + d), f);
#pragma unroll
            for (int t = 0; t < 8; ++t) acc += q[d + t] * f[t]; }
        const float s = (acc * 0.125f + bias) * LOG2E, mx = fmaxf(m, s), corr = __builtin_amdgcn_exp2f(m - mx), p = __builtin_amdgcn_exp2f(s - mx);
        m = mx; l = l * corr + p; const bf16_t* vp = kp + 1024;
#pragma unroll
        for (int e = 0; e < 64; e += 8) { float f[8]; unpack8(*(const u32x4*)(vp + e), f);
#pragma unroll
            for (int t = 0; t < 8; ++t) o[e + t] = o[e + t] * corr + p * f[t]; }
    }
    const float inv = 1.0f / l;
#pragma unroll
    for (int e = 0; e < 64; e += 8) { float t8[8];
#pragma unroll
        for (int t = 0; t < 8; ++t) t8[t] = o[e + t] * inv;
        *(u32x4*)(O + row * DM + h * 64 + e) = pack8(t8); }
}

namespace fa {
typedef float f32x16 __attribute__((ext_vector_type(16)));
typedef short s16x4 __attribute__((ext_vector_type(4)));
#define FA_SBAR() __builtin_amdgcn_sched_barrier(0)
__device__ __forceinline__ int crow(int r, int hi) { return (r & 3) + 8 * (r >> 2) + 4 * hi; }
constexpr float THR = 8.f;
template <int SCALE_E6> __device__ __forceinline__ void partialSM(f32x16& p0, f32x16& p1, float& m_reg, float& mn, float& alpha) {
    constexpr float SCALE = SCALE_E6 * 1e-6f, C = SCALE * 1.4426950408889634f;
    float pmax = p0[0];
#pragma unroll
    for (int r = 1; r < 16; ++r) pmax = fmaxf(pmax, p0[r]);
#pragma unroll
    for (int r = 0; r < 16; ++r) pmax = fmaxf(pmax, p1[r]);
    { auto rr = __builtin_amdgcn_permlane32_swap(__float_as_uint(pmax), __float_as_uint(pmax), false, false); pmax = fmaxf(__uint_as_float(rr[0]), __uint_as_float(rr[1])); }
    if (__builtin_expect(__all(pmax - m_reg <= THR / SCALE), 1)) { mn = m_reg; alpha = 1.f; }
    else { mn = fmaxf(m_reg, pmax); alpha = __builtin_amdgcn_exp2f((m_reg - mn) * C); m_reg = mn; }
    const float mnC = -mn * C;
#pragma unroll
    for (int r = 0; r < 16; ++r) p0[r] = fmaf(p0[r], C, mnC);
#pragma unroll
    for (int r = 0; r < 16; ++r) p1[r] = fmaf(p1[r], C, mnC);
#pragma unroll
    for (int r = 0; r < 16; ++r) p0[r] = __builtin_amdgcn_exp2f(p0[r]);
}
__device__ __forceinline__ void finishSM(f32x16& p0, f32x16& p1, float alpha, float& l_reg, bf16x8& pa0, bf16x8& pa1, bf16x8& pa2, bf16x8& pa3) {
#pragma unroll
    for (int r = 0; r < 16; ++r) p1[r] = __builtin_amdgcn_exp2f(p1[r]);
    float ps = 0;
#pragma unroll
    for (int r = 0; r < 16; ++r) ps += p0[r];
#pragma unroll
    for (int r = 0; r < 16; ++r) ps += p1[r];
    { auto rr = __builtin_amdgcn_permlane32_swap(__float_as_uint(ps), __float_as_uint(ps), false, false); ps = __uint_as_float(rr[0]) + __uint_as_float(rr[1]); }
    l_reg = l_reg * alpha + ps;
#define FA_PK4(P, BASE, OUT) do { unsigned a0 = cvt_pk_bf16(P[BASE + 0], P[BASE + 1]), a1 = cvt_pk_bf16(P[BASE + 2], P[BASE + 3]);   \
    unsigned b0 = cvt_pk_bf16(P[BASE + 4], P[BASE + 5]), b1 = cvt_pk_bf16(P[BASE + 6], P[BASE + 7]);                              \
    auto r0 = __builtin_amdgcn_permlane32_swap(a0, b0, false, false); auto r1 = __builtin_amdgcn_permlane32_swap(a1, b1, false, false); \
    u32x4 w = {r0[0], r1[0], r0[1], r1[1]}; OUT = *reinterpret_cast<bf16x8*>(&w); } while (0)
    FA_PK4(p0, 0, pa0); FA_PK4(p0, 8, pa1); FA_PK4(p1, 0, pa2); FA_PK4(p1, 8, pa3);
#undef FA_PK4
}
template <int NKS> __device__ __forceinline__ void qkt(f32x16& p0, f32x16& p1, const LAS char* Ks, const bf16x8 (&qr)[NKS], int r32, int hi) {
    p0 = f32x16{}; p1 = f32x16{};
#pragma unroll
    for (int d0 = 0; d0 < NKS; ++d0) {
        const bf16x8 b0 = *(const LAS bf16x8*)(Ks + ((2 * d0 + hi) * 64 + r32) * 16);
        const bf16x8 b1 = *(const LAS bf16x8*)(Ks + ((2 * d0 + hi) * 64 + 32 + r32) * 16);
        p0 = __builtin_amdgcn_mfma_f32_32x32x16_bf16(b0, qr[d0], p0, 0, 0, 0);
        p1 = __builtin_amdgcn_mfma_f32_32x32x16_bf16(b1, qr[d0], p1, 0, 0, 0); }
}
template <int NCB> __device__ __forceinline__ int v_st(int k, int c) { const int kk = (k & ~0xC) | ((k & 4) << 1) | ((k & 8) >> 1); return ((kk >> 3) * NCB + (c >> 5)) * 512 + ((kk & 7) * 32 + (c & 31)) * 2; }
__device__ __forceinline__ int v_rd_base(int lane) { return ((lane & 3) << 3) | (((lane >> 2) & 3) << 6) | (((lane >> 4) & 1) << 5) | (((lane >> 5) & 1) << 8); }
template <int NCB> constexpr int v_rd_off(int d0, int ks, int half) { return d0 * 512 + ks * (NCB * 1024) + half * (NCB * 512); }
template <int OFF> __device__ __forceinline__ s16x4 tr_read(int vb) { s16x4 r; asm volatile("ds_read_b64_tr_b16 %0, %1 offset:%2" : "=&v"(r) : "v"(vb), "i"(OFF) : "memory"); return r; }
template <int D0, int NCB> __device__ __forceinline__ void pv_one(f32x16& od, int vb, bf16x8 pa0, bf16x8 pa1, bf16x8 pa2, bf16x8 pa3) {
    const s16x4 l0 = tr_read<v_rd_off<NCB>(D0, 0, 0)>(vb), h0 = tr_read<v_rd_off<NCB>(D0, 0, 1)>(vb), l1 = tr_read<v_rd_off<NCB>(D0, 1, 0)>(vb), h1 = tr_read<v_rd_off<NCB>(D0, 1, 1)>(vb);
    const s16x4 l2 = tr_read<v_rd_off<NCB>(D0, 2, 0)>(vb), h2 = tr_read<v_rd_off<NCB>(D0, 2, 1)>(vb), l3 = tr_read<v_rd_off<NCB>(D0, 3, 0)>(vb), h3 = tr_read<v_rd_off<NCB>(D0, 3, 1)>(vb);
    asm volatile("s_waitcnt lgkmcnt(0)" ::: "memory"); FA_SBAR();
#define FA_PK(L, H) (bf16x8){L[0], L[1], L[2], L[3], H[0], H[1], H[2], H[3]}
    od = __builtin_amdgcn_mfma_f32_32x32x16_bf16(pa0, FA_PK(l0, h0), od, 0, 0, 0);
    od = __builtin_amdgcn_mfma_f32_32x32x16_bf16(pa1, FA_PK(l1, h1), od, 0, 0, 0);
    od = __builtin_amdgcn_mfma_f32_32x32x16_bf16(pa2, FA_PK(l2, h2), od, 0, 0, 0);
    od = __builtin_amdgcn_mfma_f32_32x32x16_bf16(pa3, FA_PK(l3, h3), od, 0, 0, 0);
#undef FA_PK
}
template <int NCB> __device__ __forceinline__ void pv_all(f32x16 (&o)[NCB], int vb, bf16x8 pa0, bf16x8 pa1, bf16x8 pa2, bf16x8 pa3) {
    pv_one<0, NCB>(o[0], vb, pa0, pa1, pa2, pa3); pv_one<1, NCB>(o[1], vb, pa0, pa1, pa2, pa3);
    if constexpr (NCB == 4) { pv_one<2, NCB>(o[2], vb, pa0, pa1, pa2, pa3); pv_one<3, NCB>(o[3], vb, pa0, pa1, pa2, pa3); }
}

template <int DQK, int DV, int SCALE_E6, int SDEPTH>
__device__ __forceinline__ void attn_stream(const Frame& F, const bf16_t* __restrict__ Qb, int LDQ, const bf16_t* __restrict__ Kh, int LDK, const bf16_t* __restrict__ KRh, const bf16_t* __restrict__ Vh, int LDV,
                                            const float* ropeB, int qpos0, f32x16 (&o)[DV / 32], float (&rli)[16]) {
    constexpr int NKS = DQK / 16, NCB = DV / 32, SHM_K = 64 * DQK * 2, SHM_V = 64 * DV * 2;
    const int tid = F.tid, wid = F.wave, lane = F.lane, r32 = lane & 31, hi = lane >> 5;
    LAS char* V_lds = (LAS char*)F.lds; LAS char* K_lds = V_lds + 2 * SHM_V;
    LAS float* wsl = (LAS float*)(K_lds + 2 * SHM_K) + wid * 64; LAS float* li_l = wsl; LAS float* al_l = wsl + 32;
    float m_reg = -1e30f, l_reg = 0.f; bf16x8 qr[NKS];
#pragma unroll
    for (int d = 0; d < NCB; ++d) o[d] = f32x16{};
    const bf16_t* Qw = Qb + (size_t)(wid * 32 + r32) * LDQ + hi * 8;
#pragma unroll
    for (int d0 = 0; d0 < NKS; ++d0) qr[d0] = *(const bf16x8*)(Qw + d0 * 16);
    if constexpr (DQK == 96) {
        const int pos = qpos0 + wid * 32 + r32; float x1[8], x2[8];
        unpack8(*(const u32x4*)&qr[4], x1); unpack8(*(const u32x4*)&qr[5], x2);
        const float* cp = ropeB + pos * 16 + 8 * hi; const float* sp = ropeB + SEQ * 16 + pos * 16 + 8 * hi;
#pragma unroll
        for (int jj = 0; jj < 8; ++jj) { const float c = cp[jj], sn = sp[jj], a = x1[jj], b = x2[jj]; x1[jj] = a * c - b * sn; x2[jj] = b * c + a * sn; }
        u32x4 w1 = pack8(x1), w2 = pack8(x2); qr[4] = *(bf16x8*)&w1; qr[5] = *(bf16x8*)&w2;
    }
    const int krow = (tid & 7) + 8 * (tid >> 6), kcs = (tid >> 3) & 7;
    const int rrow = (tid & 7) + 8 * ((tid >> 5) & 7), rcs = (tid >> 3) & 3;
    const int vr0 = (DV == 128) ? (tid >> 4) : (tid >> 3), vc = (DV == 128) ? (tid & 15) * 8 : (tid & 7) * 8;
    const int vst0 = v_st<NCB>(vr0, vc), vst1 = v_st<NCB>(32 + vr0, vc);
    const int vb0 = (int)(uintptr_t)V_lds + v_rd_base(lane);
    struct Slot { bf16x8 k0, kr, v0, v1; } sl[SDEPTH];
    constexpr int SE = 0, SO = SDEPTH - 1;
#define FA_SLOAD(i, key0) do { sl[i].k0 = *(const bf16x8*)(Kh + (size_t)((key0) + krow) * LDK + kcs * 8); \
        if constexpr (DQK == 96) sl[i].kr = *(const bf16x8*)(KRh + (size_t)((key0) + rrow) * 32 + rcs * 8); \
        sl[i].v0 = *(const bf16x8*)(Vh + (size_t)((key0) + vr0) * LDV + vc); \
        if constexpr (DV == 128) sl[i].v1 = *(const bf16x8*)(Vh + (size_t)((key0) + 32 + vr0) * LDV + vc); } while (0)
#define FA_SWRITE(b, i) do { *(LAS bf16x8*)(K_lds + (b) * SHM_K + (kcs * 64 + krow) * 16) = sl[i].k0; \
        if constexpr (DQK == 96) { if (tid < 256) *(LAS bf16x8*)(K_lds + (b) * SHM_K + ((8 + rcs) * 64 + rrow) * 16) = sl[i].kr; } \
        *(LAS bf16x8*)(V_lds + (b) * SHM_V + vst0) = sl[i].v0; \
        if constexpr (DV == 128) *(LAS bf16x8*)(V_lds + (b) * SHM_V + vst1) = sl[i].v1; } while (0)
#define FA_SWAIT() do { if constexpr (SDEPTH == 2) asm volatile("s_waitcnt vmcnt(3)" ::: "memory"); else asm volatile("s_waitcnt vmcnt(0)" ::: "memory"); } while (0)
#define FA_RESC(a) do { if (__any((a) < 1.f)) { if (hi == 0) al_l[r32] = (a); asm volatile("s_waitcnt lgkmcnt(0)" ::: "memory"); \
        _Pragma("unroll") for (int d = 0; d < NCB; ++d) _Pragma("unroll") for (int r = 0; r < 16; ++r) o[d][r] *= al_l[crow(r, hi)]; } } while (0)
    f32x16 pA0, pA1, pB0, pB1; float mnA, mnB, alA, alB; bf16x8 pa0, pa1, pa2, pa3; constexpr int NT = SEQ / 64;
    FA_SLOAD(SE, 0); asm volatile("s_waitcnt vmcnt(0)" ::: "memory"); FA_SWRITE(0, SE); __syncthreads();
    qkt<NKS>(pA0, pA1, K_lds, qr, r32, hi); partialSM<SCALE_E6>(pA0, pA1, m_reg, mnA, alA);
    FA_SLOAD(SO, 64); if constexpr (SDEPTH == 2) FA_SLOAD(SE, 128);
    FA_SWAIT(); FA_SWRITE(1, SO); __syncthreads();
#pragma unroll 1
    for (int j = 1; j + 1 < NT; j += 2) {
        FA_SBAR(); qkt<NKS>(pB0, pB1, K_lds + SHM_K, qr, r32, hi);
        finishSM(pA0, pA1, alA, l_reg, pa0, pa1, pa2, pa3); FA_SBAR();
        FA_SLOAD(SO, (j + SDEPTH) * 64); FA_SBAR();
        pv_all<NCB>(o, vb0, pa0, pa1, pa2, pa3); partialSM<SCALE_E6>(pB0, pB1, m_reg, mnB, alB);
        __syncthreads(); FA_SWAIT(); FA_SWRITE(0, SE);
        FA_RESC(alB); __syncthreads();
        FA_SBAR(); qkt<NKS>(pA0, pA1, K_lds, qr, r32, hi);
        finishSM(pB0, pB1, alB, l_reg, pa0, pa1, pa2, pa3); FA_SBAR();
        if (SDEPTH == 1 || j + 3 < NT) FA_SLOAD(SE, (j + 1 + SDEPTH) * 64); FA_SBAR();
        pv_all<NCB>(o, vb0 + SHM_V, pa0, pa1, pa2, pa3); partialSM<SCALE_E6>(pA0, pA1, m_reg, mnA, alA);
        __syncthreads(); FA_SWAIT(); FA_SWRITE(1, SO);
        FA_RESC(alA); __syncthreads();
    }
    FA_SBAR(); qkt<NKS>(pB0, pB1, K_lds + SHM_K, qr, r32, hi);
    finishSM(pA0, pA1, alA, l_reg, pa0, pa1, pa2, pa3); FA_SBAR();
    pv_all<NCB>(o, vb0, pa0, pa1, pa2, pa3); partialSM<SCALE_E6>(pB0, pB1, m_reg, mnB, alB);
    __syncthreads(); FA_RESC(alB);
    finishSM(pB0, pB1, alB, l_reg, pa0, pa1, pa2, pa3); FA_SBAR();
    pv_all<NCB>(o, vb0 + SHM_V, pa0, pa1, pa2, pa3);
    if (hi == 0) li_l[r32] = l_reg;
    asm volatile("s_waitcnt lgkmcnt(0)" ::: "memory");
#pragma unroll
    for (int r = 0; r < 16; ++r) rli[r] = __builtin_amdgcn_rcpf(li_l[crow(r, hi)]);
#undef FA_SLOAD
#undef FA_SWRITE
#undef FA_SWAIT
#undef FA_RESC
}
}

__device__ __forceinline__ void attn_diff_mfma(const Frame& F, const Args& a, int layer, int unit) {
    unsigned char* ws = a.ws; const bf16_t* H = (const bf16_t*)(ws + WS_R1); bf16_t* O = (bf16_t*)(ws + WS_R3); float* TS = (float*)(ws + WS_R1 + 256 * MiB);
    const int jl = layer >> 1; const float lambda_init = 0.8f - 0.6f * expf(-0.3f * (float)layer);
    const float lam = ((const float*)(ws + WS_LAM))[jl];
    const int qb = unit & 7, h = (unit >> 3) & 3, b = unit >> 5;
    const size_t row0 = (size_t)b * SEQ + qb * 256, key0 = (size_t)b * SEQ;
#pragma unroll 1
    for (int st = 0; st < 2; ++st) {
        fa::f32x16 o[4]; float rli[16];
        __syncthreads();
        const Frame Fs = fresh(F);
        float* stash = TS + ((size_t)unit * NTHREADS + Fs.tid) * 64;
        fa::attn_stream<64, 128, 125000, 2>(Fs, H + row0 * HLD + h * 128 + st * 64, HLD, H + key0 * HLD + 512 + h * 128 + st * 64, HLD, nullptr, H + key0 * HLD + 1024 + h * 128, HLD, nullptr, 0, o, rli);
        const Frame Fe = fresh(F); const int r32 = Fe.lane & 31, hi = Fe.lane >> 5;
        if (st == 0) {
#pragma unroll
            for (int d = 0; d < 4; ++d)
#pragma unroll
                for (int r = 0; r < 16; r += 4) *(f32x4*)(stash + d * 16 + r) = (f32x4){o[d][r] * rli[r], o[d][r + 1] * rli[r + 1], o[d][r + 2] * rli[r + 2], o[d][r + 3] * rli[r + 3]};
        } else {
            float ss[16];
#pragma unroll
            for (int r = 0; r < 16; ++r) ss[r] = 0.f;
#pragma unroll
            for (int d = 0; d < 4; ++d)
#pragma unroll
                for (int r = 0; r < 16; r += 4) { const f32x4 p0 = *(const f32x4*)(stash + d * 16 + r);
#pragma unroll
                    for (int t = 0; t < 4; ++t) { const float v = p0[t] - lam * (o[d][r + t] * rli[r + t]); o[d][r + t] = v; ss[r + t] += v * v; } }
#pragma unroll
            for (int r = 0; r < 16; ++r) { float v = ss[r]; v += __shfl_xor(v, 1); v += __shfl_xor(v, 2); v += __shfl_xor(v, 4); v += __shfl_xor(v, 8); v += __shfl_xor(v, 16);
                ss[r] = 1.0f / sqrtf(v * (1.0f / 128.0f) + RMS_EPS) * (1.0f - lambda_init); }
            const float* g = a.in[IN_SUBLN] + jl * 128;
#pragma unroll
            for (int d = 0; d < 4; ++d) { const float gd = g[d * 32 + r32];
#pragma unroll
                for (int r = 0; r < 16; ++r) { const size_t row = row0 + Fe.wave * 32 + fa::crow(r, hi);
                    O[row * DM + h * 128 + d * 32 + r32] = (bf16_t)(cvt_pk_bf16(o[d][r] * ss[r] * gd, 0.f) & 0xffffu); } }
        }
    }
}
__device__ __forceinline__ void attn_mla_mfma(const Frame& F, const Args& a, int unit) {
    unsigned char* ws = a.ws; const bf16_t* QB = (const bf16_t*)(ws + WS_R2); const bf16_t* KVB = QB + (size_t)NTOK * 768; const bf16_t* KR = KVB + (size_t)NTOK * 1024; bf16_t* O = (bf16_t*)(ws + WS_R3);
    const int qb = unit & 7, h = (unit >> 3) & 7, b = unit >> 6;
    const size_t row0 = (size_t)b * SEQ + qb * 256, key0 = (size_t)b * SEQ;
    fa::f32x16 o[2]; float rli[16];
    __syncthreads();
    const Frame Fs = fresh(F);
    fa::attn_stream<96, 64, 102062, 2>(Fs, QB + row0 * 768 + h * 96, 768, KVB + key0 * 1024 + h * 128, 1024, KR + key0 * 32, KVB + key0 * 1024 + h * 128 + 64, 1024, (const float*)(ws + WS_ROPEB), qb * 256, o, rli);
    const Frame Fe = fresh(F); const int r32 = Fe.lane & 31, hi = Fe.lane >> 5;
#pragma unroll
    for (int d = 0; d < 2; ++d)
#pragma unroll
        for (int r = 0; r < 16; ++r) { const size_t row = row0 + Fe.wave * 32 + fa::crow(r, hi);
            O[row * DM + 512 + h * 64 + d * 32 + r32] = (bf16_t)(cvt_pk_bf16(o[d][r] * rli[r], 0.f) & 0xffffu); }
}

constexpr int NA_KSTR = 580;
constexpr int NA_VOFF = 8 * NA_KSTR * 16;
constexpr int NA_BOFF = NA_VOFF + 72 * 64 * 16;
__device__ __forceinline__ void attn_na_lds(const Frame& F, const Args& a, int layer, int unit) {
    unsigned char* ws = a.ws; const bf16_t* Qc = (const bf16_t*)(ws + WS_R1); const bf16_t* Kc = Qc + (size_t)NTOK * DM; const bf16_t* Vt = Kc + (size_t)NTOK * DM; bf16_t* O = (bf16_t*)(ws + WS_R3);
    const int rp = unit & 15, h = (unit >> 4) & 15, b = unit >> 8;
    const int ra = rp * 2, r0a = min(max(ra - 4, 0), 24);
    const size_t bh = (size_t)(b * 16 + h);
    LAS char* lds = (LAS char*)F.lds; LAS float* bl = (LAS float*)(lds + NA_BOFF);
    __syncthreads();
    {
        const bf16_t* kg = Kc + (bh * SEQ + r0a * 64) * 64; const bf16_t* vg = Vt + (bh * (SEQ / 8) + r0a * 8) * 64 * 8;
        const int kk = (F.tid & 7) + 8 * (F.tid >> 6), cs = (F.tid >> 3) & 7;
        u32x4 kv[9], vv[9];
#pragma unroll
        for (int i = 0; i < 9; ++i) { kv[i] = *(const u32x4*)(kg + (size_t)(64 * i + kk) * 64 + cs * 8); vv[i] = *(const u32x4*)(vg + (size_t)(F.tid + NTHREADS * i) * 8); }
#pragma unroll
        for (int i = 0; i < 9; ++i) { *(LAS u32x4*)(lds + (cs * NA_KSTR + 64 * i + kk) * 16) = kv[i]; *(LAS u32x4*)(lds + NA_VOFF + (F.tid + NTHREADS * i) * 16) = vv[i]; }
        const float* relb = a.in[IN_RELB] + ((size_t)(layer >> 1) * 16 + h) * 465;
        if (F.tid < 465) bl[F.tid] = relb[F.tid];
    }
    __syncthreads();
    const int r = ra + (F.wave >> 2), j = F.wave & 3, qi = F.lane & 15, g = F.lane >> 4, c = 16 * j + qi;
    const int r0 = min(max(r - 4, 0), 24), d = r0 - r0a, c0 = min(max(c - 8, 0), 48), cb = (j == 0) ? 0 : (j == 1) ? 8 : (j == 2) ? 24 : 32;
    const float LOG2E = 1.4426950408889634f;
    const bf16_t* qp = Qc + (bh * SEQ + r * 64 + c) * 64 + 8 * g;
    const bf16x8 qf0 = *(const bf16x8*)qp, qf1 = *(const bf16x8*)(qp + 32);
    const int kx = 8 * (qi >> 2) + (qi & 3);
    const LAS char* kbase = lds + ((g * NA_KSTR) + d * 64 + cb + kx) * 16;
    f32x4 S[8][2];
#pragma unroll
    for (int i = 0; i < 8; ++i)
#pragma unroll
        for (int xb = 0; xb < 2; ++xb) { const LAS char* kp = kbase + (i * 64 + 4 * xb) * 16;
            const bf16x8 kf0 = *(const LAS bf16x8*)kp, kf1 = *(const LAS bf16x8*)(kp + 4 * NA_KSTR * 16);
            f32x4 z = (f32x4){0.f, 0.f, 0.f, 0.f};
            z = __builtin_amdgcn_mfma_f32_16x16x32_bf16(kf0, qf0, z, 0, 0, 0);
            z = __builtin_amdgcn_mfma_f32_16x16x32_bf16(kf1, qf1, z, 0, 0, 0);
            S[i][xb] = z; }
    float mx = -INFINITY;
#pragma unroll
    for (int i = 0; i < 8; ++i) { const LAS float* brow = bl + (r0 + i - r + 7) * 31;
#pragma unroll
        for (int xb = 0; xb < 2; ++xb)
#pragma unroll
            for (int t = 0; t < 4; ++t) { const int kc = cb + 8 * g + 4 * xb + t; const bool valid = (kc >= c0) && (kc < c0 + 16); const int co = min(max(kc - c + 15, 0), 30);
                const float v = valid ? (S[i][xb][t] * 0.125f + brow[co]) * LOG2E : -INFINITY; S[i][xb][t] = v; mx = fmaxf(mx, v); } }
    mx = fmaxf(mx, __shfl_xor(mx, 16)); mx = fmaxf(mx, __shfl_xor(mx, 32));
    float sum = 0.f; bf16x8 pf[8];
#pragma unroll
    for (int i = 0; i < 8; ++i) { float pv[8];
#pragma unroll
        for (int xb = 0; xb < 2; ++xb)
#pragma unroll
            for (int t = 0; t < 4; ++t) { const float p = __builtin_amdgcn_exp2f(S[i][xb][t] - mx); pv[xb * 4 + t] = p; sum += p; }
        const u32x4 w = pack8(pv); pf[i] = *(const bf16x8*)&w; }
    sum += __shfl_xor(sum, 16); sum += __shfl_xor(sum, 32);
    const float inv = 1.0f / sum;
    f32x4 acc[4];
    const LAS char* vbase = lds + NA_VOFF + ((d * 8 + (cb >> 3) + g) * 64 + qi) * 16;
#pragma unroll
    for (int dvb = 0; dvb < 4; ++dvb) { acc[dvb] = (f32x4){0.f, 0.f, 0.f, 0.f};
#pragma unroll
        for (int i = 0; i < 8; ++i) { const bf16x8 vf = *(const LAS bf16x8*)(vbase + (i * 8 * 64 + 16 * dvb) * 16);
            acc[dvb] = __builtin_amdgcn_mfma_f32_16x16x32_bf16(vf, pf[i], acc[dvb], 0, 0, 0); } }
    bf16_t* op = O + ((size_t)b * SEQ + r * 64 + c) * DM + h * 64 + 4 * g;
#pragma unroll
    for (int dvb = 0; dvb < 4; ++dvb) { u32x2 w; w.x = cvt_pk_bf16(acc[dvb][0] * inv, acc[dvb][1] * inv); w.y = cvt_pk_bf16(acc[dvb][2] * inv, acc[dvb][3] * inv); *(u32x2*)(op + 16 * dvb) = w; }
}

template <int PER> __device__ __forceinline__ int xcd_unit(int i, int c, int G, int nunits) {
    int u;
    if ((G & 7) == 0 && ((G >> 3) % PER) == 0) { const int gpx = (G >> 3) / PER, sl = c >> 3; u = (i * (G / PER) + (c & 7) * gpx + sl / PER) * PER + sl % PER; }
    else u = i * G + c;
    return u < nunits ? u : -1;
}

constexpr int LDS_BYTES = 160 * 1024;
constexpr int MISC_OFF = LDS_BYTES - 256;
static_assert(NA_BOFF + 2048 <= MISC_OFF, "neighbourhood attention LDS image");
constexpr int NPH_LAYER = 9, NPHASES = 1 + DEPTH * NPH_LAYER;

#define IN(k) (a.lo <= (k) && (k) < a.hi)
#define SEAM(k) do { if (IN(k) && IN((k) + 1)) { const Frame Fb = fresh(F); xcd_barrier(bar, Fb.tid); } } while (0)
template <int LAYER> __device__ __forceinline__ void layer_phases(const Frame& F, const Args& a, const XcdBarrier& bar) {
    constexpr int layer = LAYER;
        constexpr int p0 = 1 + layer * NPH_LAYER, j = layer >> 1; constexpr bool even = (layer & 1) == 0;
        if (IN(p0)) {
            const Frame Fp = fresh(F); const Args ap = fresh(a); unsigned char* w = ap.ws;
            REPEAT(1) phase_moe_weights(Fp, ap, layer);
            if constexpr (even) { g8::DenseSched S; S.init(w + WS_X, DM, (const bf16_t*)(w + WS_WIN) + (size_t)j * HLD * DM, DM, NTOK, HLD, Fp.G, Fp.bid); S.rep = 1 + ((REP_MASK >> 2) & 1);
                g8::EpiEvenIn E{(bf16_t*)(w + WS_R1), (bf16_t*)(w + WS_R2) + (size_t)NTOK * 1792, (float*)(w + WS_SSQ), (const float*)(w + WS_ROPEA), (const float*)(w + WS_ROPEB)}; g8::gemm_phase(Fp, DM, S, E); }
            else { g8::DenseSched S; S.init(w + WS_X, DM, (const bf16_t*)(w + WS_WQKV) + (size_t)j * 3072 * DM, DM, NTOK, 3072, Fp.G, Fp.bid); S.rep = 1 + ((REP_MASK >> 11) & 1);
#if NAIVE_NA
                g8::EpiPlain E{(bf16_t*)(w + WS_R1), 3072}; g8::gemm_phase(Fp, DM, S, E); }
#else
                g8::EpiQKV E{(bf16_t*)(w + WS_R1), (bf16_t*)(w + WS_R1) + (size_t)NTOK * DM, (bf16_t*)(w + WS_R1) + (size_t)2 * NTOK * DM}; g8::gemm_phase(Fp, DM, S, E); }
#endif
        }
        SEAM(p0);
        if constexpr (even) if (IN(p0 + 1)) REPEAT(3) {
            const Frame Fp = fresh(F); const Args ap = fresh(a); unsigned char* w = ap.ws;
            { g8::DenseSched S; S.init((bf16_t*)(w + WS_R1) + 1536, HLD, (const bf16_t*)(w + WS_WUQ) + (size_t)j * 768 * 256, 256, NTOK, 768, Fp.G, Fp.bid);
              g8::EpiMla<0> E{(bf16_t*)(w + WS_R2), (const float*)(w + WS_SSQ)}; g8::gemm_phase(Fp, 256, S, E); }
            const Frame Fq = fresh(F);
            { g8::DenseSched S; S.init((bf16_t*)(w + WS_R1) + 1792, HLD, (const bf16_t*)(w + WS_WUKV) + (size_t)j * 1024 * 256, 256, NTOK, 1024, Fq.G, Fq.bid);
              g8::EpiMla<1> E{(bf16_t*)(w + WS_R2) + (size_t)NTOK * 768, (const float*)(w + WS_SSQ)}; g8::gemm_phase(Fq, 256, S, E); }
        }
        SEAM(p0 + 1);
        if (IN(p0 + 2)) {
            const Frame Fp = fresh(F); const Args ap = fresh(a);
#if NAIVE_ATTN
            if (even) { for (int u = Fp.bid; u < NBATCH * 4 * 8; u += Fp.G) attn_diff_naive(Fp, ap, layer, u);
                        for (int u = Fp.bid; u < NBATCH * 8 * 4; u += Fp.G) attn_mla_naive(Fp, ap, u); }
#else
            if constexpr (even) REPEAT(4) { for (int i = 0, u; (u = xcd_unit<8>(i, Fp.bid, Fp.G, NBATCH * 4 * 8)) >= 0; ++i) attn_diff_mfma(Fp, ap, layer, u);
                        for (int i = 0, u; (u = xcd_unit<8>(i, Fp.bid, Fp.G, NBATCH * 8 * 8)) >= 0; ++i) attn_mla_mfma(Fp, ap, u); }
#endif
#if NAIVE_NA
            if (!even) { for (int u = Fp.bid; u < NBATCH * 32 * 2; u += Fp.G) attn_na_naive(Fp, ap, layer, u); }
#else
            if constexpr (!even) REPEAT(5) { for (int i = 0, u; (u = xcd_unit<16>(i, Fp.bid, Fp.G, NBATCH * 16 * 16)) >= 0; ++i) attn_na_lds(Fp, ap, layer, u); }
#endif
            __syncthreads();
        }
        SEAM(p0 + 2);
        if (IN(p0 + 3)) REPEAT(6) {
            const Frame Fp = fresh(F); const Args ap = fresh(a); unsigned char* w = ap.ws;
            g8::DenseSched S; S.init(w + WS_R3, DM, (const bf16_t*)(w + (even ? WS_WOE : WS_WOO)) + (size_t)j * DM * DM, DM, NTOK, DM, Fp.G, Fp.bid);
            g8::EpiResStats E{(const bf16_t*)(w + WS_X), (bf16_t*)(w + WS_R1), (f32x2*)(w + WS_R2)}; g8::gemm_phase(Fp, DM, S, E);
        }
        SEAM(p0 + 3);
        if (IN(p0 + 4)) REPEAT(12) { const Frame Fp = fresh(F); const Args ap = fresh(a); phase_ln1_router(Fp, ap, layer); }
        SEAM(p0 + 4);
        if (IN(p0 + 5)) REPEAT(7) { const Frame Fp = fresh(F); const Args ap = fresh(a); phase_scatter(Fp, ap); }
        SEAM(p0 + 5);
        if (IN(p0 + 6)) REPEAT(8) {
            const Frame Fp = fresh(F); const Args ap = fresh(a); unsigned char* w = ap.ws;
            g8::MoeSched<true> S; S.A = (const char*)(w + WS_X); S.Wt = (const char*)(w + WS_W13); S.tile = (const int*)(w + WS_TILE); S.slot_tok = (const int*)(w + WS_SLOT_TOK);
            S.lda2 = DM * 2; S.K2 = DM * 2; S.wstride = (size_t)1024 * 1024 * 2; S.T = S.tile[0]; S.G = Fp.G; S.c = Fp.bid;
            g8::EpiMoe1 E{(bf16_t*)(w + WS_R1)}; g8::gemm_phase(Fp, DM, S, E);
        }
        SEAM(p0 + 6);
        if (IN(p0 + 7)) REPEAT(9) {
            const Frame Fp = fresh(F); const Args ap = fresh(a); unsigned char* w = ap.ws;
            g8::MoeSched<false> S; S.A = (const char*)(w + WS_R1); S.Wt = (const char*)(w + WS_W2); S.tile = (const int*)(w + WS_TILE); S.slot_tok = (const int*)(w + WS_SLOT_TOK);
            S.lda2 = DEXP * 2; S.K2 = DEXP * 2; S.wstride = (size_t)1024 * 512 * 2; S.T = S.tile[0]; S.G = Fp.G; S.c = Fp.bid;
            g8::EpiMoe2 E{(bf16_t*)(w + WS_R2), (const float*)(w + WS_SLOT_G), (const int*)(w + WS_SLOT_DST)}; g8::gemm_phase(Fp, DEXP, S, E);
        }
        SEAM(p0 + 7);
        if (IN(p0 + 8)) { const Frame Fp = fresh(F); const Args ap = fresh(a);
            if constexpr (((REP_MASK >> 13) & 1) != 0) { phase_ln2(Fp, ap, layer, false, true); __syncthreads(); }
            phase_ln2(Fp, ap, layer, layer == DEPTH - 1); }
        SEAM(p0 + 8);
    }
#undef IN
#undef SEAM

__global__ void __launch_bounds__(NTHREADS, 2) fwd_kernel(Args a) {
    extern __shared__ __attribute__((aligned(16))) unsigned char lds_raw[];
    Frame F; F.lds = (LAS unsigned char*)lds_raw; F.wave = __builtin_amdgcn_readfirstlane((int)threadIdx.x >> 6); F.tid = 0; F.lane = 0; F.G = gridDim.x; F.bid = blockIdx.x;
    unsigned char* ws = a.ws;
    volatile LAS unsigned* MISC = (volatile LAS unsigned*)(F.lds + MISC_OFF);
    { const Frame Fp = fresh(F); if (Fp.tid < 4) MISC[Fp.tid] = 0u; }
    __syncthreads();
    const bool one = (a.hi - a.lo) > 1;
    XcdBarrier bar; bar.bar = (unsigned*)(ws + WS_CTL); bar.x = 0; bar.st = MISC;
    if (one) { const Frame Fp = fresh(F); bar = xcd_barrier_post((unsigned*)(ws + WS_CTL), MISC, Fp.tid); }
#define IN(k) (a.lo <= (k) && (k) < a.hi)
#define SEAM(k) do { if (IN(k) && IN((k) + 1)) { const Frame Fb = fresh(F); xcd_barrier(bar, Fb.tid); } } while (0)

    if (IN(0)) REPEAT(0) { const Frame Fp = fresh(F); const Args ap = fresh(a); phase_prologue(Fp, ap); }
    SEAM(0);
    layer_phases<0>(F, a, bar); layer_phases<1>(F, a, bar); layer_phases<2>(F, a, bar); layer_phases<3>(F, a, bar);
#undef IN
#undef SEAM
}

extern "C" void kernel_launch(void* const* d_in, const int* in_sizes, int n_in, void* d_out, int out_size, void* d_ws, size_t ws_size, hipStream_t stream) {
    static int grid = 0;
    if (grid == 0) {
        if (n_in != 26 || in_sizes[0] != NTOK * DM || out_size != NTOK * DM || ws_size < WS_END) {
            fprintf(stderr, "kernel_launch: unexpected shapes / workspace (n_in %d, in0 %d, out %d, ws %zu, need %zu)\n", n_in, n_in > 0 ? in_sizes[0] : -1, out_size, ws_size, (size_t)WS_END); grid = -1; return; }
        int dev = 0, cus = 0, per_cu = 0;
        if (hipGetDevice(&dev) != hipSuccess || hipDeviceGetAttribute(&cus, hipDeviceAttributeMultiprocessorCount, dev) != hipSuccess) { grid = -1; return; }
        if (hipFuncSetAttribute((const void*)fwd_kernel, hipFuncAttributeMaxDynamicSharedMemorySize, LDS_BYTES) != hipSuccess) { fprintf(stderr, "kernel_launch: hipFuncSetAttribute failed\n"); grid = -1; return; }
        if (hipOccupancyMaxActiveBlocksPerMultiprocessor(&per_cu, (const void*)fwd_kernel, NTHREADS, LDS_BYTES) != hipSuccess || per_cu < 1) fprintf(stderr, "kernel_launch: occupancy query reports %d\n", per_cu);
        (void)hipGetLastError();
        grid = cus;
    }
    if (grid < 0) return;
    (void)hipMemsetAsync((char*)d_ws + WS_CTL, 0, 64 * 1024, stream);
    Args a{};
    for (int i = 0; i < 26; ++i) a.in[i] = (const float*)d_in[i];
    a.out = (float*)d_out; a.ws = (unsigned char*)d_ws;
#if MK_ONE_LAUNCH
    a.lo = 0; a.hi = NPHASES;
    hipLaunchKernelGGL(fwd_kernel, dim3(grid), dim3(NTHREADS), LDS_BYTES, stream, a);
#else
    for (int p = 0; p < NPHASES; ++p) {
        if (p >= 1 && ((p - 1) % NPH_LAYER) == 1 && (((p - 1) / NPH_LAYER) & 1)) continue;
        a.lo = p; a.hi = p + 1;
        hipLaunchKernelGGL(fwd_kernel, dim3(grid), dim3(NTHREADS), LDS_BYTES, stream, a);
    }
#endif
}
```

```cpp
#include <hip/hip_runtime.h>
#include <cstdio>
#include <cstdint>

#ifndef NAIVE_ATTN
#define NAIVE_ATTN 0
#endif
#ifndef NAIVE_NA
#define NAIVE_NA 0
#endif
#ifndef REP_MASK
#define REP_MASK 0
#endif
#define REPEAT(k) _Pragma("unroll 1") for (int rep_ = 0; rep_ < 1 + ((REP_MASK >> (k)) & 1); ++rep_)
#ifndef MK_ONE_LAUNCH
#define MK_ONE_LAUNCH 1
#endif

typedef unsigned short bf16_t;
typedef short bf16x8 __attribute__((ext_vector_type(8)));
typedef float f32x4 __attribute__((ext_vector_type(4)));
typedef float f32x2 __attribute__((ext_vector_type(2)));
typedef unsigned u32x4 __attribute__((ext_vector_type(4)));
typedef unsigned u32x2 __attribute__((ext_vector_type(2)));
#define LAS __attribute__((address_space(3)))

constexpr int NTOK = 65536, DM = 1024, SEQ = 2048, NBATCH = 32, DEPTH = 4;
constexpr int EVEN_IN = 1952, HLD = 2048;
constexpr int NEXP = 32, DEXP = 512;
constexpr int MAXTILES = NTOK * 2 / 256 + NEXP;
constexpr int MAXSLOTS = MAXTILES * 256;
constexpr float DN_ALPHA = 1.681792830507429f;
constexpr float LN_EPS = 1e-5f, RMS_EPS = 1e-6f;
constexpr int NTHREADS = 512;

constexpr size_t MiB = 1024ull * 1024ull;
constexpr size_t WS_CTL = 0;
constexpr size_t WS_LAM = 48 * 1024;
constexpr size_t WS_ROPEA = 64 * 1024;
constexpr size_t WS_ROPEB = WS_ROPEA + 128 * 1024;
constexpr size_t WS_WR = WS_ROPEB + 256 * 1024;
constexpr size_t WS_ROUTE = WS_WR + 832 * 1024;
constexpr size_t WS_CNT = WS_ROUTE + 1 * MiB;
constexpr size_t WS_TILE = WS_CNT + 32 * 1024;
constexpr size_t WS_SLOT_TOK = WS_TILE + 4 * 1024;
constexpr size_t WS_SLOT_G = WS_SLOT_TOK + 576 * 1024;
constexpr size_t WS_SLOT_DST = WS_SLOT_G + 576 * 1024;
constexpr size_t WS_SSQ = WS_SLOT_DST + 576 * 1024;
constexpr size_t WS_WIN = 6 * MiB;
constexpr size_t WS_WUQ = WS_WIN + 8 * MiB;
constexpr size_t WS_WUKV = WS_WUQ + 1 * MiB;
constexpr size_t WS_WOE = WS_WUKV + 1 * MiB;
constexpr size_t WS_WQKV = WS_WOE + 4 * MiB;
constexpr size_t WS_WOO = WS_WQKV + 12 * MiB;
constexpr size_t WS_W13 = 36 * MiB;
constexpr size_t WS_W2 = WS_W13 + 64 * MiB;
constexpr size_t WS_X = WS_W2 + 32 * MiB;
constexpr size_t WS_R1 = WS_X + 128 * MiB;
constexpr size_t WS_R2 = WS_R1 + 384 * MiB;
constexpr size_t WS_R3 = WS_R2 + 228 * MiB;
constexpr size_t WS_END = WS_R3 + 128 * MiB;
static_assert(WS_SSQ + 2 * MiB <= WS_WIN, "misc region");
static_assert(WS_WOO + 4 * MiB <= WS_W13, "small weights region");

__device__ __forceinline__ unsigned cvt_pk_bf16(float lo, float hi) { unsigned r; asm volatile("v_cvt_pk_bf16_f32 %0, %1, %2" : "=v"(r) : "v"(lo), "v"(hi)); return r; }
__device__ __forceinline__ float bf_lo(unsigned w) { return __uint_as_float(w << 16); }
__device__ __forceinline__ float bf_hi(unsigned w) { return __uint_as_float(w & 0xffff0000u); }
__device__ __forceinline__ float bf2f(bf16_t b) { return __uint_as_float(((unsigned)b) << 16); }
__device__ __forceinline__ void unpack8(const u32x4 w, float (&f)[8]) {
    f[0] = bf_lo(w.x); f[1] = bf_hi(w.x); f[2] = bf_lo(w.y); f[3] = bf_hi(w.y); f[4] = bf_lo(w.z); f[5] = bf_hi(w.z); f[6] = bf_lo(w.w); f[7] = bf_hi(w.w); }
__device__ __forceinline__ u32x4 pack8(const float (&f)[8]) { u32x4 w; w.x = cvt_pk_bf16(f[0], f[1]); w.y = cvt_pk_bf16(f[2], f[3]); w.z = cvt_pk_bf16(f[4], f[5]); w.w = cvt_pk_bf16(f[6], f[7]); return w; }
__device__ __forceinline__ float wave_sum(float v) {
#pragma unroll
    for (int o = 32; o >= 1; o >>= 1) v += __shfl_xor(v, o);
    return v; }

struct Frame { LAS unsigned char* lds; int tid, lane, wave, G, bid; };
#define XB_TMO      128
#define XB_XCNT(j)  (256  + 64 * (j))
#define XB_XSUB(j)  (1280 + 64 * (j))
#define XB_XGEN(j)  (2304 + 64 * (j))
#define XB_TOP      3328
#define XB_TOPGEN   3392
#define XCD_BAR_WORDS 3456
#define XB_SPIN_CAP (1u << 21)
__device__ __forceinline__ unsigned xb_ld(unsigned* p)              { return __hip_atomic_load(p, __ATOMIC_RELAXED, __HIP_MEMORY_SCOPE_AGENT); }
__device__ __forceinline__ unsigned xb_add(unsigned* p, unsigned v) { return __hip_atomic_fetch_add(p, v, __ATOMIC_RELAXED, __HIP_MEMORY_SCOPE_AGENT); }
__device__ __forceinline__ unsigned xb_xcc_id() { return (unsigned)__builtin_amdgcn_s_getreg((3 << 11) | 20) & 0xFu; }
#define XB_SPIN(cond, bar) do { unsigned _sp = 0; while (cond) { __builtin_amdgcn_s_sleep(1); \
    if ((++_sp & 255u) == 0u) { if (xb_ld(&(bar)[XB_TMO])) break; if (_sp > XB_SPIN_CAP) { atomicAdd(&(bar)[XB_TMO], 1u); break; } } } } while (0)
struct XcdBarrier { unsigned* bar; unsigned x; volatile LAS unsigned* st; };
__device__ __forceinline__ XcdBarrier xcd_barrier_post(unsigned* bar, volatile LAS unsigned* st, int tid) {
    XcdBarrier b; b.bar = bar; b.x = xb_xcc_id(); b.st = st;
    if (tid == 0) (void)xb_add(&bar[XB_XCNT(b.x)], 1u);
    return b;
}
__device__ __forceinline__ void xcd_barrier_complete(unsigned* bar, unsigned x, unsigned& nloc, unsigned& nx) {
    const unsigned G = gridDim.x * gridDim.y * gridDim.z;
    unsigned sum, cnt, mine, sp = 0u;
    for (;;) {
        sum = 0u; cnt = 0u; mine = 0u;
#pragma unroll
        for (unsigned j = 0; j < 16; ++j) { const unsigned c = xb_ld(&bar[XB_XCNT(j)]); sum += c; cnt += (c > 0u) ? 1u : 0u; mine = (j == x) ? c : mine; }
        if (sum == G) break;
        __builtin_amdgcn_s_sleep(1);
        if ((++sp & 255u) == 0u) { if (xb_ld(&bar[XB_TMO])) break; if (sp > XB_SPIN_CAP) { atomicAdd(&bar[XB_TMO], 1u); break; } }
    }
    nloc = mine > 0u ? mine : 1u; nx = cnt > 0u ? cnt : 1u;
}
__device__ __forceinline__ void xcd_barrier(const XcdBarrier& b, int tid) {
    asm volatile("s_waitcnt vmcnt(0)" ::: "memory");
    __syncthreads();
    if (tid == 0) {
        unsigned* bar = b.bar; unsigned bx = b.x; asm volatile("" : "+s"(bx));
        __builtin_amdgcn_s_waitcnt(0);
        unsigned nloc = b.st[0], nx = b.st[1];
        if (nloc == 0u) { xcd_barrier_complete(bar, bx, nloc, nx); b.st[0] = nloc; b.st[1] = nx; }
        const unsigned old = xb_add(&bar[XB_XSUB(bx)], 1u);
        const unsigned gen = old / nloc;
        if (old + 1u == (gen + 1u) * nloc) {
            __builtin_amdgcn_fence(__ATOMIC_RELEASE, "agent");
            asm volatile("s_waitcnt vmcnt(0)" ::: "memory");
            const unsigned og = xb_add(&bar[XB_TOP], 1u);
            const unsigned tg = og / nx;
            if (og + 1u == (tg + 1u) * nx) xb_add(&bar[XB_TOPGEN], 1u);
            else XB_SPIN(xb_ld(&bar[XB_TOPGEN]) == tg, bar);
            __builtin_amdgcn_fence(__ATOMIC_ACQUIRE, "agent");
            xb_add(&bar[XB_XGEN(bx)], 1u);
            asm volatile("s_waitcnt vmcnt(0)" ::: "memory");
        } else {
            XB_SPIN(xb_ld(&bar[XB_XGEN(bx)]) == gen, bar);
            __builtin_amdgcn_fence(__ATOMIC_ACQUIRE, "agent");
            asm volatile("s_waitcnt vmcnt(0)" ::: "memory");
        }
    }
    __syncthreads();
}

namespace g8 {
constexpr int BM = 256, BK = 64, HALF = 128, HTB = HALF * BK * 2, STAGE_BYTES = 8 * HTB, NXCD = 8, WGM = 8;
__device__ __forceinline__ int lds_byte(int r, int c) { const int st = (r >> 4) * 2 + (c >> 5), rr = r & 15, cc = c & 31, ob = rr * 64 + cc * 2; return st * 1024 + (ob ^ (((ob >> 9) & 1) << 5)); }
__device__ __forceinline__ void stage_rc(int b, int& R, int& C) { const int st = b / 1024, sb = b % 1024, swz = sb ^ (((sb >> 9) & 1) << 5); R = (st >> 1) * 16 + swz / 64; C = (st & 1) * 32 + (swz % 64) / 2; }
__device__ __forceinline__ int perm32(int rho) { const int n = rho >> 4, i = rho & 15; return 8 * (i >> 2) + 4 * n + (i & 3); }

struct Unit { const char* A; const char* B; int row0, pm, pn, e; };
typedef f32x4 Acc[2][2][4][2];

struct DenseSched {
    const char* A; const char* Bt; unsigned lda2; int K2; int nM, nN, nwg, G, c; int rep = 1;
    __device__ __forceinline__ void init(const void* A_, int lda, const void* Bt_, int K, int M, int N, int G_, int c_) { A = (const char*)A_; Bt = (const char*)Bt_; lda2 = (unsigned)lda * 2u; K2 = K * 2; nM = M / BM; nN = N / BM; nwg = nM * nN; G = G_; c = c_; }
    __device__ __forceinline__ bool next(int i, Unit& u) const {
        long L = (long)i * G + c; if (L >= (long)nwg * rep) return false;
        if (rep > 1) L %= nwg;
        int wgid = (int)L; { const int q = nwg / NXCD, r = nwg % NXCD, xcd = wgid % NXCD, off = wgid / NXCD; wgid = (xcd < r ? xcd * (q + 1) : r * (q + 1) + (xcd - r) * q) + off; }
        const int nig = WGM * nN, gid = wgid / nig, fm = gid * WGM, gsz = (nM - fm) < WGM ? (nM - fm) : WGM;
        u.pm = fm + ((wgid % nig) % gsz); u.pn = (wgid % nig) / gsz; u.row0 = u.pm * BM; u.e = 0;
        u.A = A + (size_t)u.row0 * lda2; u.B = Bt + (size_t)u.pn * BM * K2; return true;
    }
    static constexpr bool GATHER = false;
    __device__ __forceinline__ unsigned rowoff(const Unit&, int r) const { return (unsigned)r * lda2; }
};
template <bool GATHER_> struct MoeSched {
    const char* A; const char* Wt; const int* tile; const int* slot_tok; unsigned lda2; int K2; size_t wstride; int T, G, c;
    __device__ __forceinline__ bool next(int i, Unit& u) const {
        int t, pnn;
        if ((G & 31) == 0) { const int x = c & 7, sl = c >> 3, per = G >> 5; t = i * (G >> 2) + x * per + (sl >> 2); pnn = sl & 3; }
        else { const int L = i * G + c; t = L >> 2; pnn = L & 3; }
        if (t >= T) return false;
        u.pn = pnn; u.pm = t; u.row0 = t * BM; u.e = tile[1 + t];
        u.A = GATHER_ ? A : A + (size_t)u.row0 * lda2; u.B = Wt + (size_t)u.e * wstride + (size_t)u.pn * BM * K2; return true;
    }
    static constexpr bool GATHER = GATHER_;
    __device__ __forceinline__ unsigned rowoff(const Unit& u, int r) const { return GATHER_ ? (unsigned)slot_tok[u.row0 + r] * lda2 : (unsigned)r * lda2; }
};

template <class Epi, class Sched>
__device__ __forceinline__ void gemm_phase(const Frame& F, const int K_, const Sched& S, const Epi& E) {
    LAS unsigned char* lds = F.lds;
    int K = K_; asm volatile("" : "+s"(K));
    const int tid = F.tid, wid = __builtin_amdgcn_readfirstlane(tid >> 6), lane = tid & 63, wr = wid >> 2, wc = wid & 3, fr = lane & 15, fq = lane >> 4;
    const int nt = K / BK;
    int RA[2]; unsigned CA[2], voffB[2];
#pragma unroll
    for (int i = 0; i < 2; ++i) { int R, C; stage_rc(tid * 16 + i * 8192, R, C); const int Rb = (R & ~31) + perm32(R & 31);
        RA[i] = R; CA[i] = (unsigned)C * 2u; voffB[i] = (unsigned)(Rb * K + C) * 2u; }
    const size_t kstep = (size_t)(BK * 2);
    const size_t hstepB = (size_t)HALF * K * 2;
    size_t hstepA = 0; if constexpr (!Sched::GATHER) hstepA = (size_t)S.rowoff(Unit{}, HALF);
    const unsigned ldsw = (unsigned)wid * 1024u;
    const int aoff = lds_byte(wr * 64 + fr, fq * 8), boff = lds_byte(wc * 32 + fr, fq * 8);
#define G8_SA(b, h) (((b) * 2 + (h)) * HTB)
#define G8_SB(b, h) ((4 + (b) * 2 + (h)) * HTB)
#define G8_STAGE(bufoff, gbase, voff) do { _Pragma("unroll") for (int _i = 0; _i < 2; ++_i) \
        __builtin_amdgcn_global_load_lds((const unsigned*)((const char*)(gbase) + (voff)[_i]), (LAS unsigned*)(lds + (bufoff) + ldsw + _i * 8192), 16, 0, 0); } while (0)
#define G8_STA(bufoff, gbase, h, V0, V1) do { if constexpr (Sched::GATHER) { if (h) G8_STAGE(bufoff, gbase, V1); else G8_STAGE(bufoff, gbase, V0); } else { G8_STAGE(bufoff, (gbase) + (h) * hstepA, vA0); } } while (0)
#define G8_LDA(dst, b, h) do { _Pragma("unroll") for (int m = 0; m < 4; ++m) _Pragma("unroll") for (int k = 0; k < 2; ++k) dst[m][k] = *(const LAS bf16x8*)(lds + G8_SA(b, h) + aoff + m * 2048 + k * 1024); } while (0)
#define G8_LDB(dst, b, h) do { _Pragma("unroll") for (int n = 0; n < 2; ++n) _Pragma("unroll") for (int k = 0; k < 2; ++k) dst[n][k] = *(const LAS bf16x8*)(lds + G8_SB(b, h) + boff + n * 2048 + k * 1024); } while (0)
#define G8_MMA(ai, bj, At, Bt) do { __builtin_amdgcn_s_setprio(1); _Pragma("unroll") for (int m = 0; m < 4; ++m) _Pragma("unroll") for (int n = 0; n < 2; ++n) _Pragma("unroll") for (int k = 0; k < 2; ++k) \
        acc[ai][bj][m][n] = __builtin_amdgcn_mfma_f32_16x16x32_bf16(Bt[n][k], At[m][k], acc[ai][bj][m][n], 0, 0, 0); __builtin_amdgcn_s_setprio(0); } while (0)
#define G8_WAIT_V(n) asm volatile("s_waitcnt vmcnt(" #n ")" ::: "memory")
#define G8_WAIT_L(n) asm volatile("s_waitcnt lgkmcnt(" #n ")" ::: "memory")
#define G8_BAR __builtin_amdgcn_s_barrier()
#define G8_SCHED __builtin_amdgcn_sched_barrier(0)
    Unit cur, nxt; int ui = 0;
    if (!S.next(0, cur)) return;
    Acc acc;
#pragma unroll
    for (int a = 0; a < 2; ++a)
#pragma unroll
        for (int b = 0; b < 2; ++b)
#pragma unroll
            for (int m = 0; m < 4; ++m)
#pragma unroll
                for (int n = 0; n < 2; ++n) acc[a][b][m][n] = (f32x4){0.f, 0.f, 0.f, 0.f};
    bf16x8 At[4][2], B0[2][2], B1[2][2];
    unsigned vA0[2], vA1[2], nA0[2], nA1[2];
#pragma unroll
    for (int i = 0; i < 2; ++i) { vA0[i] = S.rowoff(cur, RA[i]) + CA[i]; vA1[i] = S.rowoff(cur, HALF + RA[i]) + CA[i]; }
    const char* cA = cur.A; const char* cB = cur.B;
    G8_STAGE(G8_SB(0, 0), cB, voffB); G8_STA(G8_SA(0, 0), cA, 0, vA0, vA1); G8_STAGE(G8_SB(0, 1), cB + hstepB, voffB); G8_STA(G8_SA(0, 1), cA, 1, vA0, vA1);
    if (wr == 1) G8_BAR;
    G8_WAIT_V(4); G8_BAR;
    G8_STAGE(G8_SB(1, 0), cB + kstep, voffB); G8_STA(G8_SA(1, 0), cA + kstep, 0, vA0, vA1); G8_STAGE(G8_SB(1, 1), cB + hstepB + kstep, voffB);
    G8_WAIT_V(6); G8_BAR;
    for (;;) {
        const bool has_next = S.next(ui + 1, nxt);
        const char* nAp = has_next ? nxt.A : cA; const char* nBp = has_next ? nxt.B : cB;
#pragma unroll
        for (int i = 0; i < 2; ++i) { nA0[i] = has_next ? S.rowoff(nxt, RA[i]) + CA[i] : vA0[i]; nA1[i] = has_next ? S.rowoff(nxt, HALF + RA[i]) + CA[i] : vA1[i]; }
        for (int t = 0; t < nt; t += 2) {
            const bool last = (t == nt - 2);
            const char* a1 = cA + (size_t)(t + 1) * kstep;
            const char* a2 = last ? nAp : cA + (size_t)(t + 2) * kstep; const char* b2 = last ? nBp : cB + (size_t)(t + 2) * kstep;
            const char* a3 = a2 + kstep; const char* b3 = b2 + kstep;
            unsigned w0[2], w1[2];
#pragma unroll
            for (int i = 0; i < 2; ++i) { w0[i] = last ? nA0[i] : vA0[i]; w1[i] = last ? nA1[i] : vA1[i]; }
            G8_LDB(B0, 0, 0); G8_SCHED; G8_LDA(At, 0, 0); G8_STA(G8_SA(1, 1), a1, 1, vA0, vA1);
            G8_WAIT_L(8); G8_BAR; G8_WAIT_L(0); G8_MMA(0, 0, At, B0); G8_BAR; G8_SCHED;
            G8_LDB(B1, 0, 1); G8_STAGE(G8_SB(0, 0), b2, voffB);
            G8_BAR; G8_WAIT_L(0); G8_MMA(0, 1, At, B1); G8_BAR;
            G8_LDA(At, 0, 1); G8_STA(G8_SA(0, 0), a2, 0, w0, w1);
            G8_BAR; G8_WAIT_L(0); G8_MMA(1, 0, At, B0); G8_BAR; G8_SCHED;
            G8_STAGE(G8_SB(0, 1), b2 + hstepB, voffB);
            G8_WAIT_V(6); G8_BAR; G8_MMA(1, 1, At, B1); G8_BAR;
            G8_LDB(B0, 1, 0); G8_SCHED; G8_LDA(At, 1, 0); G8_STA(G8_SA(0, 1), a2, 1, w0, w1);
            G8_WAIT_L(8); G8_BAR; G8_WAIT_L(0); G8_MMA(0, 0, At, B0); G8_BAR; G8_SCHED;
            G8_LDB(B1, 1, 1); G8_STAGE(G8_SB(1, 0), b3, voffB);
            G8_BAR; G8_WAIT_L(0); G8_MMA(0, 1, At, B1); G8_BAR;
            G8_LDA(At, 1, 1); G8_STA(G8_SA(1, 0), a3, 0, w0, w1);
            G8_BAR; G8_WAIT_L(0); G8_MMA(1, 0, At, B0); G8_BAR; G8_SCHED;
            G8_STAGE(G8_SB(1, 1), b3 + hstepB, voffB);
            G8_WAIT_V(6); G8_BAR; G8_MMA(1, 1, At, B1); G8_BAR;
        }
        E(acc, cur, wr, wc, fr, fq);
        if (!has_next) break;
#pragma unroll
        for (int a = 0; a < 2; ++a)
#pragma unroll
            for (int b = 0; b < 2; ++b)
#pragma unroll
                for (int m = 0; m < 4; ++m)
#pragma unroll
                    for (int n = 0; n < 2; ++n) acc[a][b][m][n] = (f32x4){0.f, 0.f, 0.f, 0.f};
        cur = nxt; cA = nAp; cB = nBp; ++ui;
#pragma unroll
        for (int i = 0; i < 2; ++i) { vA0[i] = nA0[i]; vA1[i] = nA1[i]; }
    }
    G8_WAIT_V(0);
    if (wr == 0) G8_BAR;
    G8_BAR;
#undef G8_SA
#undef G8_SB
#undef G8_STAGE
#undef G8_STA
#undef G8_LDA
#undef G8_LDB
#undef G8_MMA
#undef G8_WAIT_V
#undef G8_WAIT_L
#undef G8_BAR
#undef G8_SCHED
}

__device__ __forceinline__ u32x4 pack_acc8(const f32x4 v0, const f32x4 v1) { u32x4 w; w.x = cvt_pk_bf16(v0[0], v0[1]); w.y = cvt_pk_bf16(v0[2], v0[3]); w.z = cvt_pk_bf16(v1[0], v1[1]); w.w = cvt_pk_bf16(v1[2], v1[3]); return w; }

struct EpiPlain {
    bf16_t* O; int ldc;
    __device__ __forceinline__ void operator()(Acc& acc, const Unit& u, int wr, int wc, int fr, int fq) const {
        const int row0 = u.pm * BM + wr * 64 + fr, col0 = u.pn * BM + wc * 32 + 8 * fq;
#pragma unroll
        for (int ai = 0; ai < 2; ++ai)
#pragma unroll
            for (int m = 0; m < 4; ++m) { bf16_t* rowp = O + (size_t)(row0 + ai * HALF + m * 16) * ldc + col0;
#pragma unroll
                for (int bj = 0; bj < 2; ++bj) *(u32x4*)(rowp + bj * HALF) = pack_acc8(acc[ai][bj][m][0], acc[ai][bj][m][1]); }
    }
};

struct EpiQKV {
    bf16_t* Qc; bf16_t* Kc; bf16_t* Vt;
    __device__ __forceinline__ void operator()(Acc& acc, const Unit& u, int wr, int wc, int fr, int fq) const {
        const int which = u.pn >> 2, tok0 = u.pm * BM + wr * 64 + fr;
        const int b = tok0 >> 11;
#pragma unroll
        for (int ai = 0; ai < 2; ++ai)
#pragma unroll
            for (int m = 0; m < 4; ++m) { const int s = (tok0 + ai * HALF + m * 16) & (SEQ - 1);
#pragma unroll
                for (int bj = 0; bj < 2; ++bj) { const int h = (u.pn & 3) * 4 + 2 * bj + (wc >> 1), d0 = (wc & 1) * 32 + 8 * fq;
                    if (which < 2) { bf16_t* dst = (which == 0 ? Qc : Kc) + ((size_t)(b * 16 + h) * SEQ + s) * 64 + d0;
                        *(u32x4*)dst = pack_acc8(acc[ai][bj][m][0], acc[ai][bj][m][1]); }
                    else { bf16_t* dst = Vt + (((size_t)(b * 16 + h) * (SEQ / 8) + (s >> 3)) * 64 + d0) * 8 + (s & 7);
#pragma unroll
                        for (int n = 0; n < 2; ++n)
#pragma unroll
                            for (int jj = 0; jj < 4; ++jj) dst[(4 * n + jj) * 8] = (bf16_t)(cvt_pk_bf16(acc[ai][bj][m][n][jj], 0.f) & 0xffffu); } } }
    }
};

struct EpiResStats {
    const bf16_t* X; bf16_t* Yb; f32x2* stats;
    __device__ __forceinline__ void operator()(Acc& acc, const Unit& u, int wr, int wc, int fr, int fq) const {
        const int row0 = u.pm * BM + wr * 64 + fr, col0 = u.pn * BM + wc * 32 + 8 * fq;
#pragma unroll
        for (int ai = 0; ai < 2; ++ai)
#pragma unroll
            for (int m = 0; m < 4; ++m) { const int row = row0 + ai * HALF + m * 16; const size_t off = (size_t)row * DM + col0; float s1 = 0.f, s2 = 0.f;
#pragma unroll
                for (int bj = 0; bj < 2; ++bj) { float xv[8]; unpack8(*(const u32x4*)(X + off + bj * HALF), xv); f32x4 v[2];
#pragma unroll
                    for (int n = 0; n < 2; ++n)
#pragma unroll
                        for (int j = 0; j < 4; ++j) { const float y = DN_ALPHA * xv[4 * n + j] + acc[ai][bj][m][n][j]; v[n][j] = y; s1 += y; s2 += y * y; }
                    *(u32x4*)(Yb + off + bj * HALF) = pack_acc8(v[0], v[1]); }
                s1 += __shfl_xor(s1, 16); s1 += __shfl_xor(s1, 32); s2 += __shfl_xor(s2, 16); s2 += __shfl_xor(s2, 32);
                if (fq == 0) stats[(size_t)row * 16 + u.pn * 4 + wc] = (f32x2){s1, s2};
                asm volatile("" ::: "memory"); }
    }
};

struct EpiEvenIn {
    bf16_t* H; bf16_t* KR; float* ssq; const float* ropeA; const float* ropeB;
    __device__ __forceinline__ void operator()(Acc& acc, const Unit& u, int wr, int wc, int fr, int fq) const {
        const int row0 = u.pm * BM + wr * 64 + fr, col0 = u.pn * BM + wc * 32 + 8 * fq;
        if (u.pn < 4 && (wc & 1) == 0) {
#pragma unroll
            for (int ai = 0; ai < 2; ++ai)
#pragma unroll
                for (int m = 0; m < 4; ++m) { const int pos = (row0 + ai * HALF + m * 16) & (SEQ - 1);
                    const f32x4 c0 = *(const f32x4*)(ropeA + pos * 8), c1 = *(const f32x4*)(ropeA + pos * 8 + 4);
                    const f32x4 s0 = *(const f32x4*)(ropeA + SEQ * 8 + pos * 8), s1 = *(const f32x4*)(ropeA + SEQ * 8 + pos * 8 + 4);
#pragma unroll
                    for (int bj = 0; bj < 2; ++bj)
#pragma unroll
                        for (int n = 0; n < 2; ++n) { const f32x4 own = acc[ai][bj][m][n]; f32x4 oth;
#pragma unroll
                            for (int j = 0; j < 4; ++j) oth[j] = __shfl_xor(own[j], 16);
                            const f32x4 cs = n ? c1 : c0, sn = n ? s1 : s0;
                            if (fq == 0) acc[ai][bj][m][n] = own * cs - oth * sn;
                            else if (fq == 1) acc[ai][bj][m][n] = own * cs + oth * sn; } }
        }
        if (u.pn >= 6) {
#pragma unroll
            for (int ai = 0; ai < 2; ++ai)
#pragma unroll
                for (int m = 0; m < 4; ++m) { float s = 0.f;
#pragma unroll
                    for (int bj = 0; bj < 2; ++bj) if (u.pn == 6 || bj == 0)
#pragma unroll
                        for (int n = 0; n < 2; ++n) { const f32x4 x = acc[ai][bj][m][n]; s += (x[0] * x[0] + x[1] * x[1]) + (x[2] * x[2] + x[3] * x[3]); }
                    s += __shfl_xor(s, 16); s += __shfl_xor(s, 32);
                    if (fq == 0) ssq[(size_t)(row0 + ai * HALF + m * 16) * 8 + (u.pn == 6 ? 0 : 4) + wc] = s; }
        }
        if (u.pn == 7 && wc == 0) {
#pragma unroll
            for (int ai = 0; ai < 2; ++ai)
#pragma unroll
                for (int m = 0; m < 4; ++m) { const int row = row0 + ai * HALF + m * 16, pos = row & (SEQ - 1); f32x4 o[2];
#pragma unroll
                    for (int n = 0; n < 2; ++n) { const f32x4 own = acc[ai][1][m][n]; f32x4 oth;
#pragma unroll
                        for (int j = 0; j < 4; ++j) oth[j] = __shfl_xor(own[j], 32);
                        const int i0 = 8 * (fq & 1) + 4 * n;
                        const f32x4 cs = *(const f32x4*)(ropeB + pos * 16 + i0), sn = *(const f32x4*)(ropeB + SEQ * 16 + pos * 16 + i0);
                        o[n] = (fq < 2) ? own * cs - oth * sn : own * cs + oth * sn; }
                    *(u32x4*)(KR + (size_t)row * 32 + 8 * fq) = pack_acc8(o[0], o[1]); }
        }
#pragma unroll
        for (int ai = 0; ai < 2; ++ai)
#pragma unroll
            for (int m = 0; m < 4; ++m) { bf16_t* rowp = H + (size_t)(row0 + ai * HALF + m * 16) * HLD + col0;
#pragma unroll
                for (int bj = 0; bj < 2; ++bj) *(u32x4*)(rowp + bj * HALF) = pack_acc8(acc[ai][bj][m][0], acc[ai][bj][m][1]); }
    }
};

template <int MODE> struct EpiMla {
    bf16_t* O; const float* ssq;
    __device__ __forceinline__ void operator()(Acc& acc, const Unit& u, int wr, int wc, int fr, int fq) const {
        const int row0 = u.pm * BM + wr * 64 + fr, col0 = u.pn * BM + wc * 32 + 8 * fq;
        constexpr int ldc = MODE == 0 ? 768 : 1024;
#pragma unroll
        for (int ai = 0; ai < 2; ++ai)
#pragma unroll
            for (int m = 0; m < 4; ++m) { const int row = row0 + ai * HALF + m * 16;
                const f32x4 p = *(const f32x4*)(ssq + (size_t)row * 8 + (MODE == 0 ? 0 : 4));
                const float rstd = 1.0f / sqrtf(((p[0] + p[1]) + (p[2] + p[3])) * (MODE == 0 ? 1.0f / 256.0f : 1.0f / 128.0f) + RMS_EPS);
                bf16_t* rowp = O + (size_t)row * ldc + col0;
#pragma unroll
                for (int bj = 0; bj < 2; ++bj) *(u32x4*)(rowp + bj * HALF) = pack_acc8(acc[ai][bj][m][0] * rstd, acc[ai][bj][m][1] * rstd);
                asm volatile("" ::: "memory"); }
    }
};

struct EpiMoe1 {
    bf16_t* Hdn;
    __device__ __forceinline__ void operator()(Acc& acc, const Unit& u, int wr, int wc, int fr, int fq) const {
        const int row0 = u.row0 + wr * 64 + fr, col0 = u.pn * 128 + wc * 32 + 8 * fq;
#pragma unroll
        for (int ai = 0; ai < 2; ++ai)
#pragma unroll
            for (int m = 0; m < 4; ++m) { f32x4 h[2];
#pragma unroll
                for (int n = 0; n < 2; ++n)
#pragma unroll
                    for (int j = 0; j < 4; ++j) { const float g = acc[ai][0][m][n][j], up = acc[ai][1][m][n][j]; h[n][j] = g * __builtin_amdgcn_rcpf(1.0f + __builtin_amdgcn_exp2f(-1.4426950408889634f * g)) * up; }
                *(u32x4*)(Hdn + (size_t)(row0 + ai * HALF + m * 16) * DEXP + col0) = pack_acc8(h[0], h[1]); }
    }
};
struct EpiMoe2 {
    bf16_t* Y; const float* slot_g; const int* slot_dst;
    __device__ __forceinline__ void operator()(Acc& acc, const Unit& u, int wr, int wc, int fr, int fq) const {
        const int row0 = u.row0 + wr * 64 + fr, col0 = u.pn * BM + wc * 32 + 8 * fq;
#pragma unroll
        for (int ai = 0; ai < 2; ++ai)
#pragma unroll
            for (int m = 0; m < 4; ++m) { const int slot = row0 + ai * HALF + m * 16; const int dst = slot_dst[slot]; const float g = slot_g[slot];
                if (dst >= 0) { bf16_t* rowp = Y + (size_t)dst * DM + col0;
#pragma unroll
                    for (int bj = 0; bj < 2; ++bj) *(u32x4*)(rowp + bj * HALF) = pack_acc8(acc[ai][bj][m][0] * g, acc[ai][bj][m][1] * g); } }
    }
};
}

struct Args { const float* in[26]; float* out; unsigned char* ws; int lo, hi; };
enum { IN_X = 0, IN_EWIN, IN_LQ1, IN_LK1, IN_LQ2, IN_LK2, IN_SUBLN, IN_QNG, IN_WUQ, IN_KVNG, IN_WUKV, IN_EWO, IN_OWQKV, IN_RELB, IN_OWO,
       IN_LN1G, IN_LN1B, IN_LN2G, IN_LN2B, IN_WRG, IN_BRG, IN_WRE, IN_BRE, IN_WG, IN_WU, IN_WD };

__device__ __forceinline__ Frame fresh(const Frame& F) { Frame R = F; int wv = F.wave, g = F.G, b = F.bid; asm volatile("" : "+s"(wv), "+s"(g), "+s"(b));
    int ln = (int)__builtin_amdgcn_mbcnt_hi(~0u, __builtin_amdgcn_mbcnt_lo(~0u, 0u)); asm volatile("" : "+v"(ln));
    __builtin_assume(ln >= 0 && ln < 64); __builtin_assume(wv >= 0 && wv < NTHREADS / 64); __builtin_assume(g > 0 && g <= 1024); __builtin_assume(b >= 0 && b < g);
    R.tid = wv * 64 + ln; R.lane = ln; R.wave = wv; R.G = g; R.bid = b; return R; }
__device__ __forceinline__ Args fresh(const Args& a) { Args r = a; unsigned long long z = 0ull; asm volatile("" : "+s"(z)); r.ws = a.ws + z; return r; }

__device__ __forceinline__ void tr_tile(const Frame& F, const float* src, int ldsrc, int Kv, int Nv, int k0, int n0, bf16_t* dst, int lddst, int rowmap, const float* scale) {
    LAS float* T = (LAS float*)F.lds;
    __syncthreads();
#pragma unroll
    for (int it = 0; it < 8; ++it) { const int e = it * NTHREADS + F.tid, i = e >> 6, j = e & 63; const int k = k0 + i, n = n0 + j;
        float v = 0.f; if (k < Kv && n < Nv) { v = src[(size_t)k * ldsrc + n]; if (scale) v *= scale[k]; }
        T[i * 65 + j] = v; }
    __syncthreads();
    {
        const int j = F.tid >> 3, i0 = (F.tid & 7) * 8; float f[8];
#pragma unroll
        for (int q = 0; q < 8; ++q) f[q] = T[(i0 + q) * 65 + j];
        int n = n0 + j; if (rowmap) n = (n >> 7) * 256 + (n & 127) + (rowmap == 2 ? 128 : 0);
        *(u32x4*)(dst + (size_t)n * lddst + k0 + i0) = pack8(f); }
}
__device__ __forceinline__ void tr_matrix(const Frame& F, int& cursor, const float* src, int ldsrc, int Kv, int Nv, int Kp, int Np, bf16_t* dst, int lddst, int rowmap, const float* scale) {
    const int tk = Kp / 64, tn = Np / 64, ntile = tk * tn;
    int first = (F.bid - cursor % F.G + F.G) % F.G;
    for (int t = first; t < ntile; t += F.G) tr_tile(F, src, ldsrc, Kv, Nv, (t / tn) * 64, (t % tn) * 64, dst, lddst, rowmap, scale);
    cursor += ntile;
}

__device__ __forceinline__ void phase_prologue(const Frame& F, const Args& a) {
    unsigned char* ws = a.ws;
    { const float* x = a.in[IN_X]; bf16_t* X = (bf16_t*)(ws + WS_X); const size_t n8 = (size_t)NTOK * DM / 8;
      for (size_t i = (size_t)F.bid * NTHREADS + F.tid; i < n8; i += (size_t)F.G * NTHREADS) { const f32x4 v0 = *(const f32x4*)(x + i * 8), v1 = *(const f32x4*)(x + i * 8 + 4); *(u32x4*)(X + i * 8) = g8::pack_acc8(v0, v1); } }
    { float* ra = (float*)(ws + WS_ROPEA); float* rb = (float*)(ws + WS_ROPEB);
      for (int i = F.bid * NTHREADS + F.tid; i < SEQ * 8; i += F.G * NTHREADS) { const int pos = i >> 3, f = i & 7; const float inv = powf(500000.0f, -(float)(2 * f) / 16.0f); const float ang = (float)pos * inv; ra[i] = cosf(ang); ra[SEQ * 8 + i] = sinf(ang); }
      for (int i = F.bid * NTHREADS + F.tid; i < SEQ * 16; i += F.G * NTHREADS) { const int pos = i >> 4, f = i & 15; const float inv = powf(500000.0f, -(float)(2 * f) / 32.0f); const float ang = (float)pos * inv; rb[i] = cosf(ang); rb[SEQ * 16 + i] = sinf(ang); } }
    { bf16_t* wr = (bf16_t*)(ws + WS_WR); const float* wrg = a.in[IN_WRG]; const float* wre = a.in[IN_WRE];
      for (int i = F.bid * NTHREADS + F.tid; i < DEPTH * 48 * DM; i += F.G * NTHREADS) { const int l = i / (48 * DM), r = i % (48 * DM), j = r / DM, k = r % DM;
          const float w = j < 4 ? wrg[((size_t)l * DM + k) * 4 + j] : j < 36 ? wre[((size_t)l * DM + k) * 32 + (j - 4)] : 0.f;
          const unsigned hi = cvt_pk_bf16(w, 0.f) & 0xffffu; const float rem = w - __uint_as_float(hi << 16);
          wr[(size_t)l * 2 * 48 * DM + r] = (bf16_t)hi; wr[(size_t)l * 2 * 48 * DM + 48 * DM + r] = (bf16_t)(cvt_pk_bf16(rem, 0.f) & 0xffffu); } }
    if (F.bid == 0 && F.tid < 2) { const int jl = F.tid; float d1 = 0.f, d2 = 0.f;
        for (int i = 0; i < 64; ++i) { d1 += a.in[IN_LQ1][jl * 64 + i] * a.in[IN_LK1][jl * 64 + i]; d2 += a.in[IN_LQ2][jl * 64 + i] * a.in[IN_LK2][jl * 64 + i]; }
        const float lambda_init = 0.8f - 0.6f * expf(-0.3f * (float)(2 * jl));
        ((float*)(ws + WS_LAM))[jl] = expf(d1) - expf(d2) + lambda_init; }
    int cur = 0;
    for (int l = 0; l < 2; ++l) {
        tr_matrix(F, cur, a.in[IN_EWIN] + (size_t)l * DM * EVEN_IN, EVEN_IN, DM, EVEN_IN, DM, HLD, (bf16_t*)(ws + WS_WIN) + (size_t)l * HLD * DM, DM, 0, nullptr);
        tr_matrix(F, cur, a.in[IN_WUQ] + (size_t)l * 256 * 768, 768, 256, 768, 256, 768, (bf16_t*)(ws + WS_WUQ) + (size_t)l * 768 * 256, 256, 0, a.in[IN_QNG] + l * 256);
        tr_matrix(F, cur, a.in[IN_WUKV] + (size_t)l * 128 * 1024, 1024, 128, 1024, 256, 1024, (bf16_t*)(ws + WS_WUKV) + (size_t)l * 1024 * 256, 256, 0, a.in[IN_KVNG] + l * 128);
        tr_matrix(F, cur, a.in[IN_EWO] + (size_t)l * DM * DM, DM, DM, DM, DM, DM, (bf16_t*)(ws + WS_WOE) + (size_t)l * DM * DM, DM, 0, nullptr);
        tr_matrix(F, cur, a.in[IN_OWQKV] + (size_t)l * DM * 3072, 3072, DM, 3072, DM, 3072, (bf16_t*)(ws + WS_WQKV) + (size_t)l * 3072 * DM, DM, 0, nullptr);
        tr_matrix(F, cur, a.in[IN_OWO] + (size_t)l * DM * DM, DM, DM, DM, DM, DM, (bf16_t*)(ws + WS_WOO) + (size_t)l * DM * DM, DM, 0, nullptr);
    }
    __syncthreads();
}
__device__ __forceinline__ void tr_big(const Frame& F, const float* src, int ldsrc, int k0, int n0, bf16_t* dst, int lddst, int rowmap) {
    LAS float* T = (LAS float*)F.lds;
    f32x4 v[8];
#pragma unroll
    for (int it = 0; it < 8; ++it) { const int idx = it * NTHREADS + F.tid, i = idx >> 6, c4 = idx & 63; v[it] = *(const f32x4*)(src + (size_t)(k0 + i) * ldsrc + n0 + 4 * c4); }
    __syncthreads();
#pragma unroll
    for (int it = 0; it < 8; ++it) { const int idx = it * NTHREADS + F.tid, i = idx >> 6, c4 = idx & 63; *(LAS f32x4*)(T + i * 260 + 4 * c4) = v[it]; }
    __syncthreads();
    const int nn = F.tid & 255, kh = F.tid >> 8;
    int n = n0 + nn; if (rowmap) n = (n >> 7) * 256 + (n & 127) + (rowmap == 2 ? 128 : 0);
    bf16_t* dp = dst + (size_t)n * lddst + k0 + 32 * kh;
#pragma unroll
    for (int sg = 0; sg < 4; ++sg) { float f[8];
#pragma unroll
        for (int q = 0; q < 8; ++q) f[q] = T[(32 * kh + 8 * sg + q) * 260 + nn];
        *(u32x4*)(dp + 8 * sg) = pack8(f); }
}
__device__ __forceinline__ void tr_matrix_big(const Frame& F, int& cursor, const float* src, int ldsrc, int K, int N, bf16_t* dst, int lddst, int rowmap) {
    const int tk = K / 64, tn = N / 256, ntile = tk * tn;
    const int first = (F.bid - cursor % F.G + F.G) % F.G;
    for (int t = first; t < ntile; t += F.G) tr_big(F, src, ldsrc, (t / tn) * 64, (t % tn) * 256, dst, lddst, rowmap);
    cursor += ntile;
}
__device__ __forceinline__ void phase_moe_weights(const Frame& F, const Args& a, int layer) {
    unsigned char* ws = a.ws; int cur = 0;
    for (int e = 0; e < NEXP; ++e) {
        const size_t so = ((size_t)layer * NEXP + e) * DM * DEXP;
        tr_matrix_big(F, cur, a.in[IN_WG] + so, DEXP, DM, DEXP, (bf16_t*)(ws + WS_W13) + (size_t)e * 1024 * 1024, DM, 1);
        tr_matrix_big(F, cur, a.in[IN_WU] + so, DEXP, DM, DEXP, (bf16_t*)(ws + WS_W13) + (size_t)e * 1024 * 1024, DM, 2);
        tr_matrix_big(F, cur, a.in[IN_WD] + so, DM, DEXP, DM, (bf16_t*)(ws + WS_W2) + (size_t)e * 1024 * 512, DEXP, 0);
    }
    __syncthreads();
}

template <int MODE>
__device__ __forceinline__ void phase_ln(const Frame& F, const Args& a, int layer, bool last_layer) {
    unsigned char* ws = a.ws;
    bf16_t* X = (bf16_t*)(ws + WS_X);
    const bf16_t* Ra = MODE == 0 ? (const bf16_t*)(ws + WS_R1) : (const bf16_t*)(ws + WS_R2);
    const float* gam = a.in[MODE == 0 ? IN_LN1G : IN_LN2G] + layer * DM; const float* bet = a.in[MODE == 0 ? IN_LN1B : IN_LN2B] + layer * DM;
    const float* WR = (const float*)(ws + WS_WR) + (size_t)layer * 36 * DM;
    LAS int* hist = (LAS int*)F.lds;
    for (int chunk = F.bid; chunk < NTOK / 256; chunk += F.G) {
        if (MODE == 0) { __syncthreads(); if (F.tid < NEXP) hist[F.tid] = 0; __syncthreads(); }
        for (int rr = F.wave; rr < 256; rr += NTHREADS / 64) {
            const int row = chunk * 256 + rr; float y[16];
#pragma unroll
            for (int hh = 0; hh < 2; ++hh) { const int c = hh * 512 + F.lane * 8; float xv[8], rv[8];
                unpack8(*(const u32x4*)(X + (size_t)row * DM + c), xv);
                if (MODE == 0) unpack8(*(const u32x4*)(Ra + (size_t)row * DM + c), rv);
                else { float r0[8], r1[8]; unpack8(*(const u32x4*)(Ra + (size_t)row * 2 * DM + c), r0); unpack8(*(const u32x4*)(Ra + (size_t)row * 2 * DM + DM + c), r1);
#pragma unroll
                    for (int q = 0; q < 8; ++q) rv[q] = r0[q] + r1[q]; }
#pragma unroll
                for (int q = 0; q < 8; ++q) y[hh * 8 + q] = DN_ALPHA * xv[q] + rv[q]; }
            float s = 0.f;
#pragma unroll
            for (int q = 0; q < 16; ++q) s += y[q];
            const float mean = wave_sum(s) * (1.0f / DM);
            float v = 0.f;
#pragma unroll
            for (int q = 0; q < 16; ++q) { const float d = y[q] - mean; v += d * d; }
            const float rstd = 1.0f / sqrtf(wave_sum(v) * (1.0f / DM) + LN_EPS);
#pragma unroll
            for (int hh = 0; hh < 2; ++hh) { const int c = hh * 512 + F.lane * 8;
                const f32x4 g0 = *(const f32x4*)(gam + c), g1 = *(const f32x4*)(gam + c + 4), b0 = *(const f32x4*)(bet + c), b1 = *(const f32x4*)(bet + c + 4);
#pragma unroll
                for (int q = 0; q < 4; ++q) { y[hh * 8 + q] = (y[hh * 8 + q] - mean) * rstd * g0[q] + b0[q]; y[hh * 8 + 4 + q] = (y[hh * 8 + 4 + q] - mean) * rstd * g1[q] + b1[q]; } }
            if (MODE == 1 && last_layer) {
#pragma unroll
                for (int hh = 0; hh < 2; ++hh) { float* o = a.out + (size_t)row * DM + hh * 512 + F.lane * 8;
                    *(f32x4*)o = (f32x4){y[hh * 8], y[hh * 8 + 1], y[hh * 8 + 2], y[hh * 8 + 3]}; *(f32x4*)(o + 4) = (f32x4){y[hh * 8 + 4], y[hh * 8 + 5], y[hh * 8 + 6], y[hh * 8 + 7]}; }
            } else {
#pragma unroll
                for (int hh = 0; hh < 2; ++hh) { float t8[8];
#pragma unroll
                    for (int q = 0; q < 8; ++q) t8[q] = y[hh * 8 + q];
                    *(u32x4*)(X + (size_t)row * DM + hh * 512 + F.lane * 8) = pack8(t8); }
            }
            if (MODE == 0) {
                float mine = 0.f;
#pragma unroll 2
                for (int j = 0; j < 36; ++j) { float p = 0.f;
#pragma unroll
                    for (int hh = 0; hh < 2; ++hh) { const float* w = WR + (size_t)j * DM + hh * 512 + F.lane * 8; const f32x4 w0 = *(const f32x4*)w, w1 = *(const f32x4*)(w + 4);
#pragma unroll
                        for (int q = 0; q < 4; ++q) { p += y[hh * 8 + q] * w0[q]; p += y[hh * 8 + 4 + q] * w1[q]; } }
                    p = wave_sum(p); mine = (F.lane == j) ? p : mine; }
                { const float* brg = a.in[IN_BRG] + layer * 4; const float* bre = a.in[IN_BRE] + layer * 32;
                  mine += (F.lane < 4) ? brg[F.lane] : (F.lane < 36 ? bre[F.lane - 4] : 0.f); }
                float lg[4];
#pragma unroll
                for (int j = 0; j < 4; ++j) lg[j] = __shfl(mine, j);
                int grp = 0; float gm = lg[0];
#pragma unroll
                for (int j = 1; j < 4; ++j) if (lg[j] > gm) { gm = lg[j]; grp = j; }
                float gs = 0.f;
#pragma unroll
                for (int j = 0; j < 4; ++j) gs += __expf(lg[j] - gm);
                const float gw = 1.0f / gs;
                float le[8];
#pragma unroll
                for (int i = 0; i < 8; ++i) le[i] = __shfl(mine, 4 + grp * 8 + i);
                int i1 = 0; float m1 = le[0];
#pragma unroll
                for (int i = 1; i < 8; ++i) if (le[i] > m1) { m1 = le[i]; i1 = i; }
                int i2 = -1; float m2 = -3.0e38f;
#pragma unroll
                for (int i = 0; i < 8; ++i) if (i != i1 && le[i] > m2) { m2 = le[i]; i2 = i; }
                const float e2 = __expf(m2 - m1), den = 1.0f / (1.0f + e2);
                if (F.lane == 0) {
                    const int e0 = grp * 8 + i1, e1 = grp * 8 + i2;
                    int* ri = (int*)(ws + WS_ROUTE) + (size_t)row * 4; ri[0] = e0; ri[1] = e1; ((float*)ri)[2] = den * gw; ((float*)ri)[3] = e2 * den * gw;
                    atomicAdd((int*)&hist[e0], 1); atomicAdd((int*)&hist[e1], 1);
                }
            }
        }
        if (MODE == 0) { __syncthreads(); if (F.tid < NEXP) ((int*)(ws + WS_CNT))[chunk * NEXP + F.tid] = hist[F.tid]; }
    }
    __syncthreads();
}

__device__ __forceinline__ void phase_ln1_router(const Frame& F, const Args& a, int layer) {
    unsigned char* ws = a.ws;
    bf16_t* X = (bf16_t*)(ws + WS_X); const bf16_t* Yb = (const bf16_t*)(ws + WS_R1); const f32x4* stats = (const f32x4*)(ws + WS_R2);
    const float* gam = a.in[IN_LN1G] + layer * DM; const float* bet = a.in[IN_LN1B] + layer * DM;
    const bf16_t* WRh = (const bf16_t*)(ws + WS_WR) + (size_t)layer * 2 * 48 * DM; const bf16_t* WRl = WRh + 48 * DM;
    LAS int* hist = (LAS int*)F.lds; LAS float* Lg = (LAS float*)(F.lds + 1024) + F.wave * (16 * 48);
    const int r = F.lane & 15, g = F.lane >> 4;
    for (int chunk = F.bid; chunk < NTOK / 256; chunk += F.G) {
        __syncthreads(); if (F.tid < NEXP) hist[F.tid] = 0; __syncthreads();
#pragma unroll 1
        for (int grp = 0; grp < 2; ++grp) {
            const int row = chunk * 256 + F.wave * 32 + grp * 16 + r;
            const f32x4 q0 = stats[(size_t)row * 8 + 2 * g], q1 = stats[(size_t)row * 8 + 2 * g + 1];
            float s = (q0[0] + q0[2]) + (q1[0] + q1[2]), ss = (q0[1] + q0[3]) + (q1[1] + q1[3]);
            s += __shfl_xor(s, 16); s += __shfl_xor(s, 32); ss += __shfl_xor(ss, 16); ss += __shfl_xor(ss, 32);
            const float mean = s * (1.0f / DM), var = fmaxf(ss * (1.0f / DM) - mean * mean, 0.f), rstd = 1.0f / sqrtf(var + LN_EPS);
            f32x4 acc[3];
#pragma unroll
            for (int nb = 0; nb < 3; ++nb) acc[nb] = (f32x4){0.f, 0.f, 0.f, 0.f};
#pragma unroll 4
            for (int kk = 0; kk < 32; ++kk) { float yv[8], y[8], lo[8];
                const int c = 64 * (kk >> 1) + 16 * g + 8 * (kk & 1);
                unpack8(*(const u32x4*)(Yb + (size_t)row * DM + c), yv);
                const f32x4 g0 = *(const f32x4*)(gam + c), g1 = *(const f32x4*)(gam + c + 4), b0 = *(const f32x4*)(bet + c), b1 = *(const f32x4*)(bet + c + 4);
#pragma unroll
                for (int q = 0; q < 4; ++q) { y[q] = (yv[q] - mean) * rstd * g0[q] + b0[q]; y[4 + q] = (yv[4 + q] - mean) * rstd * g1[q] + b1[q]; }
                const u32x4 hw = pack8(y); *(u32x4*)(X + (size_t)row * DM + c) = hw;
                { float hf[8]; unpack8(hw, hf);
#pragma unroll
                  for (int q = 0; q < 8; ++q) lo[q] = y[q] - hf[q]; }
                const u32x4 lw = pack8(lo); const bf16x8 ah = *(const bf16x8*)&hw, al = *(const bf16x8*)&lw;
#pragma unroll
                for (int nb = 0; nb < 3; ++nb) { const bf16x8 bh = *(const bf16x8*)(WRh + (size_t)(16 * nb + r) * DM + c), blo = *(const bf16x8*)(WRl + (size_t)(16 * nb + r) * DM + c);
                    acc[nb] = __builtin_amdgcn_mfma_f32_16x16x32_bf16(ah, bh, acc[nb], 0, 0, 0);
                    acc[nb] = __builtin_amdgcn_mfma_f32_16x16x32_bf16(al, bh, acc[nb], 0, 0, 0);
                    acc[nb] = __builtin_amdgcn_mfma_f32_16x16x32_bf16(ah, blo, acc[nb], 0, 0, 0); } }
#pragma unroll
            for (int nb = 0; nb < 3; ++nb)
#pragma unroll
                for (int t = 0; t < 4; ++t) Lg[(4 * g + t) * 48 + 16 * nb + r] = acc[nb][t];
            asm volatile("s_waitcnt lgkmcnt(0)" ::: "memory");
            if (F.lane < 16) {
                const LAS float* L = Lg + r * 48; const float* brg = a.in[IN_BRG] + layer * 4; const float* bre = a.in[IN_BRE] + layer * 32;
                float lg[4];
#pragma unroll
                for (int q = 0; q < 4; ++q) lg[q] = L[q] + brg[q];
                int grpi = 0; float gm = lg[0];
#pragma unroll
                for (int q = 1; q < 4; ++q) if (lg[q] > gm) { gm = lg[q]; grpi = q; }
                float gs = 0.f;
#pragma unroll
                for (int q = 0; q < 4; ++q) gs += __expf(lg[q] - gm);
                const float gw = 1.0f / gs;
                float le[8];
#pragma unroll
                for (int i = 0; i < 8; ++i) le[i] = L[4 + grpi * 8 + i] + bre[grpi * 8 + i];
                int i1 = 0; float m1 = le[0];
#pragma unroll
                for (int i = 1; i < 8; ++i) if (le[i] > m1) { m1 = le[i]; i1 = i; }
                int i2 = -1; float m2 = -3.0e38f;
#pragma unroll
                for (int i = 0; i < 8; ++i) if (i != i1 && le[i] > m2) { m2 = le[i]; i2 = i; }
                const float e2 = __expf(m2 - m1), den = 1.0f / (1.0f + e2);
                const int e0 = grpi * 8 + i1, e1 = grpi * 8 + i2;
                int* ri = (int*)(ws + WS_ROUTE) + (size_t)row * 4; ri[0] = e0; ri[1] = e1; ((float*)ri)[2] = den * gw; ((float*)ri)[3] = e2 * den * gw;
                atomicAdd((int*)&hist[e0], 1); atomicAdd((int*)&hist[e1], 1);
            }
            asm volatile("s_waitcnt lgkmcnt(0)" ::: "memory");
        }
        __syncthreads(); if (F.tid < NEXP) ((int*)(ws + WS_CNT))[chunk * NEXP + F.tid] = hist[F.tid];
    }
    __syncthreads();
}

__device__ __forceinline__ void phase_ln2(const Frame& F, const Args& a, int layer, bool last_layer, bool dry = false) {
    unsigned char* ws = a.ws;
    bf16_t* X = (bf16_t*)(ws + WS_X); bf16_t* XO = dry ? (bf16_t*)(ws + WS_R1) : X; const bf16_t* Y = (const bf16_t*)(ws + WS_R2);
    LAS float* gl = (LAS float*)F.lds; LAS float* bl = gl + DM;
    __syncthreads();
    for (int i = F.tid; i < DM; i += NTHREADS) { gl[i] = a.in[IN_LN2G][layer * DM + i]; bl[i] = a.in[IN_LN2B][layer * DM + i]; }
    __syncthreads();
    const int r = F.lane & 7, g = F.lane >> 3;
    const LAS float* gam = gl + 8 * g; const LAS float* bet = bl + 8 * g;
#pragma unroll 1
    for (int blk = F.bid * (NTHREADS / 64) + F.wave; blk < NTOK / 8; blk += F.G * (NTHREADS / 64)) {
        const int row = blk * 8 + r;
        const u32x4 rt = *(const u32x4*)((const int*)(ws + WS_ROUTE) + (size_t)row * 4);
        const float ga = __uint_as_float(rt.z), gb = __uint_as_float(rt.w);
        const bf16_t* xp = X + (size_t)row * DM + 8 * g; const bf16_t* y0p = Y + (size_t)rt.x * DM + 8 * g; const bf16_t* y1p = Y + (size_t)rt.y * DM + 8 * g;
        float y[128];
#pragma unroll
        for (int kk = 0; kk < 16; ++kk) { float xv[8], u0[8], u1[8]; unpack8(*(const u32x4*)(xp + 64 * kk), xv); unpack8(*(const u32x4*)(y0p + 64 * kk), u0); unpack8(*(const u32x4*)(y1p + 64 * kk), u1);
#pragma unroll
            for (int q = 0; q < 8; ++q) y[8 * kk + q] = DN_ALPHA * xv[q] + (ga * u0[q] + gb * u1[q]);
            if ((kk & 3) == 3) {
#pragma unroll
                for (int k2 = kk - 3; k2 <= kk; ++k2) asm volatile("" : "+v"(y[8 * k2]), "+v"(y[8 * k2 + 1]), "+v"(y[8 * k2 + 2]), "+v"(y[8 * k2 + 3]), "+v"(y[8 * k2 + 4]), "+v"(y[8 * k2 + 5]), "+v"(y[8 * k2 + 6]), "+v"(y[8 * k2 + 7]) :: "memory"); } }
        float s = 0.f;
#pragma unroll
        for (int q = 0; q < 128; ++q) s += y[q];
        s += __shfl_xor(s, 8); s += __shfl_xor(s, 16); s += __shfl_xor(s, 32);
        const float mean = s * (1.0f / DM);
        float v = 0.f;
#pragma unroll
        for (int q = 0; q < 128; ++q) { const float dlt = y[q] - mean; v += dlt * dlt; }
        v += __shfl_xor(v, 8); v += __shfl_xor(v, 16); v += __shfl_xor(v, 32);
        const float rstd = 1.0f / sqrtf(v * (1.0f / DM) + LN_EPS);
#pragma unroll
        for (int kk = 0; kk < 16; ++kk) { const int c = 64 * kk + 8 * g; float o8[8];
            const f32x4 g0 = *(const LAS f32x4*)(gam + 64 * kk), g1 = *(const LAS f32x4*)(gam + 64 * kk + 4), b0 = *(const LAS f32x4*)(bet + 64 * kk), b1 = *(const LAS f32x4*)(bet + 64 * kk + 4);
#pragma unroll
            for (int q = 0; q < 4; ++q) { o8[q] = (y[8 * kk + q] - mean) * rstd * g0[q] + b0[q]; o8[4 + q] = (y[8 * kk + 4 + q] - mean) * rstd * g1[q] + b1[q]; }
            if (last_layer) { float* o = a.out + (size_t)row * DM + c; *(f32x4*)o = (f32x4){o8[0], o8[1], o8[2], o8[3]}; *(f32x4*)(o + 4) = (f32x4){o8[4], o8[5], o8[6], o8[7]}; }
            else *(u32x4*)(XO + (size_t)row * DM + c) = pack8(o8);
            if (kk & 1) asm volatile("" ::: "memory"); }
    }
}

__device__ __forceinline__ void phase_scatter(const Frame& F, const Args& a) {
    unsigned char* ws = a.ws;
    const int* cnt = (const int*)(ws + WS_CNT); int* tile = (int*)(ws + WS_TILE);
    int* slot_tok = (int*)(ws + WS_SLOT_TOK); float* slot_g = (float*)(ws + WS_SLOT_G); int* slot_dst = (int*)(ws + WS_SLOT_DST);
    LAS int* C = (LAS int*)F.lds;
    LAS int* total = C + 256 * NEXP;
    LAS int* tstart = total + NEXP;
    LAS int* base = tstart + NEXP + 1;
    LAS int* el = base + NEXP;
    __syncthreads();
    for (int i = F.tid; i < 256 * NEXP; i += NTHREADS) C[i] = cnt[i];
    __syncthreads();
    if (F.tid < NEXP) { int s = 0; for (int c = 0; c < 256; ++c) s += C[c * NEXP + F.tid]; total[F.tid] = s; }
    __syncthreads();
    if (F.tid == 0) { int t = 0; for (int e = 0; e < NEXP; ++e) { tstart[e] = t; t += (total[e] + 255) >> 8; } tstart[NEXP] = t; }
    __syncthreads();
    const int T = tstart[NEXP];
    if (F.bid == 0) { if (F.tid == 0) tile[0] = T; for (int e = 0; e < NEXP; ++e) for (int t = tstart[e] + F.tid; t < tstart[e + 1]; t += NTHREADS) tile[1 + t] = e; }
    for (int e = F.bid; e < NEXP; e += F.G) { const int s0 = tstart[e] * 256 + total[e], s1 = tstart[e + 1] * 256;
        for (int s = s0 + F.tid; s < s1; s += NTHREADS) { slot_tok[s] = 0; slot_g[s] = 0.f; slot_dst[s] = -1; } }
    for (int chunk = F.bid; chunk < NTOK / 256; chunk += F.G) {
        __syncthreads();
        if (F.tid < NEXP) { int s = 0; for (int c = 0; c < chunk; ++c) s += C[c * NEXP + F.tid]; base[F.tid] = tstart[F.tid] * 256 + s; }
        const int tok = chunk * 256 + (F.tid >> 1), k = F.tid & 1;
        const int* ri = (const int*)(ws + WS_ROUTE) + (size_t)tok * 4;
        const int e = ri[k]; const float g = ((const float*)ri)[2 + k];
        el[F.tid] = e;
        __syncthreads();
        int rank = 0;
        for (int q = 0; q < F.tid; ++q) rank += (el[q] == e) ? 1 : 0;
        const int slot = base[e] + rank;
        slot_tok[slot] = tok; slot_g[slot] = g; slot_dst[slot] = tok * 2 + k;
        ((int*)(ws + WS_ROUTE))[(size_t)tok * 4 + k] = slot;
    }
    __syncthreads();
}

template <int DQK, int VP>
__device__ __forceinline__ void attn_keys64(const LAS float* Ks, const LAS float* Vs, const float (&q)[DQK], float (&o)[64], float& m, float& l, const float sc) {
#pragma unroll 1
    for (int jj = 0; jj < 64; ++jj) {
        float acc = 0.f; const LAS float* kr = Ks + jj * DQK;
#pragma unroll
        for (int d = 0; d < DQK; d += 4) { const f32x4 kv = *(const LAS f32x4*)(kr + d); acc += q[d] * kv[0] + q[d + 1] * kv[1] + q[d + 2] * kv[2] + q[d + 3] * kv[3]; }
        const float s = acc * sc, mx = fmaxf(m, s), corr = __builtin_amdgcn_exp2f(m - mx), p = __builtin_amdgcn_exp2f(s - mx);
        m = mx; l = l * corr + p; const LAS float* vr = Vs + jj * VP;
#pragma unroll
        for (int e = 0; e < 64; e += 4) { const f32x4 vv = *(const LAS f32x4*)(vr + e); o[e] = o[e] * corr + p * vv[0]; o[e + 1] = o[e + 1] * corr + p * vv[1]; o[e + 2] = o[e + 2] * corr + p * vv[2]; o[e + 3] = o[e + 3] * corr + p * vv[3]; }
    }
}
__device__ __forceinline__ void stage8(LAS float* dst, const bf16_t* src) { float f[8]; unpack8(*(const u32x4*)src, f); *(LAS f32x4*)dst = (f32x4){f[0], f[1], f[2], f[3]}; *(LAS f32x4*)(dst + 4) = (f32x4){f[4], f[5], f[6], f[7]}; }

__device__ __forceinline__ void attn_diff_naive(const Frame& F, const Args& a, int layer, int unit) {
    unsigned char* ws = a.ws; const bf16_t* H = (const bf16_t*)(ws + WS_R1); bf16_t* O = (bf16_t*)(ws + WS_R3); float* TS = (float*)(ws + WS_R1 + 256 * MiB);
    const int j = layer >> 1; const float lambda_init = 0.8f - 0.6f * expf(-0.3f * (float)layer);
    float d1 = 0.f, d2 = 0.f;
    for (int i = 0; i < 64; ++i) { d1 += a.in[IN_LQ1][j * 64 + i] * a.in[IN_LK1][j * 64 + i]; d2 += a.in[IN_LQ2][j * 64 + i] * a.in[IN_LK2][j * 64 + i]; }
    const float lam = expf(d1) - expf(d2) + lambda_init;
    const int qb = unit & 7, h = (unit >> 3) & 3, b = unit >> 5;
    const int ql = (F.tid & 31) + 32 * (F.tid >> 6), half = (F.tid >> 5) & 1;
    const size_t row = (size_t)b * SEQ + qb * 256 + ql;
    LAS float* Ks = (LAS float*)F.lds; LAS float* Vs = Ks + 64 * 64;
    const float sc = 0.125f * 1.4426950408889634f;
    float* stash = TS + row * 512 + h * 128 + half * 64;
#pragma unroll 1
    for (int st = 0; st < 2; ++st) {
        float o[64], q[64];
#pragma unroll
        for (int d = 0; d < 64; d += 8) { float f[8]; unpack8(*(const u32x4*)(H + row * HLD + h * 128 + st * 64 + d), f);
#pragma unroll
            for (int t = 0; t < 8; ++t) q[d + t] = f[t]; }
        float m = -INFINITY, l = 0.f;
#pragma unroll
        for (int e = 0; e < 64; ++e) o[e] = 0.f;
#pragma unroll 1
        for (int kt = 0; kt < SEQ / 64; ++kt) {
            __syncthreads();
            { const int key = F.tid >> 3, d8 = (F.tid & 7) * 8; const size_t krow = (size_t)b * SEQ + kt * 64 + key;
              stage8(Ks + key * 64 + d8, H + krow * HLD + 512 + h * 128 + st * 64 + d8);
              stage8(Vs + key * 128 + d8, H + krow * HLD + 1024 + h * 128 + d8); stage8(Vs + key * 128 + 64 + d8, H + krow * HLD + 1024 + h * 128 + 64 + d8); }
            __syncthreads();
            attn_keys64<64, 128>(Ks, Vs + half * 64, q, o, m, l, sc);
        }
        const float inv = 1.0f / l;
        if (st == 0) {
#pragma unroll
            for (int e = 0; e < 64; e += 4) *(f32x4*)(stash + e) = (f32x4){o[e] * inv, o[e + 1] * inv, o[e + 2] * inv, o[e + 3] * inv};
        } else {
            float ss = 0.f;
#pragma unroll
            for (int e = 0; e < 64; e += 4) { const f32x4 p0 = *(const f32x4*)(stash + e);
#pragma unroll
                for (int t = 0; t < 4; ++t) { o[e + t] = p0[t] - lam * (o[e + t] * inv); ss += o[e + t] * o[e + t]; } }
            ss += __shfl_xor(ss, 32);
            const float rs = 1.0f / sqrtf(ss * (1.0f / 128.0f) + RMS_EPS) * (1.0f - lambda_init);
            const float* g = a.in[IN_SUBLN] + j * 128 + half * 64;
#pragma unroll
            for (int e = 0; e < 64; e += 8) { float t8[8];
#pragma unroll
                for (int t = 0; t < 8; ++t) t8[t] = o[e + t] * rs * g[e + t];
                *(u32x4*)(O + row * DM + h * 128 + half * 64 + e) = pack8(t8); }
        }
    }
}
__device__ __forceinline__ void attn_mla_naive(const Frame& F, const Args& a, int unit) {
    unsigned char* ws = a.ws; const bf16_t* QB = (const bf16_t*)(ws + WS_R2); const bf16_t* KVB = QB + (size_t)NTOK * 768; const bf16_t* KR = KVB + (size_t)NTOK * 1024; bf16_t* O = (bf16_t*)(ws + WS_R3);
    const int qb = unit & 3, h = (unit >> 2) & 7, b = unit >> 5;
    const size_t row = (size_t)b * SEQ + qb * 512 + F.tid;
    LAS float* Ks = (LAS float*)F.lds; LAS float* Vs = Ks + 64 * 96;
    const float sc = 0.10206207261596575f * 1.4426950408889634f;
    float q[96], o[64];
#pragma unroll
    for (int d = 0; d < 96; d += 8) { float f[8]; unpack8(*(const u32x4*)(QB + row * 768 + h * 96 + d), f);
#pragma unroll
        for (int t = 0; t < 8; ++t) q[d + t] = f[t]; }
    { const float* rb = (const float*)(ws + WS_ROPEB); const int pos = (int)(row & (SEQ - 1));
#pragma unroll
      for (int i = 0; i < 16; i += 4) { const f32x4 cs = *(const f32x4*)(rb + pos * 16 + i), sn = *(const f32x4*)(rb + SEQ * 16 + pos * 16 + i);
#pragma unroll
          for (int t = 0; t < 4; ++t) { const float x1 = q[64 + i + t], x2 = q[80 + i + t]; q[64 + i + t] = x1 * cs[t] - x2 * sn[t]; q[80 + i + t] = x2 * cs[t] + x1 * sn[t]; } } }
    float m = -INFINITY, l = 0.f;
#pragma unroll
    for (int e = 0; e < 64; ++e) o[e] = 0.f;
#pragma unroll 1
    for (int kt = 0; kt < SEQ / 64; ++kt) {
        __syncthreads();
        { const int key = F.tid >> 3, d8 = (F.tid & 7) * 8; const size_t krow = (size_t)b * SEQ + kt * 64 + key;
          stage8(Ks + key * 96 + d8, KVB + krow * 1024 + h * 128 + d8);
          stage8(Vs + key * 64 + d8, KVB + krow * 1024 + h * 128 + 64 + d8);
          if (F.tid < 256) { const int key2 = F.tid >> 2, r8 = (F.tid & 3) * 8; stage8(Ks + key2 * 96 + 64 + r8, KR + ((size_t)b * SEQ + kt * 64 + key2) * 32 + r8); } }
        __syncthreads();
        attn_keys64<96, 64>(Ks, Vs, q, o, m, l, sc);
    }
    const float inv = 1.0f / l;
#pragma unroll
    for (int e = 0; e < 64; e += 8) { float t8[8];
#pragma unroll
        for (int t = 0; t < 8; ++t) t8[t] = o[e + t] * inv;
        *(u32x4*)(O + row * DM + 512 + h * 64 + e) = pack8(t8); }
}
__device__ __forceinline__ void attn_na_naive(const Frame& F, const Args& a, int layer, int unit) {
    unsigned char* ws = a.ws; const bf16_t* QKV = (const bf16_t*)(ws + WS_R1); bf16_t* O = (bf16_t*)(ws + WS_R3);
    const float* relb = a.in[IN_RELB] + (size_t)(layer >> 1) * 16 * 15 * 31;
    const int hh = unit & 1, r = (unit >> 1) & 31, b = unit >> 6;
    const int c = F.tid & 63, h = hh * 8 + (F.tid >> 6);
    const int r0 = min(max(r - 4, 0), 24), c0 = min(max(c - 8, 0), 48);
    const size_t row = (size_t)b * SEQ + r * 64 + c;
    const float LOG2E = 1.4426950408889634f;
    float q[64], o[64];
#pragma unroll
    for (int d = 0; d < 64; d += 8) { float f[8]; unpack8(*(const u32x4*)(QKV + row * 3072 + h * 64 + d), f);
#pragma unroll
        for (int t = 0; t < 8; ++t) q[d + t] = f[t]; }
    float m = -INFINITY, l = 0.f;
#pragma unroll
    for (int e = 0; e < 64; ++e) o[e] = 0.f;
#pragma unroll 1
    for (int ij = 0; ij < 128; ++ij) {
        const int i = ij >> 4, jj = ij & 15;
        const size_t krow = (size_t)b * SEQ + (r0 + i) * 64 + c0 + jj;
        const float bias = relb[((size_t)h * 15 + (r0 + i - r + 7)) * 31 + (c0 + jj - c + 15)];
        float acc = 0.f; const bf16_t* kp = QKV + krow * 3072 + 1024 + h * 64;
#pragma unroll
        for (int d = 0; d < 64; d += 8) { float f[8]; unpack8(*(const u32x4*)(kp + d), f);
#pragma unroll
            for (int t = 0; t < 8; ++t) acc += q[d + t] * f[t]; }
        const float s = (acc * 0.125f + bias) * LOG2E, mx = fmaxf(m, s), corr = __builtin_amdgcn_exp2f(m - mx), p = __builtin_amdgcn_exp2f(s - mx);
        m = mx; l = l * corr + p; const bf16_t* vp = kp + 1024;
#pragma unroll
        for (int e = 0; e < 64; e += 8) { float f[8]; unpack8(*(const u32x4*)(vp + e), f);
#pragma unroll
            for (int t = 0; t < 8; ++t) o[e + t] = o[e + t] * corr + p * f[t]; }
    }
    const float inv = 1.0f / l;
#pragma unroll
    for (int e = 0; e < 64; e += 8) { float t8[8];
#pragma unroll
        for (int t = 0; t < 8; ++t) t8[t] = o[e + t] * inv;
        *(u32x4*)(O + row * DM + h * 64 + e) = pack8(t8); }
}

namespace fa {
typedef float f32x16 __attribute__((ext_vector_type(16)));
typedef short s16x4 __attribute__((ext_vector_type(4)));
#define FA_SBAR() __builtin_amdgcn_sched_barrier(0)
__device__ __forceinline__ int crow(int r, int hi) { return (r & 3) + 8 * (r >> 2) + 4 * hi; }
constexpr float THR = 8.f;
template <int SCALE_E6> __device__ __forceinline__ void partialSM(f32x16& p0, f32x16& p1, float& m_reg, float& mn, float& alpha) {
    constexpr float SCALE = SCALE_E6 * 1e-6f, C = SCALE * 1.4426950408889634f;
    float pmax = p0[0];
#pragma unroll
    for (int r = 1; r < 16; ++r) pmax = fmaxf(pmax, p0[r]);
#pragma unroll
    for (int r = 0; r < 16; ++r) pmax = fmaxf(pmax, p1[r]);
    { auto rr = __builtin_amdgcn_permlane32_swap(__float_as_uint(pmax), __float_as_uint(pmax), false, false); pmax = fmaxf(__uint_as_float(rr[0]), __uint_as_float(rr[1])); }
    if (__builtin_expect(__all(pmax - m_reg <= THR / SCALE), 1)) { mn = m_reg; alpha = 1.f; }
    else { mn = fmaxf(m_reg, pmax); alpha = __builtin_amdgcn_exp2f((m_reg - mn) * C); m_reg = mn; }
    const float mnC = -mn * C;
#pragma unroll
    for (int r = 0; r < 16; ++r) p0[r] = fmaf(p0[r], C, mnC);
#pragma unroll
    for (int r = 0; r < 16; ++r) p1[r] = fmaf(p1[r], C, mnC);
#pragma unroll
    for (int r = 0; r < 16; ++r) p0[r] = __builtin_amdgcn_exp2f(p0[r]);
}
__device__ __forceinline__ void finishSM(f32x16& p0, f32x16& p1, float alpha, float& l_reg, bf16x8& pa0, bf16x8& pa1, bf16x8& pa2, bf16x8& pa3) {
#pragma unroll
    for (int r = 0; r < 16; ++r) p1[r] = __builtin_amdgcn_exp2f(p1[r]);
    float ps = 0;
#pragma unroll
    for (int r = 0; r < 16; ++r) ps += p0[r];
#pragma unroll
    for (int r = 0; r < 16; ++r) ps += p1[r];
    { auto rr = __builtin_amdgcn_permlane32_swap(__float_as_uint(ps), __float_as_uint(ps), false, false); ps = __uint_as_float(rr[0]) + __uint_as_float(rr[1]); }
    l_reg = l_reg * alpha + ps;
#define FA_PK4(P, BASE, OUT) do { unsigned a0 = cvt_pk_bf16(P[BASE + 0], P[BASE + 1]), a1 = cvt_pk_bf16(P[BASE + 2], P[BASE + 3]);   \
    unsigned b0 = cvt_pk_bf16(P[BASE + 4], P[BASE + 5]), b1 = cvt_pk_bf16(P[BASE + 6], P[BASE + 7]);                              \
    auto r0 = __builtin_amdgcn_permlane32_swap(a0, b0, false, false); auto r1 = __builtin_amdgcn_permlane32_swap(a1, b1, false, false); \
    u32x4 w = {r0[0], r1[0], r0[1], r1[1]}; OUT = *reinterpret_cast<bf16x8*>(&w); } while (0)
    FA_PK4(p0, 0, pa0); FA_PK4(p0, 8, pa1); FA_PK4(p1, 0, pa2); FA_PK4(p1, 8, pa3);
#undef FA_PK4
}
template <int NKS> __device__ __forceinline__ void qkt(f32x16& p0, f32x16& p1, const LAS char* Ks, const bf16x8 (&qr)[NKS], int r32, int hi) {
    p0 = f32x16{}; p1 = f32x16{};
#pragma unroll
    for (int d0 = 0; d0 < NKS; ++d0) {
        const bf16x8 b0 = *(const LAS bf16x8*)(Ks + ((2 * d0 + hi) * 64 + r32) * 16);
        const bf16x8 b1 = *(const LAS bf16x8*)(Ks + ((2 * d0 + hi) * 64 + 32 + r32) * 16);
        p0 = __builtin_amdgcn_mfma_f32_32x32x16_bf16(b0, qr[d0], p0, 0, 0, 0);
        p1 = __builtin_amdgcn_mfma_f32_32x32x16_bf16(b1, qr[d0], p1, 0, 0, 0); }
}
template <int NCB> __device__ __forceinline__ int v_st(int k, int c) { const int kk = (k & ~0xC) | ((k & 4) << 1) | ((k & 8) >> 1); return ((kk >> 3) * NCB + (c >> 5)) * 512 + ((kk & 7) * 32 + (c & 31)) * 2; }
__device__ __forceinline__ int v_rd_base(int lane) { return ((lane & 3) << 3) | (((lane >> 2) & 3) << 6) | (((lane >> 4) & 1) << 5) | (((lane >> 5) & 1) << 8); }
template <int NCB> constexpr int v_rd_off(int d0, int ks, int half) { return d0 * 512 + ks * (NCB * 1024) + half * (NCB * 512); }
template <int OFF> __device__ __forceinline__ s16x4 tr_read(int vb) { s16x4 r; asm volatile("ds_read_b64_tr_b16 %0, %1 offset:%2" : "=&v"(r) : "v"(vb), "i"(OFF) : "memory"); return r; }
template <int D0, int NCB> __device__ __forceinline__ void pv_one(f32x16& od, int vb, bf16x8 pa0, bf16x8 pa1, bf16x8 pa2, bf16x8 pa3) {
    const s16x4 l0 = tr_read<v_rd_off<NCB>(D0, 0, 0)>(vb), h0 = tr_read<v_rd_off<NCB>(D0, 0, 1)>(vb), l1 = tr_read<v_rd_off<NCB>(D0, 1, 0)>(vb), h1 = tr_read<v_rd_off<NCB>(D0, 1, 1)>(vb);
    const s16x4 l2 = tr_read<v_rd_off<NCB>(D0, 2, 0)>(vb), h2 = tr_read<v_rd_off<NCB>(D0, 2, 1)>(vb), l3 = tr_read<v_rd_off<NCB>(D0, 3, 0)>(vb), h3 = tr_read<v_rd_off<NCB>(D0, 3, 1)>(vb);
    asm volatile("s_waitcnt lgkmcnt(0)" ::: "memory"); FA_SBAR();
#define FA_PK(L, H) (bf16x8){L[0], L[1], L[2], L[3], H[0], H[1], H[2], H[3]}
    od = __builtin_amdgcn_mfma_f32_32x32x16_bf16(pa0, FA_PK(l0, h0), od, 0, 0, 0);
    od = __builtin_amdgcn_mfma_f32_32x32x16_bf16(pa1, FA_PK(l1, h1), od, 0, 0, 0);
    od = __builtin_amdgcn_mfma_f32_32x32x16_bf16(pa2, FA_PK(l2, h2), od, 0, 0, 0);
    od = __builtin_amdgcn_mfma_f32_32x32x16_bf16(pa3, FA_PK(l3, h3), od, 0, 0, 0);
#undef FA_PK
}
template <int NCB> __device__ __forceinline__ void pv_all(f32x16 (&o)[NCB], int vb, bf16x8 pa0, bf16x8 pa1, bf16x8 pa2, bf16x8 pa3) {
    pv_one<0, NCB>(o[0], vb, pa0, pa1, pa2, pa3); pv_one<1, NCB>(o[1], vb, pa0, pa1, pa2, pa3);
    if constexpr (NCB == 4) { pv_one<2, NCB>(o[2], vb, pa0, pa1, pa2, pa3); pv_one<3, NCB>(o[3], vb, pa0, pa1, pa2, pa3); }
}

template <int DQK, int DV, int SCALE_E6, int SDEPTH>
__device__ __forceinline__ void attn_stream(const Frame& F, const bf16_t* __restrict__ Qb, int LDQ, const bf16_t* __restrict__ Kh, int LDK, const bf16_t* __restrict__ KRh, const bf16_t* __restrict__ Vh, int LDV,
                                            const float* ropeB, int qpos0, f32x16 (&o)[DV / 32], float (&rli)[16]) {
    constexpr int NKS = DQK / 16, NCB = DV / 32, SHM_K = 64 * DQK * 2, SHM_V = 64 * DV * 2;
    const int tid = F.tid, wid = F.wave, lane = F.lane, r32 = lane & 31, hi = lane >> 5;
    LAS char* V_lds = (LAS char*)F.lds; LAS char* K_lds = V_lds + 3 * SHM_V;
    LAS float* wsl = (LAS float*)(K_lds + 2 * SHM_K) + wid * 64; LAS float* li_l = wsl; LAS float* al_l = wsl + 32;
    float m_reg = -1e30f, l_reg = 0.f; bf16x8 qr[NKS];
#pragma unroll
    for (int d = 0; d < NCB; ++d) o[d] = f32x16{};
    const bf16_t* Qw = Qb + (size_t)(wid * 32 + r32) * LDQ + hi * 8;
#pragma unroll
    for (int d0 = 0; d0 < NKS; ++d0) qr[d0] = *(const bf16x8*)(Qw + d0 * 16);
    if constexpr (DQK == 96) {
        const int pos = qpos0 + wid * 32 + r32; float x1[8], x2[8];
        unpack8(*(const u32x4*)&qr[4], x1); unpack8(*(const u32x4*)&qr[5], x2);
        const float* cp = ropeB + pos * 16 + 8 * hi; const float* sp = ropeB + SEQ * 16 + pos * 16 + 8 * hi;
#pragma unroll
        for (int jj = 0; jj < 8; ++jj) { const float c = cp[jj], sn = sp[jj], a = x1[jj], b = x2[jj]; x1[jj] = a * c - b * sn; x2[jj] = b * c + a * sn; }
        u32x4 w1 = pack8(x1), w2 = pack8(x2); qr[4] = *(bf16x8*)&w1; qr[5] = *(bf16x8*)&w2;
    }
    const int krow = (tid & 7) + 8 * (tid >> 6), kcs = (tid >> 3) & 7;
    const int rrow = (tid & 7) + 8 * ((tid >> 5) & 7), rcs = (tid >> 3) & 3;
    const int vr0 = (DV == 128) ? (tid >> 4) : (tid >> 3), vc = (DV == 128) ? (tid & 15) * 8 : (tid & 7) * 8;
    const int vst0 = v_st<NCB>(vr0, vc), vst1 = v_st<NCB>(32 + vr0, vc);
    const int vb0 = (int)(uintptr_t)V_lds + v_rd_base(lane);
    struct Slot { bf16x8 k0, kr, v0, v1; } sl[2];
#define FA_SLOAD(i, key0) do { sl[i].k0 = *(const bf16x8*)(Kh + (size_t)((key0) + krow) * LDK + kcs * 8); \
        if constexpr (DQK == 96) sl[i].kr = *(const bf16x8*)(KRh + (size_t)((key0) + rrow) * 32 + rcs * 8); \
        sl[i].v0 = *(const bf16x8*)(Vh + (size_t)((key0) + vr0) * LDV + vc); \
        if constexpr (DV == 128) sl[i].v1 = *(const bf16x8*)(Vh + (size_t)((key0) + 32 + vr0) * LDV + vc); } while (0)
#define FA_SWRITE(kb, voff, i) do { *(LAS bf16x8*)(K_lds + (kb) * SHM_K + (kcs * 64 + krow) * 16) = sl[i].k0; \
        if constexpr (DQK == 96) { if (tid < 256) *(LAS bf16x8*)(K_lds + (kb) * SHM_K + ((8 + rcs) * 64 + rrow) * 16) = sl[i].kr; } \
        *(LAS bf16x8*)(V_lds + (voff) + vst0) = sl[i].v0; \
        if constexpr (DV == 128) *(LAS bf16x8*)(V_lds + (voff) + vst1) = sl[i].v1; } while (0)
#define FA_SWAIT() asm volatile("s_waitcnt vmcnt(3)" ::: "memory")
#define FA_RESC(a) do { if (__any((a) < 1.f)) { if (hi == 0) al_l[r32] = (a); asm volatile("s_waitcnt lgkmcnt(0)" ::: "memory"); \
        _Pragma("unroll") for (int d = 0; d < NCB; ++d) _Pragma("unroll") for (int r = 0; r < 16; ++r) o[d][r] *= al_l[crow(r, hi)]; } } while (0)
#define FA_NEXT3(x) ((x) == 2 * SHM_V ? 0 : (x) + SHM_V)
    f32x16 pA0, pA1, pB0, pB1; float mnA, mnB, alA, alB; bf16x8 pa0, pa1, pa2, pa3; constexpr int NT = SEQ / 64;
    FA_SLOAD(0, 0); FA_SLOAD(1, 64); asm volatile("s_waitcnt vmcnt(0)" ::: "memory"); FA_SWRITE(0, 0, 0); FA_SWRITE(1, SHM_V, 1); FA_SLOAD(0, 128); __syncthreads();
    qkt<NKS>(pA0, pA1, K_lds, qr, r32, hi); partialSM<SCALE_E6>(pA0, pA1, m_reg, mnA, alA);
    int vrd = 0, vwr = 2 * SHM_V;
#pragma unroll 1
    for (int j = 1; j + 1 < NT; j += 2) {
        FA_SBAR(); qkt<NKS>(pB0, pB1, K_lds + SHM_K, qr, r32, hi);
        finishSM(pA0, pA1, alA, l_reg, pa0, pa1, pa2, pa3); FA_SBAR();
        FA_SLOAD(1, ((j + 2 < NT) ? (j + 2) : (NT - 1)) * 64); FA_SBAR();
        pv_all<NCB>(o, vb0 + vrd, pa0, pa1, pa2, pa3); partialSM<SCALE_E6>(pB0, pB1, m_reg, mnB, alB);
        FA_SWAIT(); FA_SWRITE(0, vwr, 0);
        FA_RESC(alB); __syncthreads();
        vrd = FA_NEXT3(vrd); vwr = FA_NEXT3(vwr);
        FA_SBAR(); qkt<NKS>(pA0, pA1, K_lds, qr, r32, hi);
        finishSM(pB0, pB1, alB, l_reg, pa0, pa1, pa2, pa3); FA_SBAR();
        FA_SLOAD(0, ((j + 3 < NT) ? (j + 3) : (NT - 1)) * 64); FA_SBAR();
        pv_all<NCB>(o, vb0 + vrd, pa0, pa1, pa2, pa3); partialSM<SCALE_E6>(pA0, pA1, m_reg, mnA, alA);
        FA_SWAIT(); FA_SWRITE(1, vwr, 1);
        FA_RESC(alA); __syncthreads();
        vrd = FA_NEXT3(vrd); vwr = FA_NEXT3(vwr);
    }
    FA_SBAR(); qkt<NKS>(pB0, pB1, K_lds + SHM_K, qr, r32, hi);
    finishSM(pA0, pA1, alA, l_reg, pa0, pa1, pa2, pa3); FA_SBAR();
    pv_all<NCB>(o, vb0 + vrd, pa0, pa1, pa2, pa3); partialSM<SCALE_E6>(pB0, pB1, m_reg, mnB, alB);
    FA_RESC(alB); vrd = FA_NEXT3(vrd);
    finishSM(pB0, pB1, alB, l_reg, pa0, pa1, pa2, pa3); FA_SBAR();
    pv_all<NCB>(o, vb0 + vrd, pa0, pa1, pa2, pa3);
    asm volatile("s_waitcnt vmcnt(0)" ::: "memory");
    if (hi == 0) li_l[r32] = l_reg;
    asm volatile("s_waitcnt lgkmcnt(0)" ::: "memory");
#pragma unroll
    for (int r = 0; r < 16; ++r) rli[r] = __builtin_amdgcn_rcpf(li_l[crow(r, hi)]);
#undef FA_SLOAD
#undef FA_SWRITE
#undef FA_SWAIT
#undef FA_RESC
#undef FA_NEXT3
}
}

__device__ __forceinline__ void attn_diff_mfma(const Frame& F, const Args& a, int layer, int unit) {
    unsigned char* ws = a.ws; const bf16_t* H = (const bf16_t*)(ws + WS_R1); bf16_t* O = (bf16_t*)(ws + WS_R3); float* TS = (float*)(ws + WS_R1 + 256 * MiB);
    const int jl = layer >> 1; const float lambda_init = 0.8f - 0.6f * expf(-0.3f * (float)layer);
    const float lam = ((const float*)(ws + WS_LAM))[jl];
    const int qb = unit & 7, h = (unit >> 3) & 3, b = unit >> 5;
    const size_t row0 = (size_t)b * SEQ + qb * 256, key0 = (size_t)b * SEQ;
#pragma unroll 1
    for (int st = 0; st < 2; ++st) {
        fa::f32x16 o[4]; float rli[16];
        __syncthreads();
        const Frame Fs = fresh(F);
        float* stash = TS + ((size_t)unit * NTHREADS + Fs.tid) * 64;
        fa::attn_stream<64, 128, 125000, 2>(Fs, H + row0 * HLD + h * 128 + st * 64, HLD, H + key0 * HLD + 512 + h * 128 + st * 64, HLD, nullptr, H + key0 * HLD + 1024 + h * 128, HLD, nullptr, 0, o, rli);
        const Frame Fe = fresh(F); const int r32 = Fe.lane & 31, hi = Fe.lane >> 5;
        if (st == 0) {
#pragma unroll
            for (int d = 0; d < 4; ++d)
#pragma unroll
                for (int r = 0; r < 16; r += 4) *(f32x4*)(stash + d * 16 + r) = (f32x4){o[d][r] * rli[r], o[d][r + 1] * rli[r + 1], o[d][r + 2] * rli[r + 2], o[d][r + 3] * rli[r + 3]};
        } else {
            float ss[16];
#pragma unroll
            for (int r = 0; r < 16; ++r) ss[r] = 0.f;
#pragma unroll
            for (int d = 0; d < 4; ++d)
#pragma unroll
                for (int r = 0; r < 16; r += 4) { const f32x4 p0 = *(const f32x4*)(stash + d * 16 + r);
#pragma unroll
                    for (int t = 0; t < 4; ++t) { const float v = p0[t] - lam * (o[d][r + t] * rli[r + t]); o[d][r + t] = v; ss[r + t] += v * v; } }
#pragma unroll
            for (int r = 0; r < 16; ++r) { float v = ss[r]; v += __shfl_xor(v, 1); v += __shfl_xor(v, 2); v += __shfl_xor(v, 4); v += __shfl_xor(v, 8); v += __shfl_xor(v, 16);
                ss[r] = 1.0f / sqrtf(v * (1.0f / 128.0f) + RMS_EPS) * (1.0f - lambda_init); }
            const float* g = a.in[IN_SUBLN] + jl * 128;
#pragma unroll
            for (int d = 0; d < 4; ++d) { const float gd = g[d * 32 + r32];
#pragma unroll
                for (int r = 0; r < 16; ++r) { const size_t row = row0 + Fe.wave * 32 + fa::crow(r, hi);
                    O[row * DM + h * 128 + d * 32 + r32] = (bf16_t)(cvt_pk_bf16(o[d][r] * ss[r] * gd, 0.f) & 0xffffu); } }
        }
    }
}
__device__ __forceinline__ void attn_mla_mfma(const Frame& F, const Args& a, int unit) {
    unsigned char* ws = a.ws; const bf16_t* QB = (const bf16_t*)(ws + WS_R2); const bf16_t* KVB = QB + (size_t)NTOK * 768; const bf16_t* KR = KVB + (size_t)NTOK * 1024; bf16_t* O = (bf16_t*)(ws + WS_R3);
    const int qb = unit & 7, h = (unit >> 3) & 7, b = unit >> 6;
    const size_t row0 = (size_t)b * SEQ + qb * 256, key0 = (size_t)b * SEQ;
    fa::f32x16 o[2]; float rli[16];
    __syncthreads();
    const Frame Fs = fresh(F);
    fa::attn_stream<96, 64, 102062, 2>(Fs, QB + row0 * 768 + h * 96, 768, KVB + key0 * 1024 + h * 128, 1024, KR + key0 * 32, KVB + key0 * 1024 + h * 128 + 64, 1024, (const float*)(ws + WS_ROPEB), qb * 256, o, rli);
    const Frame Fe = fresh(F); const int r32 = Fe.lane & 31, hi = Fe.lane >> 5;
#pragma unroll
    for (int d = 0; d < 2; ++d)
#pragma unroll
        for (int r = 0; r < 16; ++r) { const size_t row = row0 + Fe.wave * 32 + fa::crow(r, hi);
            O[row * DM + 512 + h * 64 + d * 32 + r32] = (bf16_t)(cvt_pk_bf16(o[d][r] * rli[r], 0.f) & 0xffffu); }
}

constexpr int NA_KSTR = 580;
constexpr int NA_VOFF = 8 * NA_KSTR * 16;
constexpr int NA_BOFF = NA_VOFF + 72 * 64 * 16;
__device__ __forceinline__ void attn_na_lds(const Frame& F, const Args& a, int layer, int unit) {
    unsigned char* ws = a.ws; const bf16_t* Qc = (const bf16_t*)(ws + WS_R1); const bf16_t* Kc = Qc + (size_t)NTOK * DM; const bf16_t* Vt = Kc + (size_t)NTOK * DM; bf16_t* O = (bf16_t*)(ws + WS_R3);
    const int rp = unit & 15, h = (unit >> 4) & 15, b = unit >> 8;
    const int ra = rp * 2, r0a = min(max(ra - 4, 0), 24);
    const size_t bh = (size_t)(b * 16 + h);
    LAS char* lds = (LAS char*)F.lds; LAS float* bl = (LAS float*)(lds + NA_BOFF);
    __syncthreads();
    {
        const bf16_t* kg = Kc + (bh * SEQ + r0a * 64) * 64; const bf16_t* vg = Vt + (bh * (SEQ / 8) + r0a * 8) * 64 * 8;
        const int kk = (F.tid & 7) + 8 * (F.tid >> 6), cs = (F.tid >> 3) & 7;
        u32x4 kv[9], vv[9];
#pragma unroll
        for (int i = 0; i < 9; ++i) { kv[i] = *(const u32x4*)(kg + (size_t)(64 * i + kk) * 64 + cs * 8); vv[i] = *(const u32x4*)(vg + (size_t)(F.tid + NTHREADS * i) * 8); }
#pragma unroll
        for (int i = 0; i < 9; ++i) { *(LAS u32x4*)(lds + (cs * NA_KSTR + 64 * i + kk) * 16) = kv[i]; *(LAS u32x4*)(lds + NA_VOFF + (F.tid + NTHREADS * i) * 16) = vv[i]; }
        const float* relb = a.in[IN_RELB] + ((size_t)(layer >> 1) * 16 + h) * 465;
        if (F.tid < 465) bl[F.tid] = relb[F.tid];
    }
    __syncthreads();
    const int r = ra + (F.wave >> 2), j = F.wave & 3, qi = F.lane & 15, g = F.lane >> 4, c = 16 * j + qi;
    const int r0 = min(max(r - 4, 0), 24), d = r0 - r0a, c0 = min(max(c - 8, 0), 48), cb = (j == 0) ? 0 : (j == 1) ? 8 : (j == 2) ? 24 : 32;
    const float LOG2E = 1.4426950408889634f;
    const bf16_t* qp = Qc + (bh * SEQ + r * 64 + c) * 64 + 8 * g;
    const bf16x8 qf0 = *(const bf16x8*)qp, qf1 = *(const bf16x8*)(qp + 32);
    const int kx = 8 * (qi >> 2) + (qi & 3);
    const LAS char* kbase = lds + ((g * NA_KSTR) + d * 64 + cb + kx) * 16;
    f32x4 S[8][2];
#pragma unroll
    for (int i = 0; i < 8; ++i)
#pragma unroll
        for (int xb = 0; xb < 2; ++xb) { const LAS char* kp = kbase + (i * 64 + 4 * xb) * 16;
            const bf16x8 kf0 = *(const LAS bf16x8*)kp, kf1 = *(const LAS bf16x8*)(kp + 4 * NA_KSTR * 16);
            f32x4 z = (f32x4){0.f, 0.f, 0.f, 0.f};
            z = __builtin_amdgcn_mfma_f32_16x16x32_bf16(kf0, qf0, z, 0, 0, 0);
            z = __builtin_amdgcn_mfma_f32_16x16x32_bf16(kf1, qf1, z, 0, 0, 0);
            S[i][xb] = z; }
    float mx = -INFINITY;
#pragma unroll
    for (int i = 0; i < 8; ++i) { const LAS float* brow = bl + (r0 + i - r + 7) * 31;
#pragma unroll
        for (int xb = 0; xb < 2; ++xb)
#pragma unroll
            for (int t = 0; t < 4; ++t) { const int kc = cb + 8 * g + 4 * xb + t; const bool valid = (kc >= c0) && (kc < c0 + 16); const int co = min(max(kc - c + 15, 0), 30);
                const float v = valid ? (S[i][xb][t] * 0.125f + brow[co]) * LOG2E : -INFINITY; S[i][xb][t] = v; mx = fmaxf(mx, v); } }
    mx = fmaxf(mx, __shfl_xor(mx, 16)); mx = fmaxf(mx, __shfl_xor(mx, 32));
    float sum = 0.f; bf16x8 pf[8];
#pragma unroll
    for (int i = 0; i < 8; ++i) { float pv[8];
#pragma unroll
        for (int xb = 0; xb < 2; ++xb)
#pragma unroll
            for (int t = 0; t < 4; ++t) { const float p = __builtin_amdgcn_exp2f(S[i][xb][t] - mx); pv[xb * 4 + t] = p; sum += p; }
        const u32x4 w = pack8(pv); pf[i] = *(const bf16x8*)&w; }
    sum += __shfl_xor(sum, 16); sum += __shfl_xor(sum, 32);
    const float inv = 1.0f / sum;
    f32x4 acc[4];
    const LAS char* vbase = lds + NA_VOFF + ((d * 8 + (cb >> 3) + g) * 64 + qi) * 16;
#pragma unroll
    for (int dvb = 0; dvb < 4; ++dvb) { acc[dvb] = (f32x4){0.f, 0.f, 0.f, 0.f};
#pragma unroll
        for (int i = 0; i < 8; ++i) { const bf16x8 vf = *(const LAS bf16x8*)(vbase + (i * 8 * 64 + 16 * dvb) * 16);
            acc[dvb] = __builtin_amdgcn_mfma_f32_16x16x32_bf16(vf, pf[i], acc[dvb], 0, 0, 0); } }
    bf16_t* op = O + ((size_t)b * SEQ + r * 64 + c) * DM + h * 64 + 4 * g;
#pragma unroll
    for (int dvb = 0; dvb < 4; ++dvb) { u32x2 w; w.x = cvt_pk_bf16(acc[dvb][0] * inv, acc[dvb][1] * inv); w.y = cvt_pk_bf16(acc[dvb][2] * inv, acc[dvb][3] * inv); *(u32x2*)(op + 16 * dvb) = w; }
}

template <int PER> __device__ __forceinline__ int xcd_unit(int i, int c, int G, int nunits) {
    int u;
    if ((G & 7) == 0 && ((G >> 3) % PER) == 0) { const int gpx = (G >> 3) / PER, sl = c >> 3; u = (i * (G / PER) + (c & 7) * gpx + sl / PER) * PER + sl % PER; }
    else u = i * G + c;
    return u < nunits ? u : -1;
}

constexpr int LDS_BYTES = 160 * 1024;
constexpr int MISC_OFF = LDS_BYTES - 256;
static_assert(NA_BOFF + 2048 <= MISC_OFF, "neighbourhood attention LDS image");
constexpr int NPH_LAYER = 9, NPHASES = 1 + DEPTH * NPH_LAYER;

#define IN(k) (a.lo <= (k) && (k) < a.hi)
#define SEAM(k) do { if (IN(k) && IN((k) + 1)) { const Frame Fb = fresh(F); xcd_barrier(bar, Fb.tid); } } while (0)
template <int LAYER> __device__ __forceinline__ void layer_phases(const Frame& F, const Args& a, const XcdBarrier& bar) {
    constexpr int layer = LAYER;
        constexpr int p0 = 1 + layer * NPH_LAYER, j = layer >> 1; constexpr bool even = (layer & 1) == 0;
        if (IN(p0)) {
            const Frame Fp = fresh(F); const Args ap = fresh(a); unsigned char* w = ap.ws;
            REPEAT(1) phase_moe_weights(Fp, ap, layer);
            if constexpr (even) { g8::DenseSched S; S.init(w + WS_X, DM, (const bf16_t*)(w + WS_WIN) + (size_t)j * HLD * DM, DM, NTOK, HLD, Fp.G, Fp.bid); S.rep = 1 + ((REP_MASK >> 2) & 1);
                g8::EpiEvenIn E{(bf16_t*)(w + WS_R1), (bf16_t*)(w + WS_R2) + (size_t)NTOK * 1792, (float*)(w + WS_SSQ), (const float*)(w + WS_ROPEA), (const float*)(w + WS_ROPEB)}; g8::gemm_phase(Fp, DM, S, E); }
            else { g8::DenseSched S; S.init(w + WS_X, DM, (const bf16_t*)(w + WS_WQKV) + (size_t)j * 3072 * DM, DM, NTOK, 3072, Fp.G, Fp.bid); S.rep = 1 + ((REP_MASK >> 11) & 1);
#if NAIVE_NA
                g8::EpiPlain E{(bf16_t*)(w + WS_R1), 3072}; g8::gemm_phase(Fp, DM, S, E); }
#else
                g8::EpiQKV E{(bf16_t*)(w + WS_R1), (bf16_t*)(w + WS_R1) + (size_t)NTOK * DM, (bf16_t*)(w + WS_R1) + (size_t)2 * NTOK * DM}; g8::gemm_phase(Fp, DM, S, E); }
#endif
        }
        SEAM(p0);
        if constexpr (even) if (IN(p0 + 1)) REPEAT(3) {
            const Frame Fp = fresh(F); const Args ap = fresh(a); unsigned char* w = ap.ws;
            { g8::DenseSched S; S.init((bf16_t*)(w + WS_R1) + 1536, HLD, (const bf16_t*)(w + WS_WUQ) + (size_t)j * 768 * 256, 256, NTOK, 768, Fp.G, Fp.bid);
              g8::EpiMla<0> E{(bf16_t*)(w + WS_R2), (const float*)(w + WS_SSQ)}; g8::gemm_phase(Fp, 256, S, E); }
            const Frame Fq = fresh(F);
            { g8::DenseSched S; S.init((bf16_t*)(w + WS_R1) + 1792, HLD, (const bf16_t*)(w + WS_WUKV) + (size_t)j * 1024 * 256, 256, NTOK, 1024, Fq.G, Fq.bid);
              g8::EpiMla<1> E{(bf16_t*)(w + WS_R2) + (size_t)NTOK * 768, (const float*)(w + WS_SSQ)}; g8::gemm_phase(Fq, 256, S, E); }
        }
        SEAM(p0 + 1);
        if (IN(p0 + 2)) {
            const Frame Fp = fresh(F); const Args ap = fresh(a);
#if NAIVE_ATTN
            if (even) { for (int u = Fp.bid; u < NBATCH * 4 * 8; u += Fp.G) attn_diff_naive(Fp, ap, layer, u);
                        for (int u = Fp.bid; u < NBATCH * 8 * 4; u += Fp.G) attn_mla_naive(Fp, ap, u); }
#else
            if constexpr (even) REPEAT(4) { for (int i = 0, u; (u = xcd_unit<8>(i, Fp.bid, Fp.G, NBATCH * 4 * 8)) >= 0; ++i) attn_diff_mfma(Fp, ap, layer, u);
                        for (int i = 0, u; (u = xcd_unit<8>(i, Fp.bid, Fp.G, NBATCH * 8 * 8)) >= 0; ++i) attn_mla_mfma(Fp, ap, u); }
#endif
#if NAIVE_NA
            if (!even) { for (int u = Fp.bid; u < NBATCH * 32 * 2; u += Fp.G) attn_na_naive(Fp, ap, layer, u); }
#else
            if constexpr (!even) REPEAT(5) { for (int i = 0, u; (u = xcd_unit<16>(i, Fp.bid, Fp.G, NBATCH * 16 * 16)) >= 0; ++i) attn_na_lds(Fp, ap, layer, u); }
#endif
            __syncthreads();
        }
        SEAM(p0 + 2);
        if (IN(p0 + 3)) REPEAT(6) {
            const Frame Fp = fresh(F); const Args ap = fresh(a); unsigned char* w = ap.ws;
            g8::DenseSched S; S.init(w + WS_R3, DM, (const bf16_t*)(w + (even ? WS_WOE : WS_WOO)) + (size_t)j * DM * DM, DM, NTOK, DM, Fp.G, Fp.bid);
            g8::EpiResStats E{(const bf16_t*)(w + WS_X), (bf16_t*)(w + WS_R1), (f32x2*)(w + WS_R2)}; g8::gemm_phase(Fp, DM, S, E);
        }
        SEAM(p0 + 3);
        if (IN(p0 + 4)) REPEAT(12) { const Frame Fp = fresh(F); const Args ap = fresh(a); phase_ln1_router(Fp, ap, layer); }
        SEAM(p0 + 4);
        if (IN(p0 + 5)) { const Frame Fp = fresh(F); const Args ap = fresh(a); phase_scatter(Fp, ap); }
        SEAM(p0 + 5);
        if (IN(p0 + 6)) REPEAT(8) {
            const Frame Fp = fresh(F); const Args ap = fresh(a); unsigned char* w = ap.ws;
            g8::MoeSched<true> S; S.A = (const char*)(w + WS_X); S.Wt = (const char*)(w + WS_W13); S.tile = (const int*)(w + WS_TILE); S.slot_tok = (const int*)(w + WS_SLOT_TOK);
            S.lda2 = DM * 2; S.K2 = DM * 2; S.wstride = (size_t)1024 * 1024 * 2; S.T = S.tile[0]; S.G = Fp.G; S.c = Fp.bid;
            g8::EpiMoe1 E{(bf16_t*)(w + WS_R1)}; g8::gemm_phase(Fp, DM, S, E);
        }
        SEAM(p0 + 6);
        if (IN(p0 + 7)) REPEAT(9) {
            const Frame Fp = fresh(F); const Args ap = fresh(a); unsigned char* w = ap.ws;
            g8::MoeSched<false> S; S.A = (const char*)(w + WS_R1); S.Wt = (const char*)(w + WS_W2); S.tile = (const int*)(w + WS_TILE); S.slot_tok = (const int*)(w + WS_SLOT_TOK);
            S.lda2 = DEXP * 2; S.K2 = DEXP * 2; S.wstride = (size_t)1024 * 512 * 2; S.T = S.tile[0]; S.G = Fp.G; S.c = Fp.bid;
            g8::EpiPlain E{(bf16_t*)(w + WS_R2), DM}; g8::gemm_phase(Fp, DEXP, S, E);
        }
        SEAM(p0 + 7);
        if (IN(p0 + 8)) { const Frame Fp = fresh(F); const Args ap = fresh(a);
            if constexpr (((REP_MASK >> 13) & 1) != 0) { phase_ln2(Fp, ap, layer, false, true); __syncthreads(); }
            phase_ln2(Fp, ap, layer, layer == DEPTH - 1); }
        SEAM(p0 + 8);
    }
#undef IN
#undef SEAM

__global__ void __launch_bounds__(NTHREADS, 2) fwd_kernel(Args a) {
    extern __shared__ __attribute__((aligned(16))) unsigned char lds_raw[];
    Frame F; F.lds = (LAS unsigned char*)lds_raw; F.wave = __builtin_amdgcn_readfirstlane((int)threadIdx.x >> 6); F.tid = 0; F.lane = 0; F.G = gridDim.x; F.bid = blockIdx.x;
    unsigned char* ws = a.ws;
    volatile LAS unsigned* MISC = (volatile LAS unsigned*)(F.lds + MISC_OFF);
    { const Frame Fp = fresh(F); if (Fp.tid < 4) MISC[Fp.tid] = 0u; }
    __syncthreads();
    const bool one = (a.hi - a.lo) > 1;
    XcdBarrier bar; bar.bar = (unsigned*)(ws + WS_CTL); bar.x = 0; bar.st = MISC;
    if (one) { const Frame Fp = fresh(F); bar = xcd_barrier_post((unsigned*)(ws + WS_CTL), MISC, Fp.tid); }
#define IN(k) (a.lo <= (k) && (k) < a.hi)
#define SEAM(k) do { if (IN(k) && IN((k) + 1)) { const Frame Fb = fresh(F); xcd_barrier(bar, Fb.tid); } } while (0)

    if (IN(0)) REPEAT(0) { const Frame Fp = fresh(F); const Args ap = fresh(a); phase_prologue(Fp, ap); }
    SEAM(0);
    if constexpr (((REP_MASK >> 14) & 1) != 0) { if (one) for (int xb_ = 0; xb_ < 100; ++xb_) { const Frame Fb = fresh(F); xcd_barrier(bar, Fb.tid); } }
    layer_phases<0>(F, a, bar); layer_phases<1>(F, a, bar); layer_phases<2>(F, a, bar); layer_phases<3>(F, a, bar);
#undef IN
#undef SEAM
}

extern "C" void kernel_launch(void* const* d_in, const int* in_sizes, int n_in, void* d_out, int out_size, void* d_ws, size_t ws_size, hipStream_t stream) {
    static int grid = 0;
    if (grid == 0) {
        if (n_in != 26 || in_sizes[0] != NTOK * DM || out_size != NTOK * DM || ws_size < WS_END) {
            fprintf(stderr, "kernel_launch: unexpected shapes / workspace (n_in %d, in0 %d, out %d, ws %zu, need %zu)\n", n_in, n_in > 0 ? in_sizes[0] : -1, out_size, ws_size, (size_t)WS_END); grid = -1; return; }
        int dev = 0, cus = 0, per_cu = 0;
        if (hipGetDevice(&dev) != hipSuccess || hipDeviceGetAttribute(&cus, hipDeviceAttributeMultiprocessorCount, dev) != hipSuccess) { grid = -1; return; }
        if (hipFuncSetAttribute((const void*)fwd_kernel, hipFuncAttributeMaxDynamicSharedMemorySize, LDS_BYTES) != hipSuccess) { fprintf(stderr, "kernel_launch: hipFuncSetAttribute failed\n"); grid = -1; return; }
        if (hipOccupancyMaxActiveBlocksPerMultiprocessor(&per_cu, (const void*)fwd_kernel, NTHREADS, LDS_BYTES) != hipSuccess || per_cu < 1) fprintf(stderr, "kernel_launch: occupancy query reports %d\n", per_cu);
        (void)hipGetLastError();
        grid = cus;
    }
    if (grid < 0) return;
    (void)hipMemsetAsync((char*)d_ws + WS_CTL, 0, 64 * 1024, stream);
    Args a{};
    for (int i = 0; i < 26; ++i) a.in[i] = (const float*)d_in[i];
    a.out = (float*)d_out; a.ws = (unsigned char*)d_ws;
#if MK_ONE_LAUNCH
    a.lo = 0; a.hi = NPHASES;
    hipLaunchKernelGGL(fwd_kernel, dim3(grid), dim3(NTHREADS), LDS_BYTES, stream, a);
#else
    for (int p = 0; p < NPHASES; ++p) {
        if (p >= 1 && ((p - 1) % NPH_LAYER) == 1 && (((p - 1) / NPH_LAYER) & 1)) continue;
        a.lo = p; a.hi = p + 1;
        hipLaunchKernelGGL(fwd_kernel, dim3(grid), dim3(NTHREADS), LDS_BYTES, stream, a);
    }
#endif
}
```

```cpp
#include <hip/hip_runtime.h>
#include <cstdio>
#include <cstdint>

#ifndef NAIVE_ATTN
#define NAIVE_ATTN 0
#endif
#ifndef NAIVE_NA
#define NAIVE_NA 0
#endif
#ifndef REP_MASK
#define REP_MASK 0
#endif
#define REPEAT(k) _Pragma("unroll 1") for (int rep_ = 0; rep_ < 1 + ((REP_MASK >> (k)) & 1); ++rep_)
#ifndef MK_ONE_LAUNCH
#define MK_ONE_LAUNCH 1
#endif

typedef unsigned short bf16_t;
typedef short bf16x8 __attribute__((ext_vector_type(8)));
typedef float f32x4 __attribute__((ext_vector_type(4)));
typedef float f32x2 __attribute__((ext_vector_type(2)));
typedef unsigned u32x4 __attribute__((ext_vector_type(4)));
typedef unsigned u32x2 __attribute__((ext_vector_type(2)));
#define LAS __attribute__((address_space(3)))

constexpr int NTOK = 65536, DM = 1024, SEQ = 2048, NBATCH = 32, DEPTH = 4;
constexpr int EVEN_IN = 1952, HLD = 2048;
constexpr int NEXP = 32, DEXP = 512;
constexpr int MAXTILES = NTOK * 2 / 256 + NEXP;
constexpr int MAXSLOTS = MAXTILES * 256;
constexpr float DN_ALPHA = 1.681792830507429f;
constexpr float LN_EPS = 1e-5f, RMS_EPS = 1e-6f;
constexpr int NTHREADS = 512;

constexpr size_t MiB = 1024ull * 1024ull;
constexpr size_t WS_CTL = 0;
constexpr size_t WS_LAM = 48 * 1024;
constexpr size_t WS_ROPEA = 64 * 1024;
constexpr size_t WS_ROPEB = WS_ROPEA + 128 * 1024;
constexpr size_t WS_WR = WS_ROPEB + 256 * 1024;
constexpr size_t WS_ROUTE = WS_WR + 832 * 1024;
constexpr size_t WS_CNT = WS_ROUTE + 1 * MiB;
constexpr size_t WS_TILE = WS_CNT + 32 * 1024;
constexpr size_t WS_SLOT_TOK = WS_TILE + 4 * 1024;
constexpr size_t WS_SLOT_G = WS_SLOT_TOK + 576 * 1024;
constexpr size_t WS_SLOT_DST = WS_SLOT_G + 576 * 1024;
constexpr size_t WS_SSQ = WS_SLOT_DST + 576 * 1024;
constexpr size_t WS_WIN = 6 * MiB;
constexpr size_t WS_WUQ = WS_WIN + 8 * MiB;
constexpr size_t WS_WUKV = WS_WUQ + 1 * MiB;
constexpr size_t WS_WOE = WS_WUKV + 1 * MiB;
constexpr size_t WS_WQKV = WS_WOE + 4 * MiB;
constexpr size_t WS_WOO = WS_WQKV + 12 * MiB;
constexpr size_t WS_W13 = 36 * MiB;
constexpr size_t WS_W2 = WS_W13 + 64 * MiB;
constexpr size_t WS_X = WS_W2 + 32 * MiB;
constexpr size_t WS_R1 = WS_X + 128 * MiB;
constexpr size_t WS_R2 = WS_R1 + 384 * MiB;
constexpr size_t WS_R3 = WS_R2 + 228 * MiB;
constexpr size_t WS_END = WS_R3 + 128 * MiB;
static_assert(WS_SSQ + 2 * MiB <= WS_WIN, "misc region");
static_assert(WS_WOO + 4 * MiB <= WS_W13, "small weights region");

__device__ __forceinline__ unsigned cvt_pk_bf16(float lo, float hi) { unsigned r; asm volatile("v_cvt_pk_bf16_f32 %0, %1, %2" : "=v"(r) : "v"(lo), "v"(hi)); return r; }
__device__ __forceinline__ float bf_lo(unsigned w) { return __uint_as_float(w << 16); }
__device__ __forceinline__ float bf_hi(unsigned w) { return __uint_as_float(w & 0xffff0000u); }
__device__ __forceinline__ float bf2f(bf16_t b) { return __uint_as_float(((unsigned)b) << 16); }
__device__ __forceinline__ void unpack8(const u32x4 w, float (&f)[8]) {
    f[0] = bf_lo(w.x); f[1] = bf_hi(w.x); f[2] = bf_lo(w.y); f[3] = bf_hi(w.y); f[4] = bf_lo(w.z); f[5] = bf_hi(w.z); f[6] = bf_lo(w.w); f[7] = bf_hi(w.w); }
__device__ __forceinline__ u32x4 pack8(const float (&f)[8]) { u32x4 w; w.x = cvt_pk_bf16(f[0], f[1]); w.y = cvt_pk_bf16(f[2], f[3]); w.z = cvt_pk_bf16(f[4], f[5]); w.w = cvt_pk_bf16(f[6], f[7]); return w; }
__device__ __forceinline__ float wave_sum(float v) {
#pragma unroll
    for (int o = 32; o >= 1; o >>= 1) v += __shfl_xor(v, o);
    return v; }

struct Frame { LAS unsigned char* lds; int tid, lane, wave, G, bid; };
#define XB_TMO      128
#define XB_XCNT(j)  (256  + 64 * (j))
#define XB_XSUB(j)  (1280 + 64 * (j))
#define XB_XGEN(j)  (2304 + 64 * (j))
#define XB_TOP      3328
#define XB_TOPGEN   3392
#define XCD_BAR_WORDS 3456
#define XB_SPIN_CAP (1u << 21)
__device__ __forceinline__ unsigned xb_ld(unsigned* p)              { return __hip_atomic_load(p, __ATOMIC_RELAXED, __HIP_MEMORY_SCOPE_AGENT); }
__device__ __forceinline__ unsigned xb_add(unsigned* p, unsigned v) { return __hip_atomic_fetch_add(p, v, __ATOMIC_RELAXED, __HIP_MEMORY_SCOPE_AGENT); }
__device__ __forceinline__ unsigned xb_xcc_id() { return (unsigned)__builtin_amdgcn_s_getreg((3 << 11) | 20) & 0xFu; }
#define XB_SPIN(cond, bar) do { unsigned _sp = 0; while (cond) { __builtin_amdgcn_s_sleep(1); \
    if ((++_sp & 255u) == 0u) { if (xb_ld(&(bar)[XB_TMO])) break; if (_sp > XB_SPIN_CAP) { atomicAdd(&(bar)[XB_TMO], 1u); break; } } } } while (0)
struct XcdBarrier { unsigned* bar; unsigned x; volatile LAS unsigned* st; };
__device__ __forceinline__ XcdBarrier xcd_barrier_post(unsigned* bar, volatile LAS unsigned* st, int tid) {
    XcdBarrier b; b.bar = bar; b.x = xb_xcc_id(); b.st = st;
    if (tid == 0) (void)xb_add(&bar[XB_XCNT(b.x)], 1u);
    return b;
}
__device__ __forceinline__ void xcd_barrier_complete(unsigned* bar, unsigned x, unsigned& nloc, unsigned& nx) {
    const unsigned G = gridDim.x * gridDim.y * gridDim.z;
    unsigned sum, cnt, mine, sp = 0u;
    for (;;) {
        sum = 0u; cnt = 0u; mine = 0u;
#pragma unroll
        for (unsigned j = 0; j < 16; ++j) { const unsigned c = xb_ld(&bar[XB_XCNT(j)]); sum += c; cnt += (c > 0u) ? 1u : 0u; mine = (j == x) ? c : mine; }
        if (sum == G) break;
        __builtin_amdgcn_s_sleep(1);
        if ((++sp & 255u) == 0u) { if (xb_ld(&bar[XB_TMO])) break; if (sp > XB_SPIN_CAP) { atomicAdd(&bar[XB_TMO], 1u); break; } }
    }
    nloc = mine > 0u ? mine : 1u; nx = cnt > 0u ? cnt : 1u;
}
__device__ __forceinline__ void xcd_barrier(const XcdBarrier& b, int tid) {
    asm volatile("s_waitcnt vmcnt(0)" ::: "memory");
    __syncthreads();
    if (tid == 0) {
        unsigned* bar = b.bar; unsigned bx = b.x; asm volatile("" : "+s"(bx));
        __builtin_amdgcn_s_waitcnt(0);
        unsigned nloc = b.st[0], nx = b.st[1];
        if (nloc == 0u) { xcd_barrier_complete(bar, bx, nloc, nx); b.st[0] = nloc; b.st[1] = nx; }
        const unsigned old = xb_add(&bar[XB_XSUB(bx)], 1u);
        const unsigned gen = old / nloc;
        if (old + 1u == (gen + 1u) * nloc) {
            __builtin_amdgcn_fence(__ATOMIC_RELEASE, "agent");
            asm volatile("s_waitcnt vmcnt(0)" ::: "memory");
            const unsigned og = xb_add(&bar[XB_TOP], 1u);
            const unsigned tg = og / nx;
            if (og + 1u == (tg + 1u) * nx) xb_add(&bar[XB_TOPGEN], 1u);
            else XB_SPIN(xb_ld(&bar[XB_TOPGEN]) == tg, bar);
            __builtin_amdgcn_fence(__ATOMIC_ACQUIRE, "agent");
            xb_add(&bar[XB_XGEN(bx)], 1u);
            asm volatile("s_waitcnt vmcnt(0)" ::: "memory");
        } else {
            XB_SPIN(xb_ld(&bar[XB_XGEN(bx)]) == gen, bar);
            __builtin_amdgcn_fence(__ATOMIC_ACQUIRE, "agent");
            asm volatile("s_waitcnt vmcnt(0)" ::: "memory");
        }
    }
    __syncthreads();
}

namespace g8 {
constexpr int BM = 256, BK = 64, HALF = 128, HTB = HALF * BK * 2, STAGE_BYTES = 8 * HTB, NXCD = 8, WGM = 8;
__device__ __forceinline__ int lds_byte(int r, int c) { const int st = (r >> 4) * 2 + (c >> 5), rr = r & 15, cc = c & 31, ob = rr * 64 + cc * 2; return st * 1024 + (ob ^ (((ob >> 9) & 1) << 5)); }
__device__ __forceinline__ void stage_rc(int b, int& R, int& C) { const int st = b / 1024, sb = b % 1024, swz = sb ^ (((sb >> 9) & 1) << 5); R = (st >> 1) * 16 + swz / 64; C = (st & 1) * 32 + (swz % 64) / 2; }
__device__ __forceinline__ int perm32(int rho) { const int n = rho >> 4, i = rho & 15; return 8 * (i >> 2) + 4 * n + (i & 3); }

struct Unit { const char* A; const char* B; int row0, pm, pn, e; };
typedef f32x4 Acc[2][2][4][2];

struct DenseSched {
    const char* A; const char* Bt; unsigned lda2; int K2; int nM, nN, nwg, G, c; int rep = 1;
    __device__ __forceinline__ void init(const void* A_, int lda, const void* Bt_, int K, int M, int N, int G_, int c_) { A = (const char*)A_; Bt = (const char*)Bt_; lda2 = (unsigned)lda * 2u; K2 = K * 2; nM = M / BM; nN = N / BM; nwg = nM * nN; G = G_; c = c_; }
    __device__ __forceinline__ bool next(int i, Unit& u) const {
        long L = (long)i * G + c; if (L >= (long)nwg * rep) return false;
        if (rep > 1) L %= nwg;
        int wgid = (int)L; { const int q = nwg / NXCD, r = nwg % NXCD, xcd = wgid % NXCD, off = wgid / NXCD; wgid = (xcd < r ? xcd * (q + 1) : r * (q + 1) + (xcd - r) * q) + off; }
        const int nig = WGM * nN, gid = wgid / nig, fm = gid * WGM, gsz = (nM - fm) < WGM ? (nM - fm) : WGM;
        u.pm = fm + ((wgid % nig) % gsz); u.pn = (wgid % nig) / gsz; u.row0 = u.pm * BM; u.e = 0;
        u.A = A + (size_t)u.row0 * lda2; u.B = Bt + (size_t)u.pn * BM * K2; return true;
    }
    static constexpr bool GATHER = false;
    __device__ __forceinline__ unsigned rowoff(const Unit&, int r) const { return (unsigned)r * lda2; }
};
template <bool GATHER_> struct MoeSched {
    const char* A; const char* Wt; const int* tile; const int* slot_tok; unsigned lda2; int K2; size_t wstride; int T, G, c;
    __device__ __forceinline__ bool next(int i, Unit& u) const {
        int t, pnn;
        if ((G & 31) == 0) { const int x = c & 7, sl = c >> 3, per = G >> 5; t = i * (G >> 2) + x * per + (sl >> 2); pnn = sl & 3; }
        else { const int L = i * G + c; t = L >> 2; pnn = L & 3; }
        if (t >= T) return false;
        u.pn = pnn; u.pm = t; u.row0 = t * BM; u.e = tile[1 + t];
        u.A = GATHER_ ? A : A + (size_t)u.row0 * lda2; u.B = Wt + (size_t)u.e * wstride + (size_t)u.pn * BM * K2; return true;
    }
    static constexpr bool GATHER = GATHER_;
    __device__ __forceinline__ unsigned rowoff(const Unit& u, int r) const { return GATHER_ ? (unsigned)slot_tok[u.row0 + r] * lda2 : (unsigned)r * lda2; }
};

template <class Epi, class Sched>
__device__ __forceinline__ void gemm_phase(const Frame& F, const int K_, const Sched& S, const Epi& E) {
    LAS unsigned char* lds = F.lds;
    int K = K_; asm volatile("" : "+s"(K));
    const int tid = F.tid, wid = __builtin_amdgcn_readfirstlane(tid >> 6), lane = tid & 63, wr = wid >> 2, wc = wid & 3, fr = lane & 15, fq = lane >> 4;
    const int nt = K / BK;
    int RA[2]; unsigned CA[2], voffB[2];
#pragma unroll
    for (int i = 0; i < 2; ++i) { int R, C; stage_rc(tid * 16 + i * 8192, R, C); const int Rb = (R & ~31) + perm32(R & 31);
        RA[i] = R; CA[i] = (unsigned)C * 2u; voffB[i] = (unsigned)(Rb * K + C) * 2u; }
    const size_t kstep = (size_t)(BK * 2);
    const size_t hstepB = (size_t)HALF * K * 2;
    size_t hstepA = 0; if constexpr (!Sched::GATHER) hstepA = (size_t)S.rowoff(Unit{}, HALF);
    const unsigned ldsw = (unsigned)wid * 1024u;
    const int aoff = lds_byte(wr * 64 + fr, fq * 8), boff = lds_byte(wc * 32 + fr, fq * 8);
#define G8_SA(b, h) (((b) * 2 + (h)) * HTB)
#define G8_SB(b, h) ((4 + (b) * 2 + (h)) * HTB)
#define G8_STAGE(bufoff, gbase, voff) do { _Pragma("unroll") for (int _i = 0; _i < 2; ++_i) \
        __builtin_amdgcn_global_load_lds((const unsigned*)((const char*)(gbase) + (voff)[_i]), (LAS unsigned*)(lds + (bufoff) + ldsw + _i * 8192), 16, 0, 0); } while (0)
#define G8_STA(bufoff, gbase, h, V0, V1) do { if constexpr (Sched::GATHER) { if (h) G8_STAGE(bufoff, gbase, V1); else G8_STAGE(bufoff, gbase, V0); } else { G8_STAGE(bufoff, (gbase) + (h) * hstepA, vA0); } } while (0)
#define G8_LDA(dst, b, h) do { _Pragma("unroll") for (int m = 0; m < 4; ++m) _Pragma("unroll") for (int k = 0; k < 2; ++k) dst[m][k] = *(const LAS bf16x8*)(lds + G8_SA(b, h) + aoff + m * 2048 + k * 1024); } while (0)
#define G8_LDB(dst, b, h) do { _Pragma("unroll") for (int n = 0; n < 2; ++n) _Pragma("unroll") for (int k = 0; k < 2; ++k) dst[n][k] = *(const LAS bf16x8*)(lds + G8_SB(b, h) + boff + n * 2048 + k * 1024); } while (0)
#define G8_MMA(ai, bj, At, Bt) do { __builtin_amdgcn_s_setprio(1); _Pragma("unroll") for (int m = 0; m < 4; ++m) _Pragma("unroll") for (int n = 0; n < 2; ++n) _Pragma("unroll") for (int k = 0; k < 2; ++k) \
        acc[ai][bj][m][n] = __builtin_amdgcn_mfma_f32_16x16x32_bf16(Bt[n][k], At[m][k], acc[ai][bj][m][n], 0, 0, 0); __builtin_amdgcn_s_setprio(0); } while (0)
#define G8_WAIT_V(n) asm volatile("s_waitcnt vmcnt(" #n ")" ::: "memory")
#define G8_WAIT_L(n) asm volatile("s_waitcnt lgkmcnt(" #n ")" ::: "memory")
#define G8_BAR __builtin_amdgcn_s_barrier()
#define G8_SCHED __builtin_amdgcn_sched_barrier(0)
    Unit cur, nxt; int ui = 0;
    if (!S.next(0, cur)) return;
    Acc acc;
#pragma unroll
    for (int a = 0; a < 2; ++a)
#pragma unroll
        for (int b = 0; b < 2; ++b)
#pragma unroll
            for (int m = 0; m < 4; ++m)
#pragma unroll
                for (int n = 0; n < 2; ++n) acc[a][b][m][n] = (f32x4){0.f, 0.f, 0.f, 0.f};
    bf16x8 At[4][2], B0[2][2], B1[2][2];
    unsigned vA0[2], vA1[2], nA0[2], nA1[2];
#pragma unroll
    for (int i = 0; i < 2; ++i) { vA0[i] = S.rowoff(cur, RA[i]) + CA[i]; vA1[i] = S.rowoff(cur, HALF + RA[i]) + CA[i]; }
    const char* cA = cur.A; const char* cB = cur.B;
    G8_STAGE(G8_SB(0, 0), cB, voffB); G8_STA(G8_SA(0, 0), cA, 0, vA0, vA1); G8_STAGE(G8_SB(0, 1), cB + hstepB, voffB); G8_STA(G8_SA(0, 1), cA, 1, vA0, vA1);
    if (wr == 1) G8_BAR;
    G8_WAIT_V(4); G8_BAR;
    G8_STAGE(G8_SB(1, 0), cB + kstep, voffB); G8_STA(G8_SA(1, 0), cA + kstep, 0, vA0, vA1); G8_STAGE(G8_SB(1, 1), cB + hstepB + kstep, voffB);
    G8_WAIT_V(6); G8_BAR;
    for (;;) {
        const bool has_next = S.next(ui + 1, nxt);
        const char* nAp = has_next ? nxt.A : cA; const char* nBp = has_next ? nxt.B : cB;
#pragma unroll
        for (int i = 0; i < 2; ++i) { nA0[i] = has_next ? S.rowoff(nxt, RA[i]) + CA[i] : vA0[i]; nA1[i] = has_next ? S.rowoff(nxt, HALF + RA[i]) + CA[i] : vA1[i]; }
        for (int t = 0; t < nt; t += 2) {
            const bool last = (t == nt - 2);
            const char* a1 = cA + (size_t)(t + 1) * kstep;
            const char* a2 = last ? nAp : cA + (size_t)(t + 2) * kstep; const char* b2 = last ? nBp : cB + (size_t)(t + 2) * kstep;
            const char* a3 = a2 + kstep; const char* b3 = b2 + kstep;
            unsigned w0[2], w1[2];
#pragma unroll
            for (int i = 0; i < 2; ++i) { w0[i] = last ? nA0[i] : vA0[i]; w1[i] = last ? nA1[i] : vA1[i]; }
            G8_LDB(B0, 0, 0); G8_SCHED; G8_LDA(At, 0, 0); G8_STA(G8_SA(1, 1), a1, 1, vA0, vA1);
            G8_WAIT_L(8); G8_BAR; G8_WAIT_L(0); G8_MMA(0, 0, At, B0); G8_BAR; G8_SCHED;
            G8_LDB(B1, 0, 1); G8_STAGE(G8_SB(0, 0), b2, voffB);
            G8_BAR; G8_WAIT_L(0); G8_MMA(0, 1, At, B1); G8_BAR;
            G8_LDA(At, 0, 1); G8_STA(G8_SA(0, 0), a2, 0, w0, w1);
            G8_BAR; G8_WAIT_L(0); G8_MMA(1, 0, At, B0); G8_BAR; G8_SCHED;
            G8_STAGE(G8_SB(0, 1), b2 + hstepB, voffB);
            G8_WAIT_V(6); G8_BAR; G8_MMA(1, 1, At, B1); G8_BAR;
            G8_LDB(B0, 1, 0); G8_SCHED; G8_LDA(At, 1, 0); G8_STA(G8_SA(0, 1), a2, 1, w0, w1);
            G8_WAIT_L(8); G8_BAR; G8_WAIT_L(0); G8_MMA(0, 0, At, B0); G8_BAR; G8_SCHED;
            G8_LDB(B1, 1, 1); G8_STAGE(G8_SB(1, 0), b3, voffB);
            G8_BAR; G8_WAIT_L(0); G8_MMA(0, 1, At, B1); G8_BAR;
            G8_LDA(At, 1, 1); G8_STA(G8_SA(1, 0), a3, 0, w0, w1);
            G8_BAR; G8_WAIT_L(0); G8_MMA(1, 0, At, B0); G8_BAR; G8_SCHED;
            G8_STAGE(G8_SB(1, 1), b3 + hstepB, voffB);
            G8_WAIT_V(6); G8_BAR; G8_MMA(1, 1, At, B1); G8_BAR;
        }
        E(acc, cur, wr, wc, fr, fq);
        if (!has_next) break;
#pragma unroll
        for (int a = 0; a < 2; ++a)
#pragma unroll
            for (int b = 0; b < 2; ++b)
#pragma unroll
                for (int m = 0; m < 4; ++m)
#pragma unroll
                    for (int n = 0; n < 2; ++n) acc[a][b][m][n] = (f32x4){0.f, 0.f, 0.f, 0.f};
        cur = nxt; cA = nAp; cB = nBp; ++ui;
#pragma unroll
        for (int i = 0; i < 2; ++i) { vA0[i] = nA0[i]; vA1[i] = nA1[i]; }
    }
    G8_WAIT_V(0);
    if (wr == 0) G8_BAR;
    G8_BAR;
#undef G8_SA
#undef G8_SB
#undef G8_STAGE
#undef G8_STA
#undef G8_LDA
#undef G8_LDB
#undef G8_MMA
#undef G8_WAIT_V
#undef G8_WAIT_L
#undef G8_BAR
#undef G8_SCHED
}

__device__ __forceinline__ u32x4 pack_acc8(const f32x4 v0, const f32x4 v1) { u32x4 w; w.x = cvt_pk_bf16(v0[0], v0[1]); w.y = cvt_pk_bf16(v0[2], v0[3]); w.z = cvt_pk_bf16(v1[0], v1[1]); w.w = cvt_pk_bf16(v1[2], v1[3]); return w; }

struct EpiPlain {
    bf16_t* O; int ldc;
    __device__ __forceinline__ void operator()(Acc& acc, const Unit& u, int wr, int wc, int fr, int fq) const {
        const int row0 = u.pm * BM + wr * 64 + fr, col0 = u.pn * BM + wc * 32 + 8 * fq;
#pragma unroll
        for (int ai = 0; ai < 2; ++ai)
#pragma unroll
            for (int m = 0; m < 4; ++m) { bf16_t* rowp = O + (size_t)(row0 + ai * HALF + m * 16) * ldc + col0;
#pragma unroll
                for (int bj = 0; bj < 2; ++bj) *(u32x4*)(rowp + bj * HALF) = pack_acc8(acc[ai][bj][m][0], acc[ai][bj][m][1]); }
    }
};

struct EpiQKV {
    bf16_t* Qc; bf16_t* Kc; bf16_t* Vt;
    __device__ __forceinline__ void operator()(Acc& acc, const Unit& u, int wr, int wc, int fr, int fq) const {
        const int which = u.pn >> 2, tok0 = u.pm * BM + wr * 64 + fr;
        const int b = tok0 >> 11;
#pragma unroll
        for (int ai = 0; ai < 2; ++ai)
#pragma unroll
            for (int m = 0; m < 4; ++m) { const int s = (tok0 + ai * HALF + m * 16) & (SEQ - 1);
#pragma unroll
                for (int bj = 0; bj < 2; ++bj) { const int h = (u.pn & 3) * 4 + 2 * bj + (wc >> 1), d0 = (wc & 1) * 32 + 8 * fq;
                    if (which < 2) { bf16_t* dst = (which == 0 ? Qc : Kc) + ((size_t)(b * 16 + h) * SEQ + s) * 64 + d0;
                        *(u32x4*)dst = pack_acc8(acc[ai][bj][m][0], acc[ai][bj][m][1]); }
                    else { bf16_t* dst = Vt + (((size_t)(b * 16 + h) * (SEQ / 8) + (s >> 3)) * 64 + d0) * 8 + (s & 7);
#pragma unroll
                        for (int n = 0; n < 2; ++n)
#pragma unroll
                            for (int jj = 0; jj < 4; ++jj) dst[(4 * n + jj) * 8] = (bf16_t)(cvt_pk_bf16(acc[ai][bj][m][n][jj], 0.f) & 0xffffu); } } }
    }
};

struct EpiResStats {
    const bf16_t* X; bf16_t* Yb; f32x2* stats;
    __device__ __forceinline__ void operator()(Acc& acc, const Unit& u, int wr, int wc, int fr, int fq) const {
        const int row0 = u.pm * BM + wr * 64 + fr, col0 = u.pn * BM + wc * 32 + 8 * fq;
#pragma unroll
        for (int ai = 0; ai < 2; ++ai)
#pragma unroll
            for (int m = 0; m < 4; ++m) { const int row = row0 + ai * HALF + m * 16; const size_t off = (size_t)row * DM + col0; float s1 = 0.f, s2 = 0.f;
#pragma unroll
                for (int bj = 0; bj < 2; ++bj) { float xv[8]; unpack8(*(const u32x4*)(X + off + bj * HALF), xv); f32x4 v[2];
#pragma unroll
                    for (int n = 0; n < 2; ++n)
#pragma unroll
                        for (int j = 0; j < 4; ++j) { const float y = DN_ALPHA * xv[4 * n + j] + acc[ai][bj][m][n][j]; v[n][j] = y; s1 += y; s2 += y * y; }
                    *(u32x4*)(Yb + off + bj * HALF) = pack_acc8(v[0], v[1]); }
                s1 += __shfl_xor(s1, 16); s1 += __shfl_xor(s1, 32); s2 += __shfl_xor(s2, 16); s2 += __shfl_xor(s2, 32);
                if (fq == 0) stats[(size_t)row * 16 + u.pn * 4 + wc] = (f32x2){s1, s2};
                asm volatile("" ::: "memory"); }
    }
};

struct EpiEvenIn {
    bf16_t* H; bf16_t* KR; float* ssq; const float* ropeA; const float* ropeB;
    __device__ __forceinline__ void operator()(Acc& acc, const Unit& u, int wr, int wc, int fr, int fq) const {
        const int row0 = u.pm * BM + wr * 64 + fr, col0 = u.pn * BM + wc * 32 + 8 * fq;
        if (u.pn < 4 && (wc & 1) == 0) {
#pragma unroll
            for (int ai = 0; ai < 2; ++ai)
#pragma unroll
                for (int m = 0; m < 4; ++m) { const int pos = (row0 + ai * HALF + m * 16) & (SEQ - 1);
                    const f32x4 c0 = *(const f32x4*)(ropeA + pos * 8), c1 = *(const f32x4*)(ropeA + pos * 8 + 4);
                    const f32x4 s0 = *(const f32x4*)(ropeA + SEQ * 8 + pos * 8), s1 = *(const f32x4*)(ropeA + SEQ * 8 + pos * 8 + 4);
#pragma unroll
                    for (int bj = 0; bj < 2; ++bj)
#pragma unroll
                        for (int n = 0; n < 2; ++n) { const f32x4 own = acc[ai][bj][m][n]; f32x4 oth;
#pragma unroll
                            for (int j = 0; j < 4; ++j) oth[j] = __shfl_xor(own[j], 16);
                            const f32x4 cs = n ? c1 : c0, sn = n ? s1 : s0;
                            if (fq == 0) acc[ai][bj][m][n] = own * cs - oth * sn;
                            else if (fq == 1) acc[ai][bj][m][n] = own * cs + oth * sn; } }
        }
        if (u.pn >= 6) {
#pragma unroll
            for (int ai = 0; ai < 2; ++ai)
#pragma unroll
                for (int m = 0; m < 4; ++m) { float s = 0.f;
#pragma unroll
                    for (int bj = 0; bj < 2; ++bj) if (u.pn == 6 || bj == 0)
#pragma unroll
                        for (int n = 0; n < 2; ++n) { const f32x4 x = acc[ai][bj][m][n]; s += (x[0] * x[0] + x[1] * x[1]) + (x[2] * x[2] + x[3] * x[3]); }
                    s += __shfl_xor(s, 16); s += __shfl_xor(s, 32);
                    if (fq == 0) ssq[(size_t)(row0 + ai * HALF + m * 16) * 8 + (u.pn == 6 ? 0 : 4) + wc] = s; }
        }
        if (u.pn == 7 && wc == 0) {
#pragma unroll
            for (int ai = 0; ai < 2; ++ai)
#pragma unroll
                for (int m = 0; m < 4; ++m) { const int row = row0 + ai * HALF + m * 16, pos = row & (SEQ - 1); f32x4 o[2];
#pragma unroll
                    for (int n = 0; n < 2; ++n) { const f32x4 own = acc[ai][1][m][n]; f32x4 oth;
#pragma unroll
                        for (int j = 0; j < 4; ++j) oth[j] = __shfl_xor(own[j], 32);
                        const int i0 = 8 * (fq & 1) + 4 * n;
                        const f32x4 cs = *(const f32x4*)(ropeB + pos * 16 + i0), sn = *(const f32x4*)(ropeB + SEQ * 16 + pos * 16 + i0);
                        o[n] = (fq < 2) ? own * cs - oth * sn : own * cs + oth * sn; }
                    *(u32x4*)(KR + (size_t)row * 32 + 8 * fq) = pack_acc8(o[0], o[1]); }
        }
#pragma unroll
        for (int ai = 0; ai < 2; ++ai)
#pragma unroll
            for (int m = 0; m < 4; ++m) { bf16_t* rowp = H + (size_t)(row0 + ai * HALF + m * 16) * HLD + col0;
#pragma unroll
                for (int bj = 0; bj < 2; ++bj) *(u32x4*)(rowp + bj * HALF) = pack_acc8(acc[ai][bj][m][0], acc[ai][bj][m][1]); }
    }
};

template <int MODE> struct EpiMla {
    bf16_t* O; const float* ssq;
    __device__ __forceinline__ void operator()(Acc& acc, const Unit& u, int wr, int wc, int fr, int fq) const {
        const int row0 = u.pm * BM + wr * 64 + fr, col0 = u.pn * BM + wc * 32 + 8 * fq;
        constexpr int ldc = MODE == 0 ? 768 : 1024;
#pragma unroll
        for (int ai = 0; ai < 2; ++ai)
#pragma unroll
            for (int m = 0; m < 4; ++m) { const int row = row0 + ai * HALF + m * 16;
                const f32x4 p = *(const f32x4*)(ssq + (size_t)row * 8 + (MODE == 0 ? 0 : 4));
                const float rstd = 1.0f / sqrtf(((p[0] + p[1]) + (p[2] + p[3])) * (MODE == 0 ? 1.0f / 256.0f : 1.0f / 128.0f) + RMS_EPS);
                bf16_t* rowp = O + (size_t)row * ldc + col0;
#pragma unroll
                for (int bj = 0; bj < 2; ++bj) *(u32x4*)(rowp + bj * HALF) = pack_acc8(acc[ai][bj][m][0] * rstd, acc[ai][bj][m][1] * rstd);
                asm volatile("" ::: "memory"); }
    }
};

struct EpiMoe1 {
    bf16_t* Hdn;
    __device__ __forceinline__ void operator()(Acc& acc, const Unit& u, int wr, int wc, int fr, int fq) const {
        const int row0 = u.row0 + wr * 64 + fr, col0 = u.pn * 128 + wc * 32 + 8 * fq;
#pragma unroll
        for (int ai = 0; ai < 2; ++ai)
#pragma unroll
            for (int m = 0; m < 4; ++m) { f32x4 h[2];
#pragma unroll
                for (int n = 0; n < 2; ++n)
#pragma unroll
                    for (int j = 0; j < 4; ++j) { const float g = acc[ai][0][m][n][j], up = acc[ai][1][m][n][j]; h[n][j] = g * __builtin_amdgcn_rcpf(1.0f + __builtin_amdgcn_exp2f(-1.4426950408889634f * g)) * up; }
                *(u32x4*)(Hdn + (size_t)(row0 + ai * HALF + m * 16) * DEXP + col0) = pack_acc8(h[0], h[1]); }
    }
};
struct EpiMoe2 {
    bf16_t* Y; const float* slot_g; const int* slot_dst;
    __device__ __forceinline__ void operator()(Acc& acc, const Unit& u, int wr, int wc, int fr, int fq) const {
        const int row0 = u.row0 + wr * 64 + fr, col0 = u.pn * BM + wc * 32 + 8 * fq;
#pragma unroll
        for (int ai = 0; ai < 2; ++ai)
#pragma unroll
            for (int m = 0; m < 4; ++m) { const int slot = row0 + ai * HALF + m * 16; const int dst = slot_dst[slot]; const float g = slot_g[slot];
                if (dst >= 0) { bf16_t* rowp = Y + (size_t)dst * DM + col0;
#pragma unroll
                    for (int bj = 0; bj < 2; ++bj) *(u32x4*)(rowp + bj * HALF) = pack_acc8(acc[ai][bj][m][0] * g, acc[ai][bj][m][1] * g); } }
    }
};
}

struct Args { const float* in[26]; float* out; unsigned char* ws; int lo, hi; };
enum { IN_X = 0, IN_EWIN, IN_LQ1, IN_LK1, IN_LQ2, IN_LK2, IN_SUBLN, IN_QNG, IN_WUQ, IN_KVNG, IN_WUKV, IN_EWO, IN_OWQKV, IN_RELB, IN_OWO,
       IN_LN1G, IN_LN1B, IN_LN2G, IN_LN2B, IN_WRG, IN_BRG, IN_WRE, IN_BRE, IN_WG, IN_WU, IN_WD };

__device__ __forceinline__ Frame fresh(const Frame& F) { Frame R = F; int wv = F.wave, g = F.G, b = F.bid; asm volatile("" : "+s"(wv), "+s"(g), "+s"(b));
    int ln = (int)__builtin_amdgcn_mbcnt_hi(~0u, __builtin_amdgcn_mbcnt_lo(~0u, 0u)); asm volatile("" : "+v"(ln));
    __builtin_assume(ln >= 0 && ln < 64); __builtin_assume(wv >= 0 && wv < NTHREADS / 64); __builtin_assume(g > 0 && g <= 1024); __builtin_assume(b >= 0 && b < g);
    R.tid = wv * 64 + ln; R.lane = ln; R.wave = wv; R.G = g; R.bid = b; return R; }
__device__ __forceinline__ Args fresh(const Args& a) { Args r = a; unsigned long long z = 0ull; asm volatile("" : "+s"(z)); r.ws = a.ws + z; return r; }

__device__ __forceinline__ void tr_tile(const Frame& F, const float* src, int ldsrc, int Kv, int Nv, int k0, int n0, bf16_t* dst, int lddst, int rowmap, const float* scale) {
    LAS float* T = (LAS float*)F.lds;
    __syncthreads();
#pragma unroll
    for (int it = 0; it < 8; ++it) { const int e = it * NTHREADS + F.tid, i = e >> 6, j = e & 63; const int k = k0 + i, n = n0 + j;
        float v = 0.f; if (k < Kv && n < Nv) { v = src[(size_t)k * ldsrc + n]; if (scale) v *= scale[k]; }
        T[i * 65 + j] = v; }
    __syncthreads();
    {
        const int j = F.tid >> 3, i0 = (F.tid & 7) * 8; float f[8];
#pragma unroll
        for (int q = 0; q < 8; ++q) f[q] = T[(i0 + q) * 65 + j];
        int n = n0 + j; if (rowmap) n = (n >> 7) * 256 + (n & 127) + (rowmap == 2 ? 128 : 0);
        *(u32x4*)(dst + (size_t)n * lddst + k0 + i0) = pack8(f); }
}
__device__ __forceinline__ void tr_matrix(const Frame& F, int& cursor, const float* src, int ldsrc, int Kv, int Nv, int Kp, int Np, bf16_t* dst, int lddst, int rowmap, const float* scale) {
    const int tk = Kp / 64, tn = Np / 64, ntile = tk * tn;
    int first = (F.bid - cursor % F.G + F.G) % F.G;
    for (int t = first; t < ntile; t += F.G) tr_tile(F, src, ldsrc, Kv, Nv, (t / tn) * 64, (t % tn) * 64, dst, lddst, rowmap, scale);
    cursor += ntile;
}

__device__ __forceinline__ void tr_big(const Frame& F, const float* src, int ldsrc, int k0, int n0, bf16_t* dst, int lddst, int rowmap) {
    LAS float* T = (LAS float*)F.lds;
    f32x4 v[8];
#pragma unroll
    for (int it = 0; it < 8; ++it) { const int idx = it * NTHREADS + F.tid, i = idx >> 6, c4 = idx & 63; v[it] = *(const f32x4*)(src + (size_t)(k0 + i) * ldsrc + n0 + 4 * c4); }
    __syncthreads();
#pragma unroll
    for (int it = 0; it < 8; ++it) { const int idx = it * NTHREADS + F.tid, i = idx >> 6, c4 = idx & 63; *(LAS f32x4*)(T + i * 260 + 4 * c4) = v[it]; }
    __syncthreads();
    const int nn = F.tid & 255, kh = F.tid >> 8;
    int n = n0 + nn; if (rowmap) n = (n >> 7) * 256 + (n & 127) + (rowmap == 2 ? 128 : 0);
    bf16_t* dp = dst + (size_t)n * lddst + k0 + 32 * kh;
#pragma unroll
    for (int sg = 0; sg < 4; ++sg) { float f[8];
#pragma unroll
        for (int q = 0; q < 8; ++q) f[q] = T[(32 * kh + 8 * sg + q) * 260 + nn];
        *(u32x4*)(dp + 8 * sg) = pack8(f); }
}
__device__ __forceinline__ void tr_matrix_big(const Frame& F, int& cursor, const float* src, int ldsrc, int K, int N, bf16_t* dst, int lddst, int rowmap) {
    const int tk = K / 64, tn = N / 256, ntile = tk * tn;
    const int first = (F.bid - cursor % F.G + F.G) % F.G;
    for (int t = first; t < ntile; t += F.G) tr_big(F, src, ldsrc, (t / tn) * 64, (t % tn) * 256, dst, lddst, rowmap);
    cursor += ntile;
}
__device__ __forceinline__ void phase_prologue(const Frame& F, const Args& a) {
    unsigned char* ws = a.ws;
    { const float* x = a.in[IN_X]; bf16_t* X = (bf16_t*)(ws + WS_X); const size_t n8 = (size_t)NTOK * DM / 8;
      for (size_t i = (size_t)F.bid * NTHREADS + F.tid; i < n8; i += (size_t)F.G * NTHREADS) { const f32x4 v0 = *(const f32x4*)(x + i * 8), v1 = *(const f32x4*)(x + i * 8 + 4); *(u32x4*)(X + i * 8) = g8::pack_acc8(v0, v1); } }
    { float* ra = (float*)(ws + WS_ROPEA); float* rb = (float*)(ws + WS_ROPEB);
      for (int i = F.bid * NTHREADS + F.tid; i < SEQ * 8; i += F.G * NTHREADS) { const int pos = i >> 3, f = i & 7; const float inv = powf(500000.0f, -(float)(2 * f) / 16.0f); const float ang = (float)pos * inv; ra[i] = cosf(ang); ra[SEQ * 8 + i] = sinf(ang); }
      for (int i = F.bid * NTHREADS + F.tid; i < SEQ * 16; i += F.G * NTHREADS) { const int pos = i >> 4, f = i & 15; const float inv = powf(500000.0f, -(float)(2 * f) / 32.0f); const float ang = (float)pos * inv; rb[i] = cosf(ang); rb[SEQ * 16 + i] = sinf(ang); } }
    { bf16_t* wr = (bf16_t*)(ws + WS_WR); const float* wrg = a.in[IN_WRG]; const float* wre = a.in[IN_WRE];
      for (int i = F.bid * NTHREADS + F.tid; i < DEPTH * 48 * DM; i += F.G * NTHREADS) { const int l = i / (48 * DM), r = i % (48 * DM), j = r / DM, k = r % DM;
          const float w = j < 4 ? wrg[((size_t)l * DM + k) * 4 + j] : j < 36 ? wre[((size_t)l * DM + k) * 32 + (j - 4)] : 0.f;
          const unsigned hi = cvt_pk_bf16(w, 0.f) & 0xffffu; const float rem = w - __uint_as_float(hi << 16);
          wr[(size_t)l * 2 * 48 * DM + r] = (bf16_t)hi; wr[(size_t)l * 2 * 48 * DM + 48 * DM + r] = (bf16_t)(cvt_pk_bf16(rem, 0.f) & 0xffffu); } }
    if (F.bid == 0 && F.tid < 2) { const int jl = F.tid; float d1 = 0.f, d2 = 0.f;
        for (int i = 0; i < 64; ++i) { d1 += a.in[IN_LQ1][jl * 64 + i] * a.in[IN_LK1][jl * 64 + i]; d2 += a.in[IN_LQ2][jl * 64 + i] * a.in[IN_LK2][jl * 64 + i]; }
        const float lambda_init = 0.8f - 0.6f * expf(-0.3f * (float)(2 * jl));
        ((float*)(ws + WS_LAM))[jl] = expf(d1) - expf(d2) + lambda_init; }
    int cur = 0;
    for (int l = 0; l < 2; ++l) {
        tr_matrix_big(F, cur, a.in[IN_EWIN] + (size_t)l * DM * EVEN_IN, EVEN_IN, DM, 1792, (bf16_t*)(ws + WS_WIN) + (size_t)l * HLD * DM, DM, 0);
        tr_matrix(F, cur, a.in[IN_EWIN] + (size_t)l * DM * EVEN_IN + 1792, EVEN_IN, DM, EVEN_IN - 1792, DM, HLD - 1792, (bf16_t*)(ws + WS_WIN) + (size_t)l * HLD * DM + (size_t)1792 * DM, DM, 0, nullptr);
        tr_matrix(F, cur, a.in[IN_WUQ] + (size_t)l * 256 * 768, 768, 256, 768, 256, 768, (bf16_t*)(ws + WS_WUQ) + (size_t)l * 768 * 256, 256, 0, a.in[IN_QNG] + l * 256);
        tr_matrix(F, cur, a.in[IN_WUKV] + (size_t)l * 128 * 1024, 1024, 128, 1024, 256, 1024, (bf16_t*)(ws + WS_WUKV) + (size_t)l * 1024 * 256, 256, 0, a.in[IN_KVNG] + l * 128);
        tr_matrix_big(F, cur, a.in[IN_EWO] + (size_t)l * DM * DM, DM, DM, DM, (bf16_t*)(ws + WS_WOE) + (size_t)l * DM * DM, DM, 0);
        tr_matrix_big(F, cur, a.in[IN_OWQKV] + (size_t)l * DM * 3072, 3072, DM, 3072, (bf16_t*)(ws + WS_WQKV) + (size_t)l * 3072 * DM, DM, 0);
        tr_matrix_big(F, cur, a.in[IN_OWO] + (size_t)l * DM * DM, DM, DM, DM, (bf16_t*)(ws + WS_WOO) + (size_t)l * DM * DM, DM, 0);
    }
    __syncthreads();
}
__device__ __forceinline__ void phase_moe_weights(const Frame& F, const Args& a, int layer) {
    unsigned char* ws = a.ws; int cur = 0;
    for (int e = 0; e < NEXP; ++e) {
        const size_t so = ((size_t)layer * NEXP + e) * DM * DEXP;
        tr_matrix_big(F, cur, a.in[IN_WG] + so, DEXP, DM, DEXP, (bf16_t*)(ws + WS_W13) + (size_t)e * 1024 * 1024, DM, 1);
        tr_matrix_big(F, cur, a.in[IN_WU] + so, DEXP, DM, DEXP, (bf16_t*)(ws + WS_W13) + (size_t)e * 1024 * 1024, DM, 2);
        tr_matrix_big(F, cur, a.in[IN_WD] + so, DM, DEXP, DM, (bf16_t*)(ws + WS_W2) + (size_t)e * 1024 * 512, DEXP, 0);
    }
    __syncthreads();
}

template <int MODE>
__device__ __forceinline__ void phase_ln(const Frame& F, const Args& a, int layer, bool last_layer) {
    unsigned char* ws = a.ws;
    bf16_t* X = (bf16_t*)(ws + WS_X);
    const bf16_t* Ra = MODE == 0 ? (const bf16_t*)(ws + WS_R1) : (const bf16_t*)(ws + WS_R2);
    const float* gam = a.in[MODE == 0 ? IN_LN1G : IN_LN2G] + layer * DM; const float* bet = a.in[MODE == 0 ? IN_LN1B : IN_LN2B] + layer * DM;
    const float* WR = (const float*)(ws + WS_WR) + (size_t)layer * 36 * DM;
    LAS int* hist = (LAS int*)F.lds;
    for (int chunk = F.bid; chunk < NTOK / 256; chunk += F.G) {
        if (MODE == 0) { __syncthreads(); if (F.tid < NEXP) hist[F.tid] = 0; __syncthreads(); }
        for (int rr = F.wave; rr < 256; rr += NTHREADS / 64) {
            const int row = chunk * 256 + rr; float y[16];
#pragma unroll
            for (int hh = 0; hh < 2; ++hh) { const int c = hh * 512 + F.lane * 8; float xv[8], rv[8];
                unpack8(*(const u32x4*)(X + (size_t)row * DM + c), xv);
                if (MODE == 0) unpack8(*(const u32x4*)(Ra + (size_t)row * DM + c), rv);
                else { float r0[8], r1[8]; unpack8(*(const u32x4*)(Ra + (size_t)row * 2 * DM + c), r0); unpack8(*(const u32x4*)(Ra + (size_t)row * 2 * DM + DM + c), r1);
#pragma unroll
                    for (int q = 0; q < 8; ++q) rv[q] = r0[q] + r1[q]; }
#pragma unroll
                for (int q = 0; q < 8; ++q) y[hh * 8 + q] = DN_ALPHA * xv[q] + rv[q]; }
            float s = 0.f;
#pragma unroll
            for (int q = 0; q < 16; ++q) s += y[q];
            const float mean = wave_sum(s) * (1.0f / DM);
            float v = 0.f;
#pragma unroll
            for (int q = 0; q < 16; ++q) { const float d = y[q] - mean; v += d * d; }
            const float rstd = 1.0f / sqrtf(wave_sum(v) * (1.0f / DM) + LN_EPS);
#pragma unroll
            for (int hh = 0; hh < 2; ++hh) { const int c = hh * 512 + F.lane * 8;
                const f32x4 g0 = *(const f32x4*)(gam + c), g1 = *(const f32x4*)(gam + c + 4), b0 = *(const f32x4*)(bet + c), b1 = *(const f32x4*)(bet + c + 4);
#pragma unroll
                for (int q = 0; q < 4; ++q) { y[hh * 8 + q] = (y[hh * 8 + q] - mean) * rstd * g0[q] + b0[q]; y[hh * 8 + 4 + q] = (y[hh * 8 + 4 + q] - mean) * rstd * g1[q] + b1[q]; } }
            if (MODE == 1 && last_layer) {
#pragma unroll
                for (int hh = 0; hh < 2; ++hh) { float* o = a.out + (size_t)row * DM + hh * 512 + F.lane * 8;
                    *(f32x4*)o = (f32x4){y[hh * 8], y[hh * 8 + 1], y[hh * 8 + 2], y[hh * 8 + 3]}; *(f32x4*)(o + 4) = (f32x4){y[hh * 8 + 4], y[hh * 8 + 5], y[hh * 8 + 6], y[hh * 8 + 7]}; }
            } else {
#pragma unroll
                for (int hh = 0; hh < 2; ++hh) { float t8[8];
#pragma unroll
                    for (int q = 0; q < 8; ++q) t8[q] = y[hh * 8 + q];
                    *(u32x4*)(X + (size_t)row * DM + hh * 512 + F.lane * 8) = pack8(t8); }
            }
            if (MODE == 0) {
                float mine = 0.f;
#pragma unroll 2
                for (int j = 0; j < 36; ++j) { float p = 0.f;
#pragma unroll
                    for (int hh = 0; hh < 2; ++hh) { const float* w = WR + (size_t)j * DM + hh * 512 + F.lane * 8; const f32x4 w0 = *(const f32x4*)w, w1 = *(const f32x4*)(w + 4);
#pragma unroll
                        for (int q = 0; q < 4; ++q) { p += y[hh * 8 + q] * w0[q]; p += y[hh * 8 + 4 + q] * w1[q]; } }
                    p = wave_sum(p); mine = (F.lane == j) ? p : mine; }
                { const float* brg = a.in[IN_BRG] + layer * 4; const float* bre = a.in[IN_BRE] + layer * 32;
                  mine += (F.lane < 4) ? brg[F.lane] : (F.lane < 36 ? bre[F.lane - 4] : 0.f); }
                float lg[4];
#pragma unroll
                for (int j = 0; j < 4; ++j) lg[j] = __shfl(mine, j);
                int grp = 0; float gm = lg[0];
#pragma unroll
                for (int j = 1; j < 4; ++j) if (lg[j] > gm) { gm = lg[j]; grp = j; }
                float gs = 0.f;
#pragma unroll
                for (int j = 0; j < 4; ++j) gs += __expf(lg[j] - gm);
                const float gw = 1.0f / gs;
                float le[8];
#pragma unroll
                for (int i = 0; i < 8; ++i) le[i] = __shfl(mine, 4 + grp * 8 + i);
                int i1 = 0; float m1 = le[0];
#pragma unroll
                for (int i = 1; i < 8; ++i) if (le[i] > m1) { m1 = le[i]; i1 = i; }
                int i2 = -1; float m2 = -3.0e38f;
#pragma unroll
                for (int i = 0; i < 8; ++i) if (i != i1 && le[i] > m2) { m2 = le[i]; i2 = i; }
                const float e2 = __expf(m2 - m1), den = 1.0f / (1.0f + e2);
                if (F.lane == 0) {
                    const int e0 = grp * 8 + i1, e1 = grp * 8 + i2;
                    int* ri = (int*)(ws + WS_ROUTE) + (size_t)row * 4; ri[0] = e0; ri[1] = e1; ((float*)ri)[2] = den * gw; ((float*)ri)[3] = e2 * den * gw;
                    atomicAdd((int*)&hist[e0], 1); atomicAdd((int*)&hist[e1], 1);
                }
            }
        }
        if (MODE == 0) { __syncthreads(); if (F.tid < NEXP) ((int*)(ws + WS_CNT))[chunk * NEXP + F.tid] = hist[F.tid]; }
    }
    __syncthreads();
}

constexpr int LN1_WSTR = 2080;
constexpr int LN1_WOFF = 1024 + 8 * 16 * 48 * 4;
__device__ __forceinline__ void phase_ln1_router(const Frame& F, const Args& a, int layer) {
    unsigned char* ws = a.ws;
    bf16_t* X = (bf16_t*)(ws + WS_X); const bf16_t* Yb = (const bf16_t*)(ws + WS_R1); const f32x4* stats = (const f32x4*)(ws + WS_R2);
    const float* gam = a.in[IN_LN1G] + layer * DM; const float* bet = a.in[IN_LN1B] + layer * DM;
    const bf16_t* WRh = (const bf16_t*)(ws + WS_WR) + (size_t)layer * 2 * 48 * DM; const bf16_t* WRl = WRh + 48 * DM;
    LAS int* hist = (LAS int*)F.lds; LAS float* Lg = (LAS float*)(F.lds + 1024) + F.wave * (16 * 48); LAS char* Wl = (LAS char*)F.lds + LN1_WOFF;
    const int r = F.lane & 15, g = F.lane >> 4;
    __syncthreads();
    for (int i = F.tid; i < 36 * 128; i += NTHREADS) { const int wrow = i >> 7, piece = i & 127; *(LAS u32x4*)(Wl + wrow * LN1_WSTR + piece * 16) = *(const u32x4*)(WRh + (size_t)wrow * DM + piece * 8); }
    const int wr0 = r, wr1 = 16 + r, wr2 = min(32 + r, 35);
    for (int chunk = F.bid; chunk < NTOK / 256; chunk += F.G) {
        __syncthreads(); if (F.tid < NEXP) hist[F.tid] = 0; __syncthreads();
        const int rowA = chunk * 256 + F.wave * 32 + r, rowB = rowA + 16;
        float meanA, rstdA, meanB, rstdB;
        { const f32x4 q0 = stats[(size_t)rowA * 8 + 2 * g], q1 = stats[(size_t)rowA * 8 + 2 * g + 1];
          float s = (q0[0] + q0[2]) + (q1[0] + q1[2]), ss = (q0[1] + q0[3]) + (q1[1] + q1[3]);
          s += __shfl_xor(s, 16); s += __shfl_xor(s, 32); ss += __shfl_xor(ss, 16); ss += __shfl_xor(ss, 32);
          meanA = s * (1.0f / DM); rstdA = 1.0f / sqrtf(fmaxf(ss * (1.0f / DM) - meanA * meanA, 0.f) + LN_EPS); }
        { const f32x4 q0 = stats[(size_t)rowB * 8 + 2 * g], q1 = stats[(size_t)rowB * 8 + 2 * g + 1];
          float s = (q0[0] + q0[2]) + (q1[0] + q1[2]), ss = (q0[1] + q0[3]) + (q1[1] + q1[3]);
          s += __shfl_xor(s, 16); s += __shfl_xor(s, 32); ss += __shfl_xor(ss, 16); ss += __shfl_xor(ss, 32);
          meanB = s * (1.0f / DM); rstdB = 1.0f / sqrtf(fmaxf(ss * (1.0f / DM) - meanB * meanB, 0.f) + LN_EPS); }
        f32x4 accA[3], accB[3];
#pragma unroll
        for (int nb = 0; nb < 3; ++nb) { accA[nb] = (f32x4){0.f, 0.f, 0.f, 0.f}; accB[nb] = (f32x4){0.f, 0.f, 0.f, 0.f}; }
#pragma unroll 2
        for (int kk = 0; kk < 32; ++kk) {
            const int c = 64 * (kk >> 1) + 16 * g + 8 * (kk & 1);
            float ya[8], yb[8], t8[8];
            unpack8(*(const u32x4*)(Yb + (size_t)rowA * DM + c), ya); unpack8(*(const u32x4*)(Yb + (size_t)rowB * DM + c), yb);
            const f32x4 g0 = *(const f32x4*)(gam + c), g1 = *(const f32x4*)(gam + c + 4), b0 = *(const f32x4*)(bet + c), b1 = *(const f32x4*)(bet + c + 4);
#pragma unroll
            for (int q = 0; q < 4; ++q) { ya[q] = (ya[q] - meanA) * rstdA * g0[q] + b0[q]; ya[4 + q] = (ya[4 + q] - meanA) * rstdA * g1[q] + b1[q];
                                          yb[q] = (yb[q] - meanB) * rstdB * g0[q] + b0[q]; yb[4 + q] = (yb[4 + q] - meanB) * rstdB * g1[q] + b1[q]; }
            const u32x4 hA = pack8(ya), hB = pack8(yb);
            *(u32x4*)(X + (size_t)rowA * DM + c) = hA; *(u32x4*)(X + (size_t)rowB * DM + c) = hB;
            unpack8(hA, t8);
#pragma unroll
            for (int q = 0; q < 8; ++q) ya[q] -= t8[q];
            unpack8(hB, t8);
#pragma unroll
            for (int q = 0; q < 8; ++q) yb[q] -= t8[q];
            const u32x4 lA = pack8(ya), lB = pack8(yb);
            const bf16x8 ahA = *(const bf16x8*)&hA, alA = *(const bf16x8*)&lA, ahB = *(const bf16x8*)&hB, alB = *(const bf16x8*)&lB;
#pragma unroll
            for (int nb = 0; nb < 3; ++nb) { const int wrow = nb == 0 ? wr0 : nb == 1 ? wr1 : wr2;
                const bf16x8 bh = *(const LAS bf16x8*)(Wl + wrow * LN1_WSTR + c * 2), blo = *(const bf16x8*)(WRl + (size_t)wrow * DM + c);
                accA[nb] = __builtin_amdgcn_mfma_f32_16x16x32_bf16(ahA, bh, accA[nb], 0, 0, 0);
                accB[nb] = __builtin_amdgcn_mfma_f32_16x16x32_bf16(ahB, bh, accB[nb], 0, 0, 0);
                accA[nb] = __builtin_amdgcn_mfma_f32_16x16x32_bf16(alA, bh, accA[nb], 0, 0, 0);
                accB[nb] = __builtin_amdgcn_mfma_f32_16x16x32_bf16(alB, bh, accB[nb], 0, 0, 0);
                accA[nb] = __builtin_amdgcn_mfma_f32_16x16x32_bf16(ahA, blo, accA[nb], 0, 0, 0);
                accB[nb] = __builtin_amdgcn_mfma_f32_16x16x32_bf16(ahB, blo, accB[nb], 0, 0, 0); } }
#pragma unroll 1
        for (int grp = 0; grp < 2; ++grp) {
#pragma unroll
            for (int nb = 0; nb < 3; ++nb)
#pragma unroll
                for (int t = 0; t < 4; ++t) Lg[(4 * g + t) * 48 + 16 * nb + r] = grp ? accB[nb][t] : accA[nb][t];
            asm volatile("s_waitcnt lgkmcnt(0)" ::: "memory");
            if (F.lane < 16) {
                const int row = grp ? rowB : rowA;
                const LAS float* L = Lg + r * 48; const float* brg = a.in[IN_BRG] + layer * 4; const float* bre = a.in[IN_BRE] + layer * 32;
                float lg[4];
#pragma unroll
                for (int q = 0; q < 4; ++q) lg[q] = L[q] + brg[q];
                int grpi = 0; float gm = lg[0];
#pragma unroll
                for (int q = 1; q < 4; ++q) if (lg[q] > gm) { gm = lg[q]; grpi = q; }
                float gs = 0.f;
#pragma unroll
                for (int q = 0; q < 4; ++q) gs += __expf(lg[q] - gm);
                const float gw = 1.0f / gs;
                float le[8];
#pragma unroll
                for (int i = 0; i < 8; ++i) le[i] = L[4 + grpi * 8 + i] + bre[grpi * 8 + i];
                int i1 = 0; float m1 = le[0];
#pragma unroll
                for (int i = 1; i < 8; ++i) if (le[i] > m1) { m1 = le[i]; i1 = i; }
                int i2 = -1; float m2 = -3.0e38f;
#pragma unroll
                for (int i = 0; i < 8; ++i) if (i != i1 && le[i] > m2) { m2 = le[i]; i2 = i; }
                const float e2 = __expf(m2 - m1), den = 1.0f / (1.0f + e2);
                const int e0 = grpi * 8 + i1, e1 = grpi * 8 + i2;
                int* ri = (int*)(ws + WS_ROUTE) + (size_t)row * 4; ri[0] = e0; ri[1] = e1; ((float*)ri)[2] = den * gw; ((float*)ri)[3] = e2 * den * gw;
                atomicAdd((int*)&hist[e0], 1); atomicAdd((int*)&hist[e1], 1);
            }
            asm volatile("s_waitcnt lgkmcnt(0)" ::: "memory");
        }
        __syncthreads(); if (F.tid < NEXP) ((int*)(ws + WS_CNT))[chunk * NEXP + F.tid] = hist[F.tid];
    }
    __syncthreads();
}

__device__ __forceinline__ void phase_ln2(const Frame& F, const Args& a, int layer, bool last_layer, bool dry = false) {
    unsigned char* ws = a.ws;
    bf16_t* X = (bf16_t*)(ws + WS_X); bf16_t* XO = dry ? (bf16_t*)(ws + WS_R1) : X; const bf16_t* Y = (const bf16_t*)(ws + WS_R2);
    LAS float* gl = (LAS float*)F.lds; LAS float* bl = gl + DM;
    __syncthreads();
    for (int i = F.tid; i < DM; i += NTHREADS) { gl[i] = a.in[IN_LN2G][layer * DM + i]; bl[i] = a.in[IN_LN2B][layer * DM + i]; }
    __syncthreads();
    const int r = F.lane & 7, g = F.lane >> 3;
    const LAS float* gam = gl + 8 * g; const LAS float* bet = bl + 8 * g;
#pragma unroll 1
    for (int blk = F.bid * (NTHREADS / 64) + F.wave; blk < NTOK / 8; blk += F.G * (NTHREADS / 64)) {
        const int row = blk * 8 + r;
        const u32x4 rt = *(const u32x4*)((const int*)(ws + WS_ROUTE) + (size_t)row * 4);
        const float ga = __uint_as_float(rt.z), gb = __uint_as_float(rt.w);
        const bf16_t* xp = X + (size_t)row * DM + 8 * g; const bf16_t* y0p = Y + (size_t)rt.x * DM + 8 * g; const bf16_t* y1p = Y + (size_t)rt.y * DM + 8 * g;
        float y[128];
#pragma unroll
        for (int kk = 0; kk < 16; ++kk) { float xv[8], u0[8], u1[8]; unpack8(*(const u32x4*)(xp + 64 * kk), xv); unpack8(*(const u32x4*)(y0p + 64 * kk), u0); unpack8(*(const u32x4*)(y1p + 64 * kk), u1);
#pragma unroll
            for (int q = 0; q < 8; ++q) y[8 * kk + q] = DN_ALPHA * xv[q] + (ga * u0[q] + gb * u1[q]);
            if ((kk & 3) == 3) {
#pragma unroll
                for (int k2 = kk - 3; k2 <= kk; ++k2) asm volatile("" : "+v"(y[8 * k2]), "+v"(y[8 * k2 + 1]), "+v"(y[8 * k2 + 2]), "+v"(y[8 * k2 + 3]), "+v"(y[8 * k2 + 4]), "+v"(y[8 * k2 + 5]), "+v"(y[8 * k2 + 6]), "+v"(y[8 * k2 + 7]) :: "memory"); } }
        float s = 0.f;
#pragma unroll
        for (int q = 0; q < 128; ++q) s += y[q];
        s += __shfl_xor(s, 8); s += __shfl_xor(s, 16); s += __shfl_xor(s, 32);
        const float mean = s * (1.0f / DM);
        float v = 0.f;
#pragma unroll
        for (int q = 0; q < 128; ++q) { const float dlt = y[q] - mean; v += dlt * dlt; }
        v += __shfl_xor(v, 8); v += __shfl_xor(v, 16); v += __shfl_xor(v, 32);
        const float rstd = 1.0f / sqrtf(v * (1.0f / DM) + LN_EPS);
#pragma unroll
        for (int kk = 0; kk < 16; ++kk) { const int c = 64 * kk + 8 * g; float o8[8];
            const f32x4 g0 = *(const LAS f32x4*)(gam + 64 * kk), g1 = *(const LAS f32x4*)(gam + 64 * kk + 4), b0 = *(const LAS f32x4*)(bet + 64 * kk), b1 = *(const LAS f32x4*)(bet + 64 * kk + 4);
#pragma unroll
            for (int q = 0; q < 4; ++q) { o8[q] = (y[8 * kk + q] - mean) * rstd * g0[q] + b0[q]; o8[4 + q] = (y[8 * kk + 4 + q] - mean) * rstd * g1[q] + b1[q]; }
            if (last_layer) { float* o = a.out + (size_t)row * DM + c; *(f32x4*)o = (f32x4){o8[0], o8[1], o8[2], o8[3]}; *(f32x4*)(o + 4) = (f32x4){o8[4], o8[5], o8[6], o8[7]}; }
            else *(u32x4*)(XO + (size_t)row * DM + c) = pack8(o8);
            if (kk & 1) asm volatile("" ::: "memory"); }
    }
}

__device__ __forceinline__ void phase_scatter(const Frame& F, const Args& a) {
    unsigned char* ws = a.ws;
    const int* cnt = (const int*)(ws + WS_CNT); int* tile = (int*)(ws + WS_TILE);
    int* slot_tok = (int*)(ws + WS_SLOT_TOK); float* slot_g = (float*)(ws + WS_SLOT_G); int* slot_dst = (int*)(ws + WS_SLOT_DST);
    LAS int* C = (LAS int*)F.lds;
    LAS int* total = C + 256 * NEXP;
    LAS int* tstart = total + NEXP;
    LAS int* base = tstart + NEXP + 1;
    LAS int* el = base + NEXP;
    __syncthreads();
    for (int i = F.tid; i < 256 * NEXP; i += NTHREADS) C[i] = cnt[i];
    __syncthreads();
    if (F.tid < NEXP) { int s = 0; for (int c = 0; c < 256; ++c) s += C[c * NEXP + F.tid]; total[F.tid] = s; }
    __syncthreads();
    if (F.tid == 0) { int t = 0; for (int e = 0; e < NEXP; ++e) { tstart[e] = t; t += (total[e] + 255) >> 8; } tstart[NEXP] = t; }
    __syncthreads();
    const int T = tstart[NEXP];
    if (F.bid == 0) { if (F.tid == 0) tile[0] = T; for (int e = 0; e < NEXP; ++e) for (int t = tstart[e] + F.tid; t < tstart[e + 1]; t += NTHREADS) tile[1 + t] = e; }
    for (int e = F.bid; e < NEXP; e += F.G) { const int s0 = tstart[e] * 256 + total[e], s1 = tstart[e + 1] * 256;
        for (int s = s0 + F.tid; s < s1; s += NTHREADS) { slot_tok[s] = 0; slot_g[s] = 0.f; slot_dst[s] = -1; } }
    for (int chunk = F.bid; chunk < NTOK / 256; chunk += F.G) {
        __syncthreads();
        if (F.tid < NEXP) { int s = 0; for (int c = 0; c < chunk; ++c) s += C[c * NEXP + F.tid]; base[F.tid] = tstart[F.tid] * 256 + s; }
        const int tok = chunk * 256 + (F.tid >> 1), k = F.tid & 1;
        const int* ri = (const int*)(ws + WS_ROUTE) + (size_t)tok * 4;
        const int e = ri[k]; const float g = ((const float*)ri)[2 + k];
        el[F.tid] = e;
        __syncthreads();
        int rank = 0;
        for (int q = 0; q < F.tid; ++q) rank += (el[q] == e) ? 1 : 0;
        const int slot = base[e] + rank;
        slot_tok[slot] = tok; slot_g[slot] = g; slot_dst[slot] = tok * 2 + k;
        ((int*)(ws + WS_ROUTE))[(size_t)tok * 4 + k] = slot;
    }
    __syncthreads();
}

template <int DQK, int VP>
__device__ __forceinline__ void attn_keys64(const LAS float* Ks, const LAS float* Vs, const float (&q)[DQK], float (&o)[64], float& m, float& l, const float sc) {
#pragma unroll 1
    for (int jj = 0; jj < 64; ++jj) {
        float acc = 0.f; const LAS float* kr = Ks + jj * DQK;
#pragma unroll
        for (int d = 0; d < DQK; d += 4) { const f32x4 kv = *(const LAS f32x4*)(kr + d); acc += q[d] * kv[0] + q[d + 1] * kv[1] + q[d + 2] * kv[2] + q[d + 3] * kv[3]; }
        const float s = acc * sc, mx = fmaxf(m, s), corr = __builtin_amdgcn_exp2f(m - mx), p = __builtin_amdgcn_exp2f(s - mx);
        m = mx; l = l * corr + p; const LAS float* vr = Vs + jj * VP;
#pragma unroll
        for (int e = 0; e < 64; e += 4) { const f32x4 vv = *(const LAS f32x4*)(vr + e); o[e] = o[e] * corr + p * vv[0]; o[e + 1] = o[e + 1] * corr + p * vv[1]; o[e + 2] = o[e + 2] * corr + p * vv[2]; o[e + 3] = o[e + 3] * corr + p * vv[3]; }
    }
}
__device__ __forceinline__ void stage8(LAS float* dst, const bf16_t* src) { float f[8]; unpack8(*(const u32x4*)src, f); *(LAS f32x4*)dst = (f32x4){f[0], f[1], f[2], f[3]}; *(LAS f32x4*)(dst + 4) = (f32x4){f[4], f[5], f[6], f[7]}; }

__device__ __forceinline__ void attn_diff_naive(const Frame& F, const Args& a, int layer, int unit) {
    unsigned char* ws = a.ws; const bf16_t* H = (const bf16_t*)(ws + WS_R1); bf16_t* O = (bf16_t*)(ws + WS_R3); float* TS = (float*)(ws + WS_R1 + 256 * MiB);
    const int j = layer >> 1; const float lambda_init = 0.8f - 0.6f * expf(-0.3f * (float)layer);
    float d1 = 0.f, d2 = 0.f;
    for (int i = 0; i < 64; ++i) { d1 += a.in[IN_LQ1][j * 64 + i] * a.in[IN_LK1][j * 64 + i]; d2 += a.in[IN_LQ2][j * 64 + i] * a.in[IN_LK2][j * 64 + i]; }
    const float lam = expf(d1) - expf(d2) + lambda_init;
    const int qb = unit & 7, h = (unit >> 3) & 3, b = unit >> 5;
    const int ql = (F.tid & 31) + 32 * (F.tid >> 6), half = (F.tid >> 5) & 1;
    const size_t row = (size_t)b * SEQ + qb * 256 + ql;
    LAS float* Ks = (LAS float*)F.lds; LAS float* Vs = Ks + 64 * 64;
    const float sc = 0.125f * 1.4426950408889634f;
    float* stash = TS + row * 512 + h * 128 + half * 64;
#pragma unroll 1
    for (int st = 0; st < 2; ++st) {
        float o[64], q[64];
#pragma unroll
        for (int d = 0; d < 64; d += 8) { float f[8]; unpack8(*(const u32x4*)(H + row * HLD + h * 128 + st * 64 + d), f);
#pragma unroll
            for (int t = 0; t < 8; ++t) q[d + t] = f[t]; }
        float m = -INFINITY, l = 0.f;
#pragma unroll
        for (int e = 0; e < 64; ++e) o[e] = 0.f;
#pragma unroll 1
        for (int kt = 0; kt < SEQ / 64; ++kt) {
            __syncthreads();
            { const int key = F.tid >> 3, d8 = (F.tid & 7) * 8; const size_t krow = (size_t)b * SEQ + kt * 64 + key;
              stage8(Ks + key * 64 + d8, H + krow * HLD + 512 + h * 128 + st * 64 + d8);
              stage8(Vs + key * 128 + d8, H + krow * HLD + 1024 + h * 128 + d8); stage8(Vs + key * 128 + 64 + d8, H + krow * HLD + 1024 + h * 128 + 64 + d8); }
            __syncthreads();
            attn_keys64<64, 128>(Ks, Vs + half * 64, q, o, m, l, sc);
        }
        const float inv = 1.0f / l;
        if (st == 0) {
#pragma unroll
            for (int e = 0; e < 64; e += 4) *(f32x4*)(stash + e) = (f32x4){o[e] * inv, o[e + 1] * inv, o[e + 2] * inv, o[e + 3] * inv};
        } else {
            float ss = 0.f;
#pragma unroll
            for (int e = 0; e < 64; e += 4) { const f32x4 p0 = *(const f32x4*)(stash + e);
#pragma unroll
                for (int t = 0; t < 4; ++t) { o[e + t] = p0[t] - lam * (o[e + t] * inv); ss += o[e + t] * o[e + t]; } }
            ss += __shfl_xor(ss, 32);
            const float rs = 1.0f / sqrtf(ss * (1.0f / 128.0f) + RMS_EPS) * (1.0f - lambda_init);
            const float* g = a.in[IN_SUBLN] + j * 128 + half * 64;
#pragma unroll
            for (int e = 0; e < 64; e += 8) { float t8[8];
#pragma unroll
                for (int t = 0; t < 8; ++t) t8[t] = o[e + t] * rs * g[e + t];
                *(u32x4*)(O + row * DM + h * 128 + half * 64 + e) = pack8(t8); }
        }
    }
}
__device__ __forceinline__ void attn_mla_naive(const Frame& F, const Args& a, int unit) {
    unsigned char* ws = a.ws; const bf16_t* QB = (const bf16_t*)(ws + WS_R2); const bf16_t* KVB = QB + (size_t)NTOK * 768; const bf16_t* KR = KVB + (size_t)NTOK * 1024; bf16_t* O = (bf16_t*)(ws + WS_R3);
    const int qb = unit & 3, h = (unit >> 2) & 7, b = unit >> 5;
    const size_t row = (size_t)b * SEQ + qb * 512 + F.tid;
    LAS float* Ks = (LAS float*)F.lds; LAS float* Vs = Ks + 64 * 96;
    const float sc = 0.10206207261596575f * 1.4426950408889634f;
    float q[96], o[64];
#pragma unroll
    for (int d = 0; d < 96; d += 8) { float f[8]; unpack8(*(const u32x4*)(QB + row * 768 + h * 96 + d), f);
#pragma unroll
        for (int t = 0; t < 8; ++t) q[d + t] = f[t]; }
    { const float* rb = (const float*)(ws + WS_ROPEB); const int pos = (int)(row & (SEQ - 1));
#pragma unroll
      for (int i = 0; i < 16; i += 4) { const f32x4 cs = *(const f32x4*)(rb + pos * 16 + i), sn = *(const f32x4*)(rb + SEQ * 16 + pos * 16 + i);
#pragma unroll
          for (int t = 0; t < 4; ++t) { const float x1 = q[64 + i + t], x2 = q[80 + i + t]; q[64 + i + t] = x1 * cs[t] - x2 * sn[t]; q[80 + i + t] = x2 * cs[t] + x1 * sn[t]; } } }
    float m = -INFINITY, l = 0.f;
#pragma unroll
    for (int e = 0; e < 64; ++e) o[e] = 0.f;
#pragma unroll 1
    for (int kt = 0; kt < SEQ / 64; ++kt) {
        __syncthreads();
        { const int key = F.tid >> 3, d8 = (F.tid & 7) * 8; const size_t krow = (size_t)b * SEQ + kt * 64 + key;
          stage8(Ks + key * 96 + d8, KVB + krow * 1024 + h * 128 + d8);
          stage8(Vs + key * 64 + d8, KVB + krow * 1024 + h * 128 + 64 + d8);
          if (F.tid < 256) { const int key2 = F.tid >> 2, r8 = (F.tid & 3) * 8; stage8(Ks + key2 * 96 + 64 + r8, KR + ((size_t)b * SEQ + kt * 64 + key2) * 32 + r8); } }
        __syncthreads();
        attn_keys64<96, 64>(Ks, Vs, q, o, m, l, sc);
    }
    const float inv = 1.0f / l;
#pragma unroll
    for (int e = 0; e < 64; e += 8) { float t8[8];
#pragma unroll
        for (int t = 0; t < 8; ++t) t8[t] = o[e + t] * inv;
        *(u32x4*)(O + row * DM + 512 + h * 64 + e) = pack8(t8); }
}
__device__ __forceinline__ void attn_na_naive(const Frame& F, const Args& a, int layer, int unit) {
    unsigned char* ws = a.ws; const bf16_t* QKV = (const bf16_t*)(ws + WS_R1); bf16_t* O = (bf16_t*)(ws + WS_R3);
    const float* relb = a.in[IN_RELB] + (size_t)(layer >> 1) * 16 * 15 * 31;
    const int hh = unit & 1, r = (unit >> 1) & 31, b = unit >> 6;
    const int c = F.tid & 63, h = hh * 8 + (F.tid >> 6);
    const int r0 = min(max(r - 4, 0), 24), c0 = min(max(c - 8, 0), 48);
    const size_t row = (size_t)b * SEQ + r * 64 + c;
    const float LOG2E = 1.4426950408889634f;
    float q[64], o[64];
#pragma unroll
    for (int d = 0; d < 64; d += 8) { float f[8]; unpack8(*(const u32x4*)(QKV + row * 3072 + h * 64 + d), f);
#pragma unroll
        for (int t = 0; t < 8; ++t) q[d + t] = f[t]; }
    float m = -INFINITY, l = 0.f;
#pragma unroll
    for (int e = 0; e < 64; ++e) o[e] = 0.f;
#pragma unroll 1
    for (int ij = 0; ij < 128; ++ij) {
        const int i = ij >> 4, jj = ij & 15;
        const size_t krow = (size_t)b * SEQ + (r0 + i) * 64 + c0 + jj;
        const float bias = relb[((size_t)h * 15 + (r0 + i - r + 7)) * 31 + (c0 + jj - c + 15)];
        float acc = 0.f; const bf16_t* kp = QKV + krow * 3072 + 1024 + h * 64;
#pragma unroll
        for (int d = 0; d < 64; d += 8) { float f[8]; unpack8(*(const u32x4*)(kp + d), f);
#pragma unroll
            for (int t = 0; t < 8; ++t) acc += q[d + t] * f[t]; }
        const float s = (acc * 0.125f + bias) * LOG2E, mx = fmaxf(m, s), corr = __builtin_amdgcn_exp2f(m - mx), p = __builtin_amdgcn_exp2f(s - mx);
        m = mx; l = l * corr + p; const bf16_t* vp = kp + 1024;
#pragma unroll
        for (int e = 0; e < 64; e += 8) { float f[8]; unpack8(*(const u32x4*)(vp + e), f);
#pragma unroll
            for (int t = 0; t < 8; ++t) o[e + t] = o[e + t] * corr + p * f[t]; }
    }
    const float inv = 1.0f / l;
#pragma unroll
    for (int e = 0; e < 64; e += 8) { float t8[8];
#pragma unroll
        for (int t = 0; t < 8; ++t) t8[t] = o[e + t] * inv;
        *(u32x4*)(O + row * DM + h * 64 + e) = pack8(t8); }
}

namespace fa {
typedef float f32x16 __attribute__((ext_vector_type(16)));
typedef short s16x4 __attribute__((ext_vector_type(4)));
#define FA_SBAR() __builtin_amdgcn_sched_barrier(0)
__device__ __forceinline__ int crow(int r, int hi) { return (r & 3) + 8 * (r >> 2) + 4 * hi; }
constexpr float THR = 8.f;
template <int SCALE_E6> __device__ __forceinline__ void partialSM(f32x16& p0, f32x16& p1, float& m_reg, float& mn, float& alpha) {
    constexpr float SCALE = SCALE_E6 * 1e-6f, C = SCALE * 1.4426950408889634f;
    float pmax = p0[0];
#pragma unroll
    for (int r = 1; r < 16; ++r) pmax = fmaxf(pmax, p0[r]);
#pragma unroll
    for (int r = 0; r < 16; ++r) pmax = fmaxf(pmax, p1[r]);
    { auto rr = __builtin_amdgcn_permlane32_swap(__float_as_uint(pmax), __float_as_uint(pmax), false, false); pmax = fmaxf(__uint_as_float(rr[0]), __uint_as_float(rr[1])); }
    if (__builtin_expect(__all(pmax - m_reg <= THR / SCALE), 1)) { mn = m_reg; alpha = 1.f; }
    else { mn = fmaxf(m_reg, pmax); alpha = __builtin_amdgcn_exp2f((m_reg - mn) * C); m_reg = mn; }
    const float mnC = -mn * C; const f32x2 C2 = {C, C}, M2 = {mnC, mnC};
#pragma unroll
    for (int r = 0; r < 16; r += 2) { f32x2 v = {p0[r], p0[r + 1]}; v = v * C2 + M2; p0[r] = v.x; p0[r + 1] = v.y; }
#pragma unroll
    for (int r = 0; r < 16; r += 2) { f32x2 v = {p1[r], p1[r + 1]}; v = v * C2 + M2; p1[r] = v.x; p1[r + 1] = v.y; }
#pragma unroll
    for (int r = 0; r < 16; ++r) p0[r] = __builtin_amdgcn_exp2f(p0[r]);
}
__device__ __forceinline__ void finishSM(f32x16& p0, f32x16& p1, float alpha, float& l_reg, bf16x8& pa0, bf16x8& pa1, bf16x8& pa2, bf16x8& pa3) {
#pragma unroll
    for (int r = 0; r < 16; ++r) p1[r] = __builtin_amdgcn_exp2f(p1[r]);
    f32x2 ps2 = {0.f, 0.f};
#pragma unroll
    for (int r = 0; r < 16; r += 2) ps2 += (f32x2){p0[r], p0[r + 1]};
#pragma unroll
    for (int r = 0; r < 16; r += 2) ps2 += (f32x2){p1[r], p1[r + 1]};
    float ps = ps2.x + ps2.y;
    { auto rr = __builtin_amdgcn_permlane32_swap(__float_as_uint(ps), __float_as_uint(ps), false, false); ps = __uint_as_float(rr[0]) + __uint_as_float(rr[1]); }
    l_reg = l_reg * alpha + ps;
#define FA_PK4(P, BASE, OUT) do { unsigned a0 = cvt_pk_bf16(P[BASE + 0], P[BASE + 1]), a1 = cvt_pk_bf16(P[BASE + 2], P[BASE + 3]);   \
    unsigned b0 = cvt_pk_bf16(P[BASE + 4], P[BASE + 5]), b1 = cvt_pk_bf16(P[BASE + 6], P[BASE + 7]);                              \
    auto r0 = __builtin_amdgcn_permlane32_swap(a0, b0, false, false); auto r1 = __builtin_amdgcn_permlane32_swap(a1, b1, false, false); \
    u32x4 w = {r0[0], r1[0], r0[1], r1[1]}; OUT = *reinterpret_cast<bf16x8*>(&w); } while (0)
    FA_PK4(p0, 0, pa0); FA_PK4(p0, 8, pa1); FA_PK4(p1, 0, pa2); FA_PK4(p1, 8, pa3);
#undef FA_PK4
}
template <int NKS> __device__ __forceinline__ void qkt(f32x16& p0, f32x16& p1, const LAS char* Ks, const bf16x8 (&qr)[NKS], int r32, int hi) {
    p0 = f32x16{}; p1 = f32x16{};
#pragma unroll
    for (int d0 = 0; d0 < NKS; ++d0) {
        const bf16x8 b0 = *(const LAS bf16x8*)(Ks + ((2 * d0 + hi) * 64 + r32) * 16);
        const bf16x8 b1 = *(const LAS bf16x8*)(Ks + ((2 * d0 + hi) * 64 + 32 + r32) * 16);
        p0 = __builtin_amdgcn_mfma_f32_32x32x16_bf16(b0, qr[d0], p0, 0, 0, 0);
        p1 = __builtin_amdgcn_mfma_f32_32x32x16_bf16(b1, qr[d0], p1, 0, 0, 0); }
}
template <int NCB> __device__ __forceinline__ int v_st(int k, int c) { const int kk = (k & ~0xC) | ((k & 4) << 1) | ((k & 8) >> 1); return ((kk >> 3) * NCB + (c >> 5)) * 512 + ((kk & 7) * 32 + (c & 31)) * 2; }
__device__ __forceinline__ int v_rd_base(int lane) { return ((lane & 3) << 3) | (((lane >> 2) & 3) << 6) | (((lane >> 4) & 1) << 5) | (((lane >> 5) & 1) << 8); }
template <int NCB> constexpr int v_rd_off(int d0, int ks, int half) { return d0 * 512 + ks * (NCB * 1024) + half * (NCB * 512); }
template <int OFF> __device__ __forceinline__ s16x4 tr_read(int vb) { s16x4 r; asm volatile("ds_read_b64_tr_b16 %0, %1 offset:%2" : "=&v"(r) : "v"(vb), "i"(OFF) : "memory"); return r; }
template <int D0, int NCB> __device__ __forceinline__ void pv_one(f32x16& od, int vb, bf16x8 pa0, bf16x8 pa1, bf16x8 pa2, bf16x8 pa3) {
    const s16x4 l0 = tr_read<v_rd_off<NCB>(D0, 0, 0)>(vb), h0 = tr_read<v_rd_off<NCB>(D0, 0, 1)>(vb), l1 = tr_read<v_rd_off<NCB>(D0, 1, 0)>(vb), h1 = tr_read<v_rd_off<NCB>(D0, 1, 1)>(vb);
    const s16x4 l2 = tr_read<v_rd_off<NCB>(D0, 2, 0)>(vb), h2 = tr_read<v_rd_off<NCB>(D0, 2, 1)>(vb), l3 = tr_read<v_rd_off<NCB>(D0, 3, 0)>(vb), h3 = tr_read<v_rd_off<NCB>(D0, 3, 1)>(vb);
    asm volatile("s_waitcnt lgkmcnt(0)" ::: "memory"); FA_SBAR();
#define FA_PK(L, H) (bf16x8){L[0], L[1], L[2], L[3], H[0], H[1], H[2], H[3]}
    od = __builtin_amdgcn_mfma_f32_32x32x16_bf16(pa0, FA_PK(l0, h0), od, 0, 0, 0);
    od = __builtin_amdgcn_mfma_f32_32x32x16_bf16(pa1, FA_PK(l1, h1), od, 0, 0, 0);
    od = __builtin_amdgcn_mfma_f32_32x32x16_bf16(pa2, FA_PK(l2, h2), od, 0, 0, 0);
    od = __builtin_amdgcn_mfma_f32_32x32x16_bf16(pa3, FA_PK(l3, h3), od, 0, 0, 0);
#undef FA_PK
}
template <int NCB> __device__ __forceinline__ void pv_all(f32x16 (&o)[NCB], int vb, bf16x8 pa0, bf16x8 pa1, bf16x8 pa2, bf16x8 pa3) {
    pv_one<0, NCB>(o[0], vb, pa0, pa1, pa2, pa3); pv_one<1, NCB>(o[1], vb, pa0, pa1, pa2, pa3);
    if constexpr (NCB == 4) { pv_one<2, NCB>(o[2], vb, pa0, pa1, pa2, pa3); pv_one<3, NCB>(o[3], vb, pa0, pa1, pa2, pa3); }
}

template <int DQK, int DV, int SCALE_E6, int SDEPTH>
__device__ __forceinline__ void attn_stream(const Frame& F, const bf16_t* __restrict__ Qb, int LDQ, const bf16_t* __restrict__ Kh, int LDK, const bf16_t* __restrict__ KRh, const bf16_t* __restrict__ Vh, int LDV,
                                            const float* ropeB, int qpos0, f32x16 (&o)[DV / 32], float (&rli)[16]) {
    constexpr int NKS = DQK / 16, NCB = DV / 32, SHM_K = 64 * DQK * 2, SHM_V = 64 * DV * 2;
    const int tid = F.tid, wid = F.wave, lane = F.lane, r32 = lane & 31, hi = lane >> 5;
    LAS char* V_lds = (LAS char*)F.lds; LAS char* K_lds = V_lds + 3 * SHM_V;
    LAS float* wsl = (LAS float*)(K_lds + 2 * SHM_K) + wid * 64; LAS float* li_l = wsl; LAS float* al_l = wsl + 32;
    float m_reg = -1e30f, l_reg = 0.f; bf16x8 qr[NKS];
#pragma unroll
    for (int d = 0; d < NCB; ++d) o[d] = f32x16{};
    const bf16_t* Qw = Qb + (size_t)(wid * 32 + r32) * LDQ + hi * 8;
#pragma unroll
    for (int d0 = 0; d0 < NKS; ++d0) qr[d0] = *(const bf16x8*)(Qw + d0 * 16);
    if constexpr (DQK == 96) {
        const int pos = qpos0 + wid * 32 + r32; float x1[8], x2[8];
        unpack8(*(const u32x4*)&qr[4], x1); unpack8(*(const u32x4*)&qr[5], x2);
        const float* cp = ropeB + pos * 16 + 8 * hi; const float* sp = ropeB + SEQ * 16 + pos * 16 + 8 * hi;
#pragma unroll
        for (int jj = 0; jj < 8; ++jj) { const float c = cp[jj], sn = sp[jj], a = x1[jj], b = x2[jj]; x1[jj] = a * c - b * sn; x2[jj] = b * c + a * sn; }
        u32x4 w1 = pack8(x1), w2 = pack8(x2); qr[4] = *(bf16x8*)&w1; qr[5] = *(bf16x8*)&w2;
    }
    const int krow = (tid & 7) + 8 * (tid >> 6), kcs = (tid >> 3) & 7;
    const int rrow = (tid & 7) + 8 * ((tid >> 5) & 7), rcs = (tid >> 3) & 3;
    const int vr0 = (DV == 128) ? (tid >> 4) : (tid >> 3), vc = (DV == 128) ? (tid & 15) * 8 : (tid & 7) * 8;
    const int vst0 = v_st<NCB>(vr0, vc), vst1 = v_st<NCB>(32 + vr0, vc);
    const int vb0 = (int)(uintptr_t)V_lds + v_rd_base(lane);
    struct Slot { bf16x8 k0, kr, v0, v1; } sl[2];
#define FA_SLOAD(i, key0) do { sl[i].k0 = *(const bf16x8*)(Kh + (size_t)((key0) + krow) * LDK + kcs * 8); \
        if constexpr (DQK == 96) sl[i].kr = *(const bf16x8*)(KRh + (size_t)((key0) + rrow) * 32 + rcs * 8); \
        sl[i].v0 = *(const bf16x8*)(Vh + (size_t)((key0) + vr0) * LDV + vc); \
        if constexpr (DV == 128) sl[i].v1 = *(const bf16x8*)(Vh + (size_t)((key0) + 32 + vr0) * LDV + vc); } while (0)
#define FA_SWRITE(kb, voff, i) do { *(LAS bf16x8*)(K_lds + (kb) * SHM_K + (kcs * 64 + krow) * 16) = sl[i].k0; \
        if constexpr (DQK == 96) { if (tid < 256) *(LAS bf16x8*)(K_lds + (kb) * SHM_K + ((8 + rcs) * 64 + rrow) * 16) = sl[i].kr; } \
        *(LAS bf16x8*)(V_lds + (voff) + vst0) = sl[i].v0; \
        if constexpr (DV == 128) *(LAS bf16x8*)(V_lds + (voff) + vst1) = sl[i].v1; } while (0)
#define FA_SWAIT() asm volatile("s_waitcnt vmcnt(3)" ::: "memory")
#define FA_RESC(a) do { if (__any((a) < 1.f)) { if (hi == 0) al_l[r32] = (a); asm volatile("s_waitcnt lgkmcnt(0)" ::: "memory"); \
        _Pragma("unroll") for (int d = 0; d < NCB; ++d) _Pragma("unroll") for (int r = 0; r < 16; ++r) o[d][r] *= al_l[crow(r, hi)]; } } while (0)
#define FA_NEXT3(x) ((x) == 2 * SHM_V ? 0 : (x) + SHM_V)
    f32x16 pA0, pA1, pB0, pB1; float mnA, mnB, alA, alB; bf16x8 pa0, pa1, pa2, pa3; constexpr int NT = SEQ / 64;
    FA_SLOAD(0, 0); FA_SLOAD(1, 64); asm volatile("s_waitcnt vmcnt(0)" ::: "memory"); FA_SWRITE(0, 0, 0); FA_SWRITE(1, SHM_V, 1); FA_SLOAD(0, 128); __syncthreads();
    qkt<NKS>(pA0, pA1, K_lds, qr, r32, hi); partialSM<SCALE_E6>(pA0, pA1, m_reg, mnA, alA);
    int vrd = 0, vwr = 2 * SHM_V;
#pragma unroll 1
    for (int j = 1; j + 1 < NT; j += 2) {
        FA_SBAR(); qkt<NKS>(pB0, pB1, K_lds + SHM_K, qr, r32, hi);
        finishSM(pA0, pA1, alA, l_reg, pa0, pa1, pa2, pa3); FA_SBAR();
        FA_SLOAD(1, ((j + 2 < NT) ? (j + 2) : (NT - 1)) * 64); FA_SBAR();
        pv_all<NCB>(o, vb0 + vrd, pa0, pa1, pa2, pa3); partialSM<SCALE_E6>(pB0, pB1, m_reg, mnB, alB);
        FA_SWAIT(); FA_SWRITE(0, vwr, 0);
        FA_RESC(alB); __syncthreads();
        vrd = FA_NEXT3(vrd); vwr = FA_NEXT3(vwr);
        FA_SBAR(); qkt<NKS>(pA0, pA1, K_lds, qr, r32, hi);
        finishSM(pB0, pB1, alB, l_reg, pa0, pa1, pa2, pa3); FA_SBAR();
        FA_SLOAD(0, ((j + 3 < NT) ? (j + 3) : (NT - 1)) * 64); FA_SBAR();
        pv_all<NCB>(o, vb0 + vrd, pa0, pa1, pa2, pa3); partialSM<SCALE_E6>(pA0, pA1, m_reg, mnA, alA);
        FA_SWAIT(); FA_SWRITE(1, vwr, 1);
        FA_RESC(alA); __syncthreads();
        vrd = FA_NEXT3(vrd); vwr = FA_NEXT3(vwr);
    }
    FA_SBAR(); qkt<NKS>(pB0, pB1, K_lds + SHM_K, qr, r32, hi);
    finishSM(pA0, pA1, alA, l_reg, pa0, pa1, pa2, pa3); FA_SBAR();
    pv_all<NCB>(o, vb0 + vrd, pa0, pa1, pa2, pa3); partialSM<SCALE_E6>(pB0, pB1, m_reg, mnB, alB);
    FA_RESC(alB); vrd = FA_NEXT3(vrd);
    finishSM(pB0, pB1, alB, l_reg, pa0, pa1, pa2, pa3); FA_SBAR();
    pv_all<NCB>(o, vb0 + vrd, pa0, pa1, pa2, pa3);
    asm volatile("s_waitcnt vmcnt(0)" ::: "memory");
    if (hi == 0) li_l[r32] = l_reg;
    asm volatile("s_waitcnt lgkmcnt(0)" ::: "memory");
#pragma unroll
    for (int r = 0; r < 16; ++r) rli[r] = __builtin_amdgcn_rcpf(li_l[crow(r, hi)]);
#undef FA_SLOAD
#undef FA_SWRITE
#undef FA_SWAIT
#undef FA_RESC
#undef FA_NEXT3
}
}

__device__ __forceinline__ void attn_diff_mfma(const Frame& F, const Args& a, int layer, int unit) {
    unsigned char* ws = a.ws; const bf16_t* H = (const bf16_t*)(ws + WS_R1); bf16_t* O = (bf16_t*)(ws + WS_R3); float* TS = (float*)(ws + WS_R1 + 256 * MiB);
    const int jl = layer >> 1; const float lambda_init = 0.8f - 0.6f * expf(-0.3f * (float)layer);
    const float lam = ((const float*)(ws + WS_LAM))[jl];
    const int qb = unit & 7, h = (unit >> 3) & 3, b = unit >> 5;
    const size_t row0 = (size_t)b * SEQ + qb * 256, key0 = (size_t)b * SEQ;
#pragma unroll 1
    for (int st = 0; st < 2; ++st) {
        fa::f32x16 o[4]; float rli[16];
        __syncthreads();
        const Frame Fs = fresh(F);
        float* stash = TS + ((size_t)unit * NTHREADS + Fs.tid) * 64;
        fa::attn_stream<64, 128, 125000, 2>(Fs, H + row0 * HLD + h * 128 + st * 64, HLD, H + key0 * HLD + 512 + h * 128 + st * 64, HLD, nullptr, H + key0 * HLD + 1024 + h * 128, HLD, nullptr, 0, o, rli);
        const Frame Fe = fresh(F); const int r32 = Fe.lane & 31, hi = Fe.lane >> 5;
        if (st == 0) {
#pragma unroll
            for (int d = 0; d < 4; ++d)
#pragma unroll
                for (int r = 0; r < 16; r += 4) *(f32x4*)(stash + d * 16 + r) = (f32x4){o[d][r] * rli[r], o[d][r + 1] * rli[r + 1], o[d][r + 2] * rli[r + 2], o[d][r + 3] * rli[r + 3]};
        } else {
            float ss[16];
#pragma unroll
            for (int r = 0; r < 16; ++r) ss[r] = 0.f;
#pragma unroll
            for (int d = 0; d < 4; ++d)
#pragma unroll
                for (int r = 0; r < 16; r += 4) { const f32x4 p0 = *(const f32x4*)(stash + d * 16 + r);
#pragma unroll
                    for (int t = 0; t < 4; ++t) { const float v = p0[t] - lam * (o[d][r + t] * rli[r + t]); o[d][r + t] = v; ss[r + t] += v * v; } }
#pragma unroll
            for (int r = 0; r < 16; ++r) { float v = ss[r]; v += __shfl_xor(v, 1); v += __shfl_xor(v, 2); v += __shfl_xor(v, 4); v += __shfl_xor(v, 8); v += __shfl_xor(v, 16);
                ss[r] = 1.0f / sqrtf(v * (1.0f / 128.0f) + RMS_EPS) * (1.0f - lambda_init); }
            const float* g = a.in[IN_SUBLN] + jl * 128;
#pragma unroll
            for (int d = 0; d < 4; ++d) { const float gd = g[d * 32 + r32];
#pragma unroll
                for (int r = 0; r < 16; ++r) { const size_t row = row0 + Fe.wave * 32 + fa::crow(r, hi);
                    O[row * DM + h * 128 + d * 32 + r32] = (bf16_t)(cvt_pk_bf16(o[d][r] * ss[r] * gd, 0.f) & 0xffffu); } }
        }
    }
}
__device__ __forceinline__ void attn_mla_mfma(const Frame& F, const Args& a, int unit) {
    unsigned char* ws = a.ws; const bf16_t* QB = (const bf16_t*)(ws + WS_R2); const bf16_t* KVB = QB + (size_t)NTOK * 768; const bf16_t* KR = KVB + (size_t)NTOK * 1024; bf16_t* O = (bf16_t*)(ws + WS_R3);
    const int qb = unit & 7, h = (unit >> 3) & 7, b = unit >> 6;
    const size_t row0 = (size_t)b * SEQ + qb * 256, key0 = (size_t)b * SEQ;
    fa::f32x16 o[2]; float rli[16];
    __syncthreads();
    const Frame Fs = fresh(F);
    fa::attn_stream<96, 64, 102062, 2>(Fs, QB + row0 * 768 + h * 96, 768, KVB + key0 * 1024 + h * 128, 1024, KR + key0 * 32, KVB + key0 * 1024 + h * 128 + 64, 1024, (const float*)(ws + WS_ROPEB), qb * 256, o, rli);
    const Frame Fe = fresh(F); const int r32 = Fe.lane & 31, hi = Fe.lane >> 5;
#pragma unroll
    for (int d = 0; d < 2; ++d)
#pragma unroll
        for (int r = 0; r < 16; ++r) { const size_t row = row0 + Fe.wave * 32 + fa::crow(r, hi);
            O[row * DM + 512 + h * 64 + d * 32 + r32] = (bf16_t)(cvt_pk_bf16(o[d][r] * rli[r], 0.f) & 0xffffu); }
}

constexpr int NA_KSTR = 580;
constexpr int NA_VOFF = 8 * NA_KSTR * 16;
constexpr int NA_BOFF = NA_VOFF + 72 * 64 * 16;
__device__ __forceinline__ void attn_na_lds(const Frame& F, const Args& a, int layer, int unit) {
    unsigned char* ws = a.ws; const bf16_t* Qc = (const bf16_t*)(ws + WS_R1); const bf16_t* Kc = Qc + (size_t)NTOK * DM; const bf16_t* Vt = Kc + (size_t)NTOK * DM; bf16_t* O = (bf16_t*)(ws + WS_R3);
    const int rp = unit & 15, h = (unit >> 4) & 15, b = unit >> 8;
    const int ra = rp * 2, r0a = min(max(ra - 4, 0), 24);
    const size_t bh = (size_t)(b * 16 + h);
    LAS char* lds = (LAS char*)F.lds; LAS float* bl = (LAS float*)(lds + NA_BOFF);
    __syncthreads();
    {
        const bf16_t* kg = Kc + (bh * SEQ + r0a * 64) * 64; const bf16_t* vg = Vt + (bh * (SEQ / 8) + r0a * 8) * 64 * 8;
        const int kk = (F.tid & 7) + 8 * (F.tid >> 6), cs = (F.tid >> 3) & 7;
        u32x4 kv[9], vv[9];
#pragma unroll
        for (int i = 0; i < 9; ++i) { kv[i] = *(const u32x4*)(kg + (size_t)(64 * i + kk) * 64 + cs * 8); vv[i] = *(const u32x4*)(vg + (size_t)(F.tid + NTHREADS * i) * 8); }
#pragma unroll
        for (int i = 0; i < 9; ++i) { *(LAS u32x4*)(lds + (cs * NA_KSTR + 64 * i + kk) * 16) = kv[i]; *(LAS u32x4*)(lds + NA_VOFF + (F.tid + NTHREADS * i) * 16) = vv[i]; }
        const float* relb = a.in[IN_RELB] + ((size_t)(layer >> 1) * 16 + h) * 465;
        if (F.tid < 465) bl[F.tid] = relb[F.tid];
    }
    __syncthreads();
    const int r = ra + (F.wave >> 2), j = F.wave & 3, qi = F.lane & 15, g = F.lane >> 4, c = 16 * j + qi;
    const int r0 = min(max(r - 4, 0), 24), d = r0 - r0a, c0 = min(max(c - 8, 0), 48), cb = (j == 0) ? 0 : (j == 1) ? 8 : (j == 2) ? 24 : 32;
    const float LOG2E = 1.4426950408889634f;
    const bf16_t* qp = Qc + (bh * SEQ + r * 64 + c) * 64 + 8 * g;
    const bf16x8 qf0 = *(const bf16x8*)qp, qf1 = *(const bf16x8*)(qp + 32);
    const int kx = 8 * (qi >> 2) + (qi & 3);
    const LAS char* kbase = lds + ((g * NA_KSTR) + d * 64 + cb + kx) * 16;
    f32x4 S[8][2];
#pragma unroll
    for (int i = 0; i < 8; ++i)
#pragma unroll
        for (int xb = 0; xb < 2; ++xb) { const LAS char* kp = kbase + (i * 64 + 4 * xb) * 16;
            const bf16x8 kf0 = *(const LAS bf16x8*)kp, kf1 = *(const LAS bf16x8*)(kp + 4 * NA_KSTR * 16);
            f32x4 z = (f32x4){0.f, 0.f, 0.f, 0.f};
            z = __builtin_amdgcn_mfma_f32_16x16x32_bf16(kf0, qf0, z, 0, 0, 0);
            z = __builtin_amdgcn_mfma_f32_16x16x32_bf16(kf1, qf1, z, 0, 0, 0);
            S[i][xb] = z; }
    float mx = -INFINITY;
#pragma unroll
    for (int i = 0; i < 8; ++i) { const LAS float* brow = bl + (r0 + i - r + 7) * 31;
#pragma unroll
        for (int xb = 0; xb < 2; ++xb)
#pragma unroll
            for (int t = 0; t < 4; ++t) { const int kc = cb + 8 * g + 4 * xb + t; const bool valid = (kc >= c0) && (kc < c0 + 16); const int co = min(max(kc - c + 15, 0), 30);
                const float v = valid ? (S[i][xb][t] * 0.125f + brow[co]) * LOG2E : -INFINITY; S[i][xb][t] = v; mx = fmaxf(mx, v); } }
    mx = fmaxf(mx, __shfl_xor(mx, 16)); mx = fmaxf(mx, __shfl_xor(mx, 32));
    float sum = 0.f; bf16x8 pf[8];
#pragma unroll
    for (int i = 0; i < 8; ++i) { float pv[8];
#pragma unroll
        for (int xb = 0; xb < 2; ++xb)
#pragma unroll
            for (int t = 0; t < 4; ++t) { const float p = __builtin_amdgcn_exp2f(S[i][xb][t] - mx); pv[xb * 4 + t] = p; sum += p; }
        const u32x4 w = pack8(pv); pf[i] = *(const bf16x8*)&w; }
    sum += __shfl_xor(sum, 16); sum += __shfl_xor(sum, 32);
    const float inv = 1.0f / sum;
    f32x4 acc[4];
    const LAS char* vbase = lds + NA_VOFF + ((d * 8 + (cb >> 3) + g) * 64 + qi) * 16;
#pragma unroll
    for (int dvb = 0; dvb < 4; ++dvb) { acc[dvb] = (f32x4){0.f, 0.f, 0.f, 0.f};
#pragma unroll
        for (int i = 0; i < 8; ++i) { const bf16x8 vf = *(const LAS bf16x8*)(vbase + (i * 8 * 64 + 16 * dvb) * 16);
            acc[dvb] = __builtin_amdgcn_mfma_f32_16x16x32_bf16(vf, pf[i], acc[dvb], 0, 0, 0); } }
    bf16_t* op = O + ((size_t)b * SEQ + r * 64 + c) * DM + h * 64 + 4 * g;
#pragma unroll
    for (int dvb = 0; dvb < 4; ++dvb) { u32x2 w; w.x = cvt_pk_bf16(acc[dvb][0] * inv, acc[dvb][1] * inv); w.y = cvt_pk_bf16(acc[dvb][2] * inv, acc[dvb][3] * inv); *(u32x2*)(op + 16 * dvb) = w; }
}

template <int PER> __device__ __forceinline__ int xcd_unit(int i, int c, int G, int nunits) {
    int u;
    if ((G & 7) == 0 && ((G >> 3) % PER) == 0) { const int gpx = (G >> 3) / PER, sl = c >> 3; u = (i * (G / PER) + (c & 7) * gpx + sl / PER) * PER + sl % PER; }
    else u = i * G + c;
    return u < nunits ? u : -1;
}

constexpr int LDS_BYTES = 160 * 1024;
constexpr int MISC_OFF = LDS_BYTES - 256;
static_assert(NA_BOFF + 2048 <= MISC_OFF, "neighbourhood attention LDS image");
constexpr int NPH_LAYER = 9, NPHASES = 1 + DEPTH * NPH_LAYER;

#define IN(k) (a.lo <= (k) && (k) < a.hi)
#define SEAM(k) do { if (IN(k) && IN((k) + 1)) { const Frame Fb = fresh(F); xcd_barrier(bar, Fb.tid); } } while (0)
template <int LAYER> __device__ __forceinline__ void layer_phases(const Frame& F, const Args& a, const XcdBarrier& bar) {
    constexpr int layer = LAYER;
        constexpr int p0 = 1 + layer * NPH_LAYER, j = layer >> 1; constexpr bool even = (layer & 1) == 0;
        if (IN(p0)) {
            const Frame Fp = fresh(F); const Args ap = fresh(a); unsigned char* w = ap.ws;
            REPEAT(1) phase_moe_weights(Fp, ap, layer);
            if constexpr (even) { g8::DenseSched S; S.init(w + WS_X, DM, (const bf16_t*)(w + WS_WIN) + (size_t)j * HLD * DM, DM, NTOK, HLD, Fp.G, Fp.bid); S.rep = 1 + ((REP_MASK >> 2) & 1);
                g8::EpiEvenIn E{(bf16_t*)(w + WS_R1), (bf16_t*)(w + WS_R2) + (size_t)NTOK * 1792, (float*)(w + WS_SSQ), (const float*)(w + WS_ROPEA), (const float*)(w + WS_ROPEB)}; g8::gemm_phase(Fp, DM, S, E); }
            else { g8::DenseSched S; S.init(w + WS_X, DM, (const bf16_t*)(w + WS_WQKV) + (size_t)j * 3072 * DM, DM, NTOK, 3072, Fp.G, Fp.bid); S.rep = 1 + ((REP_MASK >> 11) & 1);
#if NAIVE_NA
                g8::EpiPlain E{(bf16_t*)(w + WS_R1), 3072}; g8::gemm_phase(Fp, DM, S, E); }
#else
                g8::EpiQKV E{(bf16_t*)(w + WS_R1), (bf16_t*)(w + WS_R1) + (size_t)NTOK * DM, (bf16_t*)(w + WS_R1) + (size_t)2 * NTOK * DM}; g8::gemm_phase(Fp, DM, S, E); }
#endif
        }
        SEAM(p0);
        if constexpr (even) if (IN(p0 + 1)) REPEAT(3) {
            const Frame Fp = fresh(F); const Args ap = fresh(a); unsigned char* w = ap.ws;
            { g8::DenseSched S; S.init((bf16_t*)(w + WS_R1) + 1536, HLD, (const bf16_t*)(w + WS_WUQ) + (size_t)j * 768 * 256, 256, NTOK, 768, Fp.G, Fp.bid);
              g8::EpiMla<0> E{(bf16_t*)(w + WS_R2), (const float*)(w + WS_SSQ)}; g8::gemm_phase(Fp, 256, S, E); }
            const Frame Fq = fresh(F);
            { g8::DenseSched S; S.init((bf16_t*)(w + WS_R1) + 1792, HLD, (const bf16_t*)(w + WS_WUKV) + (size_t)j * 1024 * 256, 256, NTOK, 1024, Fq.G, Fq.bid);
              g8::EpiMla<1> E{(bf16_t*)(w + WS_R2) + (size_t)NTOK * 768, (const float*)(w + WS_SSQ)}; g8::gemm_phase(Fq, 256, S, E); }
        }
        SEAM(p0 + 1);
        if (IN(p0 + 2)) {
            const Frame Fp = fresh(F); const Args ap = fresh(a);
#if NAIVE_ATTN
            if (even) { for (int u = Fp.bid; u < NBATCH * 4 * 8; u += Fp.G) attn_diff_naive(Fp, ap, layer, u);
                        for (int u = Fp.bid; u < NBATCH * 8 * 4; u += Fp.G) attn_mla_naive(Fp, ap, u); }
#else
            if constexpr (even) REPEAT(4) { for (int i = 0, u; (u = xcd_unit<8>(i, Fp.bid, Fp.G, NBATCH * 4 * 8)) >= 0; ++i) attn_diff_mfma(Fp, ap, layer, u);
                        for (int i = 0, u; (u = xcd_unit<8>(i, Fp.bid, Fp.G, NBATCH * 8 * 8)) >= 0; ++i) attn_mla_mfma(Fp, ap, u); }
#endif
#if NAIVE_NA
            if (!even) { for (int u = Fp.bid; u < NBATCH * 32 * 2; u += Fp.G) attn_na_naive(Fp, ap, layer, u); }
#else
            if constexpr (!even) REPEAT(5) { for (int i = 0, u; (u = xcd_unit<16>(i, Fp.bid, Fp.G, NBATCH * 16 * 16)) >= 0; ++i) attn_na_lds(Fp, ap, layer, u); }
#endif
            __syncthreads();
        }
        SEAM(p0 + 2);
        if (IN(p0 + 3)) REPEAT(6) {
            const Frame Fp = fresh(F); const Args ap = fresh(a); unsigned char* w = ap.ws;
            g8::DenseSched S; S.init(w + WS_R3, DM, (const bf16_t*)(w + (even ? WS_WOE : WS_WOO)) + (size_t)j * DM * DM, DM, NTOK, DM, Fp.G, Fp.bid);
            g8::EpiResStats E{(const bf16_t*)(w + WS_X), (bf16_t*)(w + WS_R1), (f32x2*)(w + WS_R2)}; g8::gemm_phase(Fp, DM, S, E);
        }
        SEAM(p0 + 3);
        if (IN(p0 + 4)) REPEAT(12) { const Frame Fp = fresh(F); const Args ap = fresh(a); phase_ln1_router(Fp, ap, layer); }
        SEAM(p0 + 4);
        if (IN(p0 + 5)) { const Frame Fp = fresh(F); const Args ap = fresh(a); phase_scatter(Fp, ap); }
        SEAM(p0 + 5);
        if (IN(p0 + 6)) REPEAT(8) {
            const Frame Fp = fresh(F); const Args ap = fresh(a); unsigned char* w = ap.ws;
            g8::MoeSched<true> S; S.A = (const char*)(w + WS_X); S.Wt = (const char*)(w + WS_W13); S.tile = (const int*)(w + WS_TILE); S.slot_tok = (const int*)(w + WS_SLOT_TOK);
            S.lda2 = DM * 2; S.K2 = DM * 2; S.wstride = (size_t)1024 * 1024 * 2; S.T = S.tile[0]; S.G = Fp.G; S.c = Fp.bid;
            g8::EpiMoe1 E{(bf16_t*)(w + WS_R1)}; g8::gemm_phase(Fp, DM, S, E);
        }
        SEAM(p0 + 6);
        if (IN(p0 + 7)) REPEAT(9) {
            const Frame Fp = fresh(F); const Args ap = fresh(a); unsigned char* w = ap.ws;
            g8::MoeSched<false> S; S.A = (const char*)(w + WS_R1); S.Wt = (const char*)(w + WS_W2); S.tile = (const int*)(w + WS_TILE); S.slot_tok = (const int*)(w + WS_SLOT_TOK);
            S.lda2 = DEXP * 2; S.K2 = DEXP * 2; S.wstride = (size_t)1024 * 512 * 2; S.T = S.tile[0]; S.G = Fp.G; S.c = Fp.bid;
            g8::EpiPlain E{(bf16_t*)(w + WS_R2), DM}; g8::gemm_phase(Fp, DEXP, S, E);
        }
        SEAM(p0 + 7);
        if (IN(p0 + 8)) { const Frame Fp = fresh(F); const Args ap = fresh(a);
            if constexpr (((REP_MASK >> 13) & 1) != 0) { phase_ln2(Fp, ap, layer, false, true); __syncthreads(); }
            phase_ln2(Fp, ap, layer, layer == DEPTH - 1); }
        SEAM(p0 + 8);
    }
#undef IN
#undef SEAM

__global__ void __launch_bounds__(NTHREADS, 2) fwd_kernel(Args a) {
    extern __shared__ __attribute__((aligned(16))) unsigned char lds_raw[];
    Frame F; F.lds = (LAS unsigned char*)lds_raw; F.wave = __builtin_amdgcn_readfirstlane((int)threadIdx.x >> 6); F.tid = 0; F.lane = 0; F.G = gridDim.x; F.bid = blockIdx.x;
    unsigned char* ws = a.ws;
    volatile LAS unsigned* MISC = (volatile LAS unsigned*)(F.lds + MISC_OFF);
    { const Frame Fp = fresh(F); if (Fp.tid < 4) MISC[Fp.tid] = 0u; }
    __syncthreads();
    const bool one = (a.hi - a.lo) > 1;
    XcdBarrier bar; bar.bar = (unsigned*)(ws + WS_CTL); bar.x = 0; bar.st = MISC;
    if (one) { const Frame Fp = fresh(F); bar = xcd_barrier_post((unsigned*)(ws + WS_CTL), MISC, Fp.tid); }
#define IN(k) (a.lo <= (k) && (k) < a.hi)
#define SEAM(k) do { if (IN(k) && IN((k) + 1)) { const Frame Fb = fresh(F); xcd_barrier(bar, Fb.tid); } } while (0)

    if (IN(0)) REPEAT(0) { const Frame Fp = fresh(F); const Args ap = fresh(a); phase_prologue(Fp, ap); }
    SEAM(0);
    if constexpr (((REP_MASK >> 14) & 1) != 0) { if (one) for (int xb_ = 0; xb_ < 100; ++xb_) { const Frame Fb = fresh(F); xcd_barrier(bar, Fb.tid); } }
    layer_phases<0>(F, a, bar); layer_phases<1>(F, a, bar); layer_phases<2>(F, a, bar); layer_phases<3>(F, a, bar);
#undef IN
#undef SEAM
}

extern "C" void kernel_launch(void* const* d_in, const int* in_sizes, int n_in, void* d_out, int out_size, void* d_ws, size_t ws_size, hipStream_t stream) {
    static int grid = 0;
    if (grid == 0) {
        if (n_in != 26 || in_sizes[0] != NTOK * DM || out_size != NTOK * DM || ws_size < WS_END) {
            fprintf(stderr, "kernel_launch: unexpected shapes / workspace (n_in %d, in0 %d, out %d, ws %zu, need %zu)\n", n_in, n_in > 0 ? in_sizes[0] : -1, out_size, ws_size, (size_t)WS_END); grid = -1; return; }
        int dev = 0, cus = 0, per_cu = 0;
        if (hipGetDevice(&dev) != hipSuccess || hipDeviceGetAttribute(&cus, hipDeviceAttributeMultiprocessorCount, dev) != hipSuccess) { grid = -1; return; }
        if (hipFuncSetAttribute((const void*)fwd_kernel, hipFuncAttributeMaxDynamicSharedMemorySize, LDS_BYTES) != hipSuccess) { fprintf(stderr, "kernel_launch: hipFuncSetAttribute failed\n"); grid = -1; return; }
        if (hipOccupancyMaxActiveBlocksPerMultiprocessor(&per_cu, (const void*)fwd_kernel, NTHREADS, LDS_BYTES) != hipSuccess || per_cu < 1) fprintf(stderr, "kernel_launch: occupancy query reports %d\n", per_cu);
        (void)hipGetLastError();
        grid = cus;
    }
    if (grid < 0) return;
    (void)hipMemsetAsync((char*)d_ws + WS_CTL, 0, 64 * 1024, stream);
    Args a{};
    for (int i = 0; i < 26; ++i) a.in[i] = (const float*)d_in[i];
    a.out = (float*)d_out; a.ws = (unsigned char*)d_ws;
#if MK_ONE_LAUNCH
    a.lo = 0; a.hi = NPHASES;
    hipLaunchKernelGGL(fwd_kernel, dim3(grid), dim3(NTHREADS), LDS_BYTES, stream, a);
#else
    for (int p = 0; p < NPHASES; ++p) {
        if (p >= 1 && ((p - 1) % NPH_LAYER) == 1 && (((p - 1) / NPH_LAYER) & 1)) continue;
        a.lo = p; a.hi = p + 1;
        hipLaunchKernelGGL(fwd_kernel, dim3(grid), dim3(NTHREADS), LDS_BYTES, stream, a);
    }
#endif
}
```

```cpp
#include <hip/hip_runtime.h>
#include <cstdio>
#include <cstdint>

#ifndef NAIVE_ATTN
#define NAIVE_ATTN 0
#endif
#ifndef NAIVE_NA
#define NAIVE_NA 0
#endif
#ifndef REP_MASK
#define REP_MASK 0
#endif
#define REPEAT(k) _Pragma("unroll 1") for (int rep_ = 0; rep_ < 1 + ((REP_MASK >> (k)) & 1); ++rep_)
#ifndef PROF_TYPE
#define PROF_TYPE (-1)
#endif
#ifndef PROF_SCALE
#define PROF_SCALE 2.0e-4f
#endif
#ifndef MK_ONE_LAUNCH
#define MK_ONE_LAUNCH 1
#endif

typedef unsigned short bf16_t;
typedef short bf16x8 __attribute__((ext_vector_type(8)));
typedef float f32x4 __attribute__((ext_vector_type(4)));
typedef float f32x2 __attribute__((ext_vector_type(2)));
typedef unsigned u32x4 __attribute__((ext_vector_type(4)));
typedef unsigned u32x2 __attribute__((ext_vector_type(2)));
#define LAS __attribute__((address_space(3)))

constexpr int NTOK = 65536, DM = 1024, SEQ = 2048, NBATCH = 32, DEPTH = 4;
constexpr int EVEN_IN = 1952, HLD = 2048;
constexpr int NEXP = 32, DEXP = 512;
constexpr int MAXTILES = NTOK * 2 / 256 + NEXP;
constexpr int MAXSLOTS = MAXTILES * 256;
constexpr float DN_ALPHA = 1.681792830507429f;
constexpr float LN_EPS = 1e-5f, RMS_EPS = 1e-6f;
constexpr int NTHREADS = 512;

constexpr size_t MiB = 1024ull * 1024ull;
constexpr size_t WS_CTL = 0;
constexpr size_t WS_LAM = 48 * 1024;
constexpr size_t WS_ROPEA = 64 * 1024;
constexpr size_t WS_ROPEB = WS_ROPEA + 128 * 1024;
constexpr size_t WS_WR = WS_ROPEB + 256 * 1024;
constexpr size_t WS_ROUTE = WS_WR + 832 * 1024;
constexpr size_t WS_CNT = WS_ROUTE + 1 * MiB;
constexpr size_t WS_TILE = WS_CNT + 32 * 1024;
constexpr size_t WS_SLOT_TOK = WS_TILE + 4 * 1024;
constexpr size_t WS_SLOT_G = WS_SLOT_TOK + 576 * 1024;
constexpr size_t WS_SLOT_DST = WS_SLOT_G + 576 * 1024;
constexpr size_t WS_SSQ = WS_SLOT_DST + 576 * 1024;
constexpr size_t WS_WIN = 6 * MiB;
constexpr size_t WS_WUQ = WS_WIN + 8 * MiB;
constexpr size_t WS_WUKV = WS_WUQ + 1 * MiB;
constexpr size_t WS_WOE = WS_WUKV + 1 * MiB;
constexpr size_t WS_WQKV = WS_WOE + 4 * MiB;
constexpr size_t WS_WOO = WS_WQKV + 12 * MiB;
constexpr size_t WS_W13 = 36 * MiB;
constexpr size_t WS_W2 = WS_W13 + 64 * MiB;
constexpr size_t WS_X = WS_W2 + 32 * MiB;
constexpr size_t WS_R1 = WS_X + 128 * MiB;
constexpr size_t WS_R2 = WS_R1 + 384 * MiB;
constexpr size_t WS_R3 = WS_R2 + 228 * MiB;
constexpr size_t WS_END = WS_R3 + 128 * MiB;
static_assert(WS_SSQ + 2 * MiB <= WS_WIN, "misc region");
static_assert(WS_WOO + 4 * MiB <= WS_W13, "small weights region");

__device__ __forceinline__ unsigned cvt_pk_bf16(float lo, float hi) { unsigned r; asm volatile("v_cvt_pk_bf16_f32 %0, %1, %2" : "=v"(r) : "v"(lo), "v"(hi)); return r; }
__device__ __forceinline__ float bf_lo(unsigned w) { return __uint_as_float(w << 16); }
__device__ __forceinline__ float bf_hi(unsigned w) { return __uint_as_float(w & 0xffff0000u); }
__device__ __forceinline__ float bf2f(bf16_t b) { return __uint_as_float(((unsigned)b) << 16); }
__device__ __forceinline__ void unpack8(const u32x4 w, float (&f)[8]) {
    f[0] = bf_lo(w.x); f[1] = bf_hi(w.x); f[2] = bf_lo(w.y); f[3] = bf_hi(w.y); f[4] = bf_lo(w.z); f[5] = bf_hi(w.z); f[6] = bf_lo(w.w); f[7] = bf_hi(w.w); }
__device__ __forceinline__ u32x4 pack8(const float (&f)[8]) { u32x4 w; w.x = cvt_pk_bf16(f[0], f[1]); w.y = cvt_pk_bf16(f[2], f[3]); w.z = cvt_pk_bf16(f[4], f[5]); w.w = cvt_pk_bf16(f[6], f[7]); return w; }
__device__ __forceinline__ float wave_sum(float v) {
#pragma unroll
    for (int o = 32; o >= 1; o >>= 1) v += __shfl_xor(v, o);
    return v; }

struct Frame { LAS unsigned char* lds; int tid, lane, wave, G, bid; };
#define XB_TMO      128
#define XB_XCNT(j)  (256  + 64 * (j))
#define XB_XSUB(j)  (1280 + 64 * (j))
#define XB_XGEN(j)  (2304 + 64 * (j))
#define XB_TOP      3328
#define XB_TOPGEN   3392
#define XCD_BAR_WORDS 3456
#define XB_SPIN_CAP (1u << 21)
__device__ __forceinline__ unsigned xb_ld(unsigned* p)              { return __hip_atomic_load(p, __ATOMIC_RELAXED, __HIP_MEMORY_SCOPE_AGENT); }
__device__ __forceinline__ unsigned xb_add(unsigned* p, unsigned v) { return __hip_atomic_fetch_add(p, v, __ATOMIC_RELAXED, __HIP_MEMORY_SCOPE_AGENT); }
__device__ __forceinline__ unsigned xb_xcc_id() { return (unsigned)__builtin_amdgcn_s_getreg((3 << 11) | 20) & 0xFu; }
#define XB_SPIN(cond, bar) do { unsigned _sp = 0; while (cond) { __builtin_amdgcn_s_sleep(1); \
    if ((++_sp & 255u) == 0u) { if (xb_ld(&(bar)[XB_TMO])) break; if (_sp > XB_SPIN_CAP) { atomicAdd(&(bar)[XB_TMO], 1u); break; } } } } while (0)
struct XcdBarrier { unsigned* bar; unsigned x; volatile LAS unsigned* st; };
__device__ __forceinline__ XcdBarrier xcd_barrier_post(unsigned* bar, volatile LAS unsigned* st, int tid) {
    XcdBarrier b; b.bar = bar; b.x = xb_xcc_id(); b.st = st;
    if (tid == 0) (void)xb_add(&bar[XB_XCNT(b.x)], 1u);
    return b;
}
__device__ __forceinline__ void xcd_barrier_complete(unsigned* bar, unsigned x, unsigned& nloc, unsigned& nx) {
    const unsigned G = gridDim.x * gridDim.y * gridDim.z;
    unsigned sum, cnt, mine, sp = 0u;
    for (;;) {
        sum = 0u; cnt = 0u; mine = 0u;
#pragma unroll
        for (unsigned j = 0; j < 16; ++j) { const unsigned c = xb_ld(&bar[XB_XCNT(j)]); sum += c; cnt += (c > 0u) ? 1u : 0u; mine = (j == x) ? c : mine; }
        if (sum == G) break;
        __builtin_amdgcn_s_sleep(1);
        if ((++sp & 255u) == 0u) { if (xb_ld(&bar[XB_TMO])) break; if (sp > XB_SPIN_CAP) { atomicAdd(&bar[XB_TMO], 1u); break; } }
    }
    nloc = mine > 0u ? mine : 1u; nx = cnt > 0u ? cnt : 1u;
}
__device__ __forceinline__ void xcd_barrier(const XcdBarrier& b, int tid) {
    asm volatile("s_waitcnt vmcnt(0)" ::: "memory");
    __syncthreads();
    if (tid == 0) {
        unsigned* bar = b.bar; unsigned bx = b.x; asm volatile("" : "+s"(bx));
        __builtin_amdgcn_s_waitcnt(0);
        unsigned nloc = b.st[0], nx = b.st[1];
        if (nloc == 0u) { xcd_barrier_complete(bar, bx, nloc, nx); b.st[0] = nloc; b.st[1] = nx; }
        const unsigned old = xb_add(&bar[XB_XSUB(bx)], 1u);
        const unsigned gen = old / nloc;
        if (old + 1u == (gen + 1u) * nloc) {
            __builtin_amdgcn_fence(__ATOMIC_RELEASE, "agent");
            asm volatile("s_waitcnt vmcnt(0)" ::: "memory");
            const unsigned og = xb_add(&bar[XB_TOP], 1u);
            const unsigned tg = og / nx;
            if (og + 1u == (tg + 1u) * nx) xb_add(&bar[XB_TOPGEN], 1u);
            else XB_SPIN(xb_ld(&bar[XB_TOPGEN]) == tg, bar);
            __builtin_amdgcn_fence(__ATOMIC_ACQUIRE, "agent");
            xb_add(&bar[XB_XGEN(bx)], 1u);
            asm volatile("s_waitcnt vmcnt(0)" ::: "memory");
        } else {
            XB_SPIN(xb_ld(&bar[XB_XGEN(bx)]) == gen, bar);
            __builtin_amdgcn_fence(__ATOMIC_ACQUIRE, "agent");
            asm volatile("s_waitcnt vmcnt(0)" ::: "memory");
        }
    }
    __syncthreads();
}

namespace g8 {
constexpr int BM = 256, BK = 64, HALF = 128, HTB = HALF * BK * 2, STAGE_BYTES = 8 * HTB, NXCD = 8, WGM = 8;
__device__ __forceinline__ int lds_byte(int r, int c) { const int st = (r >> 4) * 2 + (c >> 5), rr = r & 15, cc = c & 31, ob = rr * 64 + cc * 2; return st * 1024 + (ob ^ (((ob >> 9) & 1) << 5)); }
__device__ __forceinline__ void stage_rc(int b, int& R, int& C) { const int st = b / 1024, sb = b % 1024, swz = sb ^ (((sb >> 9) & 1) << 5); R = (st >> 1) * 16 + swz / 64; C = (st & 1) * 32 + (swz % 64) / 2; }
__device__ __forceinline__ int perm32(int rho) { const int n = rho >> 4, i = rho & 15; return 8 * (i >> 2) + 4 * n + (i & 3); }

struct Unit { const char* A; const char* B; int row0, pm, pn, e; };
typedef f32x4 Acc[2][2][4][2];

struct DenseSched {
    const char* A; const char* Bt; unsigned lda2; int K2; int nM, nN, nwg, G, c; int rep = 1;
    __device__ __forceinline__ void init(const void* A_, int lda, const void* Bt_, int K, int M, int N, int G_, int c_) { A = (const char*)A_; Bt = (const char*)Bt_; lda2 = (unsigned)lda * 2u; K2 = K * 2; nM = M / BM; nN = N / BM; nwg = nM * nN; G = G_; c = c_; }
    __device__ __forceinline__ bool next(int i, Unit& u) const {
        long L = (long)i * G + c; if (L >= (long)nwg * rep) return false;
        if (rep > 1) L %= nwg;
        int wgid = (int)L; { const int q = nwg / NXCD, r = nwg % NXCD, xcd = wgid % NXCD, off = wgid / NXCD; wgid = (xcd < r ? xcd * (q + 1) : r * (q + 1) + (xcd - r) * q) + off; }
        const int nig = WGM * nN, gid = wgid / nig, fm = gid * WGM, gsz = (nM - fm) < WGM ? (nM - fm) : WGM;
        u.pm = fm + ((wgid % nig) % gsz); u.pn = (wgid % nig) / gsz; u.row0 = u.pm * BM; u.e = 0;
        u.A = A + (size_t)u.row0 * lda2; u.B = Bt + (size_t)u.pn * BM * K2; return true;
    }
    static constexpr bool GATHER = false;
    __device__ __forceinline__ unsigned rowoff(const Unit&, int r) const { return (unsigned)r * lda2; }
};
template <bool GATHER_> struct MoeSched {
    const char* A; const char* Wt; const int* tile; const int* slot_tok; unsigned lda2; int K2; size_t wstride; int T, G, c;
    __device__ __forceinline__ bool next(int i, Unit& u) const {
        int t, pnn;
        if ((G & 31) == 0) { const int x = c & 7, sl = c >> 3, per = G >> 5; t = i * (G >> 2) + x * per + (sl >> 2); pnn = sl & 3; }
        else { const int L = i * G + c; t = L >> 2; pnn = L & 3; }
        if (t >= T) return false;
        u.pn = pnn; u.pm = t; u.row0 = t * BM; u.e = tile[1 + t];
        u.A = GATHER_ ? A : A + (size_t)u.row0 * lda2; u.B = Wt + (size_t)u.e * wstride + (size_t)u.pn * BM * K2; return true;
    }
    static constexpr bool GATHER = GATHER_;
    __device__ __forceinline__ unsigned rowoff(const Unit& u, int r) const { return GATHER_ ? (unsigned)slot_tok[u.row0 + r] * lda2 : (unsigned)r * lda2; }
};

template <class Epi, class Sched>
__device__ __forceinline__ void gemm_phase(const Frame& F, const int K_, const Sched& S, const Epi& E) {
    LAS unsigned char* lds = F.lds;
    int K = K_; asm volatile("" : "+s"(K));
    const int tid = F.tid, wid = __builtin_amdgcn_readfirstlane(tid >> 6), lane = tid & 63, wr = wid >> 2, wc = wid & 3, fr = lane & 15, fq = lane >> 4;
    const int nt = K / BK;
    int RA[2]; unsigned CA[2], voffB[2];
#pragma unroll
    for (int i = 0; i < 2; ++i) { int R, C; stage_rc(tid * 16 + i * 8192, R, C); const int Rb = (R & ~31) + perm32(R & 31);
        RA[i] = R; CA[i] = (unsigned)C * 2u; voffB[i] = (unsigned)(Rb * K + C) * 2u; }
    const size_t kstep = (size_t)(BK * 2);
    const size_t hstepB = (size_t)HALF * K * 2;
    size_t hstepA = 0; if constexpr (!Sched::GATHER) hstepA = (size_t)S.rowoff(Unit{}, HALF);
    const unsigned ldsw = (unsigned)wid * 1024u;
    const int aoff = lds_byte(wr * 64 + fr, fq * 8), boff = lds_byte(wc * 32 + fr, fq * 8);
#define G8_SA(b, h) (((b) * 2 + (h)) * HTB)
#define G8_SB(b, h) ((4 + (b) * 2 + (h)) * HTB)
#define G8_STAGE(bufoff, gbase, voff) do { _Pragma("unroll") for (int _i = 0; _i < 2; ++_i) \
        __builtin_amdgcn_global_load_lds((const unsigned*)((const char*)(gbase) + (voff)[_i]), (LAS unsigned*)(lds + (bufoff) + ldsw + _i * 8192), 16, 0, 0); } while (0)
#define G8_STA(bufoff, gbase, h, V0, V1) do { if constexpr (Sched::GATHER) { if (h) G8_STAGE(bufoff, gbase, V1); else G8_STAGE(bufoff, gbase, V0); } else { G8_STAGE(bufoff, (gbase) + (h) * hstepA, vA0); } } while (0)
#define G8_LDA(dst, b, h) do { _Pragma("unroll") for (int m = 0; m < 4; ++m) _Pragma("unroll") for (int k = 0; k < 2; ++k) dst[m][k] = *(const LAS bf16x8*)(lds + G8_SA(b, h) + aoff + m * 2048 + k * 1024); } while (0)
#define G8_LDB(dst, b, h) do { _Pragma("unroll") for (int n = 0; n < 2; ++n) _Pragma("unroll") for (int k = 0; k < 2; ++k) dst[n][k] = *(const LAS bf16x8*)(lds + G8_SB(b, h) + boff + n * 2048 + k * 1024); } while (0)
#define G8_MMA(ai, bj, At, Bt) do { __builtin_amdgcn_s_setprio(1); _Pragma("unroll") for (int m = 0; m < 4; ++m) _Pragma("unroll") for (int n = 0; n < 2; ++n) _Pragma("unroll") for (int k = 0; k < 2; ++k) \
        acc[ai][bj][m][n] = __builtin_amdgcn_mfma_f32_16x16x32_bf16(Bt[n][k], At[m][k], acc[ai][bj][m][n], 0, 0, 0); __builtin_amdgcn_s_setprio(0); } while (0)
#define G8_WAIT_V(n) asm volatile("s_waitcnt vmcnt(" #n ")" ::: "memory")
#define G8_WAIT_L(n) asm volatile("s_waitcnt lgkmcnt(" #n ")" ::: "memory")
#define G8_BAR __builtin_amdgcn_s_barrier()
#define G8_SCHED __builtin_amdgcn_sched_barrier(0)
    Unit cur, nxt; int ui = 0;
    if (!S.next(0, cur)) return;
    Acc acc;
#pragma unroll
    for (int a = 0; a < 2; ++a)
#pragma unroll
        for (int b = 0; b < 2; ++b)
#pragma unroll
            for (int m = 0; m < 4; ++m)
#pragma unroll
                for (int n = 0; n < 2; ++n) acc[a][b][m][n] = (f32x4){0.f, 0.f, 0.f, 0.f};
    bf16x8 At[4][2], B0[2][2], B1[2][2];
    unsigned vA0[2], vA1[2], nA0[2], nA1[2];
#pragma unroll
    for (int i = 0; i < 2; ++i) { vA0[i] = S.rowoff(cur, RA[i]) + CA[i]; vA1[i] = S.rowoff(cur, HALF + RA[i]) + CA[i]; }
    const char* cA = cur.A; const char* cB = cur.B;
    G8_STAGE(G8_SB(0, 0), cB, voffB); G8_STA(G8_SA(0, 0), cA, 0, vA0, vA1); G8_STAGE(G8_SB(0, 1), cB + hstepB, voffB); G8_STA(G8_SA(0, 1), cA, 1, vA0, vA1);
    if (wr == 1) G8_BAR;
    G8_WAIT_V(4); G8_BAR;
    G8_STAGE(G8_SB(1, 0), cB + kstep, voffB); G8_STA(G8_SA(1, 0), cA + kstep, 0, vA0, vA1); G8_STAGE(G8_SB(1, 1), cB + hstepB + kstep, voffB);
    G8_WAIT_V(6); G8_BAR;
    for (;;) {
        const bool has_next = S.next(ui + 1, nxt);
        const char* nAp = has_next ? nxt.A : cA; const char* nBp = has_next ? nxt.B : cB;
#pragma unroll
        for (int i = 0; i < 2; ++i) { nA0[i] = has_next ? S.rowoff(nxt, RA[i]) + CA[i] : vA0[i]; nA1[i] = has_next ? S.rowoff(nxt, HALF + RA[i]) + CA[i] : vA1[i]; }
        for (int t = 0; t < nt; t += 2) {
            const bool last = (t == nt - 2);
            const char* a1 = cA + (size_t)(t + 1) * kstep;
            const char* a2 = last ? nAp : cA + (size_t)(t + 2) * kstep; const char* b2 = last ? nBp : cB + (size_t)(t + 2) * kstep;
            const char* a3 = a2 + kstep; const char* b3 = b2 + kstep;
            unsigned w0[2], w1[2];
#pragma unroll
            for (int i = 0; i < 2; ++i) { w0[i] = last ? nA0[i] : vA0[i]; w1[i] = last ? nA1[i] : vA1[i]; }
            G8_LDB(B0, 0, 0); G8_SCHED; G8_LDA(At, 0, 0); G8_STA(G8_SA(1, 1), a1, 1, vA0, vA1);
            G8_WAIT_L(8); G8_BAR; G8_WAIT_L(0); G8_MMA(0, 0, At, B0); G8_BAR; G8_SCHED;
            G8_LDB(B1, 0, 1); G8_STAGE(G8_SB(0, 0), b2, voffB);
            G8_BAR; G8_WAIT_L(0); G8_MMA(0, 1, At, B1); G8_BAR;
            G8_LDA(At, 0, 1); G8_STA(G8_SA(0, 0), a2, 0, w0, w1);
            G8_BAR; G8_WAIT_L(0); G8_MMA(1, 0, At, B0); G8_BAR; G8_SCHED;
            G8_STAGE(G8_SB(0, 1), b2 + hstepB, voffB);
            G8_WAIT_V(6); G8_BAR; G8_MMA(1, 1, At, B1); G8_BAR;
            G8_LDB(B0, 1, 0); G8_SCHED; G8_LDA(At, 1, 0); G8_STA(G8_SA(0, 1), a2, 1, w0, w1);
            G8_WAIT_L(8); G8_BAR; G8_WAIT_L(0); G8_MMA(0, 0, At, B0); G8_BAR; G8_SCHED;
            G8_LDB(B1, 1, 1); G8_STAGE(G8_SB(1, 0), b3, voffB);
            G8_BAR; G8_WAIT_L(0); G8_MMA(0, 1, At, B1); G8_BAR;
            G8_LDA(At, 1, 1); G8_STA(G8_SA(1, 0), a3, 0, w0, w1);
            G8_BAR; G8_WAIT_L(0); G8_MMA(1, 0, At, B0); G8_BAR; G8_SCHED;
            G8_STAGE(G8_SB(1, 1), b3 + hstepB, voffB);
            G8_WAIT_V(6); G8_BAR; G8_MMA(1, 1, At, B1); G8_BAR;
        }
        E(acc, cur, wr, wc, fr, fq);
        if (!has_next) break;
#pragma unroll
        for (int a = 0; a < 2; ++a)
#pragma unroll
            for (int b = 0; b < 2; ++b)
#pragma unroll
                for (int m = 0; m < 4; ++m)
#pragma unroll
                    for (int n = 0; n < 2; ++n) acc[a][b][m][n] = (f32x4){0.f, 0.f, 0.f, 0.f};
        cur = nxt; cA = nAp; cB = nBp; ++ui;
#pragma unroll
        for (int i = 0; i < 2; ++i) { vA0[i] = nA0[i]; vA1[i] = nA1[i]; }
    }
    G8_WAIT_V(0);
    if (wr == 0) G8_BAR;
    G8_BAR;
#undef G8_SA
#undef G8_SB
#undef G8_STAGE
#undef G8_STA
#undef G8_LDA
#undef G8_LDB
#undef G8_MMA
#undef G8_WAIT_V
#undef G8_WAIT_L
#undef G8_BAR
#undef G8_SCHED
}

__device__ __forceinline__ u32x4 pack_acc8(const f32x4 v0, const f32x4 v1) { u32x4 w; w.x = cvt_pk_bf16(v0[0], v0[1]); w.y = cvt_pk_bf16(v0[2], v0[3]); w.z = cvt_pk_bf16(v1[0], v1[1]); w.w = cvt_pk_bf16(v1[2], v1[3]); return w; }

struct EpiPlain {
    bf16_t* O; int ldc;
    __device__ __forceinline__ void operator()(Acc& acc, const Unit& u, int wr, int wc, int fr, int fq) const {
        const int row0 = u.pm * BM + wr * 64 + fr, col0 = u.pn * BM + wc * 32 + 8 * fq;
#pragma unroll
        for (int ai = 0; ai < 2; ++ai)
#pragma unroll
            for (int m = 0; m < 4; ++m) { bf16_t* rowp = O + (size_t)(row0 + ai * HALF + m * 16) * ldc + col0;
#pragma unroll
                for (int bj = 0; bj < 2; ++bj) *(u32x4*)(rowp + bj * HALF) = pack_acc8(acc[ai][bj][m][0], acc[ai][bj][m][1]); }
    }
};

struct EpiQKV {
    bf16_t* Qc; bf16_t* Kc; bf16_t* Vt;
    __device__ __forceinline__ void operator()(Acc& acc, const Unit& u, int wr, int wc, int fr, int fq) const {
        const int which = u.pn >> 2, tok0 = u.pm * BM + wr * 64 + fr;
        const int b = tok0 >> 11;
#pragma unroll
        for (int ai = 0; ai < 2; ++ai)
#pragma unroll
            for (int m = 0; m < 4; ++m) { const int s = (tok0 + ai * HALF + m * 16) & (SEQ - 1);
#pragma unroll
                for (int bj = 0; bj < 2; ++bj) { const int h = (u.pn & 3) * 4 + 2 * bj + (wc >> 1), d0 = (wc & 1) * 32 + 8 * fq;
                    if (which < 2) { bf16_t* dst = (which == 0 ? Qc : Kc) + ((size_t)(b * 16 + h) * SEQ + s) * 64 + d0;
                        *(u32x4*)dst = pack_acc8(acc[ai][bj][m][0], acc[ai][bj][m][1]); }
                    else { bf16_t* dst = Vt + (((size_t)(b * 16 + h) * (SEQ / 8) + (s >> 3)) * 64 + d0) * 8 + (s & 7);
#pragma unroll
                        for (int n = 0; n < 2; ++n)
#pragma unroll
                            for (int jj = 0; jj < 4; ++jj) dst[(4 * n + jj) * 8] = (bf16_t)(cvt_pk_bf16(acc[ai][bj][m][n][jj], 0.f) & 0xffffu); } } }
    }
};

struct EpiResStats {
    const bf16_t* X; bf16_t* Yb; f32x2* stats;
    __device__ __forceinline__ void operator()(Acc& acc, const Unit& u, int wr, int wc, int fr, int fq) const {
        const int row0 = u.pm * BM + wr * 64 + fr, col0 = u.pn * BM + wc * 32 + 8 * fq;
        u32x4 xr[2][4][2];
#pragma unroll
        for (int ai = 0; ai < 2; ++ai)
#pragma unroll
            for (int m = 0; m < 4; ++m)
#pragma unroll
                for (int bj = 0; bj < 2; ++bj) xr[ai][m][bj] = *(const u32x4*)(X + (size_t)(row0 + ai * HALF + m * 16) * DM + col0 + bj * HALF);
#pragma unroll
        for (int ai = 0; ai < 2; ++ai)
#pragma unroll
            for (int m = 0; m < 4; ++m) { const int row = row0 + ai * HALF + m * 16; const size_t off = (size_t)row * DM + col0; float s1 = 0.f, s2 = 0.f;
#pragma unroll
                for (int bj = 0; bj < 2; ++bj) { float xv[8]; unpack8(xr[ai][m][bj], xv); f32x4 v[2];
#pragma unroll
                    for (int n = 0; n < 2; ++n)
#pragma unroll
                        for (int j = 0; j < 4; ++j) { const float y = DN_ALPHA * xv[4 * n + j] + acc[ai][bj][m][n][j]; v[n][j] = y; s1 += y; s2 += y * y; }
                    *(u32x4*)(Yb + off + bj * HALF) = pack_acc8(v[0], v[1]); }
                s1 += __shfl_xor(s1, 16); s1 += __shfl_xor(s1, 32); s2 += __shfl_xor(s2, 16); s2 += __shfl_xor(s2, 32);
                if (fq == 0) stats[(size_t)row * 16 + u.pn * 4 + wc] = (f32x2){s1, s2}; }
    }
};

struct EpiEvenIn {
    bf16_t* H; bf16_t* KR; float* ssq; const float* ropeA; const float* ropeB;
    __device__ __forceinline__ void operator()(Acc& acc, const Unit& u, int wr, int wc, int fr, int fq) const {
        const int row0 = u.pm * BM + wr * 64 + fr, col0 = u.pn * BM + wc * 32 + 8 * fq;
        if (u.pn < 4 && (wc & 1) == 0) {
#pragma unroll
            for (int ai = 0; ai < 2; ++ai) { f32x4 tc0[4], tc1[4], ts0[4], ts1[4];
#pragma unroll
                for (int m = 0; m < 4; ++m) { const int pos = (row0 + ai * HALF + m * 16) & (SEQ - 1);
                    tc0[m] = *(const f32x4*)(ropeA + pos * 8); tc1[m] = *(const f32x4*)(ropeA + pos * 8 + 4);
                    ts0[m] = *(const f32x4*)(ropeA + SEQ * 8 + pos * 8); ts1[m] = *(const f32x4*)(ropeA + SEQ * 8 + pos * 8 + 4); }
#pragma unroll
                for (int m = 0; m < 4; ++m) { const f32x4 c0 = tc0[m], c1 = tc1[m], s0 = ts0[m], s1 = ts1[m];
#pragma unroll
                    for (int bj = 0; bj < 2; ++bj)
#pragma unroll
                        for (int n = 0; n < 2; ++n) { const f32x4 own = acc[ai][bj][m][n]; f32x4 oth;
#pragma unroll
                            for (int j = 0; j < 4; ++j) oth[j] = __shfl_xor(own[j], 16);
                            const f32x4 cs = n ? c1 : c0, sn = n ? s1 : s0;
                            if (fq == 0) acc[ai][bj][m][n] = own * cs - oth * sn;
                            else if (fq == 1) acc[ai][bj][m][n] = own * cs + oth * sn; } } }
        }
        if (u.pn >= 6) {
#pragma unroll
            for (int ai = 0; ai < 2; ++ai)
#pragma unroll
                for (int m = 0; m < 4; ++m) { float s = 0.f;
#pragma unroll
                    for (int bj = 0; bj < 2; ++bj) if (u.pn == 6 || bj == 0)
#pragma unroll
                        for (int n = 0; n < 2; ++n) { const f32x4 x = acc[ai][bj][m][n]; s += (x[0] * x[0] + x[1] * x[1]) + (x[2] * x[2] + x[3] * x[3]); }
                    s += __shfl_xor(s, 16); s += __shfl_xor(s, 32);
                    if (fq == 0) ssq[(size_t)(row0 + ai * HALF + m * 16) * 8 + (u.pn == 6 ? 0 : 4) + wc] = s; }
        }
        if (u.pn == 7 && wc == 0) {
#pragma unroll
            for (int ai = 0; ai < 2; ++ai)
#pragma unroll
                for (int m = 0; m < 4; ++m) { const int row = row0 + ai * HALF + m * 16, pos = row & (SEQ - 1); f32x4 o[2];
#pragma unroll
                    for (int n = 0; n < 2; ++n) { const f32x4 own = acc[ai][1][m][n]; f32x4 oth;
#pragma unroll
                        for (int j = 0; j < 4; ++j) oth[j] = __shfl_xor(own[j], 32);
                        const int i0 = 8 * (fq & 1) + 4 * n;
                        const f32x4 cs = *(const f32x4*)(ropeB + pos * 16 + i0), sn = *(const f32x4*)(ropeB + SEQ * 16 + pos * 16 + i0);
                        o[n] = (fq < 2) ? own * cs - oth * sn : own * cs + oth * sn; }
                    *(u32x4*)(KR + (size_t)row * 32 + 8 * fq) = pack_acc8(o[0], o[1]); }
        }
#pragma unroll
        for (int ai = 0; ai < 2; ++ai)
#pragma unroll
            for (int m = 0; m < 4; ++m) { bf16_t* rowp = H + (size_t)(row0 + ai * HALF + m * 16) * HLD + col0;
#pragma unroll
                for (int bj = 0; bj < 2; ++bj) *(u32x4*)(rowp + bj * HALF) = pack_acc8(acc[ai][bj][m][0], acc[ai][bj][m][1]); }
    }
};

template <int MODE> struct EpiMla {
    bf16_t* O; const float* ssq;
    __device__ __forceinline__ void operator()(Acc& acc, const Unit& u, int wr, int wc, int fr, int fq) const {
        const int row0 = u.pm * BM + wr * 64 + fr, col0 = u.pn * BM + wc * 32 + 8 * fq;
        constexpr int ldc = MODE == 0 ? 768 : 1024;
        f32x4 p[2][4];
#pragma unroll
        for (int ai = 0; ai < 2; ++ai)
#pragma unroll
            for (int m = 0; m < 4; ++m) p[ai][m] = *(const f32x4*)(ssq + (size_t)(row0 + ai * HALF + m * 16) * 8 + (MODE == 0 ? 0 : 4));
#pragma unroll
        for (int ai = 0; ai < 2; ++ai)
#pragma unroll
            for (int m = 0; m < 4; ++m) { const int row = row0 + ai * HALF + m * 16; const f32x4 q = p[ai][m];
                const float rstd = 1.0f / sqrtf(((q[0] + q[1]) + (q[2] + q[3])) * (MODE == 0 ? 1.0f / 256.0f : 1.0f / 128.0f) + RMS_EPS);
                bf16_t* rowp = O + (size_t)row * ldc + col0;
#pragma unroll
                for (int bj = 0; bj < 2; ++bj) *(u32x4*)(rowp + bj * HALF) = pack_acc8(acc[ai][bj][m][0] * rstd, acc[ai][bj][m][1] * rstd); }
    }
};

struct EpiMoe1 {
    bf16_t* Hdn;
    __device__ __forceinline__ void operator()(Acc& acc, const Unit& u, int wr, int wc, int fr, int fq) const {
        const int row0 = u.row0 + wr * 64 + fr, col0 = u.pn * 128 + wc * 32 + 8 * fq;
#pragma unroll
        for (int ai = 0; ai < 2; ++ai)
#pragma unroll
            for (int m = 0; m < 4; ++m) { f32x4 h[2];
#pragma unroll
                for (int n = 0; n < 2; ++n)
#pragma unroll
                    for (int j = 0; j < 4; ++j) { const float g = acc[ai][0][m][n][j], up = acc[ai][1][m][n][j]; h[n][j] = g * __builtin_amdgcn_rcpf(1.0f + __builtin_amdgcn_exp2f(-1.4426950408889634f * g)) * up; }
                *(u32x4*)(Hdn + (size_t)(row0 + ai * HALF + m * 16) * DEXP + col0) = pack_acc8(h[0], h[1]); }
    }
};
struct EpiMoe2 {
    bf16_t* Y; const float* slot_g; const int* slot_dst;
    __device__ __forceinline__ void operator()(Acc& acc, const Unit& u, int wr, int wc, int fr, int fq) const {
        const int row0 = u.row0 + wr * 64 + fr, col0 = u.pn * BM + wc * 32 + 8 * fq;
#pragma unroll
        for (int ai = 0; ai < 2; ++ai)
#pragma unroll
            for (int m = 0; m < 4; ++m) { const int slot = row0 + ai * HALF + m * 16; const int dst = slot_dst[slot]; const float g = slot_g[slot];
                if (dst >= 0) { bf16_t* rowp = Y + (size_t)dst * DM + col0;
#pragma unroll
                    for (int bj = 0; bj < 2; ++bj) *(u32x4*)(rowp + bj * HALF) = pack_acc8(acc[ai][bj][m][0] * g, acc[ai][bj][m][1] * g); } }
    }
};
}

struct Args { const float* in[26]; float* out; unsigned char* ws; int lo, hi; };
enum { IN_X = 0, IN_EWIN, IN_LQ1, IN_LK1, IN_LQ2, IN_LK2, IN_SUBLN, IN_QNG, IN_WUQ, IN_KVNG, IN_WUKV, IN_EWO, IN_OWQKV, IN_RELB, IN_OWO,
       IN_LN1G, IN_LN1B, IN_LN2G, IN_LN2B, IN_WRG, IN_BRG, IN_WRE, IN_BRE, IN_WG, IN_WU, IN_WD };

__device__ __forceinline__ Frame fresh(const Frame& F) { Frame R = F; int wv = F.wave, g = F.G, b = F.bid; asm volatile("" : "+s"(wv), "+s"(g), "+s"(b));
    int ln = (int)__builtin_amdgcn_mbcnt_hi(~0u, __builtin_amdgcn_mbcnt_lo(~0u, 0u)); asm volatile("" : "+v"(ln));
    __builtin_assume(ln >= 0 && ln < 64); __builtin_assume(wv >= 0 && wv < NTHREADS / 64); __builtin_assume(g > 0 && g <= 1024); __builtin_assume(b >= 0 && b < g);
    R.tid = wv * 64 + ln; R.lane = ln; R.wave = wv; R.G = g; R.bid = b; return R; }
__device__ __forceinline__ Args fresh(const Args& a) { Args r = a; unsigned long long z = 0ull; asm volatile("" : "+s"(z)); r.ws = a.ws + z; return r; }

__device__ __forceinline__ void tr_tile(const Frame& F, const float* src, int ldsrc, int Kv, int Nv, int k0, int n0, bf16_t* dst, int lddst, int rowmap, const float* scale) {
    LAS float* T = (LAS float*)F.lds;
    __syncthreads();
#pragma unroll
    for (int it = 0; it < 8; ++it) { const int e = it * NTHREADS + F.tid, i = e >> 6, j = e & 63; const int k = k0 + i, n = n0 + j;
        float v = 0.f; if (k < Kv && n < Nv) { v = src[(size_t)k * ldsrc + n]; if (scale) v *= scale[k]; }
        T[i * 65 + j] = v; }
    __syncthreads();
    {
        const int j = F.tid >> 3, i0 = (F.tid & 7) * 8; float f[8];
#pragma unroll
        for (int q = 0; q < 8; ++q) f[q] = T[(i0 + q) * 65 + j];
        int n = n0 + j; if (rowmap) n = (n >> 7) * 256 + (n & 127) + (rowmap == 2 ? 128 : 0);
        *(u32x4*)(dst + (size_t)n * lddst + k0 + i0) = pack8(f); }
}
__device__ __forceinline__ void tr_matrix(const Frame& F, int& cursor, const float* src, int ldsrc, int Kv, int Nv, int Kp, int Np, bf16_t* dst, int lddst, int rowmap, const float* scale) {
    const int tk = Kp / 64, tn = Np / 64, ntile = tk * tn;
    int first = (F.bid - cursor % F.G + F.G) % F.G;
    for (int t = first; t < ntile; t += F.G) tr_tile(F, src, ldsrc, Kv, Nv, (t / tn) * 64, (t % tn) * 64, dst, lddst, rowmap, scale);
    cursor += ntile;
}

__device__ __forceinline__ void tr_big(const Frame& F, const float* src, int ldsrc, int k0, int n0, bf16_t* dst, int lddst, int rowmap) {
    LAS float* T = (LAS float*)F.lds;
    f32x4 v[8];
#pragma unroll
    for (int it = 0; it < 8; ++it) { const int idx = it * NTHREADS + F.tid, i = idx >> 6, c4 = idx & 63; v[it] = *(const f32x4*)(src + (size_t)(k0 + i) * ldsrc + n0 + 4 * c4); }
    __syncthreads();
#pragma unroll
    for (int it = 0; it < 8; ++it) { const int idx = it * NTHREADS + F.tid, i = idx >> 6, c4 = idx & 63; *(LAS f32x4*)(T + i * 260 + 4 * c4) = v[it]; }
    __syncthreads();
    const int nn = F.tid & 255, kh = F.tid >> 8;
    int n = n0 + nn; if (rowmap) n = (n >> 7) * 256 + (n & 127) + (rowmap == 2 ? 128 : 0);
    bf16_t* dp = dst + (size_t)n * lddst + k0 + 32 * kh;
#pragma unroll
    for (int sg = 0; sg < 4; ++sg) { float f[8];
#pragma unroll
        for (int q = 0; q < 8; ++q) f[q] = T[(32 * kh + 8 * sg + q) * 260 + nn];
        *(u32x4*)(dp + 8 * sg) = pack8(f); }
}
__device__ __forceinline__ void tr_matrix_big(const Frame& F, int& cursor, const float* src, int ldsrc, int K, int N, bf16_t* dst, int lddst, int rowmap) {
    const int tk = K / 64, tn = N / 256, ntile = tk * tn;
    const int first = (F.bid - cursor % F.G + F.G) % F.G;
    for (int t = first; t < ntile; t += F.G) tr_big(F, src, ldsrc, (t / tn) * 64, (t % tn) * 256, dst, lddst, rowmap);
    cursor += ntile;
}
__device__ __forceinline__ void phase_prologue(const Frame& F, const Args& a) {
    unsigned char* ws = a.ws;
    { const float* x = a.in[IN_X]; bf16_t* X = (bf16_t*)(ws + WS_X); const size_t n8 = (size_t)NTOK * DM / 8;
      for (size_t i = (size_t)F.bid * NTHREADS + F.tid; i < n8; i += (size_t)F.G * NTHREADS) { const f32x4 v0 = *(const f32x4*)(x + i * 8), v1 = *(const f32x4*)(x + i * 8 + 4); *(u32x4*)(X + i * 8) = g8::pack_acc8(v0, v1); } }
    { float* ra = (float*)(ws + WS_ROPEA); float* rb = (float*)(ws + WS_ROPEB);
      for (int i = F.bid * NTHREADS + F.tid; i < SEQ * 8; i += F.G * NTHREADS) { const int pos = i >> 3, f = i & 7; const float inv = powf(500000.0f, -(float)(2 * f) / 16.0f); const float ang = (float)pos * inv; ra[i] = cosf(ang); ra[SEQ * 8 + i] = sinf(ang); }
      for (int i = F.bid * NTHREADS + F.tid; i < SEQ * 16; i += F.G * NTHREADS) { const int pos = i >> 4, f = i & 15; const float inv = powf(500000.0f, -(float)(2 * f) / 32.0f); const float ang = (float)pos * inv; rb[i] = cosf(ang); rb[SEQ * 16 + i] = sinf(ang); } }
    { bf16_t* wr = (bf16_t*)(ws + WS_WR); const float* wrg = a.in[IN_WRG]; const float* wre = a.in[IN_WRE];
      for (int i = F.bid * NTHREADS + F.tid; i < DEPTH * 48 * DM; i += F.G * NTHREADS) { const int l = i / (48 * DM), r = i % (48 * DM), j = r / DM, k = r % DM;
          const float w = j < 4 ? wrg[((size_t)l * DM + k) * 4 + j] : j < 36 ? wre[((size_t)l * DM + k) * 32 + (j - 4)] : 0.f;
          const unsigned hi = cvt_pk_bf16(w, 0.f) & 0xffffu; const float rem = w - __uint_as_float(hi << 16);
          wr[(size_t)l * 2 * 48 * DM + r] = (bf16_t)hi; wr[(size_t)l * 2 * 48 * DM + 48 * DM + r] = (bf16_t)(cvt_pk_bf16(rem, 0.f) & 0xffffu); } }
    if (F.bid == 0 && F.tid < 2) { const int jl = F.tid; float d1 = 0.f, d2 = 0.f;
        for (int i = 0; i < 64; ++i) { d1 += a.in[IN_LQ1][jl * 64 + i] * a.in[IN_LK1][jl * 64 + i]; d2 += a.in[IN_LQ2][jl * 64 + i] * a.in[IN_LK2][jl * 64 + i]; }
        const float lambda_init = 0.8f - 0.6f * expf(-0.3f * (float)(2 * jl));
        ((float*)(ws + WS_LAM))[jl] = expf(d1) - expf(d2) + lambda_init; }
    int cur = 0;
    for (int l = 0; l < 2; ++l) {
        tr_matrix_big(F, cur, a.in[IN_EWIN] + (size_t)l * DM * EVEN_IN, EVEN_IN, DM, 1792, (bf16_t*)(ws + WS_WIN) + (size_t)l * HLD * DM, DM, 0);
        tr_matrix(F, cur, a.in[IN_EWIN] + (size_t)l * DM * EVEN_IN + 1792, EVEN_IN, DM, EVEN_IN - 1792, DM, HLD - 1792, (bf16_t*)(ws + WS_WIN) + (size_t)l * HLD * DM + (size_t)1792 * DM, DM, 0, nullptr);
        tr_matrix(F, cur, a.in[IN_WUQ] + (size_t)l * 256 * 768, 768, 256, 768, 256, 768, (bf16_t*)(ws + WS_WUQ) + (size_t)l * 768 * 256, 256, 0, a.in[IN_QNG] + l * 256);
        tr_matrix(F, cur, a.in[IN_WUKV] + (size_t)l * 128 * 1024, 1024, 128, 1024, 256, 1024, (bf16_t*)(ws + WS_WUKV) + (size_t)l * 1024 * 256, 256, 0, a.in[IN_KVNG] + l * 128);
        tr_matrix_big(F, cur, a.in[IN_EWO] + (size_t)l * DM * DM, DM, DM, DM, (bf16_t*)(ws + WS_WOE) + (size_t)l * DM * DM, DM, 0);
        tr_matrix_big(F, cur, a.in[IN_OWQKV] + (size_t)l * DM * 3072, 3072, DM, 3072, (bf16_t*)(ws + WS_WQKV) + (size_t)l * 3072 * DM, DM, 0);
        tr_matrix_big(F, cur, a.in[IN_OWO] + (size_t)l * DM * DM, DM, DM, DM, (bf16_t*)(ws + WS_WOO) + (size_t)l * DM * DM, DM, 0);
    }
    __syncthreads();
}
__device__ __forceinline__ void phase_moe_weights(const Frame& F, const Args& a, int layer) {
    unsigned char* ws = a.ws; int cur = 0;
    for (int e = 0; e < NEXP; ++e) {
        const size_t so = ((size_t)layer * NEXP + e) * DM * DEXP;
        tr_matrix_big(F, cur, a.in[IN_WG] + so, DEXP, DM, DEXP, (bf16_t*)(ws + WS_W13) + (size_t)e * 1024 * 1024, DM, 1);
        tr_matrix_big(F, cur, a.in[IN_WU] + so, DEXP, DM, DEXP, (bf16_t*)(ws + WS_W13) + (size_t)e * 1024 * 1024, DM, 2);
        tr_matrix_big(F, cur, a.in[IN_WD] + so, DM, DEXP, DM, (bf16_t*)(ws + WS_W2) + (size_t)e * 1024 * 512, DEXP, 0);
    }
    __syncthreads();
}

template <int MODE>
__device__ __forceinline__ void phase_ln(const Frame& F, const Args& a, int layer, bool last_layer) {
    unsigned char* ws = a.ws;
    bf16_t* X = (bf16_t*)(ws + WS_X);
    const bf16_t* Ra = MODE == 0 ? (const bf16_t*)(ws + WS_R1) : (const bf16_t*)(ws + WS_R2);
    const float* gam = a.in[MODE == 0 ? IN_LN1G : IN_LN2G] + layer * DM; const float* bet = a.in[MODE == 0 ? IN_LN1B : IN_LN2B] + layer * DM;
    const float* WR = (const float*)(ws + WS_WR) + (size_t)layer * 36 * DM;
    LAS int* hist = (LAS int*)F.lds;
    for (int chunk = F.bid; chunk < NTOK / 256; chunk += F.G) {
        if (MODE == 0) { __syncthreads(); if (F.tid < NEXP) hist[F.tid] = 0; __syncthreads(); }
        for (int rr = F.wave; rr < 256; rr += NTHREADS / 64) {
            const int row = chunk * 256 + rr; float y[16];
#pragma unroll
            for (int hh = 0; hh < 2; ++hh) { const int c = hh * 512 + F.lane * 8; float xv[8], rv[8];
                unpack8(*(const u32x4*)(X + (size_t)row * DM + c), xv);
                if (MODE == 0) unpack8(*(const u32x4*)(Ra + (size_t)row * DM + c), rv);
                else { float r0[8], r1[8]; unpack8(*(const u32x4*)(Ra + (size_t)row * 2 * DM + c), r0); unpack8(*(const u32x4*)(Ra + (size_t)row * 2 * DM + DM + c), r1);
#pragma unroll
                    for (int q = 0; q < 8; ++q) rv[q] = r0[q] + r1[q]; }
#pragma unroll
                for (int q = 0; q < 8; ++q) y[hh * 8 + q] = DN_ALPHA * xv[q] + rv[q]; }
            float s = 0.f;
#pragma unroll
            for (int q = 0; q < 16; ++q) s += y[q];
            const float mean = wave_sum(s) * (1.0f / DM);
            float v = 0.f;
#pragma unroll
            for (int q = 0; q < 16; ++q) { const float d = y[q] - mean; v += d * d; }
            const float rstd = 1.0f / sqrtf(wave_sum(v) * (1.0f / DM) + LN_EPS);
#pragma unroll
            for (int hh = 0; hh < 2; ++hh) { const int c = hh * 512 + F.lane * 8;
                const f32x4 g0 = *(const f32x4*)(gam + c), g1 = *(const f32x4*)(gam + c + 4), b0 = *(const f32x4*)(bet + c), b1 = *(const f32x4*)(bet + c + 4);
#pragma unroll
                for (int q = 0; q < 4; ++q) { y[hh * 8 + q] = (y[hh * 8 + q] - mean) * rstd * g0[q] + b0[q]; y[hh * 8 + 4 + q] = (y[hh * 8 + 4 + q] - mean) * rstd * g1[q] + b1[q]; } }
            if (MODE == 1 && last_layer) {
#pragma unroll
                for (int hh = 0; hh < 2; ++hh) { float* o = a.out + (size_t)row * DM + hh * 512 + F.lane * 8;
                    *(f32x4*)o = (f32x4){y[hh * 8], y[hh * 8 + 1], y[hh * 8 + 2], y[hh * 8 + 3]}; *(f32x4*)(o + 4) = (f32x4){y[hh * 8 + 4], y[hh * 8 + 5], y[hh * 8 + 6], y[hh * 8 + 7]}; }
            } else {
#pragma unroll
                for (int hh = 0; hh < 2; ++hh) { float t8[8];
#pragma unroll
                    for (int q = 0; q < 8; ++q) t8[q] = y[hh * 8 + q];
                    *(u32x4*)(X + (size_t)row * DM + hh * 512 + F.lane * 8) = pack8(t8); }
            }
            if (MODE == 0) {
                float mine = 0.f;
#pragma unroll 2
                for (int j = 0; j < 36; ++j) { float p = 0.f;
#pragma unroll
                    for (int hh = 0; hh < 2; ++hh) { const float* w = WR + (size_t)j * DM + hh * 512 + F.lane * 8; const f32x4 w0 = *(const f32x4*)w, w1 = *(const f32x4*)(w + 4);
#pragma unroll
                        for (int q = 0; q < 4; ++q) { p += y[hh * 8 + q] * w0[q]; p += y[hh * 8 + 4 + q] * w1[q]; } }
                    p = wave_sum(p); mine = (F.lane == j) ? p : mine; }
                { const float* brg = a.in[IN_BRG] + layer * 4; const float* bre = a.in[IN_BRE] + layer * 32;
                  mine += (F.lane < 4) ? brg[F.lane] : (F.lane < 36 ? bre[F.lane - 4] : 0.f); }
                float lg[4];
#pragma unroll
                for (int j = 0; j < 4; ++j) lg[j] = __shfl(mine, j);
                int grp = 0; float gm = lg[0];
#pragma unroll
                for (int j = 1; j < 4; ++j) if (lg[j] > gm) { gm = lg[j]; grp = j; }
                float gs = 0.f;
#pragma unroll
                for (int j = 0; j < 4; ++j) gs += __expf(lg[j] - gm);
                const float gw = 1.0f / gs;
                float le[8];
#pragma unroll
                for (int i = 0; i < 8; ++i) le[i] = __shfl(mine, 4 + grp * 8 + i);
                int i1 = 0; float m1 = le[0];
#pragma unroll
                for (int i = 1; i < 8; ++i) if (le[i] > m1) { m1 = le[i]; i1 = i; }
                int i2 = -1; float m2 = -3.0e38f;
#pragma unroll
                for (int i = 0; i < 8; ++i) if (i != i1 && le[i] > m2) { m2 = le[i]; i2 = i; }
                const float e2 = __expf(m2 - m1), den = 1.0f / (1.0f + e2);
                if (F.lane == 0) {
                    const int e0 = grp * 8 + i1, e1 = grp * 8 + i2;
                    int* ri = (int*)(ws + WS_ROUTE) + (size_t)row * 4; ri[0] = e0; ri[1] = e1; ((float*)ri)[2] = den * gw; ((float*)ri)[3] = e2 * den * gw;
                    atomicAdd((int*)&hist[e0], 1); atomicAdd((int*)&hist[e1], 1);
                }
            }
        }
        if (MODE == 0) { __syncthreads(); if (F.tid < NEXP) ((int*)(ws + WS_CNT))[chunk * NEXP + F.tid] = hist[F.tid]; }
    }
    __syncthreads();
}

constexpr int LN1_WSTR = 2080;
constexpr int LN1_WOFF = 1024 + 8 * 16 * 48 * 4;
constexpr int LN1_GOFF = LN1_WOFF + 36 * LN1_WSTR;
__device__ __forceinline__ void phase_ln1_router(const Frame& F, const Args& a, int layer) {
    unsigned char* ws = a.ws;
    bf16_t* X = (bf16_t*)(ws + WS_X); const bf16_t* Yb = (const bf16_t*)(ws + WS_R1); const f32x4* stats = (const f32x4*)(ws + WS_R2);
    const bf16_t* WRh = (const bf16_t*)(ws + WS_WR) + (size_t)layer * 2 * 48 * DM;
    LAS int* hist = (LAS int*)F.lds; LAS float* Lg = (LAS float*)(F.lds + 1024) + F.wave * (16 * 48); LAS char* Wl = (LAS char*)F.lds + LN1_WOFF;
    LAS float* gl = (LAS float*)((LAS char*)F.lds + LN1_GOFF); LAS float* bl = gl + DM;
    const int r = F.lane & 15, g = F.lane >> 4;
    __syncthreads();
    for (int i = F.tid; i < 36 * 128; i += NTHREADS) { const int wrow = i >> 7, piece = i & 127; *(LAS u32x4*)(Wl + wrow * LN1_WSTR + piece * 16) = *(const u32x4*)(WRh + (size_t)wrow * DM + piece * 8); }
    for (int i = F.tid; i < DM; i += NTHREADS) { gl[i] = a.in[IN_LN1G][layer * DM + i]; bl[i] = a.in[IN_LN1B][layer * DM + i]; }
    const int wr0 = r, wr1 = 16 + r, wr2 = min(32 + r, 35);
    for (int chunk = F.bid; chunk < NTOK / 256; chunk += F.G) {
        __syncthreads(); if (F.tid < NEXP) hist[F.tid] = 0; __syncthreads();
        const int rowA = chunk * 256 + F.wave * 32 + r, rowB = rowA + 16;
        float meanA, rstdA, meanB, rstdB;
        { const f32x4 q0 = stats[(size_t)rowA * 8 + 2 * g], q1 = stats[(size_t)rowA * 8 + 2 * g + 1];
          float s = (q0[0] + q0[2]) + (q1[0] + q1[2]), ss = (q0[1] + q0[3]) + (q1[1] + q1[3]);
          s += __shfl_xor(s, 16); s += __shfl_xor(s, 32); ss += __shfl_xor(ss, 16); ss += __shfl_xor(ss, 32);
          meanA = s * (1.0f / DM); rstdA = 1.0f / sqrtf(fmaxf(ss * (1.0f / DM) - meanA * meanA, 0.f) + LN_EPS); }
        { const f32x4 q0 = stats[(size_t)rowB * 8 + 2 * g], q1 = stats[(size_t)rowB * 8 + 2 * g + 1];
          float s = (q0[0] + q0[2]) + (q1[0] + q1[2]), ss = (q0[1] + q0[3]) + (q1[1] + q1[3]);
          s += __shfl_xor(s, 16); s += __shfl_xor(s, 32); ss += __shfl_xor(ss, 16); ss += __shfl_xor(ss, 32);
          meanB = s * (1.0f / DM); rstdB = 1.0f / sqrtf(fmaxf(ss * (1.0f / DM) - meanB * meanB, 0.f) + LN_EPS); }
        f32x4 accA[3], accB[3];
#pragma unroll
        for (int nb = 0; nb < 3; ++nb) { accA[nb] = (f32x4){0.f, 0.f, 0.f, 0.f}; accB[nb] = (f32x4){0.f, 0.f, 0.f, 0.f}; }
        const bf16_t* ypA = Yb + (size_t)rowA * DM + 16 * g; const bf16_t* ypB = Yb + (size_t)rowB * DM + 16 * g;
#define LN1_LOAD(BUF, B) do { _Pragma("unroll") for (int q_ = 0; q_ < 4; ++q_) { const int kk_ = 4 * (B) + q_, c_ = 64 * (kk_ >> 1) + 8 * (kk_ & 1); \
            BUF[q_] = *(const u32x4*)(ypA + c_); BUF[4 + q_] = *(const u32x4*)(ypB + c_); } } while (0)
#define LN1_COMP(BUF, B) do { _Pragma("unroll") for (int q_ = 0; q_ < 4; ++q_) { const int kk = 4 * (B) + q_, c = 64 * (kk >> 1) + 16 * g + 8 * (kk & 1); \
            float ya[8], yb[8], t8[8]; unpack8(BUF[q_], ya); unpack8(BUF[4 + q_], yb); \
            const f32x4 g0 = *(const LAS f32x4*)(gl + c), g1 = *(const LAS f32x4*)(gl + c + 4), b0 = *(const LAS f32x4*)(bl + c), b1 = *(const LAS f32x4*)(bl + c + 4); \
            _Pragma("unroll") for (int q = 0; q < 4; ++q) { ya[q] = (ya[q] - meanA) * rstdA * g0[q] + b0[q]; ya[4 + q] = (ya[4 + q] - meanA) * rstdA * g1[q] + b1[q]; \
                                          yb[q] = (yb[q] - meanB) * rstdB * g0[q] + b0[q]; yb[4 + q] = (yb[4 + q] - meanB) * rstdB * g1[q] + b1[q]; } \
            const u32x4 hA = pack8(ya), hB = pack8(yb); \
            *(u32x4*)(X + (size_t)rowA * DM + c) = hA; *(u32x4*)(X + (size_t)rowB * DM + c) = hB; \
            unpack8(hA, t8); _Pragma("unroll") for (int q = 0; q < 8; ++q) ya[q] -= t8[q]; \
            unpack8(hB, t8); _Pragma("unroll") for (int q = 0; q < 8; ++q) yb[q] -= t8[q]; \
            const u32x4 lA = pack8(ya), lB = pack8(yb); \
            const bf16x8 ahA = *(const bf16x8*)&hA, alA = *(const bf16x8*)&lA, ahB = *(const bf16x8*)&hB, alB = *(const bf16x8*)&lB; \
            _Pragma("unroll") for (int nb = 0; nb < 3; ++nb) { const int wrow = nb == 0 ? wr0 : nb == 1 ? wr1 : wr2; \
                const bf16x8 bh = *(const LAS bf16x8*)(Wl + wrow * LN1_WSTR + c * 2); \
                accA[nb] = __builtin_amdgcn_mfma_f32_16x16x32_bf16(ahA, bh, accA[nb], 0, 0, 0); \
                accB[nb] = __builtin_amdgcn_mfma_f32_16x16x32_bf16(ahB, bh, accB[nb], 0, 0, 0); \
                accA[nb] = __builtin_amdgcn_mfma_f32_16x16x32_bf16(alA, bh, accA[nb], 0, 0, 0); \
                accB[nb] = __builtin_amdgcn_mfma_f32_16x16x32_bf16(alB, bh, accB[nb], 0, 0, 0); } } } while (0)
        u32x4 bu0[8], bu1[8];
        LN1_LOAD(bu0, 0);
#pragma unroll
        for (int b2 = 0; b2 < 4; ++b2) {
            LN1_LOAD(bu1, 2 * b2 + 1); __builtin_amdgcn_sched_barrier(0);
            LN1_COMP(bu0, 2 * b2); __builtin_amdgcn_sched_barrier(0);
            if (b2 < 3) LN1_LOAD(bu0, 2 * b2 + 2);
            __builtin_amdgcn_sched_barrier(0);
            LN1_COMP(bu1, 2 * b2 + 1); __builtin_amdgcn_sched_barrier(0);
        }
#undef LN1_LOAD
#undef LN1_COMP
#pragma unroll 1
        for (int grp = 0; grp < 2; ++grp) {
#pragma unroll
            for (int nb = 0; nb < 3; ++nb)
#pragma unroll
                for (int t = 0; t < 4; ++t) Lg[(4 * g + t) * 48 + 16 * nb + r] = grp ? accB[nb][t] : accA[nb][t];
            asm volatile("s_waitcnt lgkmcnt(0)" ::: "memory");
            if (F.lane < 16) {
                const int row = grp ? rowB : rowA;
                const LAS float* L = Lg + r * 48; const float* brg = a.in[IN_BRG] + layer * 4; const float* bre = a.in[IN_BRE] + layer * 32;
                float lg[4];
#pragma unroll
                for (int q = 0; q < 4; ++q) lg[q] = L[q] + brg[q];
                int grpi = 0; float gm = lg[0];
#pragma unroll
                for (int q = 1; q < 4; ++q) if (lg[q] > gm) { gm = lg[q]; grpi = q; }
                float gs = 0.f;
#pragma unroll
                for (int q = 0; q < 4; ++q) gs += __expf(lg[q] - gm);
                const float gw = 1.0f / gs;
                float le[8];
#pragma unroll
                for (int i = 0; i < 8; ++i) le[i] = L[4 + grpi * 8 + i] + bre[grpi * 8 + i];
                int i1 = 0; float m1 = le[0];
#pragma unroll
                for (int i = 1; i < 8; ++i) if (le[i] > m1) { m1 = le[i]; i1 = i; }
                int i2 = -1; float m2 = -3.0e38f;
#pragma unroll
                for (int i = 0; i < 8; ++i) if (i != i1 && le[i] > m2) { m2 = le[i]; i2 = i; }
                const float e2 = __expf(m2 - m1), den = 1.0f / (1.0f + e2);
                const int e0 = grpi * 8 + i1, e1 = grpi * 8 + i2;
                int* ri = (int*)(ws + WS_ROUTE) + (size_t)row * 4; ri[0] = e0; ri[1] = e1; ((float*)ri)[2] = den * gw; ((float*)ri)[3] = e2 * den * gw;
                atomicAdd((int*)&hist[e0], 1); atomicAdd((int*)&hist[e1], 1);
            }
            asm volatile("s_waitcnt lgkmcnt(0)" ::: "memory");
        }
        __syncthreads(); if (F.tid < NEXP) ((int*)(ws + WS_CNT))[chunk * NEXP + F.tid] = hist[F.tid];
    }
    __syncthreads();
}

__device__ __forceinline__ void phase_ln2(const Frame& F, const Args& a, int layer, bool last_layer, bool dry = false) {
    unsigned char* ws = a.ws;
    bf16_t* X = (bf16_t*)(ws + WS_X); bf16_t* XO = dry ? (bf16_t*)(ws + WS_R1) : X; const bf16_t* Y = (const bf16_t*)(ws + WS_R2);
    LAS float* gl = (LAS float*)F.lds; LAS float* bl = gl + DM;
    __syncthreads();
    for (int i = F.tid; i < DM; i += NTHREADS) { gl[i] = a.in[IN_LN2G][layer * DM + i]; bl[i] = a.in[IN_LN2B][layer * DM + i]; }
    __syncthreads();
    const int r = F.lane & 7, g = F.lane >> 3;
    const LAS float* gam = gl + 8 * g; const LAS float* bet = bl + 8 * g;
#pragma unroll 1
    for (int blk = F.bid * (NTHREADS / 64) + F.wave; blk < NTOK / 8; blk += F.G * (NTHREADS / 64)) {
        const int row = blk * 8 + r;
        const u32x4 rt = *(const u32x4*)((const int*)(ws + WS_ROUTE) + (size_t)row * 4);
        const float ga = __uint_as_float(rt.z), gb = __uint_as_float(rt.w);
        const bf16_t* xp = X + (size_t)row * DM + 8 * g; const bf16_t* y0p = Y + (size_t)rt.x * DM + 8 * g; const bf16_t* y1p = Y + (size_t)rt.y * DM + 8 * g;
        float y[128];
#pragma unroll
        for (int kk = 0; kk < 16; ++kk) { float xv[8], u0[8], u1[8]; unpack8(*(const u32x4*)(xp + 64 * kk), xv); unpack8(*(const u32x4*)(y0p + 64 * kk), u0); unpack8(*(const u32x4*)(y1p + 64 * kk), u1);
#pragma unroll
            for (int q = 0; q < 8; ++q) y[8 * kk + q] = DN_ALPHA * xv[q] + (ga * u0[q] + gb * u1[q]);
            if ((kk & 3) == 3) {
#pragma unroll
                for (int k2 = kk - 3; k2 <= kk; ++k2) asm volatile("" : "+v"(y[8 * k2]), "+v"(y[8 * k2 + 1]), "+v"(y[8 * k2 + 2]), "+v"(y[8 * k2 + 3]), "+v"(y[8 * k2 + 4]), "+v"(y[8 * k2 + 5]), "+v"(y[8 * k2 + 6]), "+v"(y[8 * k2 + 7]) :: "memory"); } }
        float s = 0.f;
#pragma unroll
        for (int q = 0; q < 128; ++q) s += y[q];
        s += __shfl_xor(s, 8); s += __shfl_xor(s, 16); s += __shfl_xor(s, 32);
        const float mean = s * (1.0f / DM);
        float v = 0.f;
#pragma unroll
        for (int q = 0; q < 128; ++q) { const float dlt = y[q] - mean; v += dlt * dlt; }
        v += __shfl_xor(v, 8); v += __shfl_xor(v, 16); v += __shfl_xor(v, 32);
        const float rstd = 1.0f / sqrtf(v * (1.0f / DM) + LN_EPS);
#pragma unroll
        for (int kk = 0; kk < 16; ++kk) { const int c = 64 * kk + 8 * g; float o8[8];
            const f32x4 g0 = *(const LAS f32x4*)(gam + 64 * kk), g1 = *(const LAS f32x4*)(gam + 64 * kk + 4), b0 = *(const LAS f32x4*)(bet + 64 * kk), b1 = *(const LAS f32x4*)(bet + 64 * kk + 4);
#pragma unroll
            for (int q = 0; q < 4; ++q) { o8[q] = (y[8 * kk + q] - mean) * rstd * g0[q] + b0[q]; o8[4 + q] = (y[8 * kk + 4 + q] - mean) * rstd * g1[q] + b1[q]; }
#if PROF_TYPE >= 0
            if (last_layer) { const float dl = 1.0f + ((const float*)(ws + WS_LAM))[8 + F.bid];
#pragma unroll
                for (int q = 0; q < 8; ++q) o8[q] *= dl; }
#endif
            if (last_layer) { float* o = a.out + (size_t)row * DM + c; *(f32x4*)o = (f32x4){o8[0], o8[1], o8[2], o8[3]}; *(f32x4*)(o + 4) = (f32x4){o8[4], o8[5], o8[6], o8[7]}; }
            else *(u32x4*)(XO + (size_t)row * DM + c) = pack8(o8);
            if (kk & 1) asm volatile("" ::: "memory"); }
    }
}

__device__ __forceinline__ void phase_scatter(const Frame& F, const Args& a) {
    unsigned char* ws = a.ws;
    const int* cnt = (const int*)(ws + WS_CNT); int* tile = (int*)(ws + WS_TILE);
    int* slot_tok = (int*)(ws + WS_SLOT_TOK); float* slot_g = (float*)(ws + WS_SLOT_G); int* slot_dst = (int*)(ws + WS_SLOT_DST);
    LAS int* C = (LAS int*)F.lds;
    LAS int* total = C + 256 * NEXP;
    LAS int* tstart = total + NEXP;
    LAS int* base = tstart + NEXP + 1;
    LAS int* el = base + NEXP;
    __syncthreads();
    for (int i = F.tid; i < 256 * NEXP; i += NTHREADS) C[i] = cnt[i];
    __syncthreads();
    if (F.tid < NEXP) { int s = 0; for (int c = 0; c < 256; ++c) s += C[c * NEXP + F.tid]; total[F.tid] = s; }
    __syncthreads();
    if (F.tid == 0) { int t = 0; for (int e = 0; e < NEXP; ++e) { tstart[e] = t; t += (total[e] + 255) >> 8; } tstart[NEXP] = t; }
    __syncthreads();
    const int T = tstart[NEXP];
    if (F.bid == 0) { if (F.tid == 0) tile[0] = T; for (int e = 0; e < NEXP; ++e) for (int t = tstart[e] + F.tid; t < tstart[e + 1]; t += NTHREADS) tile[1 + t] = e; }
    for (int e = F.bid; e < NEXP; e += F.G) { const int s0 = tstart[e] * 256 + total[e], s1 = tstart[e + 1] * 256;
        for (int s = s0 + F.tid; s < s1; s += NTHREADS) { slot_tok[s] = 0; slot_g[s] = 0.f; slot_dst[s] = -1; } }
    for (int chunk = F.bid; chunk < NTOK / 256; chunk += F.G) {
        __syncthreads();
        if (F.tid < NEXP) { int s = 0; for (int c = 0; c < chunk; ++c) s += C[c * NEXP + F.tid]; base[F.tid] = tstart[F.tid] * 256 + s; }
        const int tok = chunk * 256 + (F.tid >> 1), k = F.tid & 1;
        const int* ri = (const int*)(ws + WS_ROUTE) + (size_t)tok * 4;
        const int e = ri[k]; const float g = ((const float*)ri)[2 + k];
        el[F.tid] = e;
        __syncthreads();
        int rank = 0;
        for (int q = 0; q < F.tid; ++q) rank += (el[q] == e) ? 1 : 0;
        const int slot = base[e] + rank;
        slot_tok[slot] = tok; slot_g[slot] = g; slot_dst[slot] = tok * 2 + k;
        ((int*)(ws + WS_ROUTE))[(size_t)tok * 4 + k] = slot;
    }
    __syncthreads();
}

template <int DQK, int VP>
__device__ __forceinline__ void attn_keys64(const LAS float* Ks, const LAS float* Vs, const float (&q)[DQK], float (&o)[64], float& m, float& l, const float sc) {
#pragma unroll 1
    for (int jj = 0; jj < 64; ++jj) {
        float acc = 0.f; const LAS float* kr = Ks + jj * DQK;
#pragma unroll
        for (int d = 0; d < DQK; d += 4) { const f32x4 kv = *(const LAS f32x4*)(kr + d); acc += q[d] * kv[0] + q[d + 1] * kv[1] + q[d + 2] * kv[2] + q[d + 3] * kv[3]; }
        const float s = acc * sc, mx = fmaxf(m, s), corr = __builtin_amdgcn_exp2f(m - mx), p = __builtin_amdgcn_exp2f(s - mx);
        m = mx; l = l * corr + p; const LAS float* vr = Vs + jj * VP;
#pragma unroll
        for (int e = 0; e < 64; e += 4) { const f32x4 vv = *(const LAS f32x4*)(vr + e); o[e] = o[e] * corr + p * vv[0]; o[e + 1] = o[e + 1] * corr + p * vv[1]; o[e + 2] = o[e + 2] * corr + p * vv[2]; o[e + 3] = o[e + 3] * corr + p * vv[3]; }
    }
}
__device__ __forceinline__ void stage8(LAS float* dst, const bf16_t* src) { float f[8]; unpack8(*(const u32x4*)src, f); *(LAS f32x4*)dst = (f32x4){f[0], f[1], f[2], f[3]}; *(LAS f32x4*)(dst + 4) = (f32x4){f[4], f[5], f[6], f[7]}; }

__device__ __forceinline__ void attn_diff_naive(const Frame& F, const Args& a, int layer, int unit) {
    unsigned char* ws = a.ws; const bf16_t* H = (const bf16_t*)(ws + WS_R1); bf16_t* O = (bf16_t*)(ws + WS_R3); float* TS = (float*)(ws + WS_R1 + 256 * MiB);
    const int j = layer >> 1; const float lambda_init = 0.8f - 0.6f * expf(-0.3f * (float)layer);
    float d1 = 0.f, d2 = 0.f;
    for (int i = 0; i < 64; ++i) { d1 += a.in[IN_LQ1][j * 64 + i] * a.in[IN_LK1][j * 64 + i]; d2 += a.in[IN_LQ2][j * 64 + i] * a.in[IN_LK2][j * 64 + i]; }
    const float lam = expf(d1) - expf(d2) + lambda_init;
    const int qb = unit & 7, h = (unit >> 3) & 3, b = unit >> 5;
    const int ql = (F.tid & 31) + 32 * (F.tid >> 6), half = (F.tid >> 5) & 1;
    const size_t row = (size_t)b * SEQ + qb * 256 + ql;
    LAS float* Ks = (LAS float*)F.lds; LAS float* Vs = Ks + 64 * 64;
    const float sc = 0.125f * 1.4426950408889634f;
    float* stash = TS + row * 512 + h * 128 + half * 64;
#pragma unroll 1
    for (int st = 0; st < 2; ++st) {
        float o[64], q[64];
#pragma unroll
        for (int d = 0; d < 64; d += 8) { float f[8]; unpack8(*(const u32x4*)(H + row * HLD + h * 128 + st * 64 + d), f);
#pragma unroll
            for (int t = 0; t < 8; ++t) q[d + t] = f[t]; }
        float m = -INFINITY, l = 0.f;
#pragma unroll
        for (int e = 0; e < 64; ++e) o[e] = 0.f;
#pragma unroll 1
        for (int kt = 0; kt < SEQ / 64; ++kt) {
            __syncthreads();
            { const int key = F.tid >> 3, d8 = (F.tid & 7) * 8; const size_t krow = (size_t)b * SEQ + kt * 64 + key;
              stage8(Ks + key * 64 + d8, H + krow * HLD + 512 + h * 128 + st * 64 + d8);
              stage8(Vs + key * 128 + d8, H + krow * HLD + 1024 + h * 128 + d8); stage8(Vs + key * 128 + 64 + d8, H + krow * HLD + 1024 + h * 128 + 64 + d8); }
            __syncthreads();
            attn_keys64<64, 128>(Ks, Vs + half * 64, q, o, m, l, sc);
        }
        const float inv = 1.0f / l;
        if (st == 0) {
#pragma unroll
            for (int e = 0; e < 64; e += 4) *(f32x4*)(stash + e) = (f32x4){o[e] * inv, o[e + 1] * inv, o[e + 2] * inv, o[e + 3] * inv};
        } else {
            float ss = 0.f;
#pragma unroll
            for (int e = 0; e < 64; e += 4) { const f32x4 p0 = *(const f32x4*)(stash + e);
#pragma unroll
                for (int t = 0; t < 4; ++t) { o[e + t] = p0[t] - lam * (o[e + t] * inv); ss += o[e + t] * o[e + t]; } }
            ss += __shfl_xor(ss, 32);
            const float rs = 1.0f / sqrtf(ss * (1.0f / 128.0f) + RMS_EPS) * (1.0f - lambda_init);
            const float* g = a.in[IN_SUBLN] + j * 128 + half * 64;
#pragma unroll
            for (int e = 0; e < 64; e += 8) { float t8[8];
#pragma unroll
                for (int t = 0; t < 8; ++t) t8[t] = o[e + t] * rs * g[e + t];
                *(u32x4*)(O + row * DM + h * 128 + half * 64 + e) = pack8(t8); }
        }
    }
}
__device__ __forceinline__ void attn_mla_naive(const Frame& F, const Args& a, int unit) {
    unsigned char* ws = a.ws; const bf16_t* QB = (const bf16_t*)(ws + WS_R2); const bf16_t* KVB = QB + (size_t)NTOK * 768; const bf16_t* KR = KVB + (size_t)NTOK * 1024; bf16_t* O = (bf16_t*)(ws + WS_R3);
    const int qb = unit & 3, h = (unit >> 2) & 7, b = unit >> 5;
    const size_t row = (size_t)b * SEQ + qb * 512 + F.tid;
    LAS float* Ks = (LAS float*)F.lds; LAS float* Vs = Ks + 64 * 96;
    const float sc = 0.10206207261596575f * 1.4426950408889634f;
    float q[96], o[64];
#pragma unroll
    for (int d = 0; d < 96; d += 8) { float f[8]; unpack8(*(const u32x4*)(QB + row * 768 + h * 96 + d), f);
#pragma unroll
        for (int t = 0; t < 8; ++t) q[d + t] = f[t]; }
    { const float* rb = (const float*)(ws + WS_ROPEB); const int pos = (int)(row & (SEQ - 1));
#pragma unroll
      for (int i = 0; i < 16; i += 4) { const f32x4 cs = *(const f32x4*)(rb + pos * 16 + i), sn = *(const f32x4*)(rb + SEQ * 16 + pos * 16 + i);
#pragma unroll
          for (int t = 0; t < 4; ++t) { const float x1 = q[64 + i + t], x2 = q[80 + i + t]; q[64 + i + t] = x1 * cs[t] - x2 * sn[t]; q[80 + i + t] = x2 * cs[t] + x1 * sn[t]; } } }
    float m = -INFINITY, l = 0.f;
#pragma unroll
    for (int e = 0; e < 64; ++e) o[e] = 0.f;
#pragma unroll 1
    for (int kt = 0; kt < SEQ / 64; ++kt) {
        __syncthreads();
        { const int key = F.tid >> 3, d8 = (F.tid & 7) * 8; const size_t krow = (size_t)b * SEQ + kt * 64 + key;
          stage8(Ks + key * 96 + d8, KVB + krow * 1024 + h * 128 + d8);
          stage8(Vs + key * 64 + d8, KVB + krow * 1024 + h * 128 + 64 + d8);
          if (F.tid < 256) { const int key2 = F.tid >> 2, r8 = (F.tid & 3) * 8; stage8(Ks + key2 * 96 + 64 + r8, KR + ((size_t)b * SEQ + kt * 64 + key2) * 32 + r8); } }
        __syncthreads();
        attn_keys64<96, 64>(Ks, Vs, q, o, m, l, sc);
    }
    const float inv = 1.0f / l;
#pragma unroll
    for (int e = 0; e < 64; e += 8) { float t8[8];
#pragma unroll
        for (int t = 0; t < 8; ++t) t8[t] = o[e + t] * inv;
        *(u32x4*)(O + row * DM + 512 + h * 64 + e) = pack8(t8); }
}
__device__ __forceinline__ void attn_na_naive(const Frame& F, const Args& a, int layer, int unit) {
    unsigned char* ws = a.ws; const bf16_t* QKV = (const bf16_t*)(ws + WS_R1); bf16_t* O = (bf16_t*)(ws + WS_R3);
    const float* relb = a.in[IN_RELB] + (size_t)(layer >> 1) * 16 * 15 * 31;
    const int hh = unit & 1, r = (unit >> 1) & 31, b = unit >> 6;
    const int c = F.tid & 63, h = hh * 8 + (F.tid >> 6);
    const int r0 = min(max(r - 4, 0), 24), c0 = min(max(c - 8, 0), 48);
    const size_t row = (size_t)b * SEQ + r * 64 + c;
    const float LOG2E = 1.4426950408889634f;
    float q[64], o[64];
#pragma unroll
    for (int d = 0; d < 64; d += 8) { float f[8]; unpack8(*(const u32x4*)(QKV + row * 3072 + h * 64 + d), f);
#pragma unroll
        for (int t = 0; t < 8; ++t) q[d + t] = f[t]; }
    float m = -INFINITY, l = 0.f;
#pragma unroll
    for (int e = 0; e < 64; ++e) o[e] = 0.f;
#pragma unroll 1
    for (int ij = 0; ij < 128; ++ij) {
        const int i = ij >> 4, jj = ij & 15;
        const size_t krow = (size_t)b * SEQ + (r0 + i) * 64 + c0 + jj;
        const float bias = relb[((size_t)h * 15 + (r0 + i - r + 7)) * 31 + (c0 + jj - c + 15)];
        float acc = 0.f; const bf16_t* kp = QKV + krow * 3072 + 1024 + h * 64;
#pragma unroll
        for (int d = 0; d < 64; d += 8) { float f[8]; unpack8(*(const u32x4*)(kp + d), f);
#pragma unroll
            for (int t = 0; t < 8; ++t) acc += q[d + t] * f[t]; }
        const float s = (acc * 0.125f + bias) * LOG2E, mx = fmaxf(m, s), corr = __builtin_amdgcn_exp2f(m - mx), p = __builtin_amdgcn_exp2f(s - mx);
        m = mx; l = l * corr + p; const bf16_t* vp = kp + 1024;
#pragma unroll
        for (int e = 0; e < 64; e += 8) { float f[8]; unpack8(*(const u32x4*)(vp + e), f);
#pragma unroll
            for (int t = 0; t < 8; ++t) o[e + t] = o[e + t] * corr + p * f[t]; }
    }
    const float inv = 1.0f / l;
#pragma unroll
    for (int e = 0; e < 64; e += 8) { float t8[8];
#pragma unroll
        for (int t = 0; t < 8; ++t) t8[t] = o[e + t] * inv;
        *(u32x4*)(O + row * DM + h * 64 + e) = pack8(t8); }
}

namespace fa {
typedef float f32x16 __attribute__((ext_vector_type(16)));
typedef short s16x4 __attribute__((ext_vector_type(4)));
#define FA_SBAR() __builtin_amdgcn_sched_barrier(0)
__device__ __forceinline__ int crow(int r, int hi) { return (r & 3) + 8 * (r >> 2) + 4 * hi; }
constexpr float THR = 8.f;
template <int SCALE_E6> __device__ __forceinline__ void partialSM(f32x16& p0, f32x16& p1, float& m_reg, float& mn, float& alpha) {
    constexpr float SCALE = SCALE_E6 * 1e-6f, C = SCALE * 1.4426950408889634f;
    float pmax = p0[0];
#pragma unroll
    for (int r = 1; r < 16; ++r) pmax = fmaxf(pmax, p0[r]);
#pragma unroll
    for (int r = 0; r < 16; ++r) pmax = fmaxf(pmax, p1[r]);
    { auto rr = __builtin_amdgcn_permlane32_swap(__float_as_uint(pmax), __float_as_uint(pmax), false, false); pmax = fmaxf(__uint_as_float(rr[0]), __uint_as_float(rr[1])); }
    if (__builtin_expect(__all(pmax - m_reg <= THR / SCALE), 1)) { mn = m_reg; alpha = 1.f; }
    else { mn = fmaxf(m_reg, pmax); alpha = __builtin_amdgcn_exp2f((m_reg - mn) * C); m_reg = mn; }
    const float mnC = -mn * C; const f32x2 C2 = {C, C}, M2 = {mnC, mnC};
#pragma unroll
    for (int r = 0; r < 16; r += 2) { f32x2 v = {p0[r], p0[r + 1]}; v = v * C2 + M2; p0[r] = v.x; p0[r + 1] = v.y; }
#pragma unroll
    for (int r = 0; r < 16; r += 2) { f32x2 v = {p1[r], p1[r + 1]}; v = v * C2 + M2; p1[r] = v.x; p1[r + 1] = v.y; }
#pragma unroll
    for (int r = 0; r < 16; ++r) p0[r] = __builtin_amdgcn_exp2f(p0[r]);
}
__device__ __forceinline__ void finishSM(f32x16& p0, f32x16& p1, float alpha, float& l_reg, bf16x8& pa0, bf16x8& pa1, bf16x8& pa2, bf16x8& pa3) {
#pragma unroll
    for (int r = 0; r < 16; ++r) p1[r] = __builtin_amdgcn_exp2f(p1[r]);
    f32x2 ps2 = {0.f, 0.f};
#pragma unroll
    for (int r = 0; r < 16; r += 2) ps2 += (f32x2){p0[r], p0[r + 1]};
#pragma unroll
    for (int r = 0; r < 16; r += 2) ps2 += (f32x2){p1[r], p1[r + 1]};
    float ps = ps2.x + ps2.y;
    { auto rr = __builtin_amdgcn_permlane32_swap(__float_as_uint(ps), __float_as_uint(ps), false, false); ps = __uint_as_float(rr[0]) + __uint_as_float(rr[1]); }
    l_reg = l_reg * alpha + ps;
#define FA_PK4(P, BASE, OUT) do { u32x4 w = {cvt_pk_bf16(P[BASE + 0], P[BASE + 1]), cvt_pk_bf16(P[BASE + 2], P[BASE + 3]), cvt_pk_bf16(P[BASE + 4], P[BASE + 5]), cvt_pk_bf16(P[BASE + 6], P[BASE + 7])}; \
    OUT = *reinterpret_cast<bf16x8*>(&w); } while (0)
    FA_PK4(p0, 0, pa0); FA_PK4(p0, 8, pa1); FA_PK4(p1, 0, pa2); FA_PK4(p1, 8, pa3);
#undef FA_PK4
}
template <int NKS> __device__ __forceinline__ void qkt(f32x16& p0, f32x16& p1, const LAS char* Ks, const bf16x8 (&qr)[NKS], int r32, int hi) {
    p0 = f32x16{}; p1 = f32x16{};
#pragma unroll
    for (int d0 = 0; d0 < NKS; ++d0) {
        const bf16x8 b0 = *(const LAS bf16x8*)(Ks + ((2 * d0 + hi) * 64 + r32) * 16);
        const bf16x8 b1 = *(const LAS bf16x8*)(Ks + ((2 * d0 + hi) * 64 + 32 + r32) * 16);
        p0 = __builtin_amdgcn_mfma_f32_32x32x16_bf16(b0, qr[d0], p0, 0, 0, 0);
        p1 = __builtin_amdgcn_mfma_f32_32x32x16_bf16(b1, qr[d0], p1, 0, 0, 0); }
}
template <int NCB> __device__ __forceinline__ int v_st(int k, int c) { const int kk = k; return ((kk >> 3) * NCB + (c >> 5)) * 512 + ((kk & 7) * 32 + (c & 31)) * 2; }
__device__ __forceinline__ int v_rd_base(int lane) { return ((lane & 3) << 3) | (((lane >> 2) & 3) << 6) | (((lane >> 4) & 1) << 5) | (((lane >> 5) & 1) << 8); }
template <int NCB> constexpr int v_rd_off(int d0, int ks, int half) { return d0 * 512 + ks * (NCB * 1024) + half * (NCB * 512); }
template <int OFF> __device__ __forceinline__ s16x4 tr_read(int vb) { s16x4 r; asm volatile("ds_read_b64_tr_b16 %0, %1 offset:%2" : "=&v"(r) : "v"(vb), "i"(OFF) : "memory"); return r; }
template <int D0, int NCB> __device__ __forceinline__ void pv_one(f32x16& od, int vb, bf16x8 pa0, bf16x8 pa1, bf16x8 pa2, bf16x8 pa3) {
    const s16x4 l0 = tr_read<v_rd_off<NCB>(D0, 0, 0)>(vb), h0 = tr_read<v_rd_off<NCB>(D0, 0, 1)>(vb), l1 = tr_read<v_rd_off<NCB>(D0, 1, 0)>(vb), h1 = tr_read<v_rd_off<NCB>(D0, 1, 1)>(vb);
    const s16x4 l2 = tr_read<v_rd_off<NCB>(D0, 2, 0)>(vb), h2 = tr_read<v_rd_off<NCB>(D0, 2, 1)>(vb), l3 = tr_read<v_rd_off<NCB>(D0, 3, 0)>(vb), h3 = tr_read<v_rd_off<NCB>(D0, 3, 1)>(vb);
    asm volatile("s_waitcnt lgkmcnt(0)" ::: "memory"); FA_SBAR();
#define FA_PK(L, H) (bf16x8){L[0], L[1], L[2], L[3], H[0], H[1], H[2], H[3]}
    od = __builtin_amdgcn_mfma_f32_32x32x16_bf16(pa0, FA_PK(l0, h0), od, 0, 0, 0);
    od = __builtin_amdgcn_mfma_f32_32x32x16_bf16(pa1, FA_PK(l1, h1), od, 0, 0, 0);
    od = __builtin_amdgcn_mfma_f32_32x32x16_bf16(pa2, FA_PK(l2, h2), od, 0, 0, 0);
    od = __builtin_amdgcn_mfma_f32_32x32x16_bf16(pa3, FA_PK(l3, h3), od, 0, 0, 0);
#undef FA_PK
}
template <int NCB> __device__ __forceinline__ void pv_all(f32x16 (&o)[NCB], int vb, bf16x8 pa0, bf16x8 pa1, bf16x8 pa2, bf16x8 pa3) {
    pv_one<0, NCB>(o[0], vb, pa0, pa1, pa2, pa3); pv_one<1, NCB>(o[1], vb, pa0, pa1, pa2, pa3);
    if constexpr (NCB == 4) { pv_one<2, NCB>(o[2], vb, pa0, pa1, pa2, pa3); pv_one<3, NCB>(o[3], vb, pa0, pa1, pa2, pa3); }
}

template <int DQK, int DV, int SCALE_E6, int SDEPTH>
__device__ __forceinline__ void attn_stream(const Frame& F, const bf16_t* __restrict__ Qb, int LDQ, const bf16_t* __restrict__ Kh, int LDK, const bf16_t* __restrict__ KRh, const bf16_t* __restrict__ Vh, int LDV,
                                            const float* ropeB, int qpos0, f32x16 (&o)[DV / 32], float (&rli)[16]) {
    constexpr int NKS = DQK / 16, NCB = DV / 32, SHM_K = 64 * DQK * 2, SHM_V = 64 * DV * 2;
    const int tid = F.tid, wid = F.wave, lane = F.lane, r32 = lane & 31, hi = lane >> 5;
    LAS char* V_lds = (LAS char*)F.lds; LAS char* K_lds = V_lds + 3 * SHM_V;
    LAS float* wsl = (LAS float*)(K_lds + 2 * SHM_K) + wid * 64; LAS float* li_l = wsl; LAS float* al_l = wsl + 32;
    float m_reg = -1e30f, l_reg = 0.f; bf16x8 qr[NKS];
#pragma unroll
    for (int d = 0; d < NCB; ++d) o[d] = f32x16{};
    const bf16_t* Qw = Qb + (size_t)(wid * 32 + r32) * LDQ + hi * 8;
#pragma unroll
    for (int d0 = 0; d0 < NKS; ++d0) qr[d0] = *(const bf16x8*)(Qw + d0 * 16);
    if constexpr (DQK == 96) {
        const int pos = qpos0 + wid * 32 + r32; float x1[8], x2[8];
        unpack8(*(const u32x4*)&qr[4], x1); unpack8(*(const u32x4*)&qr[5], x2);
        const float* cp = ropeB + pos * 16 + 8 * hi; const float* sp = ropeB + SEQ * 16 + pos * 16 + 8 * hi;
#pragma unroll
        for (int jj = 0; jj < 8; ++jj) { const float c = cp[jj], sn = sp[jj], a = x1[jj], b = x2[jj]; x1[jj] = a * c - b * sn; x2[jj] = b * c + a * sn; }
        u32x4 w1 = pack8(x1), w2 = pack8(x2); qr[4] = *(bf16x8*)&w1; qr[5] = *(bf16x8*)&w2;
    }
    const int krow = (tid & 7) + 8 * (tid >> 6), kcs = (tid >> 3) & 7;
    const int rrow = (tid & 7) + 8 * ((tid >> 5) & 7), rcs = (tid >> 3) & 3;
    const int vr0 = (DV == 128) ? (tid >> 4) : (tid >> 3), vc = (DV == 128) ? (tid & 15) * 8 : (tid & 7) * 8;
    const int vst0 = v_st<NCB>(vr0, vc), vst1 = v_st<NCB>(32 + vr0, vc);
    const int vb0 = (int)(uintptr_t)V_lds + v_rd_base(lane);
    struct Slot { bf16x8 k0, kr, v0, v1; } sl[2];
#define FA_SLOAD(i, key0) do { sl[i].k0 = *(const bf16x8*)(Kh + (size_t)((key0) + krow) * LDK + kcs * 8); \
        if constexpr (DQK == 96) sl[i].kr = *(const bf16x8*)(KRh + (size_t)((key0) + rrow) * 32 + rcs * 8); \
        sl[i].v0 = *(const bf16x8*)(Vh + (size_t)((key0) + vr0) * LDV + vc); \
        if constexpr (DV == 128) sl[i].v1 = *(const bf16x8*)(Vh + (size_t)((key0) + 32 + vr0) * LDV + vc); } while (0)
#define FA_SWRITE(kb, voff, i) do { *(LAS bf16x8*)(K_lds + (kb) * SHM_K + (kcs * 64 + krow) * 16) = sl[i].k0; \
        if constexpr (DQK == 96) { if (tid < 256) *(LAS bf16x8*)(K_lds + (kb) * SHM_K + ((8 + rcs) * 64 + rrow) * 16) = sl[i].kr; } \
        *(LAS bf16x8*)(V_lds + (voff) + vst0) = sl[i].v0; \
        if constexpr (DV == 128) *(LAS bf16x8*)(V_lds + (voff) + vst1) = sl[i].v1; } while (0)
#define FA_SWAIT() asm volatile("s_waitcnt vmcnt(3)" ::: "memory")
#define FA_RESC(a) do { if (__any((a) < 1.f)) { if (hi == 0) al_l[r32] = (a); asm volatile("s_waitcnt lgkmcnt(0)" ::: "memory"); \
        _Pragma("unroll") for (int d = 0; d < NCB; ++d) _Pragma("unroll") for (int r = 0; r < 16; ++r) o[d][r] *= al_l[crow(r, hi)]; } } while (0)
#define FA_NEXT3(x) ((x) == 2 * SHM_V ? 0 : (x) + SHM_V)
    f32x16 pA0, pA1, pB0, pB1; float mnA, mnB, alA, alB; bf16x8 pa0, pa1, pa2, pa3; constexpr int NT = SEQ / 64;
    FA_SLOAD(0, 0); FA_SLOAD(1, 64); asm volatile("s_waitcnt vmcnt(0)" ::: "memory"); FA_SWRITE(0, 0, 0); FA_SWRITE(1, SHM_V, 1); FA_SLOAD(0, 128); __syncthreads();
    qkt<NKS>(pA0, pA1, K_lds, qr, r32, hi); partialSM<SCALE_E6>(pA0, pA1, m_reg, mnA, alA);
    int vrd = 0, vwr = 2 * SHM_V;
#pragma unroll 1
    for (int j = 1; j + 1 < NT; j += 2) {
        FA_SBAR(); qkt<NKS>(pB0, pB1, K_lds + SHM_K, qr, r32, hi);
        finishSM(pA0, pA1, alA, l_reg, pa0, pa1, pa2, pa3); FA_SBAR();
        FA_SLOAD(1, ((j + 2 < NT) ? (j + 2) : (NT - 1)) * 64); FA_SBAR();
        pv_all<NCB>(o, vb0 + vrd, pa0, pa1, pa2, pa3); partialSM<SCALE_E6>(pB0, pB1, m_reg, mnB, alB);
        FA_SWAIT(); FA_SWRITE(0, vwr, 0);
        FA_RESC(alB); __syncthreads();
        vrd = FA_NEXT3(vrd); vwr = FA_NEXT3(vwr);
        FA_SBAR(); qkt<NKS>(pA0, pA1, K_lds, qr, r32, hi);
        finishSM(pB0, pB1, alB, l_reg, pa0, pa1, pa2, pa3); FA_SBAR();
        FA_SLOAD(0, ((j + 3 < NT) ? (j + 3) : (NT - 1)) * 64); FA_SBAR();
        pv_all<NCB>(o, vb0 + vrd, pa0, pa1, pa2, pa3); partialSM<SCALE_E6>(pA0, pA1, m_reg, mnA, alA);
        FA_SWAIT(); FA_SWRITE(1, vwr, 1);
        FA_RESC(alA); __syncthreads();
        vrd = FA_NEXT3(vrd); vwr = FA_NEXT3(vwr);
    }
    FA_SBAR(); qkt<NKS>(pB0, pB1, K_lds + SHM_K, qr, r32, hi);
    finishSM(pA0, pA1, alA, l_reg, pa0, pa1, pa2, pa3); FA_SBAR();
    pv_all<NCB>(o, vb0 + vrd, pa0, pa1, pa2, pa3); partialSM<SCALE_E6>(pB0, pB1, m_reg, mnB, alB);
    FA_RESC(alB); vrd = FA_NEXT3(vrd);
    finishSM(pB0, pB1, alB, l_reg, pa0, pa1, pa2, pa3); FA_SBAR();
    pv_all<NCB>(o, vb0 + vrd, pa0, pa1, pa2, pa3);
    asm volatile("s_waitcnt vmcnt(0)" ::: "memory");
    if (hi == 0) li_l[r32] = l_reg;
    asm volatile("s_waitcnt lgkmcnt(0)" ::: "memory");
#pragma unroll
    for (int r = 0; r < 16; ++r) rli[r] = __builtin_amdgcn_rcpf(li_l[crow(r, hi)]);
#undef FA_SLOAD
#undef FA_SWRITE
#undef FA_SWAIT
#undef FA_RESC
#undef FA_NEXT3
}
}

__device__ __forceinline__ void attn_diff_mfma(const Frame& F, const Args& a, int layer, int unit) {
    unsigned char* ws = a.ws; const bf16_t* H = (const bf16_t*)(ws + WS_R1); bf16_t* O = (bf16_t*)(ws + WS_R3); float* TS = (float*)(ws + WS_R1 + 256 * MiB);
    const int jl = layer >> 1; const float lambda_init = 0.8f - 0.6f * expf(-0.3f * (float)layer);
    const float lam = ((const float*)(ws + WS_LAM))[jl];
    const int qb = unit & 7, h = (unit >> 3) & 3, b = unit >> 5;
    const size_t row0 = (size_t)b * SEQ + qb * 256, key0 = (size_t)b * SEQ;
#pragma unroll 1
    for (int st = 0; st < 2; ++st) {
        fa::f32x16 o[4]; float rli[16];
        __syncthreads();
        const Frame Fs = fresh(F);
        float* stash = TS + ((size_t)unit * NTHREADS + Fs.tid) * 64;
        fa::attn_stream<64, 128, 125000, 2>(Fs, H + row0 * HLD + h * 128 + st * 64, HLD, H + key0 * HLD + 512 + h * 128 + st * 64, HLD, nullptr, H + key0 * HLD + 1024 + h * 128, HLD, nullptr, 0, o, rli);
        const Frame Fe = fresh(F); const int r32 = Fe.lane & 31, hi = Fe.lane >> 5;
        if (st == 0) {
#pragma unroll
            for (int d = 0; d < 4; ++d)
#pragma unroll
                for (int r = 0; r < 16; r += 4) *(f32x4*)(stash + d * 16 + r) = (f32x4){o[d][r] * rli[r], o[d][r + 1] * rli[r + 1], o[d][r + 2] * rli[r + 2], o[d][r + 3] * rli[r + 3]};
        } else {
            float ss[16];
#pragma unroll
            for (int r = 0; r < 16; ++r) ss[r] = 0.f;
#pragma unroll
            for (int d = 0; d < 4; ++d)
#pragma unroll
                for (int r = 0; r < 16; r += 4) { const f32x4 p0 = *(const f32x4*)(stash + d * 16 + r);
#pragma unroll
                    for (int t = 0; t < 4; ++t) { const float v = p0[t] - lam * (o[d][r + t] * rli[r + t]); o[d][r + t] = v; ss[r + t] += v * v; } }
#pragma unroll
            for (int r = 0; r < 16; ++r) { float v = ss[r]; v += __shfl_xor(v, 1); v += __shfl_xor(v, 2); v += __shfl_xor(v, 4); v += __shfl_xor(v, 8); v += __shfl_xor(v, 16);
                ss[r] = 1.0f / sqrtf(v * (1.0f / 128.0f) + RMS_EPS) * (1.0f - lambda_init); }
            const float* g = a.in[IN_SUBLN] + jl * 128;
#pragma unroll
            for (int d = 0; d < 4; ++d) { const float gd = g[d * 32 + r32];
#pragma unroll
                for (int r = 0; r < 16; ++r) { const size_t row = row0 + Fe.wave * 32 + fa::crow(r, hi);
                    O[row * DM + h * 128 + d * 32 + r32] = (bf16_t)(cvt_pk_bf16(o[d][r] * ss[r] * gd, 0.f) & 0xffffu); } }
        }
    }
}
__device__ __forceinline__ void attn_mla_mfma(const Frame& F, const Args& a, int unit) {
    unsigned char* ws = a.ws; const bf16_t* QB = (const bf16_t*)(ws + WS_R2); const bf16_t* KVB = QB + (size_t)NTOK * 768; const bf16_t* KR = KVB + (size_t)NTOK * 1024; bf16_t* O = (bf16_t*)(ws + WS_R3);
    const int qb = unit & 7, h = (unit >> 3) & 7, b = unit >> 6;
    const size_t row0 = (size_t)b * SEQ + qb * 256, key0 = (size_t)b * SEQ;
    fa::f32x16 o[2]; float rli[16];
    __syncthreads();
    const Frame Fs = fresh(F);
    fa::attn_stream<96, 64, 102062, 2>(Fs, QB + row0 * 768 + h * 96, 768, KVB + key0 * 1024 + h * 128, 1024, KR + key0 * 32, KVB + key0 * 1024 + h * 128 + 64, 1024, (const float*)(ws + WS_ROPEB), qb * 256, o, rli);
    const Frame Fe = fresh(F); const int r32 = Fe.lane & 31, hi = Fe.lane >> 5;
#pragma unroll
    for (int d = 0; d < 2; ++d)
#pragma unroll
        for (int r = 0; r < 16; ++r) { const size_t row = row0 + Fe.wave * 32 + fa::crow(r, hi);
            O[row * DM + 512 + h * 64 + d * 32 + r32] = (bf16_t)(cvt_pk_bf16(o[d][r] * rli[r], 0.f) & 0xffffu); }
}

constexpr int NA_KSTR = 580;
constexpr int NA_VOFF = 8 * NA_KSTR * 16;
constexpr int NA_BOFF = NA_VOFF + 72 * 64 * 16;
__device__ __forceinline__ void attn_na_lds(const Frame& F, const Args& a, int layer, int unit) {
    unsigned char* ws = a.ws; const bf16_t* Qc = (const bf16_t*)(ws + WS_R1); const bf16_t* Kc = Qc + (size_t)NTOK * DM; const bf16_t* Vt = Kc + (size_t)NTOK * DM; bf16_t* O = (bf16_t*)(ws + WS_R3);
    const int rp = unit & 15, h = (unit >> 4) & 15, b = unit >> 8;
    const int ra = rp * 2, r0a = min(max(ra - 4, 0), 24);
    const size_t bh = (size_t)(b * 16 + h);
    LAS char* lds = (LAS char*)F.lds; LAS float* bl = (LAS float*)(lds + NA_BOFF);
    __syncthreads();
    {
        const bf16_t* kg = Kc + (bh * SEQ + r0a * 64) * 64; const bf16_t* vg = Vt + (bh * (SEQ / 8) + r0a * 8) * 64 * 8;
        const int kk = (F.tid & 7) + 8 * (F.tid >> 6), cs = (F.tid >> 3) & 7;
        u32x4 kv[9], vv[9];
#pragma unroll
        for (int i = 0; i < 9; ++i) { kv[i] = *(const u32x4*)(kg + (size_t)(64 * i + kk) * 64 + cs * 8); vv[i] = *(const u32x4*)(vg + (size_t)(F.tid + NTHREADS * i) * 8); }
#pragma unroll
        for (int i = 0; i < 9; ++i) { *(LAS u32x4*)(lds + (cs * NA_KSTR + 64 * i + kk) * 16) = kv[i]; *(LAS u32x4*)(lds + NA_VOFF + (F.tid + NTHREADS * i) * 16) = vv[i]; }
        const float* relb = a.in[IN_RELB] + ((size_t)(layer >> 1) * 16 + h) * 465;
        if (F.tid < 465) bl[F.tid] = relb[F.tid] * 1.4426950408889634f;
    }
    __syncthreads();
    const int r = ra + (F.wave >> 2), j = F.wave & 3, qi = F.lane & 15, g = F.lane >> 4, c = 16 * j + qi;
    const int r0 = min(max(r - 4, 0), 24), d = r0 - r0a, c0 = min(max(c - 8, 0), 48), cb = (j == 0) ? 0 : (j == 1) ? 8 : (j == 2) ? 24 : 32;
    const float LOG2E = 1.4426950408889634f;
    const bf16_t* qp = Qc + (bh * SEQ + r * 64 + c) * 64 + 8 * g;
    const bf16x8 qf0 = *(const bf16x8*)qp, qf1 = *(const bf16x8*)(qp + 32);
    const int kx = 8 * (qi >> 2) + (qi & 3);
    const LAS char* kbase = lds + ((g * NA_KSTR) + d * 64 + cb + kx) * 16;
    f32x4 S[8][2];
#pragma unroll
    for (int i = 0; i < 8; ++i)
#pragma unroll
        for (int xb = 0; xb < 2; ++xb) { const LAS char* kp = kbase + (i * 64 + 4 * xb) * 16;
            const bf16x8 kf0 = *(const LAS bf16x8*)kp, kf1 = *(const LAS bf16x8*)(kp + 4 * NA_KSTR * 16);
            f32x4 z = (f32x4){0.f, 0.f, 0.f, 0.f};
            z = __builtin_amdgcn_mfma_f32_16x16x32_bf16(kf0, qf0, z, 0, 0, 0);
            z = __builtin_amdgcn_mfma_f32_16x16x32_bf16(kf1, qf1, z, 0, 0, 0);
            S[i][xb] = z; }
    float mx = -INFINITY;
#pragma unroll
    for (int i = 0; i < 8; ++i) { const LAS float* brow = bl + (r0 + i - r + 7) * 31;
#pragma unroll
        for (int xb = 0; xb < 2; ++xb)
#pragma unroll
            for (int t = 0; t < 4; ++t) { const int kc = cb + 8 * g + 4 * xb + t; const bool valid = (kc >= c0) && (kc < c0 + 16); const int co = min(max(kc - c + 15, 0), 30);
                const float v = valid ? fmaf(S[i][xb][t], 0.125f * LOG2E, brow[co]) : -INFINITY; S[i][xb][t] = v; mx = fmaxf(mx, v); } }
    mx = fmaxf(mx, __shfl_xor(mx, 16)); mx = fmaxf(mx, __shfl_xor(mx, 32));
    float sum = 0.f; bf16x8 pf[8];
#pragma unroll
    for (int i = 0; i < 8; ++i) { float pv[8];
#pragma unroll
        for (int xb = 0; xb < 2; ++xb)
#pragma unroll
            for (int t = 0; t < 4; ++t) { const float p = __builtin_amdgcn_exp2f(S[i][xb][t] - mx); pv[xb * 4 + t] = p; sum += p; }
        const u32x4 w = pack8(pv); pf[i] = *(const bf16x8*)&w; }
    sum += __shfl_xor(sum, 16); sum += __shfl_xor(sum, 32);
    const float inv = 1.0f / sum;
    f32x4 acc[4];
    const LAS char* vbase = lds + NA_VOFF + ((d * 8 + (cb >> 3) + g) * 64 + qi) * 16;
#pragma unroll
    for (int dvb = 0; dvb < 4; ++dvb) { acc[dvb] = (f32x4){0.f, 0.f, 0.f, 0.f};
#pragma unroll
        for (int i = 0; i < 8; ++i) { const bf16x8 vf = *(const LAS bf16x8*)(vbase + (i * 8 * 64 + 16 * dvb) * 16);
            acc[dvb] = __builtin_amdgcn_mfma_f32_16x16x32_bf16(vf, pf[i], acc[dvb], 0, 0, 0); } }
    bf16_t* op = O + ((size_t)b * SEQ + r * 64 + c) * DM + h * 64 + 4 * g;
#pragma unroll
    for (int dvb = 0; dvb < 4; ++dvb) { u32x2 w; w.x = cvt_pk_bf16(acc[dvb][0] * inv, acc[dvb][1] * inv); w.y = cvt_pk_bf16(acc[dvb][2] * inv, acc[dvb][3] * inv); *(u32x2*)(op + 16 * dvb) = w; }
}

template <int PER> __device__ __forceinline__ int xcd_unit(int i, int c, int G, int nunits) {
    int u;
    if ((G & 7) == 0 && ((G >> 3) % PER) == 0) { const int gpx = (G >> 3) / PER, sl = c >> 3; u = (i * (G / PER) + (c & 7) * gpx + sl / PER) * PER + sl % PER; }
    else u = i * G + c;
    return u < nunits ? u : -1;
}

constexpr int LDS_BYTES = 160 * 1024;
constexpr int MISC_OFF = LDS_BYTES - 256;
static_assert(NA_BOFF + 2048 <= MISC_OFF, "neighbourhood attention LDS image");
constexpr int NPH_LAYER = 9, NPHASES = 1 + DEPTH * NPH_LAYER;

#define IN(k) (a.lo <= (k) && (k) < a.hi)
#if PROF_TYPE >= 0
#define SEAM(k) do { if (IN(k) && IN((k) + 1)) { const Frame Fb = fresh(F); xcd_barrier(bar, Fb.tid); if (Fb.tid == 0) ((LAS unsigned long long*)(F.lds + 152 * 1024))[(k) + 1] = __builtin_amdgcn_s_memrealtime(); } } while (0)
#else
#define SEAM(k) do { if (IN(k) && IN((k) + 1)) { const Frame Fb = fresh(F); xcd_barrier(bar, Fb.tid); } } while (0)
#endif
template <int LAYER> __device__ __forceinline__ void layer_phases(const Frame& F, const Args& a, const XcdBarrier& bar) {
    constexpr int layer = LAYER;
#if PROF_TYPE >= 0
    if constexpr (LAYER == 0) { const Frame Fb = fresh(F); if (Fb.tid == 0) ((LAS unsigned long long*)(F.lds + 152 * 1024))[1] = __builtin_amdgcn_s_memrealtime(); }
#endif
        constexpr int p0 = 1 + layer * NPH_LAYER, j = layer >> 1; constexpr bool even = (layer & 1) == 0;
        if (IN(p0)) {
            const Frame Fp = fresh(F); const Args ap = fresh(a); unsigned char* w = ap.ws;
            REPEAT(1) phase_moe_weights(Fp, ap, layer);
            if constexpr (even) { g8::DenseSched S; S.init(w + WS_X, DM, (const bf16_t*)(w + WS_WIN) + (size_t)j * HLD * DM, DM, NTOK, HLD, Fp.G, Fp.bid); S.rep = 1 + ((REP_MASK >> 2) & 1);
                g8::EpiEvenIn E{(bf16_t*)(w + WS_R1), (bf16_t*)(w + WS_R2) + (size_t)NTOK * 1792, (float*)(w + WS_SSQ), (const float*)(w + WS_ROPEA), (const float*)(w + WS_ROPEB)}; g8::gemm_phase(Fp, DM, S, E); }
            else { g8::DenseSched S; S.init(w + WS_X, DM, (const bf16_t*)(w + WS_WQKV) + (size_t)j * 3072 * DM, DM, NTOK, 3072, Fp.G, Fp.bid); S.rep = 1 + ((REP_MASK >> 11) & 1);
#if NAIVE_NA
                g8::EpiPlain E{(bf16_t*)(w + WS_R1), 3072}; g8::gemm_phase(Fp, DM, S, E); }
#else
                g8::EpiQKV E{(bf16_t*)(w + WS_R1), (bf16_t*)(w + WS_R1) + (size_t)NTOK * DM, (bf16_t*)(w + WS_R1) + (size_t)2 * NTOK * DM}; g8::gemm_phase(Fp, DM, S, E); }
#endif
        }
        SEAM(p0);
        if constexpr (even) if (IN(p0 + 1)) REPEAT(3) {
            const Frame Fp = fresh(F); const Args ap = fresh(a); unsigned char* w = ap.ws;
            { g8::DenseSched S; S.init((bf16_t*)(w + WS_R1) + 1536, HLD, (const bf16_t*)(w + WS_WUQ) + (size_t)j * 768 * 256, 256, NTOK, 768, Fp.G, Fp.bid);
              g8::EpiMla<0> E{(bf16_t*)(w + WS_R2), (const float*)(w + WS_SSQ)}; g8::gemm_phase(Fp, 256, S, E); }
            const Frame Fq = fresh(F);
            { g8::DenseSched S; S.init((bf16_t*)(w + WS_R1) + 1792, HLD, (const bf16_t*)(w + WS_WUKV) + (size_t)j * 1024 * 256, 256, NTOK, 1024, Fq.G, Fq.bid);
              g8::EpiMla<1> E{(bf16_t*)(w + WS_R2) + (size_t)NTOK * 768, (const float*)(w + WS_SSQ)}; g8::gemm_phase(Fq, 256, S, E); }
        }
        SEAM(p0 + 1);
        if (IN(p0 + 2)) {
            const Frame Fp = fresh(F); const Args ap = fresh(a);
#if NAIVE_ATTN
            if (even) { for (int u = Fp.bid; u < NBATCH * 4 * 8; u += Fp.G) attn_diff_naive(Fp, ap, layer, u);
                        for (int u = Fp.bid; u < NBATCH * 8 * 4; u += Fp.G) attn_mla_naive(Fp, ap, u); }
#else
            if constexpr (even) REPEAT(4) { for (int i = 0, u; (u = xcd_unit<8>(i, Fp.bid, Fp.G, NBATCH * 4 * 8)) >= 0; ++i) attn_diff_mfma(Fp, ap, layer, u);
                        for (int i = 0, u; (u = xcd_unit<8>(i, Fp.bid, Fp.G, NBATCH * 8 * 8)) >= 0; ++i) attn_mla_mfma(Fp, ap, u); }
#endif
#if NAIVE_NA
            if (!even) { for (int u = Fp.bid; u < NBATCH * 32 * 2; u += Fp.G) attn_na_naive(Fp, ap, layer, u); }
#else
            if constexpr (!even) REPEAT(5) { for (int i = 0, u; (u = xcd_unit<16>(i, Fp.bid, Fp.G, NBATCH * 16 * 16)) >= 0; ++i) attn_na_lds(Fp, ap, layer, u); }
#endif
            __syncthreads();
        }
        SEAM(p0 + 2);
        if (IN(p0 + 3)) REPEAT(6) {
            const Frame Fp = fresh(F); const Args ap = fresh(a); unsigned char* w = ap.ws;
            g8::DenseSched S; S.init(w + WS_R3, DM, (const bf16_t*)(w + (even ? WS_WOE : WS_WOO)) + (size_t)j * DM * DM, DM, NTOK, DM, Fp.G, Fp.bid);
            g8::EpiResStats E{(const bf16_t*)(w + WS_X), (bf16_t*)(w + WS_R1), (f32x2*)(w + WS_R2)}; g8::gemm_phase(Fp, DM, S, E);
        }
        SEAM(p0 + 3);
        if (IN(p0 + 4)) REPEAT(12) { const Frame Fp = fresh(F); const Args ap = fresh(a); phase_ln1_router(Fp, ap, layer); }
        SEAM(p0 + 4);
        if (IN(p0 + 5)) { const Frame Fp = fresh(F); const Args ap = fresh(a); phase_scatter(Fp, ap); }
        SEAM(p0 + 5);
        if (IN(p0 + 6)) REPEAT(8) {
            const Frame Fp = fresh(F); const Args ap = fresh(a); unsigned char* w = ap.ws;
            g8::MoeSched<true> S; S.A = (const char*)(w + WS_X); S.Wt = (const char*)(w + WS_W13); S.tile = (const int*)(w + WS_TILE); S.slot_tok = (const int*)(w + WS_SLOT_TOK);
            S.lda2 = DM * 2; S.K2 = DM * 2; S.wstride = (size_t)1024 * 1024 * 2; S.T = S.tile[0]; S.G = Fp.G; S.c = Fp.bid;
            g8::EpiMoe1 E{(bf16_t*)(w + WS_R1)}; g8::gemm_phase(Fp, DM, S, E);
        }
        SEAM(p0 + 6);
        if (IN(p0 + 7)) REPEAT(9) {
            const Frame Fp = fresh(F); const Args ap = fresh(a); unsigned char* w = ap.ws;
            g8::MoeSched<false> S; S.A = (const char*)(w + WS_R1); S.Wt = (const char*)(w + WS_W2); S.tile = (const int*)(w + WS_TILE); S.slot_tok = (const int*)(w + WS_SLOT_TOK);
            S.lda2 = DEXP * 2; S.K2 = DEXP * 2; S.wstride = (size_t)1024 * 512 * 2; S.T = S.tile[0]; S.G = Fp.G; S.c = Fp.bid;
            g8::EpiPlain E{(bf16_t*)(w + WS_R2), DM}; g8::gemm_phase(Fp, DEXP, S, E);
        }
        SEAM(p0 + 7);
#if PROF_TYPE >= 0
        if constexpr (layer == DEPTH - 1) { const Frame Fp = fresh(F);
            if (Fp.tid == 0) { LAS unsigned long long* ts = (LAS unsigned long long*)(F.lds + 152 * 1024); unsigned long long dt = 0;
                if (PROF_TYPE == 99) dt = ts[1 + 3 * NPH_LAYER + 8] - ts[1];
                else for (int l = 0; l < DEPTH; ++l) { const int k = 1 + l * NPH_LAYER + PROF_TYPE; if (k + 1 <= 1 + 3 * NPH_LAYER + 8) dt += ts[k + 1] - ts[k]; }
                ((float*)(a.ws + WS_LAM))[8 + Fp.bid] = sqrtf((float)dt * 1e-5f * PROF_SCALE); }
            __syncthreads(); }
#endif
        if (IN(p0 + 8)) { const Frame Fp = fresh(F); const Args ap = fresh(a);
            if constexpr (((REP_MASK >> 13) & 1) != 0) { phase_ln2(Fp, ap, layer, false, true); __syncthreads(); }
            phase_ln2(Fp, ap, layer, layer == DEPTH - 1); }
        SEAM(p0 + 8);
    }
#undef IN
#undef SEAM

__global__ void __launch_bounds__(NTHREADS, 2) fwd_kernel(Args a) {
    extern __shared__ __attribute__((aligned(16))) unsigned char lds_raw[];
    Frame F; F.lds = (LAS unsigned char*)lds_raw; F.wave = __builtin_amdgcn_readfirstlane((int)threadIdx.x >> 6); F.tid = 0; F.lane = 0; F.G = gridDim.x; F.bid = blockIdx.x;
    unsigned char* ws = a.ws;
    volatile LAS unsigned* MISC = (volatile LAS unsigned*)(F.lds + MISC_OFF);
    { const Frame Fp = fresh(F); if (Fp.tid < 4) MISC[Fp.tid] = 0u; }
    __syncthreads();
    const bool one = (a.hi - a.lo) > 1;
    XcdBarrier bar; bar.bar = (unsigned*)(ws + WS_CTL); bar.x = 0; bar.st = MISC;
    if (one) { const Frame Fp = fresh(F); bar = xcd_barrier_post((unsigned*)(ws + WS_CTL), MISC, Fp.tid); }
#define IN(k) (a.lo <= (k) && (k) < a.hi)
#define SEAM(k) do { if (IN(k) && IN((k) + 1)) { const Frame Fb = fresh(F); xcd_barrier(bar, Fb.tid); } } while (0)

    if (IN(0)) REPEAT(0) { const Frame Fp = fresh(F); const Args ap = fresh(a); phase_prologue(Fp, ap); }
    SEAM(0);
    if constexpr (((REP_MASK >> 14) & 1) != 0) { if (one) for (int xb_ = 0; xb_ < 100; ++xb_) { const Frame Fb = fresh(F); xcd_barrier(bar, Fb.tid); } }
    layer_phases<0>(F, a, bar); layer_phases<1>(F, a, bar); layer_phases<2>(F, a, bar); layer_phases<3>(F, a, bar);
#undef IN
#undef SEAM
}

extern "C" void kernel_launch(void* const* d_in, const int* in_sizes, int n_in, void* d_out, int out_size, void* d_ws, size_t ws_size, hipStream_t stream) {
    static int grid = 0;
    if (grid == 0) {
        if (n_in != 26 || in_sizes[0] != NTOK * DM || out_size != NTOK * DM || ws_size < WS_END) {
            fprintf(stderr, "kernel_launch: unexpected shapes / workspace (n_in %d, in0 %d, out %d, ws %zu, need %zu)\n", n_in, n_in > 0 ? in_sizes[0] : -1, out_size, ws_size, (size_t)WS_END); grid = -1; return; }
        int dev = 0, cus = 0, per_cu = 0;
        if (hipGetDevice(&dev) != hipSuccess || hipDeviceGetAttribute(&cus, hipDeviceAttributeMultiprocessorCount, dev) != hipSuccess) { grid = -1; return; }
        if (hipFuncSetAttribute((const void*)fwd_kernel, hipFuncAttributeMaxDynamicSharedMemorySize, LDS_BYTES) != hipSuccess) { fprintf(stderr, "kernel_launch: hipFuncSetAttribute failed\n"); grid = -1; return; }
        if (hipOccupancyMaxActiveBlocksPerMultiprocessor(&per_cu, (const void*)fwd_kernel, NTHREADS, LDS_BYTES) != hipSuccess || per_cu < 1) fprintf(stderr, "kernel_launch: occupancy query reports %d\n", per_cu);
        (void)hipGetLastError();
        grid = cus;
    }
    if (grid < 0) return;
    (void)hipMemsetAsync((char*)d_ws + WS_CTL, 0, 64 * 1024, stream);
    Args a{};
    for (int i = 0; i < 26; ++i) a.in[i] = (const float*)d_in[i];
    a.out = (float*)d_out; a.ws = (unsigned char*)d_ws;
#if MK_ONE_LAUNCH
    a.lo = 0; a.hi = NPHASES;
    hipLaunchKernelGGL(fwd_kernel, dim3(grid), dim3(NTHREADS), LDS_BYTES, stream, a);
#else
    for (int p = 0; p < NPHASES; ++p) {
        if (p >= 1 && ((p - 1) % NPH_LAYER) == 1 && (((p - 1) / NPH_LAYER) & 1)) continue;
        a.lo = p; a.hi = p + 1;
        hipLaunchKernelGGL(fwd_kernel, dim3(grid), dim3(NTHREADS), LDS_BYTES, stream, a);
    }
#endif
}
```
